# Optimizing an MI355X kernel written in HIP

```python
import jax, jax.numpy as jnp
from jax import lax
import numpy as np

D_MODEL = 2048
BATCH = 4
SEQ = 4096
DEPTH = 1

HEAD_DIM = 128
N_HEADS_MIX = D_MODEL // HEAD_DIM
N_HEADS_ATTN = 3 * N_HEADS_MIX // 4
N_HEADS_SGU = N_HEADS_MIX - N_HEADS_ATTN
D_ATTN = N_HEADS_ATTN * HEAD_DIM
D_SGU = N_HEADS_SGU * HEAD_DIM
D_IN = 3 * D_ATTN + 2 * D_SGU
DILATION_PATTERNS = ((128, 1), (512, 4), (2048, 16))
ROPE_THETA = 10000.0
SGU_CHUNK = 128
PEER_HEADS = 8
PEER_NKEYS = 128
PEER_EXPERTS = PEER_NKEYS * PEER_NKEYS
PEER_DKEY = 256
PEER_TOPK = 16
PEER_TOKEN_BLOCK = 128
N_MOD = 6
RMS_EPS = 1e-6
LN_EPS = 1e-5

kernel_name = "hybrid_dilated_attn_sgu_peer_block"


def rms_norm(t, g):
    t32 = t.astype(jnp.float32)
    t32 = t32 * lax.rsqrt(jnp.mean(t32 * t32, axis=-1, keepdims=True) + RMS_EPS)
    return t32.astype(t.dtype) * g


def rope(t, positions):
    half = t.shape[-1] // 2
    inv = ROPE_THETA ** (-jnp.arange(half, dtype=jnp.float32) / half)
    ang = positions.astype(jnp.float32)[..., None] * inv
    cos = jnp.cos(ang)[:, :, None, :]
    sin = jnp.sin(ang)[:, :, None, :]
    t32 = t.astype(jnp.float32)
    t1, t2 = t32[..., :half], t32[..., half:]
    return jnp.concatenate([t1 * cos - t2 * sin, t2 * cos + t1 * sin], axis=-1).astype(t.dtype)


def dilated_window_attention(q, k, v, window, dilation):
    B, S, H, E = q.shape
    steps = window // dilation
    L = S // dilation
    nb = -(-L // steps)
    Lp = nb * steps

    def to_classes(t):
        t = t.reshape(B, L, dilation, H, E).transpose(0, 2, 1, 3, 4)
        return jnp.pad(t, ((0, 0), (0, 0), (0, Lp - L), (0, 0), (0, 0)))

    def with_prev(t):
        tb = t.reshape(B, dilation, nb, steps, H, E)
        prev = jnp.pad(tb, ((0, 0), (0, 0), (1, 0), (0, 0), (0, 0), (0, 0)))[:, :, :-1]
        return jnp.concatenate([prev, tb], axis=3)

    qb = to_classes(q).reshape(B, dilation, nb, steps, H, E)
    kb = with_prev(to_classes(k))
    vb = with_prev(to_classes(v))
    s = jnp.einsum('bdnqhe,bdnkhe->bdnhqk', qb, kb).astype(jnp.float32)
    qi = jnp.arange(steps)[:, None]
    km = jnp.arange(2 * steps)[None, :]
    band = (km >= qi) & (km <= qi + steps)
    valid = band[None] & ((jnp.arange(nb)[:, None, None] > 0) | (km[None] >= steps))
    s = jnp.where(valid[None, None, :, None], s, -jnp.inf)
    lse = jax.nn.logsumexp(s, axis=-1)
    p = jnp.exp(s - lse[..., None])
    o = jnp.einsum('bdnhqk,bdnkhe->bdnqhe', p.astype(v.dtype), vb)
    o = o.reshape(B, dilation, Lp, H, E)[:, :, :L].transpose(0, 2, 1, 3, 4).reshape(B, S, H, E)
    lse = lse.transpose(0, 1, 2, 4, 3).reshape(B, dilation, Lp, H)[:, :, :L]
    lse = lse.transpose(0, 2, 1, 3).reshape(B, S, H)
    return o, lse


def causal_chunk_sgu(u, v, w_s, b_s, ln_g, ln_b):
    B, S, Hs, E = u.shape
    n = S // SGU_CHUNK
    v32 = v.astype(jnp.float32)
    mu = jnp.mean(v32, axis=-1, keepdims=True)
    var = jnp.mean(jnp.square(v32 - mu), axis=-1, keepdims=True)
    vn = ((v32 - mu) * lax.rsqrt(var + LN_EPS)).astype(v.dtype) * ln_g + ln_b
    vc = vn.reshape(B, n, SGU_CHUNK, Hs, E)
    causal = jnp.tril(jnp.ones((SGU_CHUNK, SGU_CHUNK), dtype=bool))
    ws = jnp.where(causal[None], w_s, jnp.zeros((), w_s.dtype))
    mixed = jnp.einsum('hij,bnjhe->bnihe', ws, vc) + b_s.T[None, None, :, :, None]
    return u * mixed.reshape(B, S, Hs, E)


def peer_ffn(h, w_q, sub_keys, u_emb, v_emb):
    B, S, D = h.shape
    T = B * S
    K = PEER_TOPK
    x = h.reshape(T, D)
    q = (x @ w_q).reshape(T, PEER_HEADS, 2, PEER_DKEY // 2)
    s = jnp.einsum('thpc,hpkc->thpk', q, sub_keys).astype(jnp.float32)
    s_top, i_top = lax.top_k(s, K)
    cand_s = s_top[:, :, 0, :, None] + s_top[:, :, 1, None, :]
    cand_i = i_top[:, :, 0, :, None] * PEER_NKEYS + i_top[:, :, 1, None, :]
    best_s, pos = lax.top_k(cand_s.reshape(T, PEER_HEADS, K * K), K)
    idx = jnp.take_along_axis(cand_i.reshape(T, PEER_HEADS, K * K), pos, axis=-1)
    g = jax.nn.softmax(best_s, axis=-1).astype(h.dtype)
    nblk = T // PEER_TOKEN_BLOCK
    HK = PEER_HEADS * K

    def expert_block(args):
        xb, ib, gb = args
        ue = jnp.take(u_emb, ib, axis=0)
        a = jax.nn.gelu(jnp.einsum('td,tnd->tn', xb, ue), approximate=False)
        ve = jnp.take(v_emb, ib, axis=0)
        return jnp.einsum('tn,tnd->td', gb * a, ve)

    out = lax.map(expert_block, (x.reshape(nblk, PEER_TOKEN_BLOCK, D),
                                 idx.reshape(nblk, PEER_TOKEN_BLOCK, HK),
                                 g.reshape(nblk, PEER_TOKEN_BLOCK, HK)))
    return out.reshape(B, S, D)


def setup_inputs(seed: int = 0) -> dict:
    key = jax.random.key(seed)
    ks = jax.random.split(key, 24)
    f32 = jnp.float32
    D = D_MODEL
    nrm = lambda k, shape, scale: jax.random.normal(k, shape, f32) * scale
    x = jax.random.normal(ks[0], (BATCH, SEQ, D), f32)
    c = jax.random.normal(ks[1], (BATCH, D), f32)
    offset = jax.random.randint(ks[2], (BATCH, 1), 0, 1024, dtype=jnp.int32)
    positions = offset + jnp.arange(SEQ, dtype=jnp.int32)[None, :]
    return {
        "x": x,
        "c": c,
        "positions": positions,
        "w_ada": nrm(ks[3], (DEPTH, D, N_MOD * D), 0.5 * D ** -0.5),
        "b_ada": nrm(ks[4], (DEPTH, N_MOD * D), 0.02),
        "g_norm1": 1.0 + nrm(ks[5], (DEPTH, D), 0.05),
        "w_in": nrm(ks[6], (DEPTH, D, D_IN), D ** -0.5),
        "g_attn_out": 1.0 + nrm(ks[7], (DEPTH, D_ATTN), 0.05),
        "g_sgu_out": 1.0 + nrm(ks[8], (DEPTH, D_SGU), 0.05),
        "sgu_w": nrm(ks[9], (DEPTH, N_HEADS_SGU, SGU_CHUNK, SGU_CHUNK), SGU_CHUNK ** -0.5),
        "sgu_b": 1.0 + nrm(ks[10], (DEPTH, N_HEADS_SGU, SGU_CHUNK), 0.1),
        "sgu_ln_g": 1.0 + nrm(ks[11], (DEPTH, N_HEADS_SGU, HEAD_DIM), 0.05),
        "sgu_ln_b": nrm(ks[12], (DEPTH, N_HEADS_SGU, HEAD_DIM), 0.02),
        "w_out": nrm(ks[13], (DEPTH, D, D), D ** -0.5),
        "g_norm2": 1.0 + nrm(ks[14], (DEPTH, D), 0.05),
        "peer_w_q": nrm(ks[15], (DEPTH, D, PEER_HEADS * PEER_DKEY), D ** -0.5),
        "peer_sub_keys": nrm(ks[16], (DEPTH, PEER_HEADS, 2, PEER_NKEYS, PEER_DKEY // 2), (PEER_DKEY // 2) ** -0.5),
        "peer_u": nrm(ks[17], (DEPTH, PEER_EXPERTS, D), D ** -0.5),
        "peer_v": nrm(ks[18], (DEPTH, PEER_EXPERTS, D), 0.5),
        "g_final": 1.0 + nrm(ks[19], (D,), 0.05),
    }


def reference(x, c, positions, w_ada, b_ada, g_norm1, w_in, g_attn_out, g_sgu_out,
              sgu_w, sgu_b, sgu_ln_g, sgu_ln_b, w_out, g_norm2, peer_w_q, peer_sub_keys,
              peer_u, peer_v, g_final):
    B, S, D = x.shape
    E = HEAD_DIM
    h = x
    cond = jax.nn.silu(c)
    splits = np.cumsum([D_ATTN, D_ATTN, D_ATTN, D_SGU]).tolist()
    for l in range(DEPTH):
        mod = (cond @ w_ada[l] + b_ada[l]).reshape(B, N_MOD, D)
        sh1, sc1, gt1, sh2, sc2, gt2 = [mod[:, i, None, :] for i in range(N_MOD)]

        hn = rms_norm(h, g_norm1[l]) * (1.0 + sc1) + sh1
        proj = hn @ w_in[l]
        qa, ka, va, us, vs = jnp.split(proj, splits, axis=-1)
        qa = rope(qa.reshape(B, S, N_HEADS_ATTN, E), positions) * (E ** -0.5)
        ka = rope(ka.reshape(B, S, N_HEADS_ATTN, E), positions)
        va = va.reshape(B, S, N_HEADS_ATTN, E)
        outs, lses = [], []
        for window, dilation in DILATION_PATTERNS:
            o_i, lse_i = dilated_window_attention(qa, ka, va, window, dilation)
            outs.append(o_i)
            lses.append(lse_i)
        wts = jax.nn.softmax(jnp.stack(lses, axis=0), axis=0)
        attn = sum(wts[i][..., None] * outs[i].astype(jnp.float32) for i in range(len(outs)))
        attn = attn.astype(x.dtype).reshape(B, S, D_ATTN)

        us = jax.nn.gelu(us, approximate=False).reshape(B, S, N_HEADS_SGU, E)
        vs = jax.nn.gelu(vs, approximate=False).reshape(B, S, N_HEADS_SGU, E)
        sgu = causal_chunk_sgu(us, vs, sgu_w[l], sgu_b[l], sgu_ln_g[l], sgu_ln_b[l]).reshape(B, S, D_SGU)

        mixed = jnp.concatenate([rms_norm(attn, g_attn_out[l]), rms_norm(sgu, g_sgu_out[l])], axis=-1)
        h = h + gt1 * (mixed @ w_out[l])

        hn2 = rms_norm(h, g_norm2[l]) * (1.0 + sc2) + sh2
        h = h + gt2 * peer_ffn(hn2, peer_w_q[l], peer_sub_keys[l], peer_u[l], peer_v[l])
    return rms_norm(h, g_final)
```

```cpp
#include <hip/hip_runtime.h>
#include <hip/hip_cooperative_groups.h>
#include <cstdio>
#include <cstdint>
namespace cg = cooperative_groups;

constexpr int D = 2048, NB = 4, S = 4096, T = NB * S;
constexpr int E = 128, HA = 12, HS = 4, DA = 1536, DS = 512, DIN = 5632;
constexpr int PH = 8, PK = 16, NEXP = 16384;
constexpr int NTHR = 512, NWV = 8;

typedef unsigned short bf16_t;
typedef unsigned u32x4 __attribute__((ext_vector_type(4)));
typedef unsigned u32x2 __attribute__((ext_vector_type(2)));
typedef float f32x4 __attribute__((ext_vector_type(4)));

__device__ __forceinline__ bf16_t f2bf(float f) { unsigned u = __float_as_uint(f); u += 0x7FFFu + ((u >> 16) & 1u); return (bf16_t)(u >> 16); }
__device__ __forceinline__ float bf2f(bf16_t b) { return __uint_as_float(((unsigned)b) << 16); }
__device__ __forceinline__ unsigned pack2(float lo, float hi) { return (unsigned)f2bf(lo) | ((unsigned)f2bf(hi) << 16); }
__device__ __forceinline__ float bflo(unsigned w) { return __uint_as_float(w << 16); }
__device__ __forceinline__ float bfhi(unsigned w) { return __uint_as_float(w & 0xffff0000u); }
__device__ __forceinline__ float wave_sum(float v) {
#pragma unroll
    for (int o = 32; o >= 1; o >>= 1) v += __shfl_xor(v, o);
    return v; }
__device__ __forceinline__ float wave_max(float v) {
#pragma unroll
    for (int o = 32; o >= 1; o >>= 1) v = fmaxf(v, __shfl_xor(v, o));
    return v; }
__device__ __forceinline__ int wave_min_i(int v) {
#pragma unroll
    for (int o = 32; o >= 1; o >>= 1) v = min(v, __shfl_xor(v, o));
    return v; }
__device__ __forceinline__ float gelu_erf(float v) { return 0.5f * v * (1.0f + erff(v * 0.70710678118654752f)); }

constexpr size_t OFF_CTL  = 0;
constexpr size_t OFF_MOD  = 65536;
constexpr size_t OFF_SGUW = OFF_MOD + 393216;
constexpr size_t OFF_SUBK = OFF_SGUW + 131072;
constexpr size_t OFF_LSE  = OFF_SUBK + 524288;
constexpr size_t OFF_IDX  = OFF_LSE + (size_t)3 * T * 12 * 4;
constexpr size_t OFF_GATE = OFF_IDX + (size_t)T * 128 * 4;
constexpr size_t OFF_WIN  = OFF_GATE + (size_t)T * 128 * 4;
constexpr size_t OFF_WOUT = OFF_WIN + (size_t)DIN * D * 2;
constexpr size_t OFF_WQ   = OFF_WOUT + (size_t)D * D * 2;
constexpr size_t OFF_UTAB = OFF_WQ + (size_t)D * D * 2;
constexpr size_t OFF_VTAB = OFF_UTAB + (size_t)NEXP * D * 2;
constexpr size_t OFF_A    = OFF_VTAB + (size_t)NEXP * D * 2;
constexpr size_t OFF_QKV  = OFF_A + (size_t)T * D * 2;
constexpr size_t QKV_ONE  = (size_t)T * DA * 2;
constexpr size_t OFF_US   = OFF_QKV + 3 * QKV_ONE;
constexpr size_t OFF_VS   = OFF_US + (size_t)T * DS * 2;
constexpr size_t OFF_SGUO = OFF_VS + (size_t)T * DS * 2;
constexpr size_t OFF_O12  = OFF_SGUO + (size_t)T * DS * 2;
constexpr size_t WS_END   = OFF_O12 + 2 * QKV_ONE;

struct Params {
    const float* x; const float* c; const int* pos; const float* w_ada; const float* b_ada; const float* g_norm1; const float* w_in;
    const float* g_attn_out; const float* g_sgu_out; const float* sgu_w; const float* sgu_b; const float* sgu_ln_g; const float* sgu_ln_b;
    const float* w_out; const float* g_norm2; const float* peer_w_q; const float* peer_sub_keys; const float* peer_u; const float* peer_v;
    const float* g_final; float* out; unsigned char* ws;
};
__device__ __forceinline__ float mod1(const Params& p, int b, int i, int col) { const long long v = ((const long long*)(p.ws + OFF_MOD))[b * 12288 + i * D + col]; return (float)((double)v * 2.3283064365386963e-10); }
__device__ __forceinline__ float4 mod4(const Params& p, int b, int i, int col) { return make_float4(mod1(p, b, i, col), mod1(p, b, i, col + 1), mod1(p, b, i, col + 2), mod1(p, b, i, col + 3)); }
__device__ __forceinline__ bf16_t* P_opat(const Params& p, int pat) { return (bf16_t*)(pat == 0 ? p.ws + OFF_A : p.ws + OFF_O12 + (size_t)(pat - 1) * QKV_ONE); }

__device__ __forceinline__ void conv_transpose(const float* __restrict__ W, int N, bf16_t* __restrict__ WT, int perm_limit, float* tile, int bid, int nblk, int tid) {
    const int ntiles = 32 * (N / 64);
    for (int tI = bid; tI < ntiles; tI += nblk) {
        const int tk = tI & 31, tn = tI >> 5, k0 = tk * 64, n0 = tn * 64;
        int l0 = n0;
        if (n0 < perm_limit) { const int base = n0 & ~255, pb = (n0 >> 6) & 3, bj = pb >> 1, qhi = pb & 1; l0 = base + 64 * bj + 128 * qhi; }
        __syncthreads();
#pragma unroll
        for (int pass = 0; pass < 2; ++pass) { const int r = pass * 32 + (tid >> 4), c4 = (tid & 15) * 4;
            const float4 v = *(const float4*)(W + (size_t)(k0 + r) * N + l0 + c4);
            tile[r * 65 + c4 + 0] = v.x; tile[r * 65 + c4 + 1] = v.y; tile[r * 65 + c4 + 2] = v.z; tile[r * 65 + c4 + 3] = v.w; }
        __syncthreads();
        const int n = tid >> 3, kq = (tid & 7) * 8;
        u32x4 w;
        w.x = pack2(tile[(kq + 0) * 65 + n], tile[(kq + 1) * 65 + n]); w.y = pack2(tile[(kq + 2) * 65 + n], tile[(kq + 3) * 65 + n]);
        w.z = pack2(tile[(kq + 4) * 65 + n], tile[(kq + 5) * 65 + n]); w.w = pack2(tile[(kq + 6) * 65 + n], tile[(kq + 7) * 65 + n]);
        *(u32x4*)(WT + (size_t)(n0 + n) * D + k0 + kq) = w;
    }
}
__device__ __forceinline__ void conv_flat(const float* __restrict__ src, bf16_t* __restrict__ dst, size_t n8, int bid, int nblk, int tid) {
    for (size_t i = (size_t)bid * NTHR + tid; i < n8; i += (size_t)nblk * NTHR) {
        const float4 a = ((const float4*)src)[2 * i], b = ((const float4*)src)[2 * i + 1];
        u32x4 w; w.x = pack2(a.x, a.y); w.y = pack2(a.z, a.w); w.z = pack2(b.x, b.y); w.w = pack2(b.z, b.w);
        ((u32x4*)dst)[i] = w; }
}
__device__ void phase_conv(const Params& p, unsigned char* lds) {
    const int tid = threadIdx.x, bid = blockIdx.x, nblk = gridDim.x;
    unsigned long long* mod = (unsigned long long*)(p.ws + OFF_MOD);
    for (int it = bid; it < 768; it += nblk) {
        const int cb = it % 6, kc = it / 6, col = cb * 2048 + tid * 4;
        float acc[4][4];
#pragma unroll
        for (int b = 0; b < 4; ++b) { acc[b][0] = 0.f; acc[b][1] = 0.f; acc[b][2] = 0.f; acc[b][3] = 0.f; }
        for (int kk = 0; kk < 16; ++kk) { const int k = kc * 16 + kk;
            const float4 w = *(const float4*)(p.w_ada + (size_t)k * 12288 + col);
#pragma unroll
            for (int b = 0; b < 4; ++b) { const float cv = p.c[b * D + k]; const float s = cv / (1.f + __expf(-cv));
                acc[b][0] += s * w.x; acc[b][1] += s * w.y; acc[b][2] += s * w.z; acc[b][3] += s * w.w; } }
        if (kc == 0) { const float4 bv = *(const float4*)(p.b_ada + col);
#pragma unroll
            for (int b = 0; b < 4; ++b) { acc[b][0] += bv.x; acc[b][1] += bv.y; acc[b][2] += bv.z; acc[b][3] += bv.w; } }
#pragma unroll
        for (int b = 0; b < 4; ++b)
#pragma unroll
            for (int j = 0; j < 4; ++j) atomicAdd(mod + b * 12288 + col + j, (unsigned long long)__double2ll_rn((double)acc[b][j] * 4294967296.0));
    }
    conv_transpose(p.w_in, DIN, (bf16_t*)(p.ws + OFF_WIN), 3072, (float*)lds, bid, nblk, tid);
    conv_transpose(p.w_out, D, (bf16_t*)(p.ws + OFF_WOUT), 0, (float*)lds, bid, nblk, tid);
    conv_transpose(p.peer_w_q, D, (bf16_t*)(p.ws + OFF_WQ), 0, (float*)lds, bid, nblk, tid);
    conv_flat(p.peer_u, (bf16_t*)(p.ws + OFF_UTAB), (size_t)NEXP * D / 8, bid, nblk, tid);
    conv_flat(p.peer_v, (bf16_t*)(p.ws + OFF_VTAB), (size_t)NEXP * D / 8, bid, nblk, tid);
    conv_flat(p.peer_sub_keys, (bf16_t*)(p.ws + OFF_SUBK), (size_t)8 * 2 * 128 * 128 / 8, bid, nblk, tid);
    { bf16_t* sw = (bf16_t*)(p.ws + OFF_SGUW);
      for (int i = bid * NTHR + tid; i < 4 * 128 * 128; i += nblk * NTHR) { const int jj = i & 127, ii = (i >> 7) & 127; sw[i] = f2bf(jj <= ii ? p.sgu_w[i] : 0.f); } }
}

__device__ void phase_norm_mod(const Params& p, const float* __restrict__ src, const float* __restrict__ g, int sh_i, int sc_i, bf16_t* __restrict__ dst) {
    const int lane = threadIdx.x & 63, gw = blockIdx.x * NWV + (threadIdx.x >> 6), nw = gridDim.x * NWV;
    for (int t = gw; t < T; t += nw) {
        const float* row = src + (size_t)t * D; const int b = t / S;
        float4 v[8]; float ss = 0.f;
#pragma unroll
        for (int i = 0; i < 8; ++i) { v[i] = *(const float4*)(row + i * 256 + lane * 4); ss += v[i].x * v[i].x + v[i].y * v[i].y + v[i].z * v[i].z + v[i].w * v[i].w; }
        ss = wave_sum(ss); const float rstd = rsqrtf(ss * (1.0f / D) + 1e-6f);
#pragma unroll
        for (int i = 0; i < 8; ++i) { const int col = i * 256 + lane * 4;
            const float4 gg = *(const float4*)(g + col), sc = mod4(p, b, sc_i, col), sh = mod4(p, b, sh_i, col);
            u32x2 w; w.x = pack2(v[i].x * rstd * gg.x * (1.f + sc.x) + sh.x, v[i].y * rstd * gg.y * (1.f + sc.y) + sh.y);
            w.y = pack2(v[i].z * rstd * gg.z * (1.f + sc.z) + sh.z, v[i].w * rstd * gg.w * (1.f + sc.w) + sh.w);
            *(u32x2*)(dst + (size_t)t * D + col) = w; }
    }
}

#define NAIVE_GEMM_BODY(A_, W_, N_, r0_, c0_)                                                                 \
    float acc[16];                                                                                            \
    _Pragma("unroll") for (int r = 0; r < 16; ++r) acc[r] = 0.f;                                              \
    __syncthreads();                                                                                          \
    { const u32x4* srcA = (const u32x4*)((A_) + (size_t)(r0_) * D); u32x4* dstA = (u32x4*)lds;                  \
      for (int i = tid; i < 16 * D / 8; i += NTHR) dstA[i] = srcA[i]; }                                       \
    __syncthreads();                                                                                          \
    { const unsigned* la = (const unsigned*)lds;                                                              \
      for (int k2 = 0; k2 < D / 2; ++k2) {                                                                    \
          const float w0 = (W_)[(size_t)(2 * k2) * (N_) + (c0_) + tid], w1 = (W_)[(size_t)(2 * k2 + 1) * (N_) + (c0_) + tid]; \
          _Pragma("unroll") for (int r = 0; r < 16; ++r) { const unsigned a = la[r * (D / 2) + k2]; acc[r] += bflo(a) * w0 + bfhi(a) * w1; } } }

__device__ void phase_gemm1_naive(const Params& p, unsigned char* lds) {
    const int tid = threadIdx.x;
    const bf16_t* A = (const bf16_t*)(p.ws + OFF_A);
    float* xch = (float*)(lds + 65536);
    bf16_t* qb = (bf16_t*)(p.ws + OFF_QKV); bf16_t* kb = (bf16_t*)(p.ws + OFF_QKV + QKV_ONE); bf16_t* vb = (bf16_t*)(p.ws + OFF_QKV + 2 * QKV_ONE);
    bf16_t* usb = (bf16_t*)(p.ws + OFF_US); bf16_t* vsb = (bf16_t*)(p.ws + OFF_VS);
    const int nitems = (T / 16) * (DIN / 512);
    for (int it = blockIdx.x; it < nitems; it += gridDim.x) {
        const int cbk = it % (DIN / 512), rb = it / (DIN / 512), r0 = rb * 16, c0 = cbk * 512;
        NAIVE_GEMM_BODY(A, p.w_in, DIN, r0, c0)
        const int n = c0 + tid;
        if (n < 3072) {
#pragma unroll
            for (int r = 0; r < 16; ++r) xch[r * 512 + tid] = acc[r];
            __syncthreads();
            const int e = n & 127, hh = (n % DA) >> 7; const bool isq = n < DA;
            const int i = e & 63; const float inv = powf(10000.0f, -(float)i / 64.0f);
#pragma unroll
            for (int r = 0; r < 16; ++r) { const int t = r0 + r, b = t / S, s = t % S;
                const float ang = (float)p.pos[t] * inv; const float cs = cosf(ang), sn = sinf(ang);
                const float other = xch[r * 512 + (tid ^ 64)];
                float val = (e < 64) ? (acc[r] * cs - other * sn) : (acc[r] * cs + other * sn);
                if (isq) val *= 0.08838834764831845f;
                (isq ? qb : kb)[((size_t)(b * HA + hh) * S + s) * E + e] = f2bf(val); }
        } else if (n < 4608) {
            const int e = n & 127, hh = (n - 3072) >> 7;
#pragma unroll
            for (int r = 0; r < 16; ++r) { const int t = r0 + r, b = t / S, s = t % S; vb[((size_t)(b * HA + hh) * S + s) * E + e] = f2bf(acc[r]); }
        } else if (n < 5120) {
#pragma unroll
            for (int r = 0; r < 16; ++r) usb[(size_t)(r0 + r) * DS + (n - 4608)] = f2bf(gelu_erf(acc[r]));
        } else {
#pragma unroll
            for (int r = 0; r < 16; ++r) vsb[(size_t)(r0 + r) * DS + (n - 5120)] = f2bf(gelu_erf(acc[r]));
        }
    }
}
__device__ void phase_gemm2_naive(const Params& p, unsigned char* lds) {
    const int tid = threadIdx.x;
    const bf16_t* A = (const bf16_t*)(p.ws + OFF_QKV);
    const int nitems = (T / 16) * (D / 512);
    for (int it = blockIdx.x; it < nitems; it += gridDim.x) {
        const int cbk = it % (D / 512), rb = it / (D / 512), r0 = rb * 16, c0 = cbk * 512;
        NAIVE_GEMM_BODY(A, p.w_out, D, r0, c0)
        const int n = c0 + tid;
#pragma unroll
        for (int r = 0; r < 16; ++r) { const int t = r0 + r, b = t / S; p.out[(size_t)t * D + n] = p.x[(size_t)t * D + n] + mod1(p, b, 2, n) * acc[r]; }
    }
}
__device__ void phase_gemm3_naive(const Params& p, unsigned char* lds) {
    const int tid = threadIdx.x;
    const bf16_t* A = (const bf16_t*)(p.ws + OFF_A);
    bf16_t* pq = (bf16_t*)(p.ws + OFF_QKV + (size_t)T * D * 2);
    const int nitems = (T / 16) * (D / 512);
    for (int it = blockIdx.x; it < nitems; it += gridDim.x) {
        const int cbk = it % (D / 512), rb = it / (D / 512), r0 = rb * 16, c0 = cbk * 512;
        NAIVE_GEMM_BODY(A, p.peer_w_q, D, r0, c0)
        const int n = c0 + tid;
#pragma unroll
        for (int r = 0; r < 16; ++r) pq[(size_t)(r0 + r) * D + n] = f2bf(acc[r]);
    }
}

__device__ void phase_attn_naive(const Params& p, unsigned char* lds) {
    const int lane = threadIdx.x & 63, wave = threadIdx.x >> 6, gw = blockIdx.x * NWV + wave, nw = gridDim.x * NWV;
    float* ql = (float*)lds + wave * 128;
    const bf16_t* qb = (const bf16_t*)(p.ws + OFF_QKV); const bf16_t* kb = (const bf16_t*)(p.ws + OFF_QKV + QKV_ONE); const bf16_t* vb = (const bf16_t*)(p.ws + OFF_QKV + 2 * QKV_ONE);
    float* lse = (float*)(p.ws + OFF_LSE);
    for (int item = gw; item < NB * HA * S; item += nw) {
        const int t = item % S, h = (item / S) % HA, b = item / (S * HA);
        const size_t hb = (size_t)(b * HA + h) * S;
        { const unsigned w = *(const unsigned*)(qb + (hb + t) * E + 2 * lane); ql[2 * lane] = bflo(w); ql[2 * lane + 1] = bfhi(w); }
        __builtin_amdgcn_wave_barrier();
#pragma unroll 1
        for (int pat = 0; pat < 3; ++pat) {
            const int d = pat == 0 ? 1 : (pat == 1 ? 4 : 16);
            const int imax = min(128, t / d);
            float sc[3];
#pragma unroll
            for (int sl = 0; sl < 3; ++sl) { const int i = sl * 64 + lane; float s = -__builtin_inff();
                if (i <= imax) { const u32x4* kr = (const u32x4*)(kb + (hb + (t - i * d)) * E); s = 0.f;
                    for (int c8 = 0; c8 < 16; ++c8) { const u32x4 kk = kr[c8]; const float* qq = ql + c8 * 8;
                        s += qq[0] * bflo(kk.x) + qq[1] * bfhi(kk.x) + qq[2] * bflo(kk.y) + qq[3] * bfhi(kk.y) + qq[4] * bflo(kk.z) + qq[5] * bfhi(kk.z) + qq[6] * bflo(kk.w) + qq[7] * bfhi(kk.w); } }
                sc[sl] = s; }
            const float m = wave_max(fmaxf(sc[0], fmaxf(sc[1], sc[2])));
            float pr[3]; float l = 0.f;
#pragma unroll
            for (int sl = 0; sl < 3; ++sl) { pr[sl] = __expf(sc[sl] - m); l += pr[sl]; }
            l = wave_sum(l);
            float o0 = 0.f, o1 = 0.f;
            for (int i = 0; i <= imax; ++i) { const float pv = __shfl(i < 64 ? pr[0] : (i < 128 ? pr[1] : pr[2]), i & 63);
                const unsigned w = *(const unsigned*)(vb + (hb + (t - i * d)) * E + 2 * lane); o0 += pv * bflo(w); o1 += pv * bfhi(w); }
            const float il = 1.0f / l; const size_t tg = (size_t)b * S + t;
            *(unsigned*)(P_opat(p, pat) + tg * DA + h * E + 2 * lane) = pack2(o0 * il, o1 * il);
            if (lane == 0) lse[((size_t)pat * T + tg) * HA + h] = m + __logf(l);
        }
        __builtin_amdgcn_wave_barrier();
    }
}

__device__ void phase_sgu_ln_naive(const Params& p) {
    const int lane = threadIdx.x & 63, gw = blockIdx.x * NWV + (threadIdx.x >> 6), nw = gridDim.x * NWV;
    bf16_t* vsb = (bf16_t*)(p.ws + OFF_VS);
    for (int item = gw; item < T * HS; item += nw) {
        const int t = item / HS, h = item % HS;
        unsigned* ptr = (unsigned*)(vsb + (size_t)t * DS + h * E + 2 * lane);
        const unsigned w = *ptr; const float a = bflo(w), b = bfhi(w);
        const float mu = wave_sum(a + b) * (1.0f / E); const float da = a - mu, db = b - mu;
        const float var = wave_sum(da * da + db * db) * (1.0f / E); const float rs = rsqrtf(var + 1e-5f);
        const int e = 2 * lane;
        *ptr = pack2(da * rs * p.sgu_ln_g[h * E + e] + p.sgu_ln_b[h * E + e], db * rs * p.sgu_ln_g[h * E + e + 1] + p.sgu_ln_b[h * E + e + 1]);
    }
}
__device__ void phase_sgu_mix_naive(const Params& p) {
    const int tid = threadIdx.x;
    const bf16_t* vnb = (const bf16_t*)(p.ws + OFF_VS); const bf16_t* usb = (const bf16_t*)(p.ws + OFF_US); bf16_t* ob = (bf16_t*)(p.ws + OFF_SGUO);
    for (int t = blockIdx.x; t < T; t += gridDim.x) {
        const int h = tid >> 7, e = tid & 127, i = t & 127, t0 = t - i;
        float acc = 0.f;
        for (int j = 0; j <= i; ++j) acc += p.sgu_w[(h * 128 + i) * 128 + j] * bf2f(vnb[(size_t)(t0 + j) * DS + tid]);
        acc += p.sgu_b[h * 128 + i];
        ob[(size_t)t * DS + tid] = f2bf(bf2f(usb[(size_t)t * DS + tid]) * acc);
        (void)e;
    }
}

__device__ void phase_combine(const Params& p) {
    const int lane = threadIdx.x & 63, gw = blockIdx.x * NWV + (threadIdx.x >> 6), nw = gridDim.x * NWV;
    const float* lse = (const float*)(p.ws + OFF_LSE);
    const bf16_t* sg = (const bf16_t*)(p.ws + OFF_SGUO); bf16_t* mixed = (bf16_t*)(p.ws + OFF_QKV);
    for (int t = gw; t < T; t += nw) {
        float w0 = 0.f, w1 = 0.f, w2 = 0.f;
        if (lane < HA) { const float l0 = lse[((size_t)0 * T + t) * HA + lane], l1 = lse[((size_t)1 * T + t) * HA + lane], l2 = lse[((size_t)2 * T + t) * HA + lane];
            const float m = fmaxf(l0, fmaxf(l1, l2)); const float e0 = __expf(l0 - m), e1 = __expf(l1 - m), e2 = __expf(l2 - m); const float is = 1.0f / (e0 + e1 + e2);
            w0 = e0 * is; w1 = e1 * is; w2 = e2 * is; }
        float av[3][8]; float ss = 0.f;
#pragma unroll
        for (int i = 0; i < 3; ++i) { const int col0 = (lane + 64 * i) * 8, hh = col0 >> 7;
            const float a0 = __shfl(w0, hh), a1 = __shfl(w1, hh), a2 = __shfl(w2, hh);
            const u32x4 x0 = *(const u32x4*)(P_opat(p, 0) + (size_t)t * DA + col0), x1 = *(const u32x4*)(P_opat(p, 1) + (size_t)t * DA + col0), x2 = *(const u32x4*)(P_opat(p, 2) + (size_t)t * DA + col0);
            av[i][0] = a0 * bflo(x0.x) + a1 * bflo(x1.x) + a2 * bflo(x2.x); av[i][1] = a0 * bfhi(x0.x) + a1 * bfhi(x1.x) + a2 * bfhi(x2.x);
            av[i][2] = a0 * bflo(x0.y) + a1 * bflo(x1.y) + a2 * bflo(x2.y); av[i][3] = a0 * bfhi(x0.y) + a1 * bfhi(x1.y) + a2 * bfhi(x2.y);
            av[i][4] = a0 * bflo(x0.z) + a1 * bflo(x1.z) + a2 * bflo(x2.z); av[i][5] = a0 * bfhi(x0.z) + a1 * bfhi(x1.z) + a2 * bfhi(x2.z);
            av[i][6] = a0 * bflo(x0.w) + a1 * bflo(x1.w) + a2 * bflo(x2.w); av[i][7] = a0 * bfhi(x0.w) + a1 * bfhi(x1.w) + a2 * bfhi(x2.w);
#pragma unroll
            for (int j = 0; j < 8; ++j) ss += av[i][j] * av[i][j]; }
        ss = wave_sum(ss); const float rs = rsqrtf(ss * (1.0f / DA) + 1e-6f);
#pragma unroll
        for (int i = 0; i < 3; ++i) { const int col0 = (lane + 64 * i) * 8; const float4 g0 = *(const float4*)(p.g_attn_out + col0), g1 = *(const float4*)(p.g_attn_out + col0 + 4);
            u32x4 w; w.x = pack2(av[i][0] * rs * g0.x, av[i][1] * rs * g0.y); w.y = pack2(av[i][2] * rs * g0.z, av[i][3] * rs * g0.w);
            w.z = pack2(av[i][4] * rs * g1.x, av[i][5] * rs * g1.y); w.w = pack2(av[i][6] * rs * g1.z, av[i][7] * rs * g1.w);
            *(u32x4*)(mixed + (size_t)t * D + col0) = w; }
        { const int col0 = lane * 8; const u32x4 xs = *(const u32x4*)(sg + (size_t)t * DS + col0);
          float sv[8] = {bflo(xs.x), bfhi(xs.x), bflo(xs.y), bfhi(xs.y), bflo(xs.z), bfhi(xs.z), bflo(xs.w), bfhi(xs.w)}; float s2 = 0.f;
#pragma unroll
          for (int j = 0; j < 8; ++j) s2 += sv[j] * sv[j];
          s2 = wave_sum(s2); const float r2 = rsqrtf(s2 * (1.0f / DS) + 1e-6f);
          const float4 g0 = *(const float4*)(p.g_sgu_out + col0), g1 = *(const float4*)(p.g_sgu_out + col0 + 4);
          u32x4 w; w.x = pack2(sv[0] * r2 * g0.x, sv[1] * r2 * g0.y); w.y = pack2(sv[2] * r2 * g0.z, sv[3] * r2 * g0.w);
          w.z = pack2(sv[4] * r2 * g1.x, sv[5] * r2 * g1.y); w.w = pack2(sv[6] * r2 * g1.z, sv[7] * r2 * g1.w);
          *(u32x4*)(mixed + (size_t)t * D + DA + col0) = w; }
    }
}

__device__ void phase_topk_naive(const Params& p, unsigned char* lds) {
    const int lane = threadIdx.x & 63, wave = threadIdx.x >> 6, gw = blockIdx.x * NWV + wave, nw = gridDim.x * NWV;
    float* ql = (float*)lds + wave * 256;
    const bf16_t* pq = (const bf16_t*)(p.ws + OFF_QKV + (size_t)T * D * 2);
    int* idxo = (int*)(p.ws + OFF_IDX); float* gato = (float*)(p.ws + OFF_GATE);
    const float NEG = -__builtin_inff();
    for (int item = gw; item < T * PH; item += nw) {
        const int t = item / PH, h = item % PH;
        { const u32x2 w = *(const u32x2*)(pq + (size_t)t * D + h * 256 + 4 * lane); ql[4 * lane] = bflo(w.x); ql[4 * lane + 1] = bfhi(w.x); ql[4 * lane + 2] = bflo(w.y); ql[4 * lane + 3] = bfhi(w.y); }
        __builtin_amdgcn_wave_barrier();
        float ts[2]; int ti[2];
#pragma unroll
        for (int pp = 0; pp < 2; ++pp) {
            const float* k0 = p.peer_sub_keys + ((size_t)(h * 2 + pp) * 128 + lane) * 128; const float* k1 = k0 + 64 * 128; const float* qq = ql + pp * 128;
            float s0 = 0.f, s1 = 0.f;
            for (int c = 0; c < 128; c += 4) { const float4 a = *(const float4*)(k0 + c), b = *(const float4*)(k1 + c);
                s0 += qq[c] * a.x + qq[c + 1] * a.y + qq[c + 2] * a.z + qq[c + 3] * a.w; s1 += qq[c] * b.x + qq[c + 1] * b.y + qq[c + 2] * b.z + qq[c + 3] * b.w; }
            float tsv = 0.f; int tiv = 0;
            for (int r = 0; r < PK; ++r) { const float m = wave_max(fmaxf(s0, s1));
                const int cand = (s0 == m) ? lane : ((s1 == m) ? lane + 64 : 1000); const int key = wave_min_i(cand);
                if (lane == r) { tsv = m; tiv = key; }
                if (key == lane) s0 = NEG; if (key == lane + 64) s1 = NEG; }
            ts[pp] = tsv; ti[pp] = tiv; }
        float cs[4]; const int ci = lane >> 2, cj = (lane & 3) * 4; const float a = __shfl(ts[0], ci);
#pragma unroll
        for (int m = 0; m < 4; ++m) cs[m] = a + __shfl(ts[1], cj + m);
        float bs = 0.f; int bpos = 0;
        for (int r = 0; r < PK; ++r) { const float m = wave_max(fmaxf(fmaxf(cs[0], cs[1]), fmaxf(cs[2], cs[3])));
            int cand = 1000;
#pragma unroll
            for (int mm = 3; mm >= 0; --mm) if (cs[mm] == m) cand = ci * 16 + cj + mm;
            const int pos = wave_min_i(cand);
            if (lane == r) { bs = m; bpos = pos; }
#pragma unroll
            for (int mm = 0; mm < 4; ++mm) if (pos == ci * 16 + cj + mm) cs[mm] = NEG; }
        const int e1 = __shfl(ti[0], (bpos >> 4) & 15), e2 = __shfl(ti[1], bpos & 15);
        const float m0 = __shfl(bs, 0); const float ex = lane < PK ? __expf(bs - m0) : 0.f; const float sum = wave_sum(ex);
        if (lane < PK) { idxo[(size_t)t * 128 + h * PK + lane] = e1 * 128 + e2; gato[(size_t)t * 128 + h * PK + lane] = ex / sum; }
        __builtin_amdgcn_wave_barrier();
    }
}

__device__ void phase_gather(const Params& p) {
    const int lane = threadIdx.x & 63, gw = blockIdx.x * NWV + (threadIdx.x >> 6), nw = gridDim.x * NWV;
    const bf16_t* hn2 = (const bf16_t*)(p.ws + OFF_A); const bf16_t* ut = (const bf16_t*)(p.ws + OFF_UTAB); const bf16_t* vt = (const bf16_t*)(p.ws + OFF_VTAB);
    const int* idx = (const int*)(p.ws + OFF_IDX); const float* gate = (const float*)(p.ws + OFF_GATE);
    for (int t = gw; t < T; t += nw) {
        float xf[32], acc[32];
#pragma unroll
        for (int c = 0; c < 4; ++c) { const u32x4 w = *(const u32x4*)(hn2 + (size_t)t * D + c * 512 + lane * 8);
            xf[c * 8 + 0] = bflo(w.x); xf[c * 8 + 1] = bfhi(w.x); xf[c * 8 + 2] = bflo(w.y); xf[c * 8 + 3] = bfhi(w.y); xf[c * 8 + 4] = bflo(w.z); xf[c * 8 + 5] = bfhi(w.z); xf[c * 8 + 6] = bflo(w.w); xf[c * 8 + 7] = bfhi(w.w); }
#pragma unroll
        for (int j = 0; j < 32; ++j) acc[j] = 0.f;
#pragma unroll 2
        for (int n = 0; n < 128; ++n) {
            const int e = __builtin_amdgcn_readfirstlane(idx[(size_t)t * 128 + n]); const float g = gate[(size_t)t * 128 + n];
            const bf16_t* ur = ut + (size_t)e * D; const bf16_t* vr = vt + (size_t)e * D;
            u32x4 uw[4], vw[4];
#pragma unroll
            for (int c = 0; c < 4; ++c) { uw[c] = *(const u32x4*)(ur + c * 512 + lane * 8); vw[c] = *(const u32x4*)(vr + c * 512 + lane * 8); }
            float dsum = 0.f;
#pragma unroll
            for (int c = 0; c < 4; ++c) dsum += xf[c * 8 + 0] * bflo(uw[c].x) + xf[c * 8 + 1] * bfhi(uw[c].x) + xf[c * 8 + 2] * bflo(uw[c].y) + xf[c * 8 + 3] * bfhi(uw[c].y)
                                              + xf[c * 8 + 4] * bflo(uw[c].z) + xf[c * 8 + 5] * bfhi(uw[c].z) + xf[c * 8 + 6] * bflo(uw[c].w) + xf[c * 8 + 7] * bfhi(uw[c].w);
            dsum = wave_sum(dsum);
            const float w = g * gelu_erf(dsum);
#pragma unroll
            for (int c = 0; c < 4; ++c) { acc[c * 8 + 0] += w * bflo(vw[c].x); acc[c * 8 + 1] += w * bfhi(vw[c].x); acc[c * 8 + 2] += w * bflo(vw[c].y); acc[c * 8 + 3] += w * bfhi(vw[c].y);
                acc[c * 8 + 4] += w * bflo(vw[c].z); acc[c * 8 + 5] += w * bfhi(vw[c].z); acc[c * 8 + 6] += w * bflo(vw[c].w); acc[c * 8 + 7] += w * bfhi(vw[c].w); }
        }
        const int b = t / S; float* hrow = p.out + (size_t)t * D; float ss = 0.f;
#pragma unroll
        for (int c = 0; c < 4; ++c) { const int col = c * 512 + lane * 8;
            const float4 h0 = *(const float4*)(hrow + col), h1 = *(const float4*)(hrow + col + 4);
            const float4 g0 = mod4(p, b, 5, col), g1 = mod4(p, b, 5, col + 4);
            acc[c * 8 + 0] = h0.x + g0.x * acc[c * 8 + 0]; acc[c * 8 + 1] = h0.y + g0.y * acc[c * 8 + 1]; acc[c * 8 + 2] = h0.z + g0.z * acc[c * 8 + 2]; acc[c * 8 + 3] = h0.w + g0.w * acc[c * 8 + 3];
            acc[c * 8 + 4] = h1.x + g1.x * acc[c * 8 + 4]; acc[c * 8 + 5] = h1.y + g1.y * acc[c * 8 + 5]; acc[c * 8 + 6] = h1.z + g1.z * acc[c * 8 + 6]; acc[c * 8 + 7] = h1.w + g1.w * acc[c * 8 + 7];
#pragma unroll
            for (int j = 0; j < 8; ++j) ss += acc[c * 8 + j] * acc[c * 8 + j]; }
        ss = wave_sum(ss); const float rs = rsqrtf(ss * (1.0f / D) + 1e-6f);
#pragma unroll
        for (int c = 0; c < 4; ++c) { const int col = c * 512 + lane * 8;
            const float4 g0 = *(const float4*)(p.g_final + col), g1 = *(const float4*)(p.g_final + col + 4);
            *(float4*)(hrow + col) = make_float4(acc[c * 8 + 0] * rs * g0.x, acc[c * 8 + 1] * rs * g0.y, acc[c * 8 + 2] * rs * g0.z, acc[c * 8 + 3] * rs * g0.w);
            *(float4*)(hrow + col + 4) = make_float4(acc[c * 8 + 4] * rs * g1.x, acc[c * 8 + 5] * rs * g1.y, acc[c * 8 + 6] * rs * g1.z, acc[c * 8 + 7] * rs * g1.w); }
    }
}

constexpr int LDS_BYTES = 131072;
template <int PHASE> __global__ void __launch_bounds__(NTHR, 2) k_phase(Params p) {
    extern __shared__ __attribute__((aligned(16))) unsigned char lds[];
    if (PHASE == 0) phase_conv(p, lds);
    if (PHASE == 1) phase_norm_mod(p, p.x, p.g_norm1, 0, 1, (bf16_t*)(p.ws + OFF_A));
    if (PHASE == 2) phase_gemm1_naive(p, lds);
    if (PHASE == 3) { phase_attn_naive(p, lds); phase_sgu_ln_naive(p); }
    if (PHASE == 4) phase_sgu_mix_naive(p);
    if (PHASE == 5) phase_combine(p);
    if (PHASE == 6) phase_gemm2_naive(p, lds);
    if (PHASE == 7) phase_norm_mod(p, p.out, p.g_norm2, 3, 4, (bf16_t*)(p.ws + OFF_A));
    if (PHASE == 8) phase_gemm3_naive(p, lds);
    if (PHASE == 9) phase_topk_naive(p, lds);
    if (PHASE == 10) phase_gather(p);
}

template <int PHASE> static void launch_phase(const Params& p, int grid, hipStream_t stream) {
    static bool attr = false;
    if (!attr) { (void)hipFuncSetAttribute((const void*)k_phase<PHASE>, hipFuncAttributeMaxDynamicSharedMemorySize, LDS_BYTES); attr = true; }
    hipLaunchKernelGGL(k_phase<PHASE>, dim3(grid), dim3(NTHR), LDS_BYTES, stream, p);
}

extern "C" void kernel_launch(void* const* d_in, const int* in_sizes, int n_in, void* d_out, int out_size, void* d_ws, size_t ws_size, hipStream_t stream) {
    if (n_in != 20 || out_size != T * D || ws_size < WS_END) { fprintf(stderr, "kernel_launch: unexpected problem (n_in %d out %d ws %zu, need %zu)\n", n_in, out_size, ws_size, (size_t)WS_END); return; }
    Params p{};
    p.x = (const float*)d_in[0]; p.c = (const float*)d_in[1]; p.pos = (const int*)d_in[2]; p.w_ada = (const float*)d_in[3]; p.b_ada = (const float*)d_in[4];
    p.g_norm1 = (const float*)d_in[5]; p.w_in = (const float*)d_in[6]; p.g_attn_out = (const float*)d_in[7]; p.g_sgu_out = (const float*)d_in[8];
    p.sgu_w = (const float*)d_in[9]; p.sgu_b = (const float*)d_in[10]; p.sgu_ln_g = (const float*)d_in[11]; p.sgu_ln_b = (const float*)d_in[12];
    p.w_out = (const float*)d_in[13]; p.g_norm2 = (const float*)d_in[14]; p.peer_w_q = (const float*)d_in[15]; p.peer_sub_keys = (const float*)d_in[16];
    p.peer_u = (const float*)d_in[17]; p.peer_v = (const float*)d_in[18]; p.g_final = (const float*)d_in[19];
    p.out = (float*)d_out; p.ws = (unsigned char*)d_ws;
    (void)hipMemsetAsync((char*)d_ws + OFF_CTL, 0, OFF_SGUW - OFF_CTL, stream);
    const int grid = 256;
    launch_phase<0>(p, grid, stream); launch_phase<1>(p, grid, stream); launch_phase<2>(p, grid, stream); launch_phase<3>(p, grid, stream);
    launch_phase<4>(p, grid, stream); launch_phase<5>(p, grid, stream); launch_phase<6>(p, grid, stream); launch_phase<7>(p, grid, stream);
    launch_phase<8>(p, grid, stream); launch_phase<9>(p, grid, stream); launch_phase<10>(p, grid, stream);
}
```

```cpp
#include <hip/hip_runtime.h>
#include <hip/hip_cooperative_groups.h>
#include <cstdio>
#include <cstdint>
namespace cg = cooperative_groups;

constexpr int D = 2048, NB = 4, S = 4096, T = NB * S;
constexpr int E = 128, HA = 12, HS = 4, DA = 1536, DS = 512, DIN = 5632;
constexpr int PH = 8, PK = 16, NEXP = 16384;
constexpr int NTHR = 512, NWV = 8;

typedef unsigned short bf16_t;
typedef unsigned u32x4 __attribute__((ext_vector_type(4)));
typedef unsigned u32x2 __attribute__((ext_vector_type(2)));
typedef float f32x4 __attribute__((ext_vector_type(4)));

__device__ __forceinline__ bf16_t f2bf(float f) { unsigned u = __float_as_uint(f); u += 0x7FFFu + ((u >> 16) & 1u); return (bf16_t)(u >> 16); }
__device__ __forceinline__ float bf2f(bf16_t b) { return __uint_as_float(((unsigned)b) << 16); }
__device__ __forceinline__ unsigned pack2(float lo, float hi) { return (unsigned)f2bf(lo) | ((unsigned)f2bf(hi) << 16); }
__device__ __forceinline__ float bflo(unsigned w) { return __uint_as_float(w << 16); }
__device__ __forceinline__ float bfhi(unsigned w) { return __uint_as_float(w & 0xffff0000u); }
__device__ __forceinline__ float wave_sum(float v) {
#pragma unroll
    for (int o = 32; o >= 1; o >>= 1) v += __shfl_xor(v, o);
    return v; }
__device__ __forceinline__ float wave_max(float v) {
#pragma unroll
    for (int o = 32; o >= 1; o >>= 1) v = fmaxf(v, __shfl_xor(v, o));
    return v; }
__device__ __forceinline__ int wave_min_i(int v) {
#pragma unroll
    for (int o = 32; o >= 1; o >>= 1) v = min(v, __shfl_xor(v, o));
    return v; }
__device__ __forceinline__ float gelu_erf(float v) { return 0.5f * v * (1.0f + erff(v * 0.70710678118654752f)); }

constexpr size_t OFF_CTL  = 0;
constexpr size_t OFF_MOD  = 65536;
constexpr size_t OFF_SGUW = OFF_MOD + 393216;
constexpr size_t OFF_SUBK = OFF_SGUW + 131072;
constexpr size_t OFF_LSE  = OFF_SUBK + 524288;
constexpr size_t OFF_IDX  = OFF_LSE + (size_t)3 * T * 12 * 4;
constexpr size_t OFF_GATE = OFF_IDX + (size_t)T * 128 * 4;
constexpr size_t OFF_WIN  = OFF_GATE + (size_t)T * 128 * 4;
constexpr size_t OFF_WOUT = OFF_WIN + (size_t)DIN * D * 2;
constexpr size_t OFF_WQ   = OFF_WOUT + (size_t)D * D * 2;
constexpr size_t OFF_UTAB = OFF_WQ + (size_t)D * D * 2;
constexpr size_t OFF_VTAB = OFF_UTAB + (size_t)NEXP * D * 2;
constexpr size_t OFF_A    = OFF_VTAB + (size_t)NEXP * D * 2;
constexpr size_t OFF_QKV  = OFF_A + (size_t)T * D * 2;
constexpr size_t QKV_ONE  = (size_t)T * DA * 2;
constexpr size_t OFF_US   = OFF_QKV + 3 * QKV_ONE;
constexpr size_t OFF_VS   = OFF_US + (size_t)T * DS * 2;
constexpr size_t OFF_SGUO = OFF_VS + (size_t)T * DS * 2;
constexpr size_t OFF_O12  = OFF_SGUO + (size_t)T * DS * 2;
constexpr size_t WS_END   = OFF_O12 + 2 * QKV_ONE;

struct Params {
    const float* x; const float* c; const int* pos; const float* w_ada; const float* b_ada; const float* g_norm1; const float* w_in;
    const float* g_attn_out; const float* g_sgu_out; const float* sgu_w; const float* sgu_b; const float* sgu_ln_g; const float* sgu_ln_b;
    const float* w_out; const float* g_norm2; const float* peer_w_q; const float* peer_sub_keys; const float* peer_u; const float* peer_v;
    const float* g_final; float* out; unsigned char* ws;
};
__device__ __forceinline__ float mod1(const Params& p, int b, int i, int col) { const long long v = ((const long long*)(p.ws + OFF_MOD))[b * 12288 + i * D + col]; return (float)((double)v * 2.3283064365386963e-10); }
__device__ __forceinline__ float4 mod4(const Params& p, int b, int i, int col) { return make_float4(mod1(p, b, i, col), mod1(p, b, i, col + 1), mod1(p, b, i, col + 2), mod1(p, b, i, col + 3)); }
__device__ __forceinline__ bf16_t* P_opat(const Params& p, int pat) { return (bf16_t*)(pat == 0 ? p.ws + OFF_A : p.ws + OFF_O12 + (size_t)(pat - 1) * QKV_ONE); }

__device__ __forceinline__ void conv_transpose(const float* __restrict__ W, int N, bf16_t* __restrict__ WT, int perm_limit, float* tile, int bid, int nblk, int tid) {
    const int ntiles = 32 * (N / 64);
    for (int tI = bid; tI < ntiles; tI += nblk) {
        const int tk = tI & 31, tn = tI >> 5, k0 = tk * 64, n0 = tn * 64;
        int l0 = n0;
        if (n0 < perm_limit) { const int base = n0 & ~255, pb = (n0 >> 6) & 3, bj = pb >> 1, qhi = pb & 1; l0 = base + 64 * bj + 128 * qhi; }
        __syncthreads();
#pragma unroll
        for (int pass = 0; pass < 2; ++pass) { const int r = pass * 32 + (tid >> 4), c4 = (tid & 15) * 4;
            const float4 v = *(const float4*)(W + (size_t)(k0 + r) * N + l0 + c4);
            tile[r * 65 + c4 + 0] = v.x; tile[r * 65 + c4 + 1] = v.y; tile[r * 65 + c4 + 2] = v.z; tile[r * 65 + c4 + 3] = v.w; }
        __syncthreads();
        const int n = tid >> 3, kq = (tid & 7) * 8;
        u32x4 w;
        w.x = pack2(tile[(kq + 0) * 65 + n], tile[(kq + 1) * 65 + n]); w.y = pack2(tile[(kq + 2) * 65 + n], tile[(kq + 3) * 65 + n]);
        w.z = pack2(tile[(kq + 4) * 65 + n], tile[(kq + 5) * 65 + n]); w.w = pack2(tile[(kq + 6) * 65 + n], tile[(kq + 7) * 65 + n]);
        *(u32x4*)(WT + (size_t)(n0 + n) * D + k0 + kq) = w;
    }
}
__device__ __forceinline__ void conv_flat(const float* __restrict__ src, bf16_t* __restrict__ dst, size_t n8, int bid, int nblk, int tid) {
    for (size_t i = (size_t)bid * NTHR + tid; i < n8; i += (size_t)nblk * NTHR) {
        const float4 a = ((const float4*)src)[2 * i], b = ((const float4*)src)[2 * i + 1];
        u32x4 w; w.x = pack2(a.x, a.y); w.y = pack2(a.z, a.w); w.z = pack2(b.x, b.y); w.w = pack2(b.z, b.w);
        ((u32x4*)dst)[i] = w; }
}
__device__ void phase_conv(const Params& p, unsigned char* lds) {
    const int tid = threadIdx.x, bid = blockIdx.x, nblk = gridDim.x;
    unsigned long long* mod = (unsigned long long*)(p.ws + OFF_MOD);
    for (int it = bid; it < 768; it += nblk) {
        const int cb = it % 6, kc = it / 6, col = cb * 2048 + tid * 4;
        float acc[4][4];
#pragma unroll
        for (int b = 0; b < 4; ++b) { acc[b][0] = 0.f; acc[b][1] = 0.f; acc[b][2] = 0.f; acc[b][3] = 0.f; }
        for (int kk = 0; kk < 16; ++kk) { const int k = kc * 16 + kk;
            const float4 w = *(const float4*)(p.w_ada + (size_t)k * 12288 + col);
#pragma unroll
            for (int b = 0; b < 4; ++b) { const float cv = p.c[b * D + k]; const float s = cv / (1.f + __expf(-cv));
                acc[b][0] += s * w.x; acc[b][1] += s * w.y; acc[b][2] += s * w.z; acc[b][3] += s * w.w; } }
        if (kc == 0) { const float4 bv = *(const float4*)(p.b_ada + col);
#pragma unroll
            for (int b = 0; b < 4; ++b) { acc[b][0] += bv.x; acc[b][1] += bv.y; acc[b][2] += bv.z; acc[b][3] += bv.w; } }
#pragma unroll
        for (int b = 0; b < 4; ++b)
#pragma unroll
            for (int j = 0; j < 4; ++j) atomicAdd(mod + b * 12288 + col + j, (unsigned long long)__double2ll_rn((double)acc[b][j] * 4294967296.0));
    }
    conv_transpose(p.w_in, DIN, (bf16_t*)(p.ws + OFF_WIN), 3072, (float*)lds, bid, nblk, tid);
    conv_transpose(p.w_out, D, (bf16_t*)(p.ws + OFF_WOUT), 0, (float*)lds, bid, nblk, tid);
    conv_transpose(p.peer_w_q, D, (bf16_t*)(p.ws + OFF_WQ), 0, (float*)lds, bid, nblk, tid);
    conv_flat(p.peer_u, (bf16_t*)(p.ws + OFF_UTAB), (size_t)NEXP * D / 8, bid, nblk, tid);
    conv_flat(p.peer_v, (bf16_t*)(p.ws + OFF_VTAB), (size_t)NEXP * D / 8, bid, nblk, tid);
    conv_flat(p.peer_sub_keys, (bf16_t*)(p.ws + OFF_SUBK), (size_t)8 * 2 * 128 * 128 / 8, bid, nblk, tid);
    { bf16_t* sw = (bf16_t*)(p.ws + OFF_SGUW);
      for (int i = bid * NTHR + tid; i < 4 * 128 * 128; i += nblk * NTHR) { const int jj = i & 127, ii = (i >> 7) & 127; sw[i] = f2bf(jj <= ii ? p.sgu_w[i] : 0.f); } }
}

__device__ void phase_norm_mod(const Params& p, const float* __restrict__ src, const float* __restrict__ g, int sh_i, int sc_i, bf16_t* __restrict__ dst) {
    const int lane = threadIdx.x & 63, gw = blockIdx.x * NWV + (threadIdx.x >> 6), nw = gridDim.x * NWV;
    for (int t = gw; t < T; t += nw) {
        const float* row = src + (size_t)t * D; const int b = t / S;
        float4 v[8]; float ss = 0.f;
#pragma unroll
        for (int i = 0; i < 8; ++i) { v[i] = *(const float4*)(row + i * 256 + lane * 4); ss += v[i].x * v[i].x + v[i].y * v[i].y + v[i].z * v[i].z + v[i].w * v[i].w; }
        ss = wave_sum(ss); const float rstd = rsqrtf(ss * (1.0f / D) + 1e-6f);
#pragma unroll
        for (int i = 0; i < 8; ++i) { const int col = i * 256 + lane * 4;
            const float4 gg = *(const float4*)(g + col), sc = mod4(p, b, sc_i, col), sh = mod4(p, b, sh_i, col);
            u32x2 w; w.x = pack2(v[i].x * rstd * gg.x * (1.f + sc.x) + sh.x, v[i].y * rstd * gg.y * (1.f + sc.y) + sh.y);
            w.y = pack2(v[i].z * rstd * gg.z * (1.f + sc.z) + sh.z, v[i].w * rstd * gg.w * (1.f + sc.w) + sh.w);
            *(u32x2*)(dst + (size_t)t * D + col) = w; }
    }
}

#define NAIVE_GEMM_BODY(A_, W_, N_, r0_, c0_)                                                                 \
    float acc[16];                                                                                            \
    _Pragma("unroll") for (int r = 0; r < 16; ++r) acc[r] = 0.f;                                              \
    __syncthreads();                                                                                          \
    { const u32x4* srcA = (const u32x4*)((A_) + (size_t)(r0_) * D); u32x4* dstA = (u32x4*)lds;                  \
      for (int i = tid; i < 16 * D / 8; i += NTHR) dstA[i] = srcA[i]; }                                       \
    __syncthreads();                                                                                          \
    { const unsigned* la = (const unsigned*)lds;                                                              \
      for (int k2 = 0; k2 < D / 2; ++k2) {                                                                    \
          const float w0 = (W_)[(size_t)(2 * k2) * (N_) + (c0_) + tid], w1 = (W_)[(size_t)(2 * k2 + 1) * (N_) + (c0_) + tid]; \
          _Pragma("unroll") for (int r = 0; r < 16; ++r) { const unsigned a = la[r * (D / 2) + k2]; acc[r] += bflo(a) * w0 + bfhi(a) * w1; } } }

__device__ void phase_gemm1_naive(const Params& p, unsigned char* lds) {
    const int tid = threadIdx.x;
    const bf16_t* A = (const bf16_t*)(p.ws + OFF_A);
    float* xch = (float*)(lds + 65536);
    bf16_t* qb = (bf16_t*)(p.ws + OFF_QKV); bf16_t* kb = (bf16_t*)(p.ws + OFF_QKV + QKV_ONE); bf16_t* vb = (bf16_t*)(p.ws + OFF_QKV + 2 * QKV_ONE);
    bf16_t* usb = (bf16_t*)(p.ws + OFF_US); bf16_t* vsb = (bf16_t*)(p.ws + OFF_VS);
    const int nitems = (T / 16) * (DIN / 512);
    for (int it = blockIdx.x; it < nitems; it += gridDim.x) {
        const int cbk = it % (DIN / 512), rb = it / (DIN / 512), r0 = rb * 16, c0 = cbk * 512;
        NAIVE_GEMM_BODY(A, p.w_in, DIN, r0, c0)
        const int n = c0 + tid;
        if (n < 3072) {
#pragma unroll
            for (int r = 0; r < 16; ++r) xch[r * 512 + tid] = acc[r];
            __syncthreads();
            const int e = n & 127, hh = (n % DA) >> 7; const bool isq = n < DA;
            const int i = e & 63; const float inv = powf(10000.0f, -(float)i / 64.0f);
#pragma unroll
            for (int r = 0; r < 16; ++r) { const int t = r0 + r, b = t / S, s = t % S;
                const float ang = (float)p.pos[t] * inv; const float cs = cosf(ang), sn = sinf(ang);
                const float other = xch[r * 512 + (tid ^ 64)];
                float val = (e < 64) ? (acc[r] * cs - other * sn) : (acc[r] * cs + other * sn);
                if (isq) val *= 0.08838834764831845f;
                (isq ? qb : kb)[((size_t)(b * HA + hh) * S + s) * E + e] = f2bf(val); }
        } else if (n < 4608) {
            const int e = n & 127, hh = (n - 3072) >> 7;
#pragma unroll
            for (int r = 0; r < 16; ++r) { const int t = r0 + r, b = t / S, s = t % S; vb[((size_t)(b * HA + hh) * S + s) * E + e] = f2bf(acc[r]); }
        } else if (n < 5120) {
#pragma unroll
            for (int r = 0; r < 16; ++r) usb[(size_t)(r0 + r) * DS + (n - 4608)] = f2bf(gelu_erf(acc[r]));
        } else {
#pragma unroll
            for (int r = 0; r < 16; ++r) vsb[(size_t)(r0 + r) * DS + (n - 5120)] = f2bf(gelu_erf(acc[r]));
        }
    }
}
__device__ void phase_gemm2_naive(const Params& p, unsigned char* lds) {
    const int tid = threadIdx.x;
    const bf16_t* A = (const bf16_t*)(p.ws + OFF_QKV);
    const int nitems = (T / 16) * (D / 512);
    for (int it = blockIdx.x; it < nitems; it += gridDim.x) {
        const int cbk = it % (D / 512), rb = it / (D / 512), r0 = rb * 16, c0 = cbk * 512;
        NAIVE_GEMM_BODY(A, p.w_out, D, r0, c0)
        const int n = c0 + tid;
#pragma unroll
        for (int r = 0; r < 16; ++r) { const int t = r0 + r, b = t / S; p.out[(size_t)t * D + n] = p.x[(size_t)t * D + n] + mod1(p, b, 2, n) * acc[r]; }
    }
}
__device__ void phase_gemm3_naive(const Params& p, unsigned char* lds) {
    const int tid = threadIdx.x;
    const bf16_t* A = (const bf16_t*)(p.ws + OFF_A);
    bf16_t* pq = (bf16_t*)(p.ws + OFF_QKV + (size_t)T * D * 2);
    const int nitems = (T / 16) * (D / 512);
    for (int it = blockIdx.x; it < nitems; it += gridDim.x) {
        const int cbk = it % (D / 512), rb = it / (D / 512), r0 = rb * 16, c0 = cbk * 512;
        NAIVE_GEMM_BODY(A, p.peer_w_q, D, r0, c0)
        const int n = c0 + tid;
#pragma unroll
        for (int r = 0; r < 16; ++r) pq[(size_t)(r0 + r) * D + n] = f2bf(acc[r]);
    }
}

__device__ void phase_attn_naive(const Params& p, unsigned char* lds) {
    const int lane = threadIdx.x & 63, wave = threadIdx.x >> 6, gw = blockIdx.x * NWV + wave, nw = gridDim.x * NWV;
    float* ql = (float*)lds + wave * 128;
    const bf16_t* qb = (const bf16_t*)(p.ws + OFF_QKV); const bf16_t* kb = (const bf16_t*)(p.ws + OFF_QKV + QKV_ONE); const bf16_t* vb = (const bf16_t*)(p.ws + OFF_QKV + 2 * QKV_ONE);
    float* lse = (float*)(p.ws + OFF_LSE);
    for (int item = gw; item < NB * HA * S; item += nw) {
        const int t = item % S, h = (item / S) % HA, b = item / (S * HA);
        const size_t hb = (size_t)(b * HA + h) * S;
        { const unsigned w = *(const unsigned*)(qb + (hb + t) * E + 2 * lane); ql[2 * lane] = bflo(w); ql[2 * lane + 1] = bfhi(w); }
        __builtin_amdgcn_wave_barrier();
#pragma unroll 1
        for (int pat = 0; pat < 3; ++pat) {
            const int d = pat == 0 ? 1 : (pat == 1 ? 4 : 16);
            const int imax = min(128, t / d);
            float sc[3];
#pragma unroll
            for (int sl = 0; sl < 3; ++sl) { const int i = sl * 64 + lane; float s = -__builtin_inff();
                if (i <= imax) { const u32x4* kr = (const u32x4*)(kb + (hb + (t - i * d)) * E); s = 0.f;
                    for (int c8 = 0; c8 < 16; ++c8) { const u32x4 kk = kr[c8]; const float* qq = ql + c8 * 8;
                        s += qq[0] * bflo(kk.x) + qq[1] * bfhi(kk.x) + qq[2] * bflo(kk.y) + qq[3] * bfhi(kk.y) + qq[4] * bflo(kk.z) + qq[5] * bfhi(kk.z) + qq[6] * bflo(kk.w) + qq[7] * bfhi(kk.w); } }
                sc[sl] = s; }
            const float m = wave_max(fmaxf(sc[0], fmaxf(sc[1], sc[2])));
            float pr[3]; float l = 0.f;
#pragma unroll
            for (int sl = 0; sl < 3; ++sl) { pr[sl] = __expf(sc[sl] - m); l += pr[sl]; }
            l = wave_sum(l);
            float o0 = 0.f, o1 = 0.f;
            for (int i = 0; i <= imax; ++i) { const float pv = __shfl(i < 64 ? pr[0] : (i < 128 ? pr[1] : pr[2]), i & 63);
                const unsigned w = *(const unsigned*)(vb + (hb + (t - i * d)) * E + 2 * lane); o0 += pv * bflo(w); o1 += pv * bfhi(w); }
            const float il = 1.0f / l; const size_t tg = (size_t)b * S + t;
            *(unsigned*)(P_opat(p, pat) + tg * DA + h * E + 2 * lane) = pack2(o0 * il, o1 * il);
            if (lane == 0) lse[((size_t)pat * T + tg) * HA + h] = m + __logf(l);
        }
        __builtin_amdgcn_wave_barrier();
    }
}

__device__ void phase_sgu_ln_naive(const Params& p) {
    const int lane = threadIdx.x & 63, gw = blockIdx.x * NWV + (threadIdx.x >> 6), nw = gridDim.x * NWV;
    bf16_t* vsb = (bf16_t*)(p.ws + OFF_VS);
    for (int item = gw; item < T * HS; item += nw) {
        const int t = item / HS, h = item % HS;
        unsigned* ptr = (unsigned*)(vsb + (size_t)t * DS + h * E + 2 * lane);
        const unsigned w = *ptr; const float a = bflo(w), b = bfhi(w);
        const float mu = wave_sum(a + b) * (1.0f / E); const float da = a - mu, db = b - mu;
        const float var = wave_sum(da * da + db * db) * (1.0f / E); const float rs = rsqrtf(var + 1e-5f);
        const int e = 2 * lane;
        *ptr = pack2(da * rs * p.sgu_ln_g[h * E + e] + p.sgu_ln_b[h * E + e], db * rs * p.sgu_ln_g[h * E + e + 1] + p.sgu_ln_b[h * E + e + 1]);
    }
}
__device__ void phase_sgu_mix_naive(const Params& p) {
    const int tid = threadIdx.x;
    const bf16_t* vnb = (const bf16_t*)(p.ws + OFF_VS); const bf16_t* usb = (const bf16_t*)(p.ws + OFF_US); bf16_t* ob = (bf16_t*)(p.ws + OFF_SGUO);
    for (int t = blockIdx.x; t < T; t += gridDim.x) {
        const int h = tid >> 7, e = tid & 127, i = t & 127, t0 = t - i;
        float acc = 0.f;
        for (int j = 0; j <= i; ++j) acc += p.sgu_w[(h * 128 + i) * 128 + j] * bf2f(vnb[(size_t)(t0 + j) * DS + tid]);
        acc += p.sgu_b[h * 128 + i];
        ob[(size_t)t * DS + tid] = f2bf(bf2f(usb[(size_t)t * DS + tid]) * acc);
        (void)e;
    }
}

__device__ void phase_combine(const Params& p) {
    const int lane = threadIdx.x & 63, gw = blockIdx.x * NWV + (threadIdx.x >> 6), nw = gridDim.x * NWV;
    const float* lse = (const float*)(p.ws + OFF_LSE);
    const bf16_t* sg = (const bf16_t*)(p.ws + OFF_SGUO); bf16_t* mixed = (bf16_t*)(p.ws + OFF_QKV);
    for (int t = gw; t < T; t += nw) {
        float w0 = 0.f, w1 = 0.f, w2 = 0.f;
        if (lane < HA) { const float l0 = lse[((size_t)0 * T + t) * HA + lane], l1 = lse[((size_t)1 * T + t) * HA + lane], l2 = lse[((size_t)2 * T + t) * HA + lane];
            const float m = fmaxf(l0, fmaxf(l1, l2)); const float e0 = __expf(l0 - m), e1 = __expf(l1 - m), e2 = __expf(l2 - m); const float is = 1.0f / (e0 + e1 + e2);
            w0 = e0 * is; w1 = e1 * is; w2 = e2 * is; }
        float av[3][8]; float ss = 0.f;
#pragma unroll
        for (int i = 0; i < 3; ++i) { const int col0 = (lane + 64 * i) * 8, hh = col0 >> 7;
            const float a0 = __shfl(w0, hh), a1 = __shfl(w1, hh), a2 = __shfl(w2, hh);
            const u32x4 x0 = *(const u32x4*)(P_opat(p, 0) + (size_t)t * DA + col0), x1 = *(const u32x4*)(P_opat(p, 1) + (size_t)t * DA + col0), x2 = *(const u32x4*)(P_opat(p, 2) + (size_t)t * DA + col0);
            av[i][0] = a0 * bflo(x0.x) + a1 * bflo(x1.x) + a2 * bflo(x2.x); av[i][1] = a0 * bfhi(x0.x) + a1 * bfhi(x1.x) + a2 * bfhi(x2.x);
            av[i][2] = a0 * bflo(x0.y) + a1 * bflo(x1.y) + a2 * bflo(x2.y); av[i][3] = a0 * bfhi(x0.y) + a1 * bfhi(x1.y) + a2 * bfhi(x2.y);
            av[i][4] = a0 * bflo(x0.z) + a1 * bflo(x1.z) + a2 * bflo(x2.z); av[i][5] = a0 * bfhi(x0.z) + a1 * bfhi(x1.z) + a2 * bfhi(x2.z);
            av[i][6] = a0 * bflo(x0.w) + a1 * bflo(x1.w) + a2 * bflo(x2.w); av[i][7] = a0 * bfhi(x0.w) + a1 * bfhi(x1.w) + a2 * bfhi(x2.w);
#pragma unroll
            for (int j = 0; j < 8; ++j) ss += av[i][j] * av[i][j]; }
        ss = wave_sum(ss); const float rs = rsqrtf(ss * (1.0f / DA) + 1e-6f);
#pragma unroll
        for (int i = 0; i < 3; ++i) { const int col0 = (lane + 64 * i) * 8; const float4 g0 = *(const float4*)(p.g_attn_out + col0), g1 = *(const float4*)(p.g_attn_out + col0 + 4);
            u32x4 w; w.x = pack2(av[i][0] * rs * g0.x, av[i][1] * rs * g0.y); w.y = pack2(av[i][2] * rs * g0.z, av[i][3] * rs * g0.w);
            w.z = pack2(av[i][4] * rs * g1.x, av[i][5] * rs * g1.y); w.w = pack2(av[i][6] * rs * g1.z, av[i][7] * rs * g1.w);
            *(u32x4*)(mixed + (size_t)t * D + col0) = w; }
        { const int col0 = lane * 8; const u32x4 xs = *(const u32x4*)(sg + (size_t)t * DS + col0);
          float sv[8] = {bflo(xs.x), bfhi(xs.x), bflo(xs.y), bfhi(xs.y), bflo(xs.z), bfhi(xs.z), bflo(xs.w), bfhi(xs.w)}; float s2 = 0.f;
#pragma unroll
          for (int j = 0; j < 8; ++j) s2 += sv[j] * sv[j];
          s2 = wave_sum(s2); const float r2 = rsqrtf(s2 * (1.0f / DS) + 1e-6f);
          const float4 g0 = *(const float4*)(p.g_sgu_out + col0), g1 = *(const float4*)(p.g_sgu_out + col0 + 4);
          u32x4 w; w.x = pack2(sv[0] * r2 * g0.x, sv[1] * r2 * g0.y); w.y = pack2(sv[2] * r2 * g0.z, sv[3] * r2 * g0.w);
          w.z = pack2(sv[4] * r2 * g1.x, sv[5] * r2 * g1.y); w.w = pack2(sv[6] * r2 * g1.z, sv[7] * r2 * g1.w);
          *(u32x4*)(mixed + (size_t)t * D + DA + col0) = w; }
    }
}

__device__ void phase_topk_naive(const Params& p, unsigned char* lds) {
    const int lane = threadIdx.x & 63, wave = threadIdx.x >> 6, gw = blockIdx.x * NWV + wave, nw = gridDim.x * NWV;
    float* ql = (float*)lds + wave * 256;
    const bf16_t* pq = (const bf16_t*)(p.ws + OFF_QKV + (size_t)T * D * 2);
    int* idxo = (int*)(p.ws + OFF_IDX); float* gato = (float*)(p.ws + OFF_GATE);
    const float NEG = -__builtin_inff();
    for (int item = gw; item < T * PH; item += nw) {
        const int t = item / PH, h = item % PH;
        { const u32x2 w = *(const u32x2*)(pq + (size_t)t * D + h * 256 + 4 * lane); ql[4 * lane] = bflo(w.x); ql[4 * lane + 1] = bfhi(w.x); ql[4 * lane + 2] = bflo(w.y); ql[4 * lane + 3] = bfhi(w.y); }
        __builtin_amdgcn_wave_barrier();
        float ts[2]; int ti[2];
#pragma unroll
        for (int pp = 0; pp < 2; ++pp) {
            const float* k0 = p.peer_sub_keys + ((size_t)(h * 2 + pp) * 128 + lane) * 128; const float* k1 = k0 + 64 * 128; const float* qq = ql + pp * 128;
            float s0 = 0.f, s1 = 0.f;
            for (int c = 0; c < 128; c += 4) { const float4 a = *(const float4*)(k0 + c), b = *(const float4*)(k1 + c);
                s0 += qq[c] * a.x + qq[c + 1] * a.y + qq[c + 2] * a.z + qq[c + 3] * a.w; s1 += qq[c] * b.x + qq[c + 1] * b.y + qq[c + 2] * b.z + qq[c + 3] * b.w; }
            float tsv = 0.f; int tiv = 0;
            for (int r = 0; r < PK; ++r) { const float m = wave_max(fmaxf(s0, s1));
                const int cand = (s0 == m) ? lane : ((s1 == m) ? lane + 64 : 1000); const int key = wave_min_i(cand);
                if (lane == r) { tsv = m; tiv = key; }
                if (key == lane) s0 = NEG; if (key == lane + 64) s1 = NEG; }
            ts[pp] = tsv; ti[pp] = tiv; }
        float cs[4]; const int ci = lane >> 2, cj = (lane & 3) * 4; const float a = __shfl(ts[0], ci);
#pragma unroll
        for (int m = 0; m < 4; ++m) cs[m] = a + __shfl(ts[1], cj + m);
        float bs = 0.f; int bpos = 0;
        for (int r = 0; r < PK; ++r) { const float m = wave_max(fmaxf(fmaxf(cs[0], cs[1]), fmaxf(cs[2], cs[3])));
            int cand = 1000;
#pragma unroll
            for (int mm = 3; mm >= 0; --mm) if (cs[mm] == m) cand = ci * 16 + cj + mm;
            const int pos = wave_min_i(cand);
            if (lane == r) { bs = m; bpos = pos; }
#pragma unroll
            for (int mm = 0; mm < 4; ++mm) if (pos == ci * 16 + cj + mm) cs[mm] = NEG; }
        const int e1 = __shfl(ti[0], (bpos >> 4) & 15), e2 = __shfl(ti[1], bpos & 15);
        const float m0 = __shfl(bs, 0); const float ex = lane < PK ? __expf(bs - m0) : 0.f; const float sum = wave_sum(ex);
        if (lane < PK) { idxo[(size_t)t * 128 + h * PK + lane] = e1 * 128 + e2; gato[(size_t)t * 128 + h * PK + lane] = ex / sum; }
        __builtin_amdgcn_wave_barrier();
    }
}

__device__ void phase_gather(const Params& p) {
    const int lane = threadIdx.x & 63, gw = blockIdx.x * NWV + (threadIdx.x >> 6), nw = gridDim.x * NWV;
    const bf16_t* hn2 = (const bf16_t*)(p.ws + OFF_A); const bf16_t* ut = (const bf16_t*)(p.ws + OFF_UTAB); const bf16_t* vt = (const bf16_t*)(p.ws + OFF_VTAB);
    const int* idx = (const int*)(p.ws + OFF_IDX); const float* gate = (const float*)(p.ws + OFF_GATE);
    for (int t = gw; t < T; t += nw) {
        float xf[32], acc[32];
#pragma unroll
        for (int c = 0; c < 4; ++c) { const u32x4 w = *(const u32x4*)(hn2 + (size_t)t * D + c * 512 + lane * 8);
            xf[c * 8 + 0] = bflo(w.x); xf[c * 8 + 1] = bfhi(w.x); xf[c * 8 + 2] = bflo(w.y); xf[c * 8 + 3] = bfhi(w.y); xf[c * 8 + 4] = bflo(w.z); xf[c * 8 + 5] = bfhi(w.z); xf[c * 8 + 6] = bflo(w.w); xf[c * 8 + 7] = bfhi(w.w); }
#pragma unroll
        for (int j = 0; j < 32; ++j) acc[j] = 0.f;
#pragma unroll 2
        for (int n = 0; n < 128; ++n) {
            const int e = __builtin_amdgcn_readfirstlane(idx[(size_t)t * 128 + n]); const float g = gate[(size_t)t * 128 + n];
            const bf16_t* ur = ut + (size_t)e * D; const bf16_t* vr = vt + (size_t)e * D;
            u32x4 uw[4], vw[4];
#pragma unroll
            for (int c = 0; c < 4; ++c) { uw[c] = *(const u32x4*)(ur + c * 512 + lane * 8); vw[c] = *(const u32x4*)(vr + c * 512 + lane * 8); }
            float dsum = 0.f;
#pragma unroll
            for (int c = 0; c < 4; ++c) dsum += xf[c * 8 + 0] * bflo(uw[c].x) + xf[c * 8 + 1] * bfhi(uw[c].x) + xf[c * 8 + 2] * bflo(uw[c].y) + xf[c * 8 + 3] * bfhi(uw[c].y)
                                              + xf[c * 8 + 4] * bflo(uw[c].z) + xf[c * 8 + 5] * bfhi(uw[c].z) + xf[c * 8 + 6] * bflo(uw[c].w) + xf[c * 8 + 7] * bfhi(uw[c].w);
            dsum = wave_sum(dsum);
            const float w = g * gelu_erf(dsum);
#pragma unroll
            for (int c = 0; c < 4; ++c) { acc[c * 8 + 0] += w * bflo(vw[c].x); acc[c * 8 + 1] += w * bfhi(vw[c].x); acc[c * 8 + 2] += w * bflo(vw[c].y); acc[c * 8 + 3] += w * bfhi(vw[c].y);
                acc[c * 8 + 4] += w * bflo(vw[c].z); acc[c * 8 + 5] += w * bfhi(vw[c].z); acc[c * 8 + 6] += w * bflo(vw[c].w); acc[c * 8 + 7] += w * bfhi(vw[c].w); }
        }
        const int b = t / S; float* hrow = p.out + (size_t)t * D; float ss = 0.f;
#pragma unroll
        for (int c = 0; c < 4; ++c) { const int col = c * 512 + lane * 8;
            const float4 h0 = *(const float4*)(hrow + col), h1 = *(const float4*)(hrow + col + 4);
            const float4 g0 = mod4(p, b, 5, col), g1 = mod4(p, b, 5, col + 4);
            acc[c * 8 + 0] = h0.x + g0.x * acc[c * 8 + 0]; acc[c * 8 + 1] = h0.y + g0.y * acc[c * 8 + 1]; acc[c * 8 + 2] = h0.z + g0.z * acc[c * 8 + 2]; acc[c * 8 + 3] = h0.w + g0.w * acc[c * 8 + 3];
            acc[c * 8 + 4] = h1.x + g1.x * acc[c * 8 + 4]; acc[c * 8 + 5] = h1.y + g1.y * acc[c * 8 + 5]; acc[c * 8 + 6] = h1.z + g1.z * acc[c * 8 + 6]; acc[c * 8 + 7] = h1.w + g1.w * acc[c * 8 + 7];
#pragma unroll
            for (int j = 0; j < 8; ++j) ss += acc[c * 8 + j] * acc[c * 8 + j]; }
        ss = wave_sum(ss); const float rs = rsqrtf(ss * (1.0f / D) + 1e-6f);
#pragma unroll
        for (int c = 0; c < 4; ++c) { const int col = c * 512 + lane * 8;
            const float4 g0 = *(const float4*)(p.g_final + col), g1 = *(const float4*)(p.g_final + col + 4);
            *(float4*)(hrow + col) = make_float4(acc[c * 8 + 0] * rs * g0.x, acc[c * 8 + 1] * rs * g0.y, acc[c * 8 + 2] * rs * g0.z, acc[c * 8 + 3] * rs * g0.w);
            *(float4*)(hrow + col + 4) = make_float4(acc[c * 8 + 4] * rs * g1.x, acc[c * 8 + 5] * rs * g1.y, acc[c * 8 + 6] * rs * g1.z, acc[c * 8 + 7] * rs * g1.w); }
    }
}

constexpr int LDS_BYTES = 131072;
template <int PHASE> __global__ void __launch_bounds__(NTHR, 2) k_phase(Params p) {
    extern __shared__ __attribute__((aligned(16))) unsigned char lds[];
    if (PHASE == 0) phase_conv(p, lds);
    if (PHASE == 1) phase_norm_mod(p, p.x, p.g_norm1, 0, 1, (bf16_t*)(p.ws + OFF_A));
    if (PHASE == 2) phase_gemm1_naive(p, lds);
    if (PHASE == 3) { phase_attn_naive(p, lds); phase_sgu_ln_naive(p); }
    if (PHASE == 4) phase_sgu_mix_naive(p);
    if (PHASE == 5) phase_combine(p);
    if (PHASE == 6) phase_gemm2_naive(p, lds);
    if (PHASE == 7) phase_norm_mod(p, p.out, p.g_norm2, 3, 4, (bf16_t*)(p.ws + OFF_A));
    if (PHASE == 8) phase_gemm3_naive(p, lds);
    if (PHASE == 9) phase_topk_naive(p, lds);
    if (PHASE == 10) phase_gather(p);
}

__global__ void __launch_bounds__(NTHR, 2) k_mega(Params p) {
    extern __shared__ __attribute__((aligned(16))) unsigned char lds[];
    cg::grid_group grid = cg::this_grid();
    phase_conv(p, lds); grid.sync();
    phase_norm_mod(p, p.x, p.g_norm1, 0, 1, (bf16_t*)(p.ws + OFF_A)); grid.sync();
    phase_gemm1_naive(p, lds); grid.sync();
    phase_attn_naive(p, lds); phase_sgu_ln_naive(p); grid.sync();
    phase_sgu_mix_naive(p); grid.sync();
    phase_combine(p); grid.sync();
    phase_gemm2_naive(p, lds); grid.sync();
    phase_norm_mod(p, p.out, p.g_norm2, 3, 4, (bf16_t*)(p.ws + OFF_A)); grid.sync();
    phase_gemm3_naive(p, lds); grid.sync();
    phase_topk_naive(p, lds); grid.sync();
    phase_gather(p);
}

#ifndef MEGA
#define MEGA 1
#endif
template <int PHASE> static void launch_phase(const Params& p, int grid, hipStream_t stream) {
    static bool attr = false;
    if (!attr) { (void)hipFuncSetAttribute((const void*)k_phase<PHASE>, hipFuncAttributeMaxDynamicSharedMemorySize, LDS_BYTES); attr = true; }
    hipLaunchKernelGGL(k_phase<PHASE>, dim3(grid), dim3(NTHR), LDS_BYTES, stream, p);
}

extern "C" void kernel_launch(void* const* d_in, const int* in_sizes, int n_in, void* d_out, int out_size, void* d_ws, size_t ws_size, hipStream_t stream) {
    if (n_in != 20 || out_size != T * D || ws_size < WS_END) { fprintf(stderr, "kernel_launch: unexpected problem (n_in %d out %d ws %zu, need %zu)\n", n_in, out_size, ws_size, (size_t)WS_END); return; }
    Params p{};
    p.x = (const float*)d_in[0]; p.c = (const float*)d_in[1]; p.pos = (const int*)d_in[2]; p.w_ada = (const float*)d_in[3]; p.b_ada = (const float*)d_in[4];
    p.g_norm1 = (const float*)d_in[5]; p.w_in = (const float*)d_in[6]; p.g_attn_out = (const float*)d_in[7]; p.g_sgu_out = (const float*)d_in[8];
    p.sgu_w = (const float*)d_in[9]; p.sgu_b = (const float*)d_in[10]; p.sgu_ln_g = (const float*)d_in[11]; p.sgu_ln_b = (const float*)d_in[12];
    p.w_out = (const float*)d_in[13]; p.g_norm2 = (const float*)d_in[14]; p.peer_w_q = (const float*)d_in[15]; p.peer_sub_keys = (const float*)d_in[16];
    p.peer_u = (const float*)d_in[17]; p.peer_v = (const float*)d_in[18]; p.g_final = (const float*)d_in[19];
    p.out = (float*)d_out; p.ws = (unsigned char*)d_ws;
    (void)hipMemsetAsync((char*)d_ws + OFF_CTL, 0, OFF_SGUW - OFF_CTL, stream);
#if MEGA
    static int grid_blocks = 0;
    if (!grid_blocks) {
        int dev = 0, cus = 0, per_cu = 0;
        (void)hipGetDevice(&dev); (void)hipDeviceGetAttribute(&cus, hipDeviceAttributeMultiprocessorCount, dev);
        (void)hipFuncSetAttribute((const void*)k_mega, hipFuncAttributeMaxDynamicSharedMemorySize, LDS_BYTES);
        (void)hipOccupancyMaxActiveBlocksPerMultiprocessor(&per_cu, (const void*)k_mega, NTHR, LDS_BYTES);
        if (per_cu < 1) { fprintf(stderr, "kernel_launch: occupancy query says %d blocks per CU\n", per_cu); per_cu = 1; }
        if (per_cu > 1) per_cu = 1;
        grid_blocks = cus * per_cu;
    }
    void* args[] = {(void*)&p};
    hipError_t e = hipLaunchCooperativeKernel((const void*)k_mega, dim3(grid_blocks), dim3(NTHR), args, LDS_BYTES, stream);
    if (e != hipSuccess) fprintf(stderr, "cooperative launch failed: %s (grid %d)\n", hipGetErrorString(e), grid_blocks);
#else
    const int grid = 256;
    launch_phase<0>(p, grid, stream); launch_phase<1>(p, grid, stream); launch_phase<2>(p, grid, stream); launch_phase<3>(p, grid, stream);
    launch_phase<4>(p, grid, stream); launch_phase<5>(p, grid, stream); launch_phase<6>(p, grid, stream); launch_phase<7>(p, grid, stream);
    launch_phase<8>(p, grid, stream); launch_phase<9>(p, grid, stream); launch_phase<10>(p, grid, stream);
#endif
}
```

```cpp
#include <hip/hip_runtime.h>
#include <hip/hip_cooperative_groups.h>
#include <cstdio>
#include <cstdint>
namespace cg = cooperative_groups;

constexpr int D = 2048, NB = 4, S = 4096, T = NB * S;
constexpr int E = 128, HA = 12, HS = 4, DA = 1536, DS = 512, DIN = 5632;
constexpr int PH = 8, PK = 16, NEXP = 16384;
constexpr int NTHR = 512, NWV = 8;

typedef unsigned short bf16_t;
typedef unsigned u32x4 __attribute__((ext_vector_type(4)));
typedef unsigned u32x2 __attribute__((ext_vector_type(2)));
typedef float f32x4 __attribute__((ext_vector_type(4)));

__device__ __forceinline__ bf16_t f2bf(float f) { unsigned u = __float_as_uint(f); u += 0x7FFFu + ((u >> 16) & 1u); return (bf16_t)(u >> 16); }
__device__ __forceinline__ float bf2f(bf16_t b) { return __uint_as_float(((unsigned)b) << 16); }
__device__ __forceinline__ unsigned pack2(float lo, float hi) { return (unsigned)f2bf(lo) | ((unsigned)f2bf(hi) << 16); }
__device__ __forceinline__ float bflo(unsigned w) { return __uint_as_float(w << 16); }
__device__ __forceinline__ float bfhi(unsigned w) { return __uint_as_float(w & 0xffff0000u); }
__device__ __forceinline__ float wave_sum(float v) {
#pragma unroll
    for (int o = 32; o >= 1; o >>= 1) v += __shfl_xor(v, o);
    return v; }
__device__ __forceinline__ float wave_max(float v) {
#pragma unroll
    for (int o = 32; o >= 1; o >>= 1) v = fmaxf(v, __shfl_xor(v, o));
    return v; }
__device__ __forceinline__ int wave_min_i(int v) {
#pragma unroll
    for (int o = 32; o >= 1; o >>= 1) v = min(v, __shfl_xor(v, o));
    return v; }
__device__ __forceinline__ float gelu_erf(float v) { return 0.5f * v * (1.0f + erff(v * 0.70710678118654752f)); }

constexpr size_t OFF_CTL  = 0;
constexpr size_t OFF_MOD  = 65536;
constexpr size_t OFF_SGUW = OFF_MOD + 393216;
constexpr size_t OFF_SUBK = OFF_SGUW + 131072;
constexpr size_t OFF_LSE  = OFF_SUBK + 524288;
constexpr size_t OFF_IDX  = OFF_LSE + (size_t)3 * T * 12 * 4;
constexpr size_t OFF_GATE = OFF_IDX + (size_t)T * 128 * 4;
constexpr size_t OFF_WIN  = OFF_GATE + (size_t)T * 128 * 4;
constexpr size_t OFF_WOUT = OFF_WIN + (size_t)DIN * D * 2;
constexpr size_t OFF_WQ   = OFF_WOUT + (size_t)D * D * 2;
constexpr size_t OFF_UTAB = OFF_WQ + (size_t)D * D * 2;
constexpr size_t OFF_VTAB = OFF_UTAB + (size_t)NEXP * D * 2;
constexpr size_t OFF_A    = OFF_VTAB + (size_t)NEXP * D * 2;
constexpr size_t OFF_QKV  = OFF_A + (size_t)T * D * 2;
constexpr size_t QKV_ONE  = (size_t)T * DA * 2;
constexpr size_t OFF_US   = OFF_QKV + 3 * QKV_ONE;
constexpr size_t OFF_VS   = OFF_US + (size_t)T * DS * 2;
constexpr size_t OFF_SGUO = OFF_VS + (size_t)T * DS * 2;
constexpr size_t OFF_O12  = OFF_SGUO + (size_t)T * DS * 2;
constexpr size_t WS_END   = OFF_O12 + 2 * QKV_ONE;

struct Params {
    const float* x; const float* c; const int* pos; const float* w_ada; const float* b_ada; const float* g_norm1; const float* w_in;
    const float* g_attn_out; const float* g_sgu_out; const float* sgu_w; const float* sgu_b; const float* sgu_ln_g; const float* sgu_ln_b;
    const float* w_out; const float* g_norm2; const float* peer_w_q; const float* peer_sub_keys; const float* peer_u; const float* peer_v;
    const float* g_final; float* out; unsigned char* ws;
};
__device__ __forceinline__ float mod1(const Params& p, int b, int i, int col) { const long long v = ((const long long*)(p.ws + OFF_MOD))[b * 12288 + i * D + col]; return (float)((double)v * 2.3283064365386963e-10); }
__device__ __forceinline__ float4 mod4(const Params& p, int b, int i, int col) { return make_float4(mod1(p, b, i, col), mod1(p, b, i, col + 1), mod1(p, b, i, col + 2), mod1(p, b, i, col + 3)); }
__device__ __forceinline__ bf16_t* P_opat(const Params& p, int pat) { return (bf16_t*)(pat == 0 ? p.ws + OFF_A : p.ws + OFF_O12 + (size_t)(pat - 1) * QKV_ONE); }

namespace pg8 {
#define PG8_LAS __attribute__((address_space(3)))
typedef unsigned short bf16_t;
typedef short bf16x8 __attribute__((ext_vector_type(8)));
typedef float f32x4 __attribute__((ext_vector_type(4)));
typedef unsigned u32x4 __attribute__((ext_vector_type(4)));
constexpr int BM = 256, BK = 64, HALF = 128, HTB = HALF * BK * 2  , STAGE_BYTES = 8 * HTB, NXCD = 8, WGM = 8;

__host__ __device__ __forceinline__ int lds_byte(int r, int c) { const int st = (r >> 4) * 2 + (c >> 5), rr = r & 15, cc = c & 31, ob = rr * 64 + cc * 2; return st * 1024 + (ob ^ (((ob >> 9) & 1) << 5)); }
__host__ __device__ __forceinline__ void stage_rc(int b, int& R, int& C) { const int st = b / 1024, sb = b % 1024, swz = sb ^ (((sb >> 9) & 1) << 5); R = (st >> 1) * 16 + swz / 64; C = (st & 1) * 32 + (swz % 64) / 2; }
__host__ __device__ __forceinline__ int perm32(int rho) { const int n = rho >> 4, i = rho & 15; return 8 * (i >> 2) + 4 * n + (i & 3); }

struct Unit { int pm, pn; };
struct Gemm { const bf16_t* A; const bf16_t* Bt; int M, N, K; };

struct StaticOrder {
    int nM, nN, nwg, G, c;
    __host__ __device__ void init(int M, int N, int G_, int c_) { nM = M / BM; nN = N / BM; nwg = nM * nN; G = G_; c = c_; }
    __host__ __device__ bool next(int i, Unit& u) const {
        const long L = (long)i * G + c; if (L >= nwg) return false;
        int wgid = (int)L; { const int q = nwg / NXCD, r = nwg % NXCD, xcd = wgid % NXCD, off = wgid / NXCD; wgid = (xcd < r ? xcd * (q + 1) : r * (q + 1) + (xcd - r) * q) + off; }
        const int nig = WGM * nN, gid = wgid / nig, fm = gid * WGM, gsz = (nM - fm) < WGM ? (nM - fm) : WGM;
        u.pm = fm + ((wgid % nig) % gsz); u.pn = (wgid % nig) / gsz; return true;
    }
    __device__ __forceinline__ void a_ready(const Unit&) const {}
    __device__ __forceinline__ void done(const Unit&) const {}
};

__device__ __forceinline__ unsigned cvt_pk_bf16(float lo, float hi) { unsigned r; asm volatile("v_cvt_pk_bf16_f32 %0, %1, %2" : "=v"(r) : "v"(lo), "v"(hi)); return r; }
typedef float f32x2 __attribute__((ext_vector_type(2)));
__device__ __forceinline__ f32x2 gelu_pk(f32x2 v) {
    const f32x2 av = __builtin_elementwise_abs(v), d = av * 0.2316418882f + 1.0f;
    f32x2 t; t.x = __builtin_amdgcn_rcpf(d.x); t.y = __builtin_amdgcn_rcpf(d.y);
    f32x2 q = t * 0.5307027145f + (-0.7265760135f); q = q * t + 0.7107068705f; q = q * t + (-0.142248368f); q = q * t + 0.127414796f; q = q * t;
    const f32x2 s = (v * v) * (-0.72134752044f);
    f32x2 e; e.x = __builtin_amdgcn_exp2f(s.x); e.y = __builtin_amdgcn_exp2f(s.y);
    const f32x2 m = v * (q * e), r = v - m;
    f32x2 o; o.x = v.x < 0.f ? m.x : r.x; o.y = v.y < 0.f ? m.y : r.y; return o;
}

template <class Epi, class Sched, bool ALIGN_EPI = false, bool SP2 = false>
__device__ __forceinline__ void gemm_phase(PG8_LAS unsigned char* lds, const Gemm g, const Sched& S, const Epi& E) {
    const int tid = threadIdx.x, wid = __builtin_amdgcn_readfirstlane(tid >> 6), lane = tid & 63, wr = wid >> 2, wc = wid & 3, fr = lane & 15, fq = lane >> 4;
    const int K = g.K, nt = K / BK;
    unsigned voffA[2], voffB[2];
#pragma unroll
    for (int i = 0; i < 2; ++i) { int R, C; stage_rc(tid * 16 + i * 8192, R, C); const int Rb = Epi::PERM ? ((R & ~31) + perm32(R & 31)) : R;
        voffA[i] = (unsigned)(R * K + C) * 2u; voffB[i] = (unsigned)(Rb * K + C) * 2u; }
    const size_t kstep = (size_t)(BK * 2);
    const size_t hstep = (size_t)HALF * K * 2;
    const size_t tstep = 2 * hstep;
    const unsigned ldsw = (unsigned)wid * 1024u;
    const int aoff = lds_byte(wr * 64 + fr, fq * 8), boff = lds_byte(wc * 32 + fr, fq * 8);
#define PG8_SA(b, h) (((b) * 2 + (h)) * HTB)
#define PG8_SB(b, h) ((4 + (b) * 2 + (h)) * HTB)
#define PG8_STAGE(bufoff, gbase, voff) do { _Pragma("unroll") for (int _i = 0; _i < 2; ++_i) \
        __builtin_amdgcn_global_load_lds((const unsigned*)((const char*)(gbase) + (voff)[_i]), (PG8_LAS unsigned*)(lds + (bufoff) + ldsw + _i * 8192), 16, 0, 0); } while (0)
#define PG8_LDA(dst, b, h) do { _Pragma("unroll") for (int m = 0; m < 4; ++m) _Pragma("unroll") for (int k = 0; k < 2; ++k) dst[m][k] = *(const PG8_LAS bf16x8*)(lds + PG8_SA(b, h) + aoff + m * 2048 + k * 1024); } while (0)
#define PG8_LDB(dst, b, h) do { _Pragma("unroll") for (int n = 0; n < 2; ++n) _Pragma("unroll") for (int k = 0; k < 2; ++k) dst[n][k] = *(const PG8_LAS bf16x8*)(lds + PG8_SB(b, h) + boff + n * 2048 + k * 1024); } while (0)
#define PG8_MMA(ai, bj, At, Bt) do { __builtin_amdgcn_s_setprio(1); _Pragma("unroll") for (int m = 0; m < 4; ++m) _Pragma("unroll") for (int n = 0; n < 2; ++n) _Pragma("unroll") for (int k = 0; k < 2; ++k) \
        acc[ai][bj][m][n] = __builtin_amdgcn_mfma_f32_16x16x32_bf16(Bt[n][k], At[m][k], acc[ai][bj][m][n], 0, 0, 0); __builtin_amdgcn_s_setprio(0); } while (0)
#define PG8_WAIT_V(n) asm volatile("s_waitcnt vmcnt(" #n ")" ::: "memory")
#define PG8_WAIT_L(n) asm volatile("s_waitcnt lgkmcnt(" #n ")" ::: "memory")
#define PG8_BAR __builtin_amdgcn_s_barrier()
#define PG8_SCHED __builtin_amdgcn_sched_barrier(0)
    Unit cur, nxt; int ui = 0;
    if (!S.next(0, cur)) return;
    f32x4 acc[2][2][4][2];
#pragma unroll
    for (int a = 0; a < 2; ++a)
#pragma unroll
        for (int b = 0; b < 2; ++b)
#pragma unroll
            for (int m = 0; m < 4; ++m)
#pragma unroll
                for (int n = 0; n < 2; ++n) acc[a][b][m][n] = (f32x4){0.f, 0.f, 0.f, 0.f};
    bf16x8 At[4][2], B0[2][2], B1[2][2];
    const char* cA = (const char*)g.A + (size_t)cur.pm * tstep; const char* cB = (const char*)g.Bt + (size_t)cur.pn * tstep;
    S.a_ready(cur);
    if constexpr (SP2) {
        PG8_STAGE(PG8_SB(0, 0), cB, voffB); PG8_STAGE(PG8_SB(0, 1), cB + hstep, voffB); PG8_STAGE(PG8_SA(0, 0), cA, voffA); PG8_STAGE(PG8_SA(0, 1), cA + hstep, voffA);
        if (wr == 1) PG8_BAR;
        PG8_WAIT_V(2); PG8_BAR;
        PG8_STAGE(PG8_SB(1, 0), cB + kstep, voffB); PG8_STAGE(PG8_SA(1, 0), cA + kstep, voffA); PG8_STAGE(PG8_SB(1, 1), cB + hstep + kstep, voffB);
        PG8_WAIT_V(6); PG8_BAR;
    } else {
        PG8_STAGE(PG8_SB(0, 0), cB, voffB); PG8_STAGE(PG8_SA(0, 0), cA, voffA); PG8_STAGE(PG8_SB(0, 1), cB + hstep, voffB); PG8_STAGE(PG8_SA(0, 1), cA + hstep, voffA);
        if (wr == 1) PG8_BAR;
        PG8_WAIT_V(4); PG8_BAR;
        PG8_STAGE(PG8_SB(1, 0), cB + kstep, voffB); PG8_STAGE(PG8_SA(1, 0), cA + kstep, voffA); PG8_STAGE(PG8_SB(1, 1), cB + hstep + kstep, voffB);
        PG8_WAIT_V(6); PG8_BAR;
    }
    for (;;) {
        const bool has_next = S.next(ui + 1, nxt);
        const char* nA = has_next ? (const char*)g.A + (size_t)nxt.pm * tstep : cA; const char* nB = has_next ? (const char*)g.Bt + (size_t)nxt.pn * tstep : cB;
        for (int t = 0; t < nt; t += 2) {
            const bool last = (t == nt - 2);
            const char* a1 = cA + (size_t)(t + 1) * kstep;
            const char* a2 = last ? nA : cA + (size_t)(t + 2) * kstep; const char* b2 = last ? nB : cB + (size_t)(t + 2) * kstep;
            const char* a3 = a2 + kstep; const char* b3 = b2 + kstep;
            if (last && has_next) S.a_ready(nxt);
            if constexpr (SP2) {
            PG8_LDB(B0, 0, 0); PG8_LDB(B1, 0, 1); PG8_SCHED; PG8_LDA(At, 0, 0); PG8_STAGE(PG8_SA(1, 1), a1 + hstep, voffA);
            PG8_WAIT_V(8); PG8_WAIT_L(0); PG8_BAR; PG8_MMA(0, 0, At, B0); PG8_MMA(0, 1, At, B1); PG8_BAR; PG8_SCHED;
            PG8_LDA(At, 0, 1); PG8_STAGE(PG8_SB(0, 0), b2, voffB); PG8_STAGE(PG8_SB(0, 1), b2 + hstep, voffB); PG8_STAGE(PG8_SA(0, 0), a2, voffA);
            PG8_WAIT_V(8); PG8_WAIT_L(0); PG8_BAR; PG8_MMA(1, 0, At, B0); PG8_MMA(1, 1, At, B1); PG8_BAR; PG8_SCHED;
            PG8_LDB(B0, 1, 0); PG8_LDB(B1, 1, 1); PG8_SCHED; PG8_LDA(At, 1, 0); PG8_STAGE(PG8_SA(0, 1), a2 + hstep, voffA);
            PG8_WAIT_V(8); PG8_WAIT_L(0); PG8_BAR; PG8_MMA(0, 0, At, B0); PG8_MMA(0, 1, At, B1); PG8_BAR; PG8_SCHED;
            PG8_LDA(At, 1, 1); PG8_STAGE(PG8_SB(1, 0), b3, voffB); PG8_STAGE(PG8_SB(1, 1), b3 + hstep, voffB); PG8_STAGE(PG8_SA(1, 0), a3, voffA);
            PG8_WAIT_V(8); PG8_WAIT_L(0); PG8_BAR; PG8_MMA(1, 0, At, B0); PG8_MMA(1, 1, At, B1); PG8_BAR; PG8_SCHED;
            } else {
            PG8_LDB(B0, 0, 0); PG8_SCHED; PG8_LDA(At, 0, 0); PG8_STAGE(PG8_SA(1, 1), a1 + hstep, voffA);
            PG8_WAIT_L(8); PG8_BAR; PG8_WAIT_L(0); PG8_MMA(0, 0, At, B0); PG8_BAR; PG8_SCHED;
            PG8_LDB(B1, 0, 1); PG8_STAGE(PG8_SB(0, 0), b2, voffB);
            PG8_BAR; PG8_WAIT_L(0); PG8_MMA(0, 1, At, B1); PG8_BAR;
            PG8_LDA(At, 0, 1); PG8_STAGE(PG8_SA(0, 0), a2, voffA);
            PG8_BAR; PG8_WAIT_L(0); PG8_MMA(1, 0, At, B0); PG8_BAR; PG8_SCHED;
            PG8_STAGE(PG8_SB(0, 1), b2 + hstep, voffB);
            PG8_WAIT_V(6); PG8_BAR; PG8_MMA(1, 1, At, B1); PG8_BAR;
            PG8_LDB(B0, 1, 0); PG8_SCHED; PG8_LDA(At, 1, 0); PG8_STAGE(PG8_SA(0, 1), a2 + hstep, voffA);
            PG8_WAIT_L(8); PG8_BAR; PG8_WAIT_L(0); PG8_MMA(0, 0, At, B0); PG8_BAR; PG8_SCHED;
            PG8_LDB(B1, 1, 1); PG8_STAGE(PG8_SB(1, 0), b3, voffB);
            PG8_BAR; PG8_WAIT_L(0); PG8_MMA(0, 1, At, B1); PG8_BAR;
            PG8_LDA(At, 1, 1); PG8_STAGE(PG8_SA(1, 0), a3, voffA);
            PG8_BAR; PG8_WAIT_L(0); PG8_MMA(1, 0, At, B0); PG8_BAR; PG8_SCHED;
            PG8_STAGE(PG8_SB(1, 1), b3 + hstep, voffB);
            PG8_WAIT_V(6); PG8_BAR; PG8_MMA(1, 1, At, B1); PG8_BAR;
            }
        }
        if constexpr (ALIGN_EPI) { if (wr == 0) PG8_BAR; }
        if constexpr (!Epi::AFTER_DRAIN) { E(acc, cur, wr, wc, fr, fq); S.done(cur); }
        if (!has_next) break;
#pragma unroll
        for (int a = 0; a < 2; ++a)
#pragma unroll
            for (int b = 0; b < 2; ++b)
#pragma unroll
                for (int m = 0; m < 4; ++m)
#pragma unroll
                    for (int n = 0; n < 2; ++n) acc[a][b][m][n] = (f32x4){0.f, 0.f, 0.f, 0.f};
        cur = nxt; cA = nA; cB = nB; ++ui;
        if constexpr (ALIGN_EPI) { if (wr == 1) PG8_BAR; }
    }
    PG8_WAIT_V(0);
    if constexpr (!ALIGN_EPI) { if (wr == 0) PG8_BAR; }
    PG8_BAR;
    if constexpr (Epi::AFTER_DRAIN) { E.fused(acc, cur, wr, wc, fr, fq, lds, wid, lane); S.done(cur); }
#undef PG8_SA
#undef PG8_SB
#undef PG8_STAGE
#undef PG8_LDA
#undef PG8_LDB
#undef PG8_MMA
#undef PG8_WAIT_V
#undef PG8_WAIT_L
#undef PG8_BAR
#undef PG8_SCHED
}

struct EpiProj {
    static constexpr bool PERM = true, AFTER_DRAIN = false;
    bf16_t* q; bf16_t* k; bf16_t* v; bf16_t* us; bf16_t* vs; const int* pos;
    __device__ __forceinline__ void operator()(const f32x4 (&acc)[2][2][4][2], const Unit& u, int wr, int wc, int fr, int fq) const {
        const int row0 = u.pm * BM + wr * 64 + fr, b = u.pm >> 4;
        if (u.pn < 12) {
            const bool isq = u.pn < 6; bf16_t* base = isq ? q : k;
            const int hh = 2 * (isq ? u.pn : u.pn - 6) + (wc >> 1), e0 = 32 * (wc & 1) + 8 * fq;
            const float qs = isq ? 0.08838834764831845f : 1.0f;
            float ir[8];
#pragma unroll
            for (int j = 0; j < 8; ++j) ir[j] = exp2f(-(float)(e0 + j) * (13.287712379549449f / 64.0f)) * 0.15915494309189535f;
#pragma unroll
            for (int ai = 0; ai < 2; ++ai)
#pragma unroll
                for (int m = 0; m < 4; ++m) {
                    const int t = row0 + ai * HALF + m * 16, s = t & 4095;
                    const float pf = (float)pos[t];
                    float o0[8], o1[8];
#pragma unroll
                    for (int n = 0; n < 2; ++n)
#pragma unroll
                        for (int i = 0; i < 4; ++i) { const int j = 4 * n + i;
                            const float f = __builtin_amdgcn_fractf(pf * ir[j]); const float sn = __builtin_amdgcn_sinf(f), cs = __builtin_amdgcn_cosf(f);
                            const float t1 = acc[ai][0][m][n][i], t2 = acc[ai][1][m][n][i];
                            o0[j] = (t1 * cs - t2 * sn) * qs; o1[j] = (t2 * cs + t1 * sn) * qs; }
                    bf16_t* dst = base + ((size_t)(b * 12 + hh) * 4096 + s) * 128 + e0;
                    u32x4 w0, w1;
                    w0.x = cvt_pk_bf16(o0[0], o0[1]); w0.y = cvt_pk_bf16(o0[2], o0[3]); w0.z = cvt_pk_bf16(o0[4], o0[5]); w0.w = cvt_pk_bf16(o0[6], o0[7]);
                    w1.x = cvt_pk_bf16(o1[0], o1[1]); w1.y = cvt_pk_bf16(o1[2], o1[3]); w1.z = cvt_pk_bf16(o1[4], o1[5]); w1.w = cvt_pk_bf16(o1[6], o1[7]);
                    *(u32x4*)dst = w0; *(u32x4*)(dst + 64) = w1; }
        } else if (u.pn < 18) {
            const int e0 = 32 * wc + 8 * fq;
#pragma unroll
            for (int ai = 0; ai < 2; ++ai)
#pragma unroll
                for (int m = 0; m < 4; ++m) { const int t = row0 + ai * HALF + m * 16, s = t & 4095;
#pragma unroll
                    for (int bj = 0; bj < 2; ++bj) { const int hh = 2 * (u.pn - 12) + bj; const f32x4 v0 = acc[ai][bj][m][0], v1 = acc[ai][bj][m][1];
                        u32x4 w; w.x = cvt_pk_bf16(v0[0], v0[1]); w.y = cvt_pk_bf16(v0[2], v0[3]); w.z = cvt_pk_bf16(v1[0], v1[1]); w.w = cvt_pk_bf16(v1[2], v1[3]);
                        *(u32x4*)(v + ((size_t)(b * 12 + hh) * 4096 + s) * 128 + e0) = w; } }
        } else {
            bf16_t* base = u.pn < 20 ? us : vs; const int c0 = 256 * ((u.pn - 18) & 1) + 32 * wc + 8 * fq;
#pragma unroll
            for (int ai = 0; ai < 2; ++ai)
#pragma unroll
                for (int m = 0; m < 4; ++m) { const int t = row0 + ai * HALF + m * 16;
#pragma unroll
                    for (int bj = 0; bj < 2; ++bj) { const f32x4 v0 = acc[ai][bj][m][0], v1 = acc[ai][bj][m][1];
                        const f32x2 a = gelu_pk((f32x2){v0[0], v0[1]}), bb = gelu_pk((f32x2){v0[2], v0[3]}), c = gelu_pk((f32x2){v1[0], v1[1]}), d = gelu_pk((f32x2){v1[2], v1[3]});
                        u32x4 w; w.x = cvt_pk_bf16(a.x, a.y); w.y = cvt_pk_bf16(bb.x, bb.y); w.z = cvt_pk_bf16(c.x, c.y); w.w = cvt_pk_bf16(d.x, d.y);
                        *(u32x4*)(base + (size_t)t * 512 + c0 + 128 * bj) = w; } }
        }
    }
};
struct EpiRes {
    static constexpr bool PERM = false, AFTER_DRAIN = false;
    const float* x; float* out; const long long* modq;
    __device__ __forceinline__ void operator()(const f32x4 (&acc)[2][2][4][2], const Unit& u, int wr, int wc, int fr, int fq) const {
        const int row0 = u.pm * BM + wr * 64 + fr, col0 = u.pn * BM + wc * 32 + 4 * fq, b = u.pm >> 4;
        f32x4 gt[2][2];
#pragma unroll
        for (int bj = 0; bj < 2; ++bj)
#pragma unroll
            for (int n = 0; n < 2; ++n) { const long long* mp = modq + b * 12288 + 2 * 2048 + col0 + bj * HALF + n * 16;
#pragma unroll
                for (int i = 0; i < 4; ++i) gt[bj][n][i] = (float)((double)mp[i] * 2.3283064365386963e-10); }
#pragma unroll
        for (int ai = 0; ai < 2; ++ai)
#pragma unroll
            for (int m = 0; m < 4; ++m) { const size_t off = (size_t)(row0 + ai * HALF + m * 16) * 2048 + col0;
#pragma unroll
                for (int bj = 0; bj < 2; ++bj)
#pragma unroll
                    for (int n = 0; n < 2; ++n) { const f32x4 xv = *(const f32x4*)(x + off + bj * HALF + n * 16); *(f32x4*)(out + off + bj * HALF + n * 16) = xv + gt[bj][n] * acc[ai][bj][m][n]; } }
    }
};
struct EpiPq {
    static constexpr bool PERM = true, AFTER_DRAIN = false;
    bf16_t* o;
    __device__ __forceinline__ void operator()(const f32x4 (&acc)[2][2][4][2], const Unit& u, int wr, int wc, int fr, int fq) const {
        const int row0 = u.pm * BM + wr * 64 + fr, col0 = u.pn * BM + wc * 32 + 8 * fq;
#pragma unroll
        for (int ai = 0; ai < 2; ++ai)
#pragma unroll
            for (int m = 0; m < 4; ++m) { bf16_t* rowp = o + (size_t)(row0 + ai * HALF + m * 16) * 2048 + col0;
#pragma unroll
                for (int bj = 0; bj < 2; ++bj) { const f32x4 v0 = acc[ai][bj][m][0], v1 = acc[ai][bj][m][1];
                    u32x4 w; w.x = cvt_pk_bf16(v0[0], v0[1]); w.y = cvt_pk_bf16(v0[2], v0[3]); w.z = cvt_pk_bf16(v1[0], v1[1]); w.w = cvt_pk_bf16(v1[2], v1[3]);
                    *(u32x4*)(rowp + bj * HALF) = w; } }
    }
};
}

__device__ void phase_gemm1(const Params& p, unsigned char* lds) {
    pg8::Gemm g{(const bf16_t*)(p.ws + OFF_A), (const bf16_t*)(p.ws + OFF_WIN), T, DIN, D};
    pg8::StaticOrder So; So.init(T, DIN, (int)gridDim.x, (int)blockIdx.x);
    pg8::EpiProj Ep{(bf16_t*)(p.ws + OFF_QKV), (bf16_t*)(p.ws + OFF_QKV + QKV_ONE), (bf16_t*)(p.ws + OFF_QKV + 2 * QKV_ONE), (bf16_t*)(p.ws + OFF_US), (bf16_t*)(p.ws + OFF_VS), p.pos};
    pg8::gemm_phase<pg8::EpiProj, pg8::StaticOrder, true, true>((PG8_LAS unsigned char*)lds, g, So, Ep);
}
__device__ void phase_gemm2(const Params& p, unsigned char* lds) {
    pg8::Gemm g{(const bf16_t*)(p.ws + OFF_QKV), (const bf16_t*)(p.ws + OFF_WOUT), T, D, D};
    pg8::StaticOrder So; So.init(T, D, (int)gridDim.x, (int)blockIdx.x);
    pg8::EpiRes Ep{p.x, p.out, (const long long*)(p.ws + OFF_MOD)};
    pg8::gemm_phase<pg8::EpiRes, pg8::StaticOrder, true, true>((PG8_LAS unsigned char*)lds, g, So, Ep);
}
__device__ void phase_gemm3(const Params& p, unsigned char* lds) {
    pg8::Gemm g{(const bf16_t*)(p.ws + OFF_A), (const bf16_t*)(p.ws + OFF_WQ), T, D, D};
    pg8::StaticOrder So; So.init(T, D, (int)gridDim.x, (int)blockIdx.x);
    pg8::EpiPq Ep{(bf16_t*)(p.ws + OFF_QKV + (size_t)T * D * 2)};
    pg8::gemm_phase<pg8::EpiPq, pg8::StaticOrder, true, true>((PG8_LAS unsigned char*)lds, g, So, Ep);
}

__device__ __forceinline__ void conv_transpose(const float* __restrict__ W, int N, bf16_t* __restrict__ WT, int perm_limit, float* tile, int bid, int nblk, int tid) {
    const int ntiles = 32 * (N / 64);
    for (int tI = bid; tI < ntiles; tI += nblk) {
        const int tk = tI & 31, tn = tI >> 5, k0 = tk * 64, n0 = tn * 64;
        int l0 = n0;
        if (n0 < perm_limit) { const int base = n0 & ~255, pb = (n0 >> 6) & 3, bj = pb >> 1, qhi = pb & 1; l0 = base + 64 * bj + 128 * qhi; }
        __syncthreads();
#pragma unroll
        for (int pass = 0; pass < 2; ++pass) { const int r = pass * 32 + (tid >> 4), c4 = (tid & 15) * 4;
            const float4 v = *(const float4*)(W + (size_t)(k0 + r) * N + l0 + c4);
            tile[r * 65 + c4 + 0] = v.x; tile[r * 65 + c4 + 1] = v.y; tile[r * 65 + c4 + 2] = v.z; tile[r * 65 + c4 + 3] = v.w; }
        __syncthreads();
        const int n = tid >> 3, kq = (tid & 7) * 8;
        u32x4 w;
        w.x = pack2(tile[(kq + 0) * 65 + n], tile[(kq + 1) * 65 + n]); w.y = pack2(tile[(kq + 2) * 65 + n], tile[(kq + 3) * 65 + n]);
        w.z = pack2(tile[(kq + 4) * 65 + n], tile[(kq + 5) * 65 + n]); w.w = pack2(tile[(kq + 6) * 65 + n], tile[(kq + 7) * 65 + n]);
        *(u32x4*)(WT + (size_t)(n0 + n) * D + k0 + kq) = w;
    }
}
__device__ __forceinline__ void conv_flat(const float* __restrict__ src, bf16_t* __restrict__ dst, size_t n8, int bid, int nblk, int tid) {
    for (size_t i = (size_t)bid * NTHR + tid; i < n8; i += (size_t)nblk * NTHR) {
        const float4 a = ((const float4*)src)[2 * i], b = ((const float4*)src)[2 * i + 1];
        u32x4 w; w.x = pack2(a.x, a.y); w.y = pack2(a.z, a.w); w.z = pack2(b.x, b.y); w.w = pack2(b.z, b.w);
        ((u32x4*)dst)[i] = w; }
}
__device__ void phase_conv(const Params& p, unsigned char* lds) {
    const int tid = threadIdx.x, bid = blockIdx.x, nblk = gridDim.x;
    unsigned long long* mod = (unsigned long long*)(p.ws + OFF_MOD);
    for (int it = bid; it < 768; it += nblk) {
        const int cb = it % 6, kc = it / 6, col = cb * 2048 + tid * 4;
        float acc[4][4];
#pragma unroll
        for (int b = 0; b < 4; ++b) { acc[b][0] = 0.f; acc[b][1] = 0.f; acc[b][2] = 0.f; acc[b][3] = 0.f; }
        for (int kk = 0; kk < 16; ++kk) { const int k = kc * 16 + kk;
            const float4 w = *(const float4*)(p.w_ada + (size_t)k * 12288 + col);
#pragma unroll
            for (int b = 0; b < 4; ++b) { const float cv = p.c[b * D + k]; const float s = cv / (1.f + __expf(-cv));
                acc[b][0] += s * w.x; acc[b][1] += s * w.y; acc[b][2] += s * w.z; acc[b][3] += s * w.w; } }
        if (kc == 0) { const float4 bv = *(const float4*)(p.b_ada + col);
#pragma unroll
            for (int b = 0; b < 4; ++b) { acc[b][0] += bv.x; acc[b][1] += bv.y; acc[b][2] += bv.z; acc[b][3] += bv.w; } }
#pragma unroll
        for (int b = 0; b < 4; ++b)
#pragma unroll
            for (int j = 0; j < 4; ++j) atomicAdd(mod + b * 12288 + col + j, (unsigned long long)__double2ll_rn((double)acc[b][j] * 4294967296.0));
    }
    conv_transpose(p.w_in, DIN, (bf16_t*)(p.ws + OFF_WIN), 3072, (float*)lds, bid, nblk, tid);
    conv_transpose(p.w_out, D, (bf16_t*)(p.ws + OFF_WOUT), 0, (float*)lds, bid, nblk, tid);
    conv_transpose(p.peer_w_q, D, (bf16_t*)(p.ws + OFF_WQ), 0, (float*)lds, bid, nblk, tid);
    conv_flat(p.peer_u, (bf16_t*)(p.ws + OFF_UTAB), (size_t)NEXP * D / 8, bid, nblk, tid);
    conv_flat(p.peer_v, (bf16_t*)(p.ws + OFF_VTAB), (size_t)NEXP * D / 8, bid, nblk, tid);
    conv_flat(p.peer_sub_keys, (bf16_t*)(p.ws + OFF_SUBK), (size_t)8 * 2 * 128 * 128 / 8, bid, nblk, tid);
    { bf16_t* sw = (bf16_t*)(p.ws + OFF_SGUW);
      for (int i = bid * NTHR + tid; i < 4 * 128 * 128; i += nblk * NTHR) { const int jj = i & 127, ii = (i >> 7) & 127; sw[i] = f2bf(jj <= ii ? p.sgu_w[i] : 0.f); } }
}

__device__ void phase_norm_mod(const Params& p, const float* __restrict__ src, const float* __restrict__ g, int sh_i, int sc_i, bf16_t* __restrict__ dst) {
    const int lane = threadIdx.x & 63, gw = blockIdx.x * NWV + (threadIdx.x >> 6), nw = gridDim.x * NWV;
    for (int t = gw; t < T; t += nw) {
        const float* row = src + (size_t)t * D; const int b = t / S;
        float4 v[8]; float ss = 0.f;
#pragma unroll
        for (int i = 0; i < 8; ++i) { v[i] = *(const float4*)(row + i * 256 + lane * 4); ss += v[i].x * v[i].x + v[i].y * v[i].y + v[i].z * v[i].z + v[i].w * v[i].w; }
        ss = wave_sum(ss); const float rstd = rsqrtf(ss * (1.0f / D) + 1e-6f);
#pragma unroll
        for (int i = 0; i < 8; ++i) { const int col = i * 256 + lane * 4;
            const float4 gg = *(const float4*)(g + col), sc = mod4(p, b, sc_i, col), sh = mod4(p, b, sh_i, col);
            u32x2 w; w.x = pack2(v[i].x * rstd * gg.x * (1.f + sc.x) + sh.x, v[i].y * rstd * gg.y * (1.f + sc.y) + sh.y);
            w.y = pack2(v[i].z * rstd * gg.z * (1.f + sc.z) + sh.z, v[i].w * rstd * gg.w * (1.f + sc.w) + sh.w);
            *(u32x2*)(dst + (size_t)t * D + col) = w; }
    }
}

#define NAIVE_GEMM_BODY(A_, W_, N_, r0_, c0_)                                                                 \
    float acc[16];                                                                                            \
    _Pragma("unroll") for (int r = 0; r < 16; ++r) acc[r] = 0.f;                                              \
    __syncthreads();                                                                                          \
    { const u32x4* srcA = (const u32x4*)((A_) + (size_t)(r0_) * D); u32x4* dstA = (u32x4*)lds;                  \
      for (int i = tid; i < 16 * D / 8; i += NTHR) dstA[i] = srcA[i]; }                                       \
    __syncthreads();                                                                                          \
    { const unsigned* la = (const unsigned*)lds;                                                              \
      for (int k2 = 0; k2 < D / 2; ++k2) {                                                                    \
          const float w0 = (W_)[(size_t)(2 * k2) * (N_) + (c0_) + tid], w1 = (W_)[(size_t)(2 * k2 + 1) * (N_) + (c0_) + tid]; \
          _Pragma("unroll") for (int r = 0; r < 16; ++r) { const unsigned a = la[r * (D / 2) + k2]; acc[r] += bflo(a) * w0 + bfhi(a) * w1; } } }

__device__ void phase_gemm1_naive(const Params& p, unsigned char* lds) {
    const int tid = threadIdx.x;
    const bf16_t* A = (const bf16_t*)(p.ws + OFF_A);
    float* xch = (float*)(lds + 65536);
    bf16_t* qb = (bf16_t*)(p.ws + OFF_QKV); bf16_t* kb = (bf16_t*)(p.ws + OFF_QKV + QKV_ONE); bf16_t* vb = (bf16_t*)(p.ws + OFF_QKV + 2 * QKV_ONE);
    bf16_t* usb = (bf16_t*)(p.ws + OFF_US); bf16_t* vsb = (bf16_t*)(p.ws + OFF_VS);
    const int nitems = (T / 16) * (DIN / 512);
    for (int it = blockIdx.x; it < nitems; it += gridDim.x) {
        const int cbk = it % (DIN / 512), rb = it / (DIN / 512), r0 = rb * 16, c0 = cbk * 512;
        NAIVE_GEMM_BODY(A, p.w_in, DIN, r0, c0)
        const int n = c0 + tid;
        if (n < 3072) {
#pragma unroll
            for (int r = 0; r < 16; ++r) xch[r * 512 + tid] = acc[r];
            __syncthreads();
            const int e = n & 127, hh = (n % DA) >> 7; const bool isq = n < DA;
            const int i = e & 63; const float inv = powf(10000.0f, -(float)i / 64.0f);
#pragma unroll
            for (int r = 0; r < 16; ++r) { const int t = r0 + r, b = t / S, s = t % S;
                const float ang = (float)p.pos[t] * inv; const float cs = cosf(ang), sn = sinf(ang);
                const float other = xch[r * 512 + (tid ^ 64)];
                float val = (e < 64) ? (acc[r] * cs - other * sn) : (acc[r] * cs + other * sn);
                if (isq) val *= 0.08838834764831845f;
                (isq ? qb : kb)[((size_t)(b * HA + hh) * S + s) * E + e] = f2bf(val); }
        } else if (n < 4608) {
            const int e = n & 127, hh = (n - 3072) >> 7;
#pragma unroll
            for (int r = 0; r < 16; ++r) { const int t = r0 + r, b = t / S, s = t % S; vb[((size_t)(b * HA + hh) * S + s) * E + e] = f2bf(acc[r]); }
        } else if (n < 5120) {
#pragma unroll
            for (int r = 0; r < 16; ++r) usb[(size_t)(r0 + r) * DS + (n - 4608)] = f2bf(gelu_erf(acc[r]));
        } else {
#pragma unroll
            for (int r = 0; r < 16; ++r) vsb[(size_t)(r0 + r) * DS + (n - 5120)] = f2bf(gelu_erf(acc[r]));
        }
    }
}
__device__ void phase_gemm2_naive(const Params& p, unsigned char* lds) {
    const int tid = threadIdx.x;
    const bf16_t* A = (const bf16_t*)(p.ws + OFF_QKV);
    const int nitems = (T / 16) * (D / 512);
    for (int it = blockIdx.x; it < nitems; it += gridDim.x) {
        const int cbk = it % (D / 512), rb = it / (D / 512), r0 = rb * 16, c0 = cbk * 512;
        NAIVE_GEMM_BODY(A, p.w_out, D, r0, c0)
        const int n = c0 + tid;
#pragma unroll
        for (int r = 0; r < 16; ++r) { const int t = r0 + r, b = t / S; p.out[(size_t)t * D + n] = p.x[(size_t)t * D + n] + mod1(p, b, 2, n) * acc[r]; }
    }
}
__device__ void phase_gemm3_naive(const Params& p, unsigned char* lds) {
    const int tid = threadIdx.x;
    const bf16_t* A = (const bf16_t*)(p.ws + OFF_A);
    bf16_t* pq = (bf16_t*)(p.ws + OFF_QKV + (size_t)T * D * 2);
    const int nitems = (T / 16) * (D / 512);
    for (int it = blockIdx.x; it < nitems; it += gridDim.x) {
        const int cbk = it % (D / 512), rb = it / (D / 512), r0 = rb * 16, c0 = cbk * 512;
        NAIVE_GEMM_BODY(A, p.peer_w_q, D, r0, c0)
        const int n = c0 + tid;
#pragma unroll
        for (int r = 0; r < 16; ++r) pq[(size_t)(r0 + r) * D + n] = f2bf(acc[r]);
    }
}

__device__ void phase_attn_naive(const Params& p, unsigned char* lds) {
    const int lane = threadIdx.x & 63, wave = threadIdx.x >> 6, gw = blockIdx.x * NWV + wave, nw = gridDim.x * NWV;
    float* ql = (float*)lds + wave * 128;
    const bf16_t* qb = (const bf16_t*)(p.ws + OFF_QKV); const bf16_t* kb = (const bf16_t*)(p.ws + OFF_QKV + QKV_ONE); const bf16_t* vb = (const bf16_t*)(p.ws + OFF_QKV + 2 * QKV_ONE);
    float* lse = (float*)(p.ws + OFF_LSE);
    for (int item = gw; item < NB * HA * S; item += nw) {
        const int t = item % S, h = (item / S) % HA, b = item / (S * HA);
        const size_t hb = (size_t)(b * HA + h) * S;
        { const unsigned w = *(const unsigned*)(qb + (hb + t) * E + 2 * lane); ql[2 * lane] = bflo(w); ql[2 * lane + 1] = bfhi(w); }
        __builtin_amdgcn_wave_barrier();
#pragma unroll 1
        for (int pat = 0; pat < 3; ++pat) {
            const int d = pat == 0 ? 1 : (pat == 1 ? 4 : 16);
            const int imax = min(128, t / d);
            float sc[3];
#pragma unroll
            for (int sl = 0; sl < 3; ++sl) { const int i = sl * 64 + lane; float s = -__builtin_inff();
                if (i <= imax) { const u32x4* kr = (const u32x4*)(kb + (hb + (t - i * d)) * E); s = 0.f;
                    for (int c8 = 0; c8 < 16; ++c8) { const u32x4 kk = kr[c8]; const float* qq = ql + c8 * 8;
                        s += qq[0] * bflo(kk.x) + qq[1] * bfhi(kk.x) + qq[2] * bflo(kk.y) + qq[3] * bfhi(kk.y) + qq[4] * bflo(kk.z) + qq[5] * bfhi(kk.z) + qq[6] * bflo(kk.w) + qq[7] * bfhi(kk.w); } }
                sc[sl] = s; }
            const float m = wave_max(fmaxf(sc[0], fmaxf(sc[1], sc[2])));
            float pr[3]; float l = 0.f;
#pragma unroll
            for (int sl = 0; sl < 3; ++sl) { pr[sl] = __expf(sc[sl] - m); l += pr[sl]; }
            l = wave_sum(l);
            float o0 = 0.f, o1 = 0.f;
            for (int i = 0; i <= imax; ++i) { const float pv = __shfl(i < 64 ? pr[0] : (i < 128 ? pr[1] : pr[2]), i & 63);
                const unsigned w = *(const unsigned*)(vb + (hb + (t - i * d)) * E + 2 * lane); o0 += pv * bflo(w); o1 += pv * bfhi(w); }
            const float il = 1.0f / l; const size_t tg = (size_t)b * S + t;
            *(unsigned*)(P_opat(p, pat) + tg * DA + h * E + 2 * lane) = pack2(o0 * il, o1 * il);
            if (lane == 0) lse[((size_t)pat * T + tg) * HA + h] = m + __logf(l);
        }
        __builtin_amdgcn_wave_barrier();
    }
}

#define LAS __attribute__((address_space(3)))
typedef short bf16x8 __attribute__((ext_vector_type(8)));
typedef short s16x4 __attribute__((ext_vector_type(4)));
constexpr int ATT_VOFF = 65536, ATT_VSTRIDE = 288;
__device__ __forceinline__ unsigned cvt_pk(float lo, float hi) { unsigned r; asm volatile("v_cvt_pk_bf16_f32 %0, %1, %2" : "=v"(r) : "v"(lo), "v"(hi)); return r; }
__device__ void phase_attn(const Params& p, unsigned char* lds_) {
    LAS unsigned char* lds = (LAS unsigned char*)lds_;
    const int tid = threadIdx.x, lane = tid & 63, w = __builtin_amdgcn_readfirstlane(tid >> 6), l15 = lane & 15, g = lane >> 4;
    const bf16_t* qb = (const bf16_t*)(p.ws + OFF_QKV); const bf16_t* kb = (const bf16_t*)(p.ws + OFF_QKV + QKV_ONE); const bf16_t* vb = (const bf16_t*)(p.ws + OFF_QKV + 2 * QKV_ONE);
    float* lse = (float*)(p.ws + OFF_LSE);
    const int G = gridDim.x, vcu = (G % 8 == 0) ? (int)(blockIdx.x & 7) * (G >> 3) + (int)(blockIdx.x >> 3) : (int)blockIdx.x;
    const float NEG = -__builtin_inff();
    for (int item = vcu; item < 3 * 48 * 32; item += G) {
        const int pat = item / 1536, rem = item % 1536, bh = rem >> 5, ci = rem & 31;
        const int dsh = 2 * pat, d = 1 << dsh, nblk = 32 >> dsh, r = ci / nblk, n = ci % nblk;
        const size_t hb = (size_t)bh * S;
        __syncthreads();
#pragma unroll
        for (int i = 0; i < 8; ++i) { const int ch = i * NTHR + tid, kk = ch >> 4, c = ch & 15;
            if (n > 0 || kk >= 128) { const int tp = (((n - 1) * 128 + kk) << dsh) + r;
                const u32x4 kv = *(const u32x4*)(kb + (hb + tp) * E + c * 8), vv = *(const u32x4*)(vb + (hb + tp) * E + c * 8);
                *(LAS u32x4*)(lds + kk * 256 + ((c ^ (kk & 15)) << 4)) = kv;
                *(LAS u32x4*)(lds + ATT_VOFF + kk * ATT_VSTRIDE + c * 16) = vv; } }
        const int jj = 16 * w + l15, tq = ((n * 128 + jj) << dsh) + r;
        bf16x8 qf[4];
#pragma unroll
        for (int ks = 0; ks < 4; ++ks) qf[ks] = *(const bf16x8*)(qb + (hb + tq) * E + 32 * ks + 8 * g);
        __syncthreads();
        const int s0 = w >> 1;
        f32x4 sA[5], sB[5];
#pragma unroll
        for (int si = 0; si < 5; ++si) {
            const int step = s0 + si;
            if (n == 0 && step < 4) { sA[si] = (f32x4){NEG, NEG, NEG, NEG}; sB[si] = (f32x4){NEG, NEG, NEG, NEG}; continue; }
            f32x4 a = {0.f, 0.f, 0.f, 0.f}, b = {0.f, 0.f, 0.f, 0.f};
            const int keyA = 32 * step + l15, keyB = keyA + 16;
#pragma unroll
            for (int ks = 0; ks < 4; ++ks) {
                const bf16x8 kA = *(const LAS bf16x8*)(lds + keyA * 256 + (((4 * ks + g) ^ (keyA & 15)) << 4));
                const bf16x8 kB = *(const LAS bf16x8*)(lds + keyB * 256 + (((4 * ks + g) ^ (keyB & 15)) << 4));
                a = __builtin_amdgcn_mfma_f32_16x16x32_bf16(kA, qf[ks], a, 0, 0, 0);
                b = __builtin_amdgcn_mfma_f32_16x16x32_bf16(kB, qf[ks], b, 0, 0, 0); }
#pragma unroll
            for (int rg = 0; rg < 4; ++rg) { const int ka = 32 * step + 4 * g + rg, kb2 = ka + 16;
                const bool oka = (unsigned)(ka - jj) <= 128u && (n > 0 || ka >= 128), okb = (unsigned)(kb2 - jj) <= 128u && (n > 0 || kb2 >= 128);
                a[rg] = oka ? a[rg] : NEG; b[rg] = okb ? b[rg] : NEG; }
            sA[si] = a; sB[si] = b;
        }
        float m = NEG;
#pragma unroll
        for (int si = 0; si < 5; ++si)
#pragma unroll
            for (int rg = 0; rg < 4; ++rg) m = fmaxf(m, fmaxf(sA[si][rg], sB[si][rg]));
        m = fmaxf(m, __shfl_xor(m, 16)); m = fmaxf(m, __shfl_xor(m, 32));
        float l = 0.f; const float mL = m * 1.4426950408889634f;
#pragma unroll
        for (int si = 0; si < 5; ++si)
#pragma unroll
            for (int rg = 0; rg < 4; ++rg) { sA[si][rg] = __builtin_amdgcn_exp2f(sA[si][rg] * 1.4426950408889634f - mL); sB[si][rg] = __builtin_amdgcn_exp2f(sB[si][rg] * 1.4426950408889634f - mL); l += sA[si][rg] + sB[si][rg]; }
        l += __shfl_xor(l, 16); l += __shfl_xor(l, 32);
        f32x4 o[8];
#pragma unroll
        for (int dt = 0; dt < 8; ++dt) o[dt] = (f32x4){0.f, 0.f, 0.f, 0.f};
#pragma unroll
        for (int si = 0; si < 5; ++si) {
            const int step = s0 + si;
            if (n == 0 && step < 4) continue;
            u32x4 pw; pw.x = cvt_pk(sA[si][0], sA[si][1]); pw.y = cvt_pk(sA[si][2], sA[si][3]); pw.z = cvt_pk(sB[si][0], sB[si][1]); pw.w = cvt_pk(sB[si][2], sB[si][3]);
            const bf16x8 pf = *reinterpret_cast<const bf16x8*>(&pw);
            LAS unsigned char* vrow = lds + ATT_VOFF + (32 * step + 4 * g + (l15 >> 2)) * ATT_VSTRIDE + (l15 & 3) * 8;
#pragma unroll
            for (int dt = 0; dt < 8; ++dt) {
                const s16x4 v0 = __builtin_amdgcn_ds_read_tr16_b64_v4i16((LAS s16x4*)(vrow + dt * 32));
                const s16x4 v1 = __builtin_amdgcn_ds_read_tr16_b64_v4i16((LAS s16x4*)(vrow + dt * 32 + 16 * ATT_VSTRIDE));
                const bf16x8 vf = {v0[0], v0[1], v0[2], v0[3], v1[0], v1[1], v1[2], v1[3]};
                o[dt] = __builtin_amdgcn_mfma_f32_16x16x32_bf16(vf, pf, o[dt], 0, 0, 0); }
        }
        const float il = 1.0f / l; const int b_ = bh / HA, h = bh % HA; const size_t tg = (size_t)b_ * S + tq;
        bf16_t* orow = P_opat(p, pat) + tg * DA + h * E + 4 * g;
#pragma unroll
        for (int dt = 0; dt < 8; ++dt) { u32x2 ww; ww.x = cvt_pk(o[dt][0] * il, o[dt][1] * il); ww.y = cvt_pk(o[dt][2] * il, o[dt][3] * il); *(u32x2*)(orow + 16 * dt) = ww; }
        if (g == 0) lse[((size_t)pat * T + tg) * HA + h] = m + __logf(l);
    }
}

__device__ void phase_sgu(const Params& p, unsigned char* lds_) {
    LAS unsigned char* lds = (LAS unsigned char*)lds_;
    const int tid = threadIdx.x, lane = tid & 63, w = __builtin_amdgcn_readfirstlane(tid >> 6), l15 = lane & 15, g = lane >> 4;
    const bf16_t* vsb = (const bf16_t*)(p.ws + OFF_VS); const bf16_t* usb = (const bf16_t*)(p.ws + OFF_US); bf16_t* ob = (bf16_t*)(p.ws + OFF_SGUO);
    const bf16_t* sw = (const bf16_t*)(p.ws + OFF_SGUW);
    for (int item = blockIdx.x; item < (T / 128) * HS; item += gridDim.x) {
        const int h = item & 3, t0 = (item >> 2) * 128;
        __syncthreads();
        {
            const int j = tid >> 2, part = tid & 3;
            const u32x4* src = (const u32x4*)(vsb + (size_t)(t0 + j) * DS + h * E + part * 32);
            u32x4 x[4]; float sum = 0.f;
#pragma unroll
            for (int i = 0; i < 4; ++i) { x[i] = src[i]; sum += bflo(x[i].x) + bfhi(x[i].x) + bflo(x[i].y) + bfhi(x[i].y) + bflo(x[i].z) + bfhi(x[i].z) + bflo(x[i].w) + bfhi(x[i].w); }
            sum += __shfl_xor(sum, 1); sum += __shfl_xor(sum, 2);
            const float mu = sum * (1.0f / E); float var = 0.f;
#pragma unroll
            for (int i = 0; i < 4; ++i) { float dd;
                dd = bflo(x[i].x) - mu; var += dd * dd; dd = bfhi(x[i].x) - mu; var += dd * dd; dd = bflo(x[i].y) - mu; var += dd * dd; dd = bfhi(x[i].y) - mu; var += dd * dd;
                dd = bflo(x[i].z) - mu; var += dd * dd; dd = bfhi(x[i].z) - mu; var += dd * dd; dd = bflo(x[i].w) - mu; var += dd * dd; dd = bfhi(x[i].w) - mu; var += dd * dd; }
            var += __shfl_xor(var, 1); var += __shfl_xor(var, 2);
            const float rs = rsqrtf(var * (1.0f / E) + 1e-5f);
            const float* lg = p.sgu_ln_g + h * E + part * 32; const float* lb = p.sgu_ln_b + h * E + part * 32;
#pragma unroll
            for (int i = 0; i < 4; ++i) { const float4 g0 = *(const float4*)(lg + i * 8), g1 = *(const float4*)(lg + i * 8 + 4), b0 = *(const float4*)(lb + i * 8), b1 = *(const float4*)(lb + i * 8 + 4);
                u32x4 o; o.x = cvt_pk((bflo(x[i].x) - mu) * rs * g0.x + b0.x, (bfhi(x[i].x) - mu) * rs * g0.y + b0.y); o.y = cvt_pk((bflo(x[i].y) - mu) * rs * g0.z + b0.z, (bfhi(x[i].y) - mu) * rs * g0.w + b0.w);
                o.z = cvt_pk((bflo(x[i].z) - mu) * rs * g1.x + b1.x, (bfhi(x[i].z) - mu) * rs * g1.y + b1.y); o.w = cvt_pk((bflo(x[i].w) - mu) * rs * g1.z + b1.z, (bfhi(x[i].w) - mu) * rs * g1.w + b1.w);
                *(LAS u32x4*)(lds + j * ATT_VSTRIDE + part * 64 + i * 16) = o; }
        }
        __syncthreads();
        f32x4 acc[8];
#pragma unroll
        for (int et = 0; et < 8; ++et) acc[et] = (f32x4){0.f, 0.f, 0.f, 0.f};
        const int irow = 16 * w + l15, nsteps = (16 * w + 15) / 32 + 1;
        const bf16_t* wrow = sw + ((size_t)h * 128 + irow) * 128;
        for (int st = 0; st < nsteps; ++st) {
            const u32x2 wa = *(const u32x2*)(wrow + 32 * st + 4 * g), wb = *(const u32x2*)(wrow + 32 * st + 16 + 4 * g);
            u32x4 wf4; wf4.x = wa.x; wf4.y = wa.y; wf4.z = wb.x; wf4.w = wb.y;
            const bf16x8 wf = *reinterpret_cast<const bf16x8*>(&wf4);
            LAS unsigned char* vrow = lds + (32 * st + 4 * g + (l15 >> 2)) * ATT_VSTRIDE + (l15 & 3) * 8;
#pragma unroll
            for (int et = 0; et < 8; ++et) {
                const s16x4 v0 = __builtin_amdgcn_ds_read_tr16_b64_v4i16((LAS s16x4*)(vrow + et * 32));
                const s16x4 v1 = __builtin_amdgcn_ds_read_tr16_b64_v4i16((LAS s16x4*)(vrow + et * 32 + 16 * ATT_VSTRIDE));
                const bf16x8 vf = {v0[0], v0[1], v0[2], v0[3], v1[0], v1[1], v1[2], v1[3]};
                acc[et] = __builtin_amdgcn_mfma_f32_16x16x32_bf16(vf, wf, acc[et], 0, 0, 0); }
        }
        const float bias = p.sgu_b[h * 128 + irow];
        const size_t base = (size_t)(t0 + irow) * DS + h * E + 4 * g;
#pragma unroll
        for (int et = 0; et < 8; ++et) { const u32x2 uu = *(const u32x2*)(usb + base + 16 * et);
            u32x2 oo; oo.x = cvt_pk(bflo(uu.x) * (acc[et][0] + bias), bfhi(uu.x) * (acc[et][1] + bias)); oo.y = cvt_pk(bflo(uu.y) * (acc[et][2] + bias), bfhi(uu.y) * (acc[et][3] + bias));
            *(u32x2*)(ob + base + 16 * et) = oo; }
    }
}

__device__ void phase_sgu_ln_naive(const Params& p) {
    const int lane = threadIdx.x & 63, gw = blockIdx.x * NWV + (threadIdx.x >> 6), nw = gridDim.x * NWV;
    bf16_t* vsb = (bf16_t*)(p.ws + OFF_VS);
    for (int item = gw; item < T * HS; item += nw) {
        const int t = item / HS, h = item % HS;
        unsigned* ptr = (unsigned*)(vsb + (size_t)t * DS + h * E + 2 * lane);
        const unsigned w = *ptr; const float a = bflo(w), b = bfhi(w);
        const float mu = wave_sum(a + b) * (1.0f / E); const float da = a - mu, db = b - mu;
        const float var = wave_sum(da * da + db * db) * (1.0f / E); const float rs = rsqrtf(var + 1e-5f);
        const int e = 2 * lane;
        *ptr = pack2(da * rs * p.sgu_ln_g[h * E + e] + p.sgu_ln_b[h * E + e], db * rs * p.sgu_ln_g[h * E + e + 1] + p.sgu_ln_b[h * E + e + 1]);
    }
}
__device__ void phase_sgu_mix_naive(const Params& p) {
    const int tid = threadIdx.x;
    const bf16_t* vnb = (const bf16_t*)(p.ws + OFF_VS); const bf16_t* usb = (const bf16_t*)(p.ws + OFF_US); bf16_t* ob = (bf16_t*)(p.ws + OFF_SGUO);
    for (int t = blockIdx.x; t < T; t += gridDim.x) {
        const int h = tid >> 7, e = tid & 127, i = t & 127, t0 = t - i;
        float acc = 0.f;
        for (int j = 0; j <= i; ++j) acc += p.sgu_w[(h * 128 + i) * 128 + j] * bf2f(vnb[(size_t)(t0 + j) * DS + tid]);
        acc += p.sgu_b[h * 128 + i];
        ob[(size_t)t * DS + tid] = f2bf(bf2f(usb[(size_t)t * DS + tid]) * acc);
        (void)e;
    }
}

__device__ void phase_combine(const Params& p) {
    const int lane = threadIdx.x & 63, gw = blockIdx.x * NWV + (threadIdx.x >> 6), nw = gridDim.x * NWV;
    const float* lse = (const float*)(p.ws + OFF_LSE);
    const bf16_t* sg = (const bf16_t*)(p.ws + OFF_SGUO); bf16_t* mixed = (bf16_t*)(p.ws + OFF_QKV);
    for (int t = gw; t < T; t += nw) {
        float w0 = 0.f, w1 = 0.f, w2 = 0.f;
        if (lane < HA) { const float l0 = lse[((size_t)0 * T + t) * HA + lane], l1 = lse[((size_t)1 * T + t) * HA + lane], l2 = lse[((size_t)2 * T + t) * HA + lane];
            const float m = fmaxf(l0, fmaxf(l1, l2)); const float e0 = __expf(l0 - m), e1 = __expf(l1 - m), e2 = __expf(l2 - m); const float is = 1.0f / (e0 + e1 + e2);
            w0 = e0 * is; w1 = e1 * is; w2 = e2 * is; }
        float av[3][8]; float ss = 0.f;
#pragma unroll
        for (int i = 0; i < 3; ++i) { const int col0 = (lane + 64 * i) * 8, hh = col0 >> 7;
            const float a0 = __shfl(w0, hh), a1 = __shfl(w1, hh), a2 = __shfl(w2, hh);
            const u32x4 x0 = *(const u32x4*)(P_opat(p, 0) + (size_t)t * DA + col0), x1 = *(const u32x4*)(P_opat(p, 1) + (size_t)t * DA + col0), x2 = *(const u32x4*)(P_opat(p, 2) + (size_t)t * DA + col0);
            av[i][0] = a0 * bflo(x0.x) + a1 * bflo(x1.x) + a2 * bflo(x2.x); av[i][1] = a0 * bfhi(x0.x) + a1 * bfhi(x1.x) + a2 * bfhi(x2.x);
            av[i][2] = a0 * bflo(x0.y) + a1 * bflo(x1.y) + a2 * bflo(x2.y); av[i][3] = a0 * bfhi(x0.y) + a1 * bfhi(x1.y) + a2 * bfhi(x2.y);
            av[i][4] = a0 * bflo(x0.z) + a1 * bflo(x1.z) + a2 * bflo(x2.z); av[i][5] = a0 * bfhi(x0.z) + a1 * bfhi(x1.z) + a2 * bfhi(x2.z);
            av[i][6] = a0 * bflo(x0.w) + a1 * bflo(x1.w) + a2 * bflo(x2.w); av[i][7] = a0 * bfhi(x0.w) + a1 * bfhi(x1.w) + a2 * bfhi(x2.w);
#pragma unroll
            for (int j = 0; j < 8; ++j) ss += av[i][j] * av[i][j]; }
        ss = wave_sum(ss); const float rs = rsqrtf(ss * (1.0f / DA) + 1e-6f);
#pragma unroll
        for (int i = 0; i < 3; ++i) { const int col0 = (lane + 64 * i) * 8; const float4 g0 = *(const float4*)(p.g_attn_out + col0), g1 = *(const float4*)(p.g_attn_out + col0 + 4);
            u32x4 w; w.x = pack2(av[i][0] * rs * g0.x, av[i][1] * rs * g0.y); w.y = pack2(av[i][2] * rs * g0.z, av[i][3] * rs * g0.w);
            w.z = pack2(av[i][4] * rs * g1.x, av[i][5] * rs * g1.y); w.w = pack2(av[i][6] * rs * g1.z, av[i][7] * rs * g1.w);
            *(u32x4*)(mixed + (size_t)t * D + col0) = w; }
        { const int col0 = lane * 8; const u32x4 xs = *(const u32x4*)(sg + (size_t)t * DS + col0);
          float sv[8] = {bflo(xs.x), bfhi(xs.x), bflo(xs.y), bfhi(xs.y), bflo(xs.z), bfhi(xs.z), bflo(xs.w), bfhi(xs.w)}; float s2 = 0.f;
#pragma unroll
          for (int j = 0; j < 8; ++j) s2 += sv[j] * sv[j];
          s2 = wave_sum(s2); const float r2 = rsqrtf(s2 * (1.0f / DS) + 1e-6f);
          const float4 g0 = *(const float4*)(p.g_sgu_out + col0), g1 = *(const float4*)(p.g_sgu_out + col0 + 4);
          u32x4 w; w.x = pack2(sv[0] * r2 * g0.x, sv[1] * r2 * g0.y); w.y = pack2(sv[2] * r2 * g0.z, sv[3] * r2 * g0.w);
          w.z = pack2(sv[4] * r2 * g1.x, sv[5] * r2 * g1.y); w.w = pack2(sv[6] * r2 * g1.z, sv[7] * r2 * g1.w);
          *(u32x4*)(mixed + (size_t)t * D + DA + col0) = w; }
    }
}

__device__ void phase_topk_naive(const Params& p, unsigned char* lds) {
    const int lane = threadIdx.x & 63, wave = threadIdx.x >> 6, gw = blockIdx.x * NWV + wave, nw = gridDim.x * NWV;
    float* ql = (float*)lds + wave * 256;
    const bf16_t* pq = (const bf16_t*)(p.ws + OFF_QKV + (size_t)T * D * 2);
    int* idxo = (int*)(p.ws + OFF_IDX); float* gato = (float*)(p.ws + OFF_GATE);
    const float NEG = -__builtin_inff();
    for (int item = gw; item < T * PH; item += nw) {
        const int t = item / PH, h = item % PH;
        { const u32x2 w = *(const u32x2*)(pq + (size_t)t * D + h * 256 + 4 * lane); ql[4 * lane] = bflo(w.x); ql[4 * lane + 1] = bfhi(w.x); ql[4 * lane + 2] = bflo(w.y); ql[4 * lane + 3] = bfhi(w.y); }
        __builtin_amdgcn_wave_barrier();
        float ts[2]; int ti[2];
#pragma unroll
        for (int pp = 0; pp < 2; ++pp) {
            const float* k0 = p.peer_sub_keys + ((size_t)(h * 2 + pp) * 128 + lane) * 128; const float* k1 = k0 + 64 * 128; const float* qq = ql + pp * 128;
            float s0 = 0.f, s1 = 0.f;
            for (int c = 0; c < 128; c += 4) { const float4 a = *(const float4*)(k0 + c), b = *(const float4*)(k1 + c);
                s0 += qq[c] * a.x + qq[c + 1] * a.y + qq[c + 2] * a.z + qq[c + 3] * a.w; s1 += qq[c] * b.x + qq[c + 1] * b.y + qq[c + 2] * b.z + qq[c + 3] * b.w; }
            float tsv = 0.f; int tiv = 0;
            for (int r = 0; r < PK; ++r) { const float m = wave_max(fmaxf(s0, s1));
                const int cand = (s0 == m) ? lane : ((s1 == m) ? lane + 64 : 1000); const int key = wave_min_i(cand);
                if (lane == r) { tsv = m; tiv = key; }
                if (key == lane) s0 = NEG; if (key == lane + 64) s1 = NEG; }
            ts[pp] = tsv; ti[pp] = tiv; }
        float cs[4]; const int ci = lane >> 2, cj = (lane & 3) * 4; const float a = __shfl(ts[0], ci);
#pragma unroll
        for (int m = 0; m < 4; ++m) cs[m] = a + __shfl(ts[1], cj + m);
        float bs = 0.f; int bpos = 0;
        for (int r = 0; r < PK; ++r) { const float m = wave_max(fmaxf(fmaxf(cs[0], cs[1]), fmaxf(cs[2], cs[3])));
            int cand = 1000;
#pragma unroll
            for (int mm = 3; mm >= 0; --mm) if (cs[mm] == m) cand = ci * 16 + cj + mm;
            const int pos = wave_min_i(cand);
            if (lane == r) { bs = m; bpos = pos; }
#pragma unroll
            for (int mm = 0; mm < 4; ++mm) if (pos == ci * 16 + cj + mm) cs[mm] = NEG; }
        const int e1 = __shfl(ti[0], (bpos >> 4) & 15), e2 = __shfl(ti[1], bpos & 15);
        const float m0 = __shfl(bs, 0); const float ex = lane < PK ? __expf(bs - m0) : 0.f; const float sum = wave_sum(ex);
        if (lane < PK) { idxo[(size_t)t * 128 + h * PK + lane] = e1 * 128 + e2; gato[(size_t)t * 128 + h * PK + lane] = ex / sum; }
        __builtin_amdgcn_wave_barrier();
    }
}

__device__ __forceinline__ int f2key(float f) { const int b = __float_as_int(f); return b ^ ((b >> 31) & 0x7fffffff); }
__device__ __forceinline__ float key2f(int k) { return __int_as_float(k ^ ((k >> 31) & 0x7fffffff)); }
typedef int i32x16 __attribute__((ext_vector_type(16)));
typedef float f32x16v __attribute__((ext_vector_type(16)));
#define TK_CE(v, i, l) do { const int _a = v[i], _b = v[l]; v[i] = max(_a, _b); v[l] = min(_a, _b); } while (0)
__device__ __forceinline__ i32x16 sort16_desc(i32x16 v) {
#pragma unroll
    for (int lk = 1; lk <= 4; ++lk)
#pragma unroll
        for (int lj = 3; lj >= 0; --lj) { if (lj >= lk) continue; const int k = 1 << lk, j = 1 << lj;
#pragma unroll
            for (int i = 0; i < 16; ++i) { const int l = i ^ j; if (l > i) { if ((i & k) == 0) TK_CE(v, i, l); else TK_CE(v, l, i); } } }
    return v;
}
__device__ __forceinline__ i32x16 bitonic_merge16_desc(i32x16 v) {
#pragma unroll
    for (int lj = 3; lj >= 0; --lj) { const int j = 1 << lj;
#pragma unroll
        for (int i = 0; i < 16; ++i) { const int l = i ^ j; if (l > i) TK_CE(v, i, l); } }
    return v;
}
__device__ __forceinline__ i32x16 merge_top16(i32x16 a, i32x16 b) {
#pragma unroll
    for (int i = 0; i < 16; ++i) a[i] = max(a[i], b[15 - i]);
    return bitonic_merge16_desc(a);
}
__device__ __forceinline__ i32x16 xlane_merge_top16(i32x16 a, int xr) {
    i32x16 b;
#pragma unroll
    for (int i = 0; i < 16; ++i) b[i] = __shfl_xor(a[i], xr);
    return merge_top16(a, b);
}
__device__ __forceinline__ int sel2i(bool c, int x, int y) { return c ? y : x; }
__device__ __forceinline__ int sel16(i32x16 v, int i) {
    const bool c0 = (i & 1) != 0, c1 = (i & 2) != 0, c2 = (i & 4) != 0, c3 = (i & 8) != 0;
    const int a0 = sel2i(c0, v[0], v[1]), a1 = sel2i(c0, v[2], v[3]), a2 = sel2i(c0, v[4], v[5]), a3 = sel2i(c0, v[6], v[7]);
    const int a4 = sel2i(c0, v[8], v[9]), a5 = sel2i(c0, v[10], v[11]), a6 = sel2i(c0, v[12], v[13]), a7 = sel2i(c0, v[14], v[15]);
    const int b0 = sel2i(c1, a0, a1), b1 = sel2i(c1, a2, a3), b2 = sel2i(c1, a4, a5), b3 = sel2i(c1, a6, a7);
    const int d0 = sel2i(c2, b0, b1), d1 = sel2i(c2, b2, b3);
    return sel2i(c3, d0, d1);
}
__device__ __forceinline__ int sel4i(int g, int a, int b, int c, int d) { return g == 0 ? a : (g == 1 ? b : (g == 2 ? c : d)); }
__device__ __forceinline__ float sel4f(int g, float a, float b, float c, float d) { return g == 0 ? a : (g == 1 ? b : (g == 2 ? c : d)); }
constexpr int TK_TAB[64] = {
    0x00, 0x01, 0x02, 0x03, 0x04, 0x05, 0x06, 0x07, 0x08, 0x09, 0x0A, 0x0B, 0x0C, 0x0D, 0x0E, 0x0F,
    0x10, 0x11, 0x12, 0x13, 0x14, 0x15, 0x16, 0x17, 0x40, 0x41, 0x42, 0x80, 0x90, 0xFF, 0xFF, 0xFF,
    0x20, 0x21, 0x22, 0x23, 0x24, 0x30, 0x31, 0x32, 0x33, 0x50, 0x51, 0xA0, 0xB0, 0xFF, 0xFF, 0xFF,
    0x60, 0x61, 0x70, 0x71, 0xC0, 0xD0, 0xE0, 0xF0, 0xFF, 0xFF, 0xFF, 0xFF, 0xFF, 0xFF, 0xFF, 0xFF};
template <int C> __device__ __forceinline__ int tk_make_cand(i32x16 sp0, i32x16 sp1, int g) {
    constexpr int NONE = (int)0x80000000;
    constexpr int e0 = TK_TAB[C], e1 = TK_TAB[16 + C], e2 = TK_TAB[32 + C], e3 = TK_TAB[48 + C];
    constexpr int r0 = (e0 >> 4) & 15, r1 = e1 == 0xFF ? 0 : (e1 >> 4) & 15, r2 = e2 == 0xFF ? 0 : (e2 >> 4) & 15, r3 = e3 == 0xFF ? 0 : (e3 >> 4) & 15;
    constexpr int c0 = e0 & 15, c1 = e1 == 0xFF ? 0 : e1 & 15, c2 = e2 == 0xFF ? 0 : e2 & 15, c3 = e3 == 0xFF ? 0 : e3 & 15;
    const int av = sel4i(g, sp0[r0], sp0[r1], sp0[r2], sp0[r3]);
    const int bv = sel4i(g, sp1[c0], sp1[c1], sp1[c2], sp1[c3]);
    const int code = sel4i(g, e0, e1, e2, e3);
    const float sum = key2f(av & ~127) + key2f(bv & ~127);
    return code == 0xFF ? NONE : ((f2key(sum) & ~255) | code);
}
__device__ void phase_topk(const Params& p, unsigned char* lds_) {
    LAS unsigned char* lds = (LAS unsigned char*)lds_;
    const int tid = threadIdx.x, lane = tid & 63, w = __builtin_amdgcn_readfirstlane(tid >> 6), l15 = lane & 15, g = lane >> 4;
    const bf16_t* pq = (const bf16_t*)(p.ws + OFF_QKV + (size_t)T * D * 2); const bf16_t* skb = (const bf16_t*)(p.ws + OFF_SUBK);
    int* idxo = (int*)(p.ws + OFF_IDX); float* gato = (float*)(p.ws + OFF_GATE);
    int cur_h = -1;
    for (int task = blockIdx.x; task < (T / 128) * PH; task += gridDim.x) {
        const int h = task & 7, tt = task >> 3;
        if (h != cur_h) {
            __syncthreads();
#pragma unroll
            for (int i = 0; i < 8; ++i) { const int ch = i * NTHR + tid, row = ch >> 4, c = ch & 15;
                *(LAS u32x4*)(lds + row * 256 + ((c ^ (row & 15)) << 4)) = *(const u32x4*)(skb + ((size_t)h * 256 + row) * 128 + c * 8); }
            __syncthreads();
            cur_h = h;
        }
        const int t = tt * 128 + 16 * w + l15;
        i32x16 sp0, sp1;
#pragma unroll
        for (int pp = 0; pp < 2; ++pp) {
            bf16x8 bq[4];
#pragma unroll
            for (int ks = 0; ks < 4; ++ks) bq[ks] = *(const bf16x8*)(pq + (size_t)t * D + h * 256 + pp * 128 + 32 * ks + 8 * g);
            i32x16 ka, kb2;
#pragma unroll
            for (int kt = 0; kt < 8; ++kt) {
                f32x4 a = {0.f, 0.f, 0.f, 0.f};
                const int row = pp * 128 + 16 * kt + l15;
#pragma unroll
                for (int ks = 0; ks < 4; ++ks) { const bf16x8 kf = *(const LAS bf16x8*)(lds + row * 256 + (((4 * ks + g) ^ (row & 15)) << 4)); a = __builtin_amdgcn_mfma_f32_16x16x32_bf16(kf, bq[ks], a, 0, 0, 0); }
#pragma unroll
                for (int rg = 0; rg < 4; ++rg) { const int key = (f2key(a[rg]) & ~127) | (16 * kt + rg + 4 * g);
                    if (kt < 4) ka[kt * 4 + rg] = key; else kb2[(kt - 4) * 4 + rg] = key; }
            }
            ka = merge_top16(sort16_desc(ka), sort16_desc(kb2));
            ka = xlane_merge_top16(ka, 16); ka = xlane_merge_top16(ka, 32);
            if (pp == 0) sp0 = ka; else sp1 = ka;
        }
        i32x16 cd;
        cd[0] = tk_make_cand<0>(sp0, sp1, g); cd[1] = tk_make_cand<1>(sp0, sp1, g); cd[2] = tk_make_cand<2>(sp0, sp1, g); cd[3] = tk_make_cand<3>(sp0, sp1, g);
        cd[4] = tk_make_cand<4>(sp0, sp1, g); cd[5] = tk_make_cand<5>(sp0, sp1, g); cd[6] = tk_make_cand<6>(sp0, sp1, g); cd[7] = tk_make_cand<7>(sp0, sp1, g);
        cd[8] = tk_make_cand<8>(sp0, sp1, g); cd[9] = tk_make_cand<9>(sp0, sp1, g); cd[10] = tk_make_cand<10>(sp0, sp1, g); cd[11] = tk_make_cand<11>(sp0, sp1, g);
        cd[12] = tk_make_cand<12>(sp0, sp1, g); cd[13] = tk_make_cand<13>(sp0, sp1, g); cd[14] = tk_make_cand<14>(sp0, sp1, g); cd[15] = tk_make_cand<15>(sp0, sp1, g);
        cd = sort16_desc(cd); cd = xlane_merge_top16(cd, 16); cd = xlane_merge_top16(cd, 32);
        f32x16v ex; float sum = 0.f; const float m0 = key2f(cd[0] & ~255);
#pragma unroll
        for (int i = 0; i < 16; ++i) { ex[i] = __expf(key2f(cd[i] & ~255) - m0); sum += ex[i]; }
        const float is = 1.0f / sum;
        int oi[4]; float og[4];
#pragma unroll
        for (int c = 0; c < 4; ++c) {
            const int key = sel4i(g, cd[c], cd[4 + c], cd[8 + c], cd[12 + c]);
            const float e = sel4f(g, ex[c], ex[4 + c], ex[8 + c], ex[12 + c]);
            const int i1 = sel16(sp0, (key >> 4) & 15) & 127, i2 = sel16(sp1, key & 15) & 127;
            oi[c] = i1 * 128 + i2; og[c] = e * is; }
        *(int4*)(idxo + (size_t)t * 128 + h * PK + 4 * g) = make_int4(oi[0], oi[1], oi[2], oi[3]);
        *(float4*)(gato + (size_t)t * 128 + h * PK + 4 * g) = make_float4(og[0], og[1], og[2], og[3]);
    }
}

__device__ void phase_gather(const Params& p) {
    const int lane = threadIdx.x & 63, gw = blockIdx.x * NWV + (threadIdx.x >> 6), nw = gridDim.x * NWV;
    const bf16_t* hn2 = (const bf16_t*)(p.ws + OFF_A); const bf16_t* ut = (const bf16_t*)(p.ws + OFF_UTAB); const bf16_t* vt = (const bf16_t*)(p.ws + OFF_VTAB);
    const int* idx = (const int*)(p.ws + OFF_IDX); const float* gate = (const float*)(p.ws + OFF_GATE);
    for (int t = gw; t < T; t += nw) {
        float xf[32], acc[32];
#pragma unroll
        for (int c = 0; c < 4; ++c) { const u32x4 w = *(const u32x4*)(hn2 + (size_t)t * D + c * 512 + lane * 8);
            xf[c * 8 + 0] = bflo(w.x); xf[c * 8 + 1] = bfhi(w.x); xf[c * 8 + 2] = bflo(w.y); xf[c * 8 + 3] = bfhi(w.y); xf[c * 8 + 4] = bflo(w.z); xf[c * 8 + 5] = bfhi(w.z); xf[c * 8 + 6] = bflo(w.w); xf[c * 8 + 7] = bfhi(w.w); }
#pragma unroll
        for (int j = 0; j < 32; ++j) acc[j] = 0.f;
#pragma unroll 2
        for (int n = 0; n < 128; ++n) {
            const int e = __builtin_amdgcn_readfirstlane(idx[(size_t)t * 128 + n]); const float g = gate[(size_t)t * 128 + n];
            const bf16_t* ur = ut + (size_t)e * D; const bf16_t* vr = vt + (size_t)e * D;
            u32x4 uw[4], vw[4];
#pragma unroll
            for (int c = 0; c < 4; ++c) { uw[c] = *(const u32x4*)(ur + c * 512 + lane * 8); vw[c] = *(const u32x4*)(vr + c * 512 + lane * 8); }
            float dsum = 0.f;
#pragma unroll
            for (int c = 0; c < 4; ++c) dsum += xf[c * 8 + 0] * bflo(uw[c].x) + xf[c * 8 + 1] * bfhi(uw[c].x) + xf[c * 8 + 2] * bflo(uw[c].y) + xf[c * 8 + 3] * bfhi(uw[c].y)
                                              + xf[c * 8 + 4] * bflo(uw[c].z) + xf[c * 8 + 5] * bfhi(uw[c].z) + xf[c * 8 + 6] * bflo(uw[c].w) + xf[c * 8 + 7] * bfhi(uw[c].w);
            dsum = wave_sum(dsum);
            const float w = g * gelu_erf(dsum);
#pragma unroll
            for (int c = 0; c < 4; ++c) { acc[c * 8 + 0] += w * bflo(vw[c].x); acc[c * 8 + 1] += w * bfhi(vw[c].x); acc[c * 8 + 2] += w * bflo(vw[c].y); acc[c * 8 + 3] += w * bfhi(vw[c].y);
                acc[c * 8 + 4] += w * bflo(vw[c].z); acc[c * 8 + 5] += w * bfhi(vw[c].z); acc[c * 8 + 6] += w * bflo(vw[c].w); acc[c * 8 + 7] += w * bfhi(vw[c].w); }
        }
        const int b = t / S; float* hrow = p.out + (size_t)t * D; float ss = 0.f;
#pragma unroll
        for (int c = 0; c < 4; ++c) { const int col = c * 512 + lane * 8;
            const float4 h0 = *(const float4*)(hrow + col), h1 = *(const float4*)(hrow + col + 4);
            const float4 g0 = mod4(p, b, 5, col), g1 = mod4(p, b, 5, col + 4);
            acc[c * 8 + 0] = h0.x + g0.x * acc[c * 8 + 0]; acc[c * 8 + 1] = h0.y + g0.y * acc[c * 8 + 1]; acc[c * 8 + 2] = h0.z + g0.z * acc[c * 8 + 2]; acc[c * 8 + 3] = h0.w + g0.w * acc[c * 8 + 3];
            acc[c * 8 + 4] = h1.x + g1.x * acc[c * 8 + 4]; acc[c * 8 + 5] = h1.y + g1.y * acc[c * 8 + 5]; acc[c * 8 + 6] = h1.z + g1.z * acc[c * 8 + 6]; acc[c * 8 + 7] = h1.w + g1.w * acc[c * 8 + 7];
#pragma unroll
            for (int j = 0; j < 8; ++j) ss += acc[c * 8 + j] * acc[c * 8 + j]; }
        ss = wave_sum(ss); const float rs = rsqrtf(ss * (1.0f / D) + 1e-6f);
#pragma unroll
        for (int c = 0; c < 4; ++c) { const int col = c * 512 + lane * 8;
            const float4 g0 = *(const float4*)(p.g_final + col), g1 = *(const float4*)(p.g_final + col + 4);
            *(float4*)(hrow + col) = make_float4(acc[c * 8 + 0] * rs * g0.x, acc[c * 8 + 1] * rs * g0.y, acc[c * 8 + 2] * rs * g0.z, acc[c * 8 + 3] * rs * g0.w);
            *(float4*)(hrow + col + 4) = make_float4(acc[c * 8 + 4] * rs * g1.x, acc[c * 8 + 5] * rs * g1.y, acc[c * 8 + 6] * rs * g1.z, acc[c * 8 + 7] * rs * g1.w); }
    }
}

constexpr int LDS_BYTES = 147456;
template <int PHASE> __global__ void __launch_bounds__(NTHR, 2) k_phase(Params p) {
    extern __shared__ __attribute__((aligned(16))) unsigned char lds[];
    if (PHASE == 0) phase_conv(p, lds);
    if (PHASE == 1) phase_norm_mod(p, p.x, p.g_norm1, 0, 1, (bf16_t*)(p.ws + OFF_A));
    if (PHASE == 2) phase_gemm1_naive(p, lds);
    if (PHASE == 3) { phase_attn_naive(p, lds); phase_sgu_ln_naive(p); }
    if (PHASE == 4) phase_sgu_mix_naive(p);
    if (PHASE == 5) phase_combine(p);
    if (PHASE == 6) phase_gemm2_naive(p, lds);
    if (PHASE == 7) phase_norm_mod(p, p.out, p.g_norm2, 3, 4, (bf16_t*)(p.ws + OFF_A));
    if (PHASE == 8) phase_gemm3_naive(p, lds);
    if (PHASE == 9) phase_topk_naive(p, lds);
    if (PHASE == 10) phase_gather(p);
}

#ifndef PHASE_MASK
#define PHASE_MASK 0x3FF
#endif
__global__ void __launch_bounds__(NTHR, 2) k_mega(Params p) {
    extern __shared__ __attribute__((aligned(16))) unsigned char lds[];
    cg::grid_group grid = cg::this_grid();
    if (PHASE_MASK & 1) { phase_conv(p, lds); grid.sync(); }
    if (PHASE_MASK & 2) { phase_norm_mod(p, p.x, p.g_norm1, 0, 1, (bf16_t*)(p.ws + OFF_A)); grid.sync(); }
    if (PHASE_MASK & 4) { phase_gemm1(p, lds); grid.sync(); }
    if (PHASE_MASK & 8) { phase_attn(p, lds); phase_sgu(p, lds); grid.sync(); }
    if (PHASE_MASK & 16) { phase_combine(p); grid.sync(); }
    if (PHASE_MASK & 32) { phase_gemm2(p, lds); grid.sync(); }
    if (PHASE_MASK & 64) { phase_norm_mod(p, p.out, p.g_norm2, 3, 4, (bf16_t*)(p.ws + OFF_A)); grid.sync(); }
    if (PHASE_MASK & 128) { phase_gemm3(p, lds); grid.sync(); }
    if (PHASE_MASK & 256) { phase_topk(p, lds); grid.sync(); }
    if (PHASE_MASK & 512) { phase_gather(p); }
}

#ifndef MEGA
#define MEGA 1
#endif
template <int PHASE> static void launch_phase(const Params& p, int grid, hipStream_t stream) {
    static bool attr = false;
    if (!attr) { (void)hipFuncSetAttribute((const void*)k_phase<PHASE>, hipFuncAttributeMaxDynamicSharedMemorySize, LDS_BYTES); attr = true; }
    hipLaunchKernelGGL(k_phase<PHASE>, dim3(grid), dim3(NTHR), LDS_BYTES, stream, p);
}

extern "C" void kernel_launch(void* const* d_in, const int* in_sizes, int n_in, void* d_out, int out_size, void* d_ws, size_t ws_size, hipStream_t stream) {
    if (n_in != 20 || out_size != T * D || ws_size < WS_END) { fprintf(stderr, "kernel_launch: unexpected problem (n_in %d out %d ws %zu, need %zu)\n", n_in, out_size, ws_size, (size_t)WS_END); return; }
    Params p{};
    p.x = (const float*)d_in[0]; p.c = (const float*)d_in[1]; p.pos = (const int*)d_in[2]; p.w_ada = (const float*)d_in[3]; p.b_ada = (const float*)d_in[4];
    p.g_norm1 = (const float*)d_in[5]; p.w_in = (const float*)d_in[6]; p.g_attn_out = (const float*)d_in[7]; p.g_sgu_out = (const float*)d_in[8];
    p.sgu_w = (const float*)d_in[9]; p.sgu_b = (const float*)d_in[10]; p.sgu_ln_g = (const float*)d_in[11]; p.sgu_ln_b = (const float*)d_in[12];
    p.w_out = (const float*)d_in[13]; p.g_norm2 = (const float*)d_in[14]; p.peer_w_q = (const float*)d_in[15]; p.peer_sub_keys = (const float*)d_in[16];
    p.peer_u = (const float*)d_in[17]; p.peer_v = (const float*)d_in[18]; p.g_final = (const float*)d_in[19];
    p.out = (float*)d_out; p.ws = (unsigned char*)d_ws;
    (void)hipMemsetAsync((char*)d_ws + OFF_CTL, 0, OFF_SGUW - OFF_CTL, stream);
#if MEGA
    static int grid_blocks = 0;
    if (!grid_blocks) {
        int dev = 0, cus = 0, per_cu = 0;
        (void)hipGetDevice(&dev); (void)hipDeviceGetAttribute(&cus, hipDeviceAttributeMultiprocessorCount, dev);
        (void)hipFuncSetAttribute((const void*)k_mega, hipFuncAttributeMaxDynamicSharedMemorySize, LDS_BYTES);
        (void)hipOccupancyMaxActiveBlocksPerMultiprocessor(&per_cu, (const void*)k_mega, NTHR, LDS_BYTES);
        if (per_cu < 1) { fprintf(stderr, "kernel_launch: occupancy query says %d blocks per CU\n", per_cu); per_cu = 1; }
        if (per_cu > 1) per_cu = 1;
        grid_blocks = cus * per_cu;
    }
    void* args[] = {(void*)&p};
    hipError_t e = hipLaunchCooperativeKernel((const void*)k_mega, dim3(grid_blocks), dim3(NTHR), args, LDS_BYTES, stream);
    if (e != hipSuccess) fprintf(stderr, "cooperative launch failed: %s (grid %d)\n", hipGetErrorString(e), grid_blocks);
#else
    const int grid = 256;
    launch_phase<0>(p, grid, stream); launch_phase<1>(p, grid, stream); launch_phase<2>(p, grid, stream); launch_phase<3>(p, grid, stream);
    launch_phase<4>(p, grid, stream); launch_phase<5>(p, grid, stream); launch_phase<6>(p, grid, stream); launch_phase<7>(p, grid, stream);
    launch_phase<8>(p, grid, stream); launch_phase<9>(p, grid, stream); launch_phase<10>(p, grid, stream);
#endif
}
```

```cpp
#include <hip/hip_runtime.h>
#include <hip/hip_cooperative_groups.h>
#include <cstdio>
#include <cstdint>
namespace cg = cooperative_groups;

constexpr int D = 2048, NB = 4, S = 4096, T = NB * S;
constexpr int E = 128, HA = 12, HS = 4, DA = 1536, DS = 512, DIN = 5632;
constexpr int PH = 8, PK = 16, NEXP = 16384;
constexpr int NTHR = 512, NWV = 8;

typedef unsigned short bf16_t;
typedef unsigned u32x4 __attribute__((ext_vector_type(4)));
typedef unsigned u32x2 __attribute__((ext_vector_type(2)));
typedef float f32x4 __attribute__((ext_vector_type(4)));

__device__ __forceinline__ bf16_t f2bf(float f) { unsigned u = __float_as_uint(f); u += 0x7FFFu + ((u >> 16) & 1u); return (bf16_t)(u >> 16); }
__device__ __forceinline__ float bf2f(bf16_t b) { return __uint_as_float(((unsigned)b) << 16); }
__device__ __forceinline__ unsigned pack2(float lo, float hi) { return (unsigned)f2bf(lo) | ((unsigned)f2bf(hi) << 16); }
__device__ __forceinline__ float bflo(unsigned w) { return __uint_as_float(w << 16); }
__device__ __forceinline__ float bfhi(unsigned w) { return __uint_as_float(w & 0xffff0000u); }
__device__ __forceinline__ float wave_sum(float v) {
#pragma unroll
    for (int o = 32; o >= 1; o >>= 1) v += __shfl_xor(v, o);
    return v; }
__device__ __forceinline__ float wave_max(float v) {
#pragma unroll
    for (int o = 32; o >= 1; o >>= 1) v = fmaxf(v, __shfl_xor(v, o));
    return v; }
__device__ __forceinline__ int wave_min_i(int v) {
#pragma unroll
    for (int o = 32; o >= 1; o >>= 1) v = min(v, __shfl_xor(v, o));
    return v; }
__device__ __forceinline__ float gelu_erf(float v) { return 0.5f * v * (1.0f + erff(v * 0.70710678118654752f)); }

constexpr size_t OFF_CTL  = 0;
constexpr size_t OFF_MOD  = 65536;
constexpr size_t OFF_SGUW = OFF_MOD + 393216;
constexpr size_t OFF_SUBK = OFF_SGUW + 131072;
constexpr size_t OFF_LSE  = OFF_SUBK + 524288;
constexpr size_t OFF_IDX  = OFF_LSE + (size_t)3 * T * 12 * 4;
constexpr size_t OFF_GATE = OFF_IDX + (size_t)T * 128 * 4;
constexpr size_t OFF_WIN  = OFF_GATE + (size_t)T * 128 * 4;
constexpr size_t OFF_WOUT = OFF_WIN + (size_t)DIN * D * 2;
constexpr size_t OFF_WQ   = OFF_WOUT + (size_t)D * D * 2;
constexpr size_t OFF_UTAB = OFF_WQ + (size_t)D * D * 2;
constexpr size_t TAB8_BYTES = (size_t)NEXP * D;
constexpr size_t OFF_VTAB = OFF_UTAB + (size_t)NEXP * D * 2;
constexpr size_t OFF_A    = OFF_VTAB + (size_t)NEXP * D * 2;
constexpr size_t OFF_QKV  = OFF_A + (size_t)T * D * 2;
constexpr size_t QKV_ONE  = (size_t)T * DA * 2;
constexpr size_t OFF_US   = OFF_QKV + 3 * QKV_ONE;
constexpr size_t OFF_VS   = OFF_US + (size_t)T * DS * 2;
constexpr size_t OFF_SGUO = OFF_VS + (size_t)T * DS * 2;
constexpr size_t OFF_O12  = OFF_SGUO + (size_t)T * DS * 2;
constexpr size_t WS_END   = OFF_O12 + 2 * QKV_ONE;

struct Params {
    const float* x; const float* c; const int* pos; const float* w_ada; const float* b_ada; const float* g_norm1; const float* w_in;
    const float* g_attn_out; const float* g_sgu_out; const float* sgu_w; const float* sgu_b; const float* sgu_ln_g; const float* sgu_ln_b;
    const float* w_out; const float* g_norm2; const float* peer_w_q; const float* peer_sub_keys; const float* peer_u; const float* peer_v;
    const float* g_final; float* out; unsigned char* ws;
};
__device__ __forceinline__ float fx2f(long long v) { return (float)(int)(v >> 32) + (float)(unsigned)v * 2.3283064365386963e-10f; }
__device__ __forceinline__ float mod1(const Params& p, int b, int i, int col) { return fx2f(((const long long*)(p.ws + OFF_MOD))[b * 12288 + i * D + col]); }
__device__ __forceinline__ float4 mod4q(const long long* mp) { return make_float4(fx2f(mp[0]), fx2f(mp[1]), fx2f(mp[2]), fx2f(mp[3])); }
__device__ __forceinline__ float4 mod4(const Params& p, int b, int i, int col) { return mod4q((const long long*)(p.ws + OFF_MOD) + b * 12288 + i * D + col); }
__device__ __forceinline__ bf16_t* P_opat(const Params& p, int pat) { return (bf16_t*)(pat == 0 ? p.ws + OFF_A : p.ws + OFF_O12 + (size_t)(pat - 1) * QKV_ONE); }

namespace pg8 {
#define PG8_LAS __attribute__((address_space(3)))
typedef unsigned short bf16_t;
typedef short bf16x8 __attribute__((ext_vector_type(8)));
typedef float f32x4 __attribute__((ext_vector_type(4)));
typedef unsigned u32x4 __attribute__((ext_vector_type(4)));
constexpr int BM = 256, BK = 64, HALF = 128, HTB = HALF * BK * 2  , STAGE_BYTES = 8 * HTB, NXCD = 8, WGM = 8;

__host__ __device__ __forceinline__ int lds_byte(int r, int c) { const int st = (r >> 4) * 2 + (c >> 5), rr = r & 15, cc = c & 31, ob = rr * 64 + cc * 2; return st * 1024 + (ob ^ (((ob >> 9) & 1) << 5)); }
__host__ __device__ __forceinline__ void stage_rc(int b, int& R, int& C) { const int st = b / 1024, sb = b % 1024, swz = sb ^ (((sb >> 9) & 1) << 5); R = (st >> 1) * 16 + swz / 64; C = (st & 1) * 32 + (swz % 64) / 2; }
__host__ __device__ __forceinline__ int perm32(int rho) { const int n = rho >> 4, i = rho & 15; return 8 * (i >> 2) + 4 * n + (i & 3); }

struct Unit { int pm, pn; };
struct Gemm { const bf16_t* A; const bf16_t* Bt; int M, N, K; };

struct StaticOrder {
    int nM, nN, nwg, G, c;
    __host__ __device__ void init(int M, int N, int G_, int c_) { nM = M / BM; nN = N / BM; nwg = nM * nN; G = G_; c = c_; }
    __host__ __device__ bool next(int i, Unit& u) const {
        const long L = (long)i * G + c; if (L >= nwg) return false;
        int wgid = (int)L; { const int q = nwg / NXCD, r = nwg % NXCD, xcd = wgid % NXCD, off = wgid / NXCD; wgid = (xcd < r ? xcd * (q + 1) : r * (q + 1) + (xcd - r) * q) + off; }
        const int nig = WGM * nN, gid = wgid / nig, fm = gid * WGM, gsz = (nM - fm) < WGM ? (nM - fm) : WGM;
        u.pm = fm + ((wgid % nig) % gsz); u.pn = (wgid % nig) / gsz; return true;
    }
    __device__ __forceinline__ void a_ready(const Unit&) const {}
    __device__ __forceinline__ void done(const Unit&) const {}
};

__device__ __forceinline__ unsigned cvt_pk_bf16(float lo, float hi) { unsigned r; asm volatile("v_cvt_pk_bf16_f32 %0, %1, %2" : "=v"(r) : "v"(lo), "v"(hi)); return r; }
typedef float f32x2 __attribute__((ext_vector_type(2)));
__device__ __forceinline__ f32x2 gelu_pk(f32x2 v) {
    const f32x2 av = __builtin_elementwise_abs(v), d = av * 0.2316418882f + 1.0f;
    f32x2 t; t.x = __builtin_amdgcn_rcpf(d.x); t.y = __builtin_amdgcn_rcpf(d.y);
    f32x2 q = t * 0.5307027145f + (-0.7265760135f); q = q * t + 0.7107068705f; q = q * t + (-0.142248368f); q = q * t + 0.127414796f; q = q * t;
    const f32x2 s = (v * v) * (-0.72134752044f);
    f32x2 e; e.x = __builtin_amdgcn_exp2f(s.x); e.y = __builtin_amdgcn_exp2f(s.y);
    const f32x2 m = v * (q * e), r = v - m;
    f32x2 o; o.x = v.x < 0.f ? m.x : r.x; o.y = v.y < 0.f ? m.y : r.y; return o;
}

template <class Epi, class Sched, bool ALIGN_EPI = false, bool SP2 = false>
__device__ __forceinline__ void gemm_phase(PG8_LAS unsigned char* lds, const Gemm g, const Sched& S, const Epi& E) {
    const int tid = threadIdx.x, wid = __builtin_amdgcn_readfirstlane(tid >> 6), lane = tid & 63, wr = wid >> 2, wc = wid & 3, fr = lane & 15, fq = lane >> 4;
    const int K = g.K, nt = K / BK;
    unsigned voffA[2], voffB[2];
#pragma unroll
    for (int i = 0; i < 2; ++i) { int R, C; stage_rc(tid * 16 + i * 8192, R, C); const int Rb = Epi::PERM ? ((R & ~31) + perm32(R & 31)) : R;
        voffA[i] = (unsigned)(R * K + C) * 2u; voffB[i] = (unsigned)(Rb * K + C) * 2u; }
    const size_t kstep = (size_t)(BK * 2);
    const size_t hstep = (size_t)HALF * K * 2;
    const size_t tstep = 2 * hstep;
    const unsigned ldsw = (unsigned)wid * 1024u;
    const int aoff = lds_byte(wr * 64 + fr, fq * 8), boff = lds_byte(wc * 32 + fr, fq * 8);
#define PG8_SA(b, h) (((b) * 2 + (h)) * HTB)
#define PG8_SB(b, h) ((4 + (b) * 2 + (h)) * HTB)
#define PG8_STAGE(bufoff, gbase, voff) do { _Pragma("unroll") for (int _i = 0; _i < 2; ++_i) \
        __builtin_amdgcn_global_load_lds((const unsigned*)((const char*)(gbase) + (voff)[_i]), (PG8_LAS unsigned*)(lds + (bufoff) + ldsw + _i * 8192), 16, 0, 0); } while (0)
#define PG8_LDA(dst, b, h) do { _Pragma("unroll") for (int m = 0; m < 4; ++m) _Pragma("unroll") for (int k = 0; k < 2; ++k) dst[m][k] = *(const PG8_LAS bf16x8*)(lds + PG8_SA(b, h) + aoff + m * 2048 + k * 1024); } while (0)
#define PG8_LDB(dst, b, h) do { _Pragma("unroll") for (int n = 0; n < 2; ++n) _Pragma("unroll") for (int k = 0; k < 2; ++k) dst[n][k] = *(const PG8_LAS bf16x8*)(lds + PG8_SB(b, h) + boff + n * 2048 + k * 1024); } while (0)
#define PG8_MMA(ai, bj, At, Bt) do { __builtin_amdgcn_s_setprio(1); _Pragma("unroll") for (int m = 0; m < 4; ++m) _Pragma("unroll") for (int n = 0; n < 2; ++n) _Pragma("unroll") for (int k = 0; k < 2; ++k) \
        acc[ai][bj][m][n] = __builtin_amdgcn_mfma_f32_16x16x32_bf16(Bt[n][k], At[m][k], acc[ai][bj][m][n], 0, 0, 0); __builtin_amdgcn_s_setprio(0); } while (0)
#define PG8_WAIT_V(n) asm volatile("s_waitcnt vmcnt(" #n ")" ::: "memory")
#define PG8_WAIT_L(n) asm volatile("s_waitcnt lgkmcnt(" #n ")" ::: "memory")
#define PG8_BAR __builtin_amdgcn_s_barrier()
#define PG8_SCHED __builtin_amdgcn_sched_barrier(0)
    Unit cur, nxt; int ui = 0;
    if (!S.next(0, cur)) return;
    f32x4 acc[2][2][4][2];
#pragma unroll
    for (int a = 0; a < 2; ++a)
#pragma unroll
        for (int b = 0; b < 2; ++b)
#pragma unroll
            for (int m = 0; m < 4; ++m)
#pragma unroll
                for (int n = 0; n < 2; ++n) acc[a][b][m][n] = (f32x4){0.f, 0.f, 0.f, 0.f};
    bf16x8 At[4][2], B0[2][2], B1[2][2];
    const char* cA = (const char*)g.A + (size_t)cur.pm * tstep; const char* cB = (const char*)g.Bt + (size_t)cur.pn * tstep;
    S.a_ready(cur);
    if constexpr (SP2) {
        PG8_STAGE(PG8_SB(0, 0), cB, voffB); PG8_STAGE(PG8_SB(0, 1), cB + hstep, voffB); PG8_STAGE(PG8_SA(0, 0), cA, voffA); PG8_STAGE(PG8_SA(0, 1), cA + hstep, voffA);
        if (wr == 1) PG8_BAR;
        PG8_WAIT_V(2); PG8_BAR;
        PG8_STAGE(PG8_SB(1, 0), cB + kstep, voffB); PG8_STAGE(PG8_SA(1, 0), cA + kstep, voffA); PG8_STAGE(PG8_SB(1, 1), cB + hstep + kstep, voffB);
        PG8_WAIT_V(6); PG8_BAR;
    } else {
        PG8_STAGE(PG8_SB(0, 0), cB, voffB); PG8_STAGE(PG8_SA(0, 0), cA, voffA); PG8_STAGE(PG8_SB(0, 1), cB + hstep, voffB); PG8_STAGE(PG8_SA(0, 1), cA + hstep, voffA);
        if (wr == 1) PG8_BAR;
        PG8_WAIT_V(4); PG8_BAR;
        PG8_STAGE(PG8_SB(1, 0), cB + kstep, voffB); PG8_STAGE(PG8_SA(1, 0), cA + kstep, voffA); PG8_STAGE(PG8_SB(1, 1), cB + hstep + kstep, voffB);
        PG8_WAIT_V(6); PG8_BAR;
    }
    for (;;) {
        const bool has_next = S.next(ui + 1, nxt);
        const char* nA = has_next ? (const char*)g.A + (size_t)nxt.pm * tstep : cA; const char* nB = has_next ? (const char*)g.Bt + (size_t)nxt.pn * tstep : cB;
        for (int t = 0; t < nt; t += 2) {
            const bool last = (t == nt - 2);
            const char* a1 = cA + (size_t)(t + 1) * kstep;
            const char* a2 = last ? nA : cA + (size_t)(t + 2) * kstep; const char* b2 = last ? nB : cB + (size_t)(t + 2) * kstep;
            const char* a3 = a2 + kstep; const char* b3 = b2 + kstep;
            if (last && has_next) S.a_ready(nxt);
            if constexpr (SP2) {
            PG8_LDB(B0, 0, 0); PG8_LDB(B1, 0, 1); PG8_SCHED; PG8_LDA(At, 0, 0); PG8_STAGE(PG8_SA(1, 1), a1 + hstep, voffA);
            PG8_WAIT_V(8); PG8_WAIT_L(0); PG8_BAR; PG8_MMA(0, 0, At, B0); PG8_MMA(0, 1, At, B1); PG8_BAR; PG8_SCHED;
            PG8_LDA(At, 0, 1); PG8_STAGE(PG8_SB(0, 0), b2, voffB); PG8_STAGE(PG8_SB(0, 1), b2 + hstep, voffB); PG8_STAGE(PG8_SA(0, 0), a2, voffA);
            PG8_WAIT_V(8); PG8_WAIT_L(0); PG8_BAR; PG8_MMA(1, 0, At, B0); PG8_MMA(1, 1, At, B1); PG8_BAR; PG8_SCHED;
            PG8_LDB(B0, 1, 0); PG8_LDB(B1, 1, 1); PG8_SCHED; PG8_LDA(At, 1, 0); PG8_STAGE(PG8_SA(0, 1), a2 + hstep, voffA);
            PG8_WAIT_V(8); PG8_WAIT_L(0); PG8_BAR; PG8_MMA(0, 0, At, B0); PG8_MMA(0, 1, At, B1); PG8_BAR; PG8_SCHED;
            PG8_LDA(At, 1, 1); PG8_STAGE(PG8_SB(1, 0), b3, voffB); PG8_STAGE(PG8_SB(1, 1), b3 + hstep, voffB); PG8_STAGE(PG8_SA(1, 0), a3, voffA);
            PG8_WAIT_V(8); PG8_WAIT_L(0); PG8_BAR; PG8_MMA(1, 0, At, B0); PG8_MMA(1, 1, At, B1); PG8_BAR; PG8_SCHED;
            } else {
            PG8_LDB(B0, 0, 0); PG8_SCHED; PG8_LDA(At, 0, 0); PG8_STAGE(PG8_SA(1, 1), a1 + hstep, voffA);
            PG8_WAIT_L(8); PG8_BAR; PG8_WAIT_L(0); PG8_MMA(0, 0, At, B0); PG8_BAR; PG8_SCHED;
            PG8_LDB(B1, 0, 1); PG8_STAGE(PG8_SB(0, 0), b2, voffB);
            PG8_BAR; PG8_WAIT_L(0); PG8_MMA(0, 1, At, B1); PG8_BAR;
            PG8_LDA(At, 0, 1); PG8_STAGE(PG8_SA(0, 0), a2, voffA);
            PG8_BAR; PG8_WAIT_L(0); PG8_MMA(1, 0, At, B0); PG8_BAR; PG8_SCHED;
            PG8_STAGE(PG8_SB(0, 1), b2 + hstep, voffB);
            PG8_WAIT_V(6); PG8_BAR; PG8_MMA(1, 1, At, B1); PG8_BAR;
            PG8_LDB(B0, 1, 0); PG8_SCHED; PG8_LDA(At, 1, 0); PG8_STAGE(PG8_SA(0, 1), a2 + hstep, voffA);
            PG8_WAIT_L(8); PG8_BAR; PG8_WAIT_L(0); PG8_MMA(0, 0, At, B0); PG8_BAR; PG8_SCHED;
            PG8_LDB(B1, 1, 1); PG8_STAGE(PG8_SB(1, 0), b3, voffB);
            PG8_BAR; PG8_WAIT_L(0); PG8_MMA(0, 1, At, B1); PG8_BAR;
            PG8_LDA(At, 1, 1); PG8_STAGE(PG8_SA(1, 0), a3, voffA);
            PG8_BAR; PG8_WAIT_L(0); PG8_MMA(1, 0, At, B0); PG8_BAR; PG8_SCHED;
            PG8_STAGE(PG8_SB(1, 1), b3 + hstep, voffB);
            PG8_WAIT_V(6); PG8_BAR; PG8_MMA(1, 1, At, B1); PG8_BAR;
            }
        }
        if constexpr (ALIGN_EPI) { if (wr == 0) PG8_BAR; }
        if constexpr (!Epi::AFTER_DRAIN) { E(acc, cur, wr, wc, fr, fq); S.done(cur); }
        if (!has_next) break;
#pragma unroll
        for (int a = 0; a < 2; ++a)
#pragma unroll
            for (int b = 0; b < 2; ++b)
#pragma unroll
                for (int m = 0; m < 4; ++m)
#pragma unroll
                    for (int n = 0; n < 2; ++n) acc[a][b][m][n] = (f32x4){0.f, 0.f, 0.f, 0.f};
        cur = nxt; cA = nA; cB = nB; ++ui;
        if constexpr (ALIGN_EPI) { if (wr == 1) PG8_BAR; }
    }
    PG8_WAIT_V(0);
    if constexpr (!ALIGN_EPI) { if (wr == 0) PG8_BAR; }
    PG8_BAR;
    if constexpr (Epi::AFTER_DRAIN) { E.fused(acc, cur, wr, wc, fr, fq, lds, wid, lane); S.done(cur); }
#undef PG8_SA
#undef PG8_SB
#undef PG8_STAGE
#undef PG8_LDA
#undef PG8_LDB
#undef PG8_MMA
#undef PG8_WAIT_V
#undef PG8_WAIT_L
#undef PG8_BAR
#undef PG8_SCHED
}

struct EpiProj {
    static constexpr bool PERM = true, AFTER_DRAIN = false;
    bf16_t* q; bf16_t* k; bf16_t* v; bf16_t* us; bf16_t* vs; const int* pos;
    __device__ __forceinline__ void operator()(const f32x4 (&acc)[2][2][4][2], const Unit& u, int wr, int wc, int fr, int fq) const {
        const int row0 = u.pm * BM + wr * 64 + fr, b = u.pm >> 4;
        if (u.pn < 12) {
            const bool isq = u.pn < 6; bf16_t* base = isq ? q : k;
            const int hh = 2 * (isq ? u.pn : u.pn - 6) + (wc >> 1), e0 = 32 * (wc & 1) + 8 * fq;
            const float qs = isq ? 0.08838834764831845f : 1.0f;
            float ir[8];
#pragma unroll
            for (int j = 0; j < 8; ++j) ir[j] = exp2f(-(float)(e0 + j) * (13.287712379549449f / 64.0f)) * 0.15915494309189535f;
#pragma unroll
            for (int ai = 0; ai < 2; ++ai)
#pragma unroll
                for (int m = 0; m < 4; ++m) {
                    const int t = row0 + ai * HALF + m * 16, s = t & 4095;
                    const float pf = (float)pos[t];
                    float o0[8], o1[8];
#pragma unroll
                    for (int n = 0; n < 2; ++n)
#pragma unroll
                        for (int i = 0; i < 4; ++i) { const int j = 4 * n + i;
                            const float f = __builtin_amdgcn_fractf(pf * ir[j]); const float sn = __builtin_amdgcn_sinf(f), cs = __builtin_amdgcn_cosf(f);
                            const float t1 = acc[ai][0][m][n][i], t2 = acc[ai][1][m][n][i];
                            o0[j] = (t1 * cs - t2 * sn) * qs; o1[j] = (t2 * cs + t1 * sn) * qs; }
                    bf16_t* dst = base + ((size_t)(b * 12 + hh) * 4096 + s) * 128 + e0;
                    u32x4 w0, w1;
                    w0.x = cvt_pk_bf16(o0[0], o0[1]); w0.y = cvt_pk_bf16(o0[2], o0[3]); w0.z = cvt_pk_bf16(o0[4], o0[5]); w0.w = cvt_pk_bf16(o0[6], o0[7]);
                    w1.x = cvt_pk_bf16(o1[0], o1[1]); w1.y = cvt_pk_bf16(o1[2], o1[3]); w1.z = cvt_pk_bf16(o1[4], o1[5]); w1.w = cvt_pk_bf16(o1[6], o1[7]);
                    *(u32x4*)dst = w0; *(u32x4*)(dst + 64) = w1; }
        } else if (u.pn < 18) {
            const int e0 = 32 * wc + 8 * fq;
#pragma unroll
            for (int ai = 0; ai < 2; ++ai)
#pragma unroll
                for (int m = 0; m < 4; ++m) { const int t = row0 + ai * HALF + m * 16, s = t & 4095;
#pragma unroll
                    for (int bj = 0; bj < 2; ++bj) { const int hh = 2 * (u.pn - 12) + bj; const f32x4 v0 = acc[ai][bj][m][0], v1 = acc[ai][bj][m][1];
                        u32x4 w; w.x = cvt_pk_bf16(v0[0], v0[1]); w.y = cvt_pk_bf16(v0[2], v0[3]); w.z = cvt_pk_bf16(v1[0], v1[1]); w.w = cvt_pk_bf16(v1[2], v1[3]);
                        *(u32x4*)(v + ((size_t)(b * 12 + hh) * 4096 + s) * 128 + e0) = w; } }
        } else {
            bf16_t* base = u.pn < 20 ? us : vs; const int c0 = 256 * ((u.pn - 18) & 1) + 32 * wc + 8 * fq;
#pragma unroll
            for (int ai = 0; ai < 2; ++ai)
#pragma unroll
                for (int m = 0; m < 4; ++m) { const int t = row0 + ai * HALF + m * 16;
#pragma unroll
                    for (int bj = 0; bj < 2; ++bj) { const f32x4 v0 = acc[ai][bj][m][0], v1 = acc[ai][bj][m][1];
                        const f32x2 a = gelu_pk((f32x2){v0[0], v0[1]}), bb = gelu_pk((f32x2){v0[2], v0[3]}), c = gelu_pk((f32x2){v1[0], v1[1]}), d = gelu_pk((f32x2){v1[2], v1[3]});
                        u32x4 w; w.x = cvt_pk_bf16(a.x, a.y); w.y = cvt_pk_bf16(bb.x, bb.y); w.z = cvt_pk_bf16(c.x, c.y); w.w = cvt_pk_bf16(d.x, d.y);
                        *(u32x4*)(base + (size_t)t * 512 + c0 + 128 * bj) = w; } }
        }
    }
};
struct EpiRes {
    static constexpr bool PERM = false, AFTER_DRAIN = false;
    const float* x; float* out; const long long* modq;
    __device__ __forceinline__ void operator()(const f32x4 (&acc)[2][2][4][2], const Unit& u, int wr, int wc, int fr, int fq) const {
        const int row0 = u.pm * BM + wr * 64 + fr, col0 = u.pn * BM + wc * 32 + 4 * fq, b = u.pm >> 4;
        f32x4 gt[2][2];
#pragma unroll
        for (int bj = 0; bj < 2; ++bj)
#pragma unroll
            for (int n = 0; n < 2; ++n) { const long long* mp = modq + b * 12288 + 2 * 2048 + col0 + bj * HALF + n * 16;
#pragma unroll
                for (int i = 0; i < 4; ++i) gt[bj][n][i] = (float)(int)(mp[i] >> 32) + (float)(unsigned)mp[i] * 2.3283064365386963e-10f; }
#pragma unroll
        for (int ai = 0; ai < 2; ++ai)
#pragma unroll
            for (int m = 0; m < 4; ++m) { const size_t off = (size_t)(row0 + ai * HALF + m * 16) * 2048 + col0;
#pragma unroll
                for (int bj = 0; bj < 2; ++bj)
#pragma unroll
                    for (int n = 0; n < 2; ++n) { const f32x4 xv = *(const f32x4*)(x + off + bj * HALF + n * 16); *(f32x4*)(out + off + bj * HALF + n * 16) = xv + gt[bj][n] * acc[ai][bj][m][n]; } }
    }
};
struct EpiPq {
    static constexpr bool PERM = true, AFTER_DRAIN = false;
    bf16_t* o;
    __device__ __forceinline__ void operator()(const f32x4 (&acc)[2][2][4][2], const Unit& u, int wr, int wc, int fr, int fq) const {
        const int row0 = u.pm * BM + wr * 64 + fr, col0 = u.pn * BM + wc * 32 + 8 * fq;
#pragma unroll
        for (int ai = 0; ai < 2; ++ai)
#pragma unroll
            for (int m = 0; m < 4; ++m) { bf16_t* rowp = o + (size_t)(row0 + ai * HALF + m * 16) * 2048 + col0;
#pragma unroll
                for (int bj = 0; bj < 2; ++bj) { const f32x4 v0 = acc[ai][bj][m][0], v1 = acc[ai][bj][m][1];
                    u32x4 w; w.x = cvt_pk_bf16(v0[0], v0[1]); w.y = cvt_pk_bf16(v0[2], v0[3]); w.z = cvt_pk_bf16(v1[0], v1[1]); w.w = cvt_pk_bf16(v1[2], v1[3]);
                    *(u32x4*)(rowp + bj * HALF) = w; } }
    }
};
}

__device__ __forceinline__ void phase_gemm1(const Params& p, unsigned char* lds) {
    pg8::Gemm g{(const bf16_t*)(p.ws + OFF_A), (const bf16_t*)(p.ws + OFF_WIN), T, DIN, D};
    pg8::StaticOrder So; So.init(T, DIN, (int)gridDim.x, (int)blockIdx.x);
    pg8::EpiProj Ep{(bf16_t*)(p.ws + OFF_QKV), (bf16_t*)(p.ws + OFF_QKV + QKV_ONE), (bf16_t*)(p.ws + OFF_QKV + 2 * QKV_ONE), (bf16_t*)(p.ws + OFF_US), (bf16_t*)(p.ws + OFF_VS), p.pos};
    pg8::gemm_phase<pg8::EpiProj, pg8::StaticOrder, true, true>((PG8_LAS unsigned char*)lds, g, So, Ep);
}
__device__ __forceinline__ void phase_gemm2(const Params& p, unsigned char* lds) {
    pg8::Gemm g{(const bf16_t*)(p.ws + OFF_QKV), (const bf16_t*)(p.ws + OFF_WOUT), T, D, D};
    pg8::StaticOrder So; So.init(T, D, (int)gridDim.x, (int)blockIdx.x);
    pg8::EpiRes Ep{p.x, p.out, (const long long*)(p.ws + OFF_MOD)};
    pg8::gemm_phase<pg8::EpiRes, pg8::StaticOrder, true, true>((PG8_LAS unsigned char*)lds, g, So, Ep);
}
__device__ __forceinline__ void phase_gemm3(const Params& p, unsigned char* lds) {
    pg8::Gemm g{(const bf16_t*)(p.ws + OFF_A), (const bf16_t*)(p.ws + OFF_WQ), T, D, D};
    pg8::StaticOrder So; So.init(T, D, (int)gridDim.x, (int)blockIdx.x);
    pg8::EpiPq Ep{(bf16_t*)(p.ws + OFF_QKV + (size_t)T * D * 2)};
    pg8::gemm_phase<pg8::EpiPq, pg8::StaticOrder, true, true>((PG8_LAS unsigned char*)lds, g, So, Ep);
}

__device__ __forceinline__ void conv_transpose(const float* __restrict__ W, int N, bf16_t* __restrict__ WT, int perm_limit, float* tile, int bid, int nblk, int tid) {
    const int ntiles = 32 * (N / 64);
    for (int tI = bid; tI < ntiles; tI += nblk) {
        const int tk = tI & 31, tn = tI >> 5, k0 = tk * 64, n0 = tn * 64;
        int l0 = n0;
        if (n0 < perm_limit) { const int base = n0 & ~255, pb = (n0 >> 6) & 3, bj = pb >> 1, qhi = pb & 1; l0 = base + 64 * bj + 128 * qhi; }
        __syncthreads();
#pragma unroll
        for (int pass = 0; pass < 2; ++pass) { const int r = pass * 32 + (tid >> 4), c4 = (tid & 15) * 4;
            const float4 v = *(const float4*)(W + (size_t)(k0 + r) * N + l0 + c4);
            tile[r * 65 + c4 + 0] = v.x; tile[r * 65 + c4 + 1] = v.y; tile[r * 65 + c4 + 2] = v.z; tile[r * 65 + c4 + 3] = v.w; }
        __syncthreads();
        const int n = tid >> 3, kq = (tid & 7) * 8;
        u32x4 w;
        w.x = pack2(tile[(kq + 0) * 65 + n], tile[(kq + 1) * 65 + n]); w.y = pack2(tile[(kq + 2) * 65 + n], tile[(kq + 3) * 65 + n]);
        w.z = pack2(tile[(kq + 4) * 65 + n], tile[(kq + 5) * 65 + n]); w.w = pack2(tile[(kq + 6) * 65 + n], tile[(kq + 7) * 65 + n]);
        *(u32x4*)(WT + (size_t)(n0 + n) * D + k0 + kq) = w;
    }
}
__device__ __forceinline__ void conv_flat(const float* __restrict__ src, bf16_t* __restrict__ dst, size_t n8, int bid, int nblk, int tid) {
    for (size_t i = (size_t)bid * NTHR + tid; i < n8; i += (size_t)nblk * NTHR) {
        const float4 a = ((const float4*)src)[2 * i], b = ((const float4*)src)[2 * i + 1];
        u32x4 w; w.x = pack2(a.x, a.y); w.y = pack2(a.z, a.w); w.z = pack2(b.x, b.y); w.w = pack2(b.z, b.w);
        ((u32x4*)dst)[i] = w; }
}
__device__ __forceinline__ void conv_rows_fp8(const float* __restrict__ src, unsigned char* __restrict__ dst, float* __restrict__ inv, int bid, int nblk, int tid) {
    const int lane = tid & 63, gw = bid * NWV + (tid >> 6), nw = nblk * NWV;
    for (int r = gw; r < NEXP; r += nw) {
        const float4* row = (const float4*)(src + (size_t)r * D);
        float4 v[8]; float m = 0.f;
#pragma unroll
        for (int i = 0; i < 8; ++i) { v[i] = row[i * 64 + lane]; m = fmaxf(m, fmaxf(fmaxf(fabsf(v[i].x), fabsf(v[i].y)), fmaxf(fabsf(v[i].z), fabsf(v[i].w)))); }
        m = wave_max(m);
        const int ex = (int)((__float_as_uint(m) >> 23) & 255u) - 126;
        const int k = (m > 0.f) ? max(-100, min(100, 8 - ex)) : 0;
        const float sc = __uint_as_float((unsigned)(127 + k) << 23), isc = __uint_as_float((unsigned)(127 - k) << 23);
        unsigned* drow = (unsigned*)(dst + (size_t)r * D);
#pragma unroll
        for (int i = 0; i < 8; ++i) { int w = __builtin_amdgcn_cvt_pk_fp8_f32(v[i].x * sc, v[i].y * sc, 0, false); w = __builtin_amdgcn_cvt_pk_fp8_f32(v[i].z * sc, v[i].w * sc, w, true); drow[i * 64 + lane] = (unsigned)w; }
        if (lane == 0) inv[r] = isc;
    }
}
__device__ __forceinline__ void phase_conv(const Params& p, unsigned char* lds, bool dup = false) {
    const int tid = threadIdx.x, bid = blockIdx.x, nblk = gridDim.x;
    unsigned long long* mod = (unsigned long long*)(p.ws + OFF_MOD);
    for (int it = bid; it < (dup ? 0 : 768); it += nblk) {
        const int cb = it % 6, kc = it / 6, col = cb * 2048 + tid * 4;
        float acc[4][4];
#pragma unroll
        for (int b = 0; b < 4; ++b) { acc[b][0] = 0.f; acc[b][1] = 0.f; acc[b][2] = 0.f; acc[b][3] = 0.f; }
        for (int kk = 0; kk < 16; ++kk) { const int k = kc * 16 + kk;
            const float4 w = *(const float4*)(p.w_ada + (size_t)k * 12288 + col);
#pragma unroll
            for (int b = 0; b < 4; ++b) { const float cv = p.c[b * D + k]; const float s = cv / (1.f + __expf(-cv));
                acc[b][0] += s * w.x; acc[b][1] += s * w.y; acc[b][2] += s * w.z; acc[b][3] += s * w.w; } }
        if (kc == 0) { const float4 bv = *(const float4*)(p.b_ada + col);
#pragma unroll
            for (int b = 0; b < 4; ++b) { acc[b][0] += bv.x; acc[b][1] += bv.y; acc[b][2] += bv.z; acc[b][3] += bv.w; } }
#pragma unroll
        for (int b = 0; b < 4; ++b)
#pragma unroll
            for (int j = 0; j < 4; ++j) atomicAdd(mod + b * 12288 + col + j, (unsigned long long)__double2ll_rn((double)acc[b][j] * 4294967296.0));
    }
    conv_transpose(p.w_in, DIN, (bf16_t*)(p.ws + OFF_WIN), 3072, (float*)lds, bid, nblk, tid);
    conv_transpose(p.w_out, D, (bf16_t*)(p.ws + OFF_WOUT), 0, (float*)lds, bid, nblk, tid);
    conv_transpose(p.peer_w_q, D, (bf16_t*)(p.ws + OFF_WQ), 0, (float*)lds, bid, nblk, tid);
    conv_rows_fp8(p.peer_u, p.ws + OFF_UTAB, (float*)(p.ws + OFF_UTAB + TAB8_BYTES), bid, nblk, tid);
    conv_rows_fp8(p.peer_v, p.ws + OFF_VTAB, (float*)(p.ws + OFF_VTAB + TAB8_BYTES), bid, nblk, tid);
    conv_flat(p.peer_sub_keys, (bf16_t*)(p.ws + OFF_SUBK), (size_t)8 * 2 * 128 * 128 / 8, bid, nblk, tid);
    { bf16_t* sw = (bf16_t*)(p.ws + OFF_SGUW);
      for (int i = bid * NTHR + tid; i < 4 * 128 * 128; i += nblk * NTHR) { const int jj = i & 127, ii = (i >> 7) & 127; sw[i] = f2bf(jj <= ii ? p.sgu_w[i] : 0.f); } }
}

__device__ __forceinline__ void phase_norm_mod(const Params& p, const float* __restrict__ src, const float* __restrict__ g, int sh_i, int sc_i, bf16_t* __restrict__ dst) {
    const int lane = threadIdx.x & 63, gw = blockIdx.x * NWV + (threadIdx.x >> 6), nw = gridDim.x * NWV;
    for (int t = gw; t < T; t += nw) {
        const float* row = src + (size_t)t * D; const int b = t / S;
        float4 v[8]; float ss = 0.f;
#pragma unroll
        for (int i = 0; i < 8; ++i) { v[i] = *(const float4*)(row + i * 256 + lane * 4); ss += v[i].x * v[i].x + v[i].y * v[i].y + v[i].z * v[i].z + v[i].w * v[i].w; }
        ss = wave_sum(ss); const float rstd = rsqrtf(ss * (1.0f / D) + 1e-6f);
#pragma unroll
        for (int i = 0; i < 8; ++i) { const int col = i * 256 + lane * 4;
            const float4 gg = *(const float4*)(g + col), sc = mod4(p, b, sc_i, col), sh = mod4(p, b, sh_i, col);
            u32x2 w; w.x = pack2(v[i].x * rstd * gg.x * (1.f + sc.x) + sh.x, v[i].y * rstd * gg.y * (1.f + sc.y) + sh.y);
            w.y = pack2(v[i].z * rstd * gg.z * (1.f + sc.z) + sh.z, v[i].w * rstd * gg.w * (1.f + sc.w) + sh.w);
            *(u32x2*)(dst + (size_t)t * D + col) = w; }
    }
}

#define NAIVE_GEMM_BODY(A_, W_, N_, r0_, c0_)                                                                 \
    float acc[16];                                                                                            \
    _Pragma("unroll") for (int r = 0; r < 16; ++r) acc[r] = 0.f;                                              \
    __syncthreads();                                                                                          \
    { const u32x4* srcA = (const u32x4*)((A_) + (size_t)(r0_) * D); u32x4* dstA = (u32x4*)lds;                  \
      for (int i = tid; i < 16 * D / 8; i += NTHR) dstA[i] = srcA[i]; }                                       \
    __syncthreads();                                                                                          \
    { const unsigned* la = (const unsigned*)lds;                                                              \
      for (int k2 = 0; k2 < D / 2; ++k2) {                                                                    \
          const float w0 = (W_)[(size_t)(2 * k2) * (N_) + (c0_) + tid], w1 = (W_)[(size_t)(2 * k2 + 1) * (N_) + (c0_) + tid]; \
          _Pragma("unroll") for (int r = 0; r < 16; ++r) { const unsigned a = la[r * (D / 2) + k2]; acc[r] += bflo(a) * w0 + bfhi(a) * w1; } } }

__device__ __forceinline__ void phase_gemm1_naive(const Params& p, unsigned char* lds) {
    const int tid = threadIdx.x;
    const bf16_t* A = (const bf16_t*)(p.ws + OFF_A);
    float* xch = (float*)(lds + 65536);
    bf16_t* qb = (bf16_t*)(p.ws + OFF_QKV); bf16_t* kb = (bf16_t*)(p.ws + OFF_QKV + QKV_ONE); bf16_t* vb = (bf16_t*)(p.ws + OFF_QKV + 2 * QKV_ONE);
    bf16_t* usb = (bf16_t*)(p.ws + OFF_US); bf16_t* vsb = (bf16_t*)(p.ws + OFF_VS);
    const int nitems = (T / 16) * (DIN / 512);
    for (int it = blockIdx.x; it < nitems; it += gridDim.x) {
        const int cbk = it % (DIN / 512), rb = it / (DIN / 512), r0 = rb * 16, c0 = cbk * 512;
        NAIVE_GEMM_BODY(A, p.w_in, DIN, r0, c0)
        const int n = c0 + tid;
        if (n < 3072) {
#pragma unroll
            for (int r = 0; r < 16; ++r) xch[r * 512 + tid] = acc[r];
            __syncthreads();
            const int e = n & 127, hh = (n % DA) >> 7; const bool isq = n < DA;
            const int i = e & 63; const float inv = powf(10000.0f, -(float)i / 64.0f);
#pragma unroll
            for (int r = 0; r < 16; ++r) { const int t = r0 + r, b = t / S, s = t % S;
                const float ang = (float)p.pos[t] * inv; const float cs = cosf(ang), sn = sinf(ang);
                const float other = xch[r * 512 + (tid ^ 64)];
                float val = (e < 64) ? (acc[r] * cs - other * sn) : (acc[r] * cs + other * sn);
                if (isq) val *= 0.08838834764831845f;
                (isq ? qb : kb)[((size_t)(b * HA + hh) * S + s) * E + e] = f2bf(val); }
        } else if (n < 4608) {
            const int e = n & 127, hh = (n - 3072) >> 7;
#pragma unroll
            for (int r = 0; r < 16; ++r) { const int t = r0 + r, b = t / S, s = t % S; vb[((size_t)(b * HA + hh) * S + s) * E + e] = f2bf(acc[r]); }
        } else if (n < 5120) {
#pragma unroll
            for (int r = 0; r < 16; ++r) usb[(size_t)(r0 + r) * DS + (n - 4608)] = f2bf(gelu_erf(acc[r]));
        } else {
#pragma unroll
            for (int r = 0; r < 16; ++r) vsb[(size_t)(r0 + r) * DS + (n - 5120)] = f2bf(gelu_erf(acc[r]));
        }
    }
}
__device__ __forceinline__ void phase_gemm2_naive(const Params& p, unsigned char* lds) {
    const int tid = threadIdx.x;
    const bf16_t* A = (const bf16_t*)(p.ws + OFF_QKV);
    const int nitems = (T / 16) * (D / 512);
    for (int it = blockIdx.x; it < nitems; it += gridDim.x) {
        const int cbk = it % (D / 512), rb = it / (D / 512), r0 = rb * 16, c0 = cbk * 512;
        NAIVE_GEMM_BODY(A, p.w_out, D, r0, c0)
        const int n = c0 + tid;
#pragma unroll
        for (int r = 0; r < 16; ++r) { const int t = r0 + r, b = t / S; p.out[(size_t)t * D + n] = p.x[(size_t)t * D + n] + mod1(p, b, 2, n) * acc[r]; }
    }
}
__device__ __forceinline__ void phase_gemm3_naive(const Params& p, unsigned char* lds) {
    const int tid = threadIdx.x;
    const bf16_t* A = (const bf16_t*)(p.ws + OFF_A);
    bf16_t* pq = (bf16_t*)(p.ws + OFF_QKV + (size_t)T * D * 2);
    const int nitems = (T / 16) * (D / 512);
    for (int it = blockIdx.x; it < nitems; it += gridDim.x) {
        const int cbk = it % (D / 512), rb = it / (D / 512), r0 = rb * 16, c0 = cbk * 512;
        NAIVE_GEMM_BODY(A, p.peer_w_q, D, r0, c0)
        const int n = c0 + tid;
#pragma unroll
        for (int r = 0; r < 16; ++r) pq[(size_t)(r0 + r) * D + n] = f2bf(acc[r]);
    }
}

__device__ __forceinline__ void phase_attn_naive(const Params& p, unsigned char* lds) {
    const int lane = threadIdx.x & 63, wave = threadIdx.x >> 6, gw = blockIdx.x * NWV + wave, nw = gridDim.x * NWV;
    float* ql = (float*)lds + wave * 128;
    const bf16_t* qb = (const bf16_t*)(p.ws + OFF_QKV); const bf16_t* kb = (const bf16_t*)(p.ws + OFF_QKV + QKV_ONE); const bf16_t* vb = (const bf16_t*)(p.ws + OFF_QKV + 2 * QKV_ONE);
    float* lse = (float*)(p.ws + OFF_LSE);
    for (int item = gw; item < NB * HA * S; item += nw) {
        const int t = item % S, h = (item / S) % HA, b = item / (S * HA);
        const size_t hb = (size_t)(b * HA + h) * S;
        { const unsigned w = *(const unsigned*)(qb + (hb + t) * E + 2 * lane); ql[2 * lane] = bflo(w); ql[2 * lane + 1] = bfhi(w); }
        __builtin_amdgcn_wave_barrier();
#pragma unroll 1
        for (int pat = 0; pat < 3; ++pat) {
            const int d = pat == 0 ? 1 : (pat == 1 ? 4 : 16);
            const int imax = min(128, t / d);
            float sc[3];
#pragma unroll
            for (int sl = 0; sl < 3; ++sl) { const int i = sl * 64 + lane; float s = -__builtin_inff();
                if (i <= imax) { const u32x4* kr = (const u32x4*)(kb + (hb + (t - i * d)) * E); s = 0.f;
                    for (int c8 = 0; c8 < 16; ++c8) { const u32x4 kk = kr[c8]; const float* qq = ql + c8 * 8;
                        s += qq[0] * bflo(kk.x) + qq[1] * bfhi(kk.x) + qq[2] * bflo(kk.y) + qq[3] * bfhi(kk.y) + qq[4] * bflo(kk.z) + qq[5] * bfhi(kk.z) + qq[6] * bflo(kk.w) + qq[7] * bfhi(kk.w); } }
                sc[sl] = s; }
            const float m = wave_max(fmaxf(sc[0], fmaxf(sc[1], sc[2])));
            float pr[3]; float l = 0.f;
#pragma unroll
            for (int sl = 0; sl < 3; ++sl) { pr[sl] = __expf(sc[sl] - m); l += pr[sl]; }
            l = wave_sum(l);
            float o0 = 0.f, o1 = 0.f;
            for (int i = 0; i <= imax; ++i) { const float pv = __shfl(i < 64 ? pr[0] : (i < 128 ? pr[1] : pr[2]), i & 63);
                const unsigned w = *(const unsigned*)(vb + (hb + (t - i * d)) * E + 2 * lane); o0 += pv * bflo(w); o1 += pv * bfhi(w); }
            const float il = 1.0f / l; const size_t tg = (size_t)b * S + t;
            *(unsigned*)(P_opat(p, pat) + tg * DA + h * E + 2 * lane) = pack2(o0 * il, o1 * il);
            if (lane == 0) lse[((size_t)pat * T + tg) * HA + h] = m + __logf(l);
        }
        __builtin_amdgcn_wave_barrier();
    }
}

#define LAS __attribute__((address_space(3)))
typedef short bf16x8 __attribute__((ext_vector_type(8)));
typedef short s16x4 __attribute__((ext_vector_type(4)));
constexpr int ATT_VOFF = 65536, ATT_VSTRIDE = 288;
__device__ __forceinline__ unsigned cvt_pk(float lo, float hi) { unsigned r; asm volatile("v_cvt_pk_bf16_f32 %0, %1, %2" : "=v"(r) : "v"(lo), "v"(hi)); return r; }
__device__ __forceinline__ void phase_attn(const Params& p, unsigned char* lds_) {
    LAS unsigned char* lds = (LAS unsigned char*)lds_;
    const int tid = threadIdx.x, lane = tid & 63, w = __builtin_amdgcn_readfirstlane(tid >> 6), l15 = lane & 15, g = lane >> 4;
    const bf16_t* qb = (const bf16_t*)(p.ws + OFF_QKV); const bf16_t* kb = (const bf16_t*)(p.ws + OFF_QKV + QKV_ONE); const bf16_t* vb = (const bf16_t*)(p.ws + OFF_QKV + 2 * QKV_ONE);
    float* lse = (float*)(p.ws + OFF_LSE);
    const int G = gridDim.x, vcu = (G % 8 == 0) ? (int)(blockIdx.x & 7) * (G >> 3) + (int)(blockIdx.x >> 3) : (int)blockIdx.x;
    const float NEG = -__builtin_inff();
    for (int item = vcu; item < 3 * 48 * 32; item += G) {
        const int pat = item / 1536, rem = item % 1536, bh = rem >> 5, ci = rem & 31;
        const int dsh = 2 * pat, d = 1 << dsh, nblk = 32 >> dsh, r = ci / nblk, n = ci % nblk;
        const size_t hb = (size_t)bh * S;
        __syncthreads();
#pragma unroll
        for (int i = 0; i < 8; ++i) { const int ch = i * NTHR + tid, kk = ch >> 4, c = ch & 15;
            if (n > 0 || kk >= 128) { const int tp = (((n - 1) * 128 + kk) << dsh) + r;
                const u32x4 kv = *(const u32x4*)(kb + (hb + tp) * E + c * 8), vv = *(const u32x4*)(vb + (hb + tp) * E + c * 8);
                *(LAS u32x4*)(lds + kk * 256 + ((c ^ (kk & 15)) << 4)) = kv;
                *(LAS u32x4*)(lds + ATT_VOFF + kk * ATT_VSTRIDE + c * 16) = vv; } }
        const int jj = 16 * w + l15, tq = ((n * 128 + jj) << dsh) + r;
        bf16x8 qf[4];
#pragma unroll
        for (int ks = 0; ks < 4; ++ks) qf[ks] = *(const bf16x8*)(qb + (hb + tq) * E + 32 * ks + 8 * g);
        __syncthreads();
        const int s0 = w >> 1;
        f32x4 sA[5], sB[5];
#pragma unroll
        for (int si = 0; si < 5; ++si) {
            const int step = s0 + si;
            if (n == 0 && step < 4) { sA[si] = (f32x4){NEG, NEG, NEG, NEG}; sB[si] = (f32x4){NEG, NEG, NEG, NEG}; continue; }
            f32x4 a = {0.f, 0.f, 0.f, 0.f}, b = {0.f, 0.f, 0.f, 0.f};
            const int keyA = 32 * step + l15, keyB = keyA + 16;
#pragma unroll
            for (int ks = 0; ks < 4; ++ks) {
                const bf16x8 kA = *(const LAS bf16x8*)(lds + keyA * 256 + (((4 * ks + g) ^ (keyA & 15)) << 4));
                const bf16x8 kB = *(const LAS bf16x8*)(lds + keyB * 256 + (((4 * ks + g) ^ (keyB & 15)) << 4));
                a = __builtin_amdgcn_mfma_f32_16x16x32_bf16(kA, qf[ks], a, 0, 0, 0);
                b = __builtin_amdgcn_mfma_f32_16x16x32_bf16(kB, qf[ks], b, 0, 0, 0); }
#pragma unroll
            for (int rg = 0; rg < 4; ++rg) { const int ka = 32 * step + 4 * g + rg, kb2 = ka + 16;
                const bool oka = (unsigned)(ka - jj) <= 128u && (n > 0 || ka >= 128), okb = (unsigned)(kb2 - jj) <= 128u && (n > 0 || kb2 >= 128);
                a[rg] = oka ? a[rg] : NEG; b[rg] = okb ? b[rg] : NEG; }
            sA[si] = a; sB[si] = b;
        }
        float m = NEG;
#pragma unroll
        for (int si = 0; si < 5; ++si)
#pragma unroll
            for (int rg = 0; rg < 4; ++rg) m = fmaxf(m, fmaxf(sA[si][rg], sB[si][rg]));
        m = fmaxf(m, __shfl_xor(m, 16)); m = fmaxf(m, __shfl_xor(m, 32));
        float l = 0.f; const float mL = m * 1.4426950408889634f;
#pragma unroll
        for (int si = 0; si < 5; ++si)
#pragma unroll
            for (int rg = 0; rg < 4; ++rg) { sA[si][rg] = __builtin_amdgcn_exp2f(sA[si][rg] * 1.4426950408889634f - mL); sB[si][rg] = __builtin_amdgcn_exp2f(sB[si][rg] * 1.4426950408889634f - mL); l += sA[si][rg] + sB[si][rg]; }
        l += __shfl_xor(l, 16); l += __shfl_xor(l, 32);
        f32x4 o[8];
#pragma unroll
        for (int dt = 0; dt < 8; ++dt) o[dt] = (f32x4){0.f, 0.f, 0.f, 0.f};
#pragma unroll
        for (int si = 0; si < 5; ++si) {
            const int step = s0 + si;
            if (n == 0 && step < 4) continue;
            u32x4 pw; pw.x = cvt_pk(sA[si][0], sA[si][1]); pw.y = cvt_pk(sA[si][2], sA[si][3]); pw.z = cvt_pk(sB[si][0], sB[si][1]); pw.w = cvt_pk(sB[si][2], sB[si][3]);
            const bf16x8 pf = *reinterpret_cast<const bf16x8*>(&pw);
            LAS unsigned char* vrow = lds + ATT_VOFF + (32 * step + 4 * g + (l15 >> 2)) * ATT_VSTRIDE + (l15 & 3) * 8;
#pragma unroll
            for (int dt = 0; dt < 8; ++dt) {
                const s16x4 v0 = __builtin_amdgcn_ds_read_tr16_b64_v4i16((LAS s16x4*)(vrow + dt * 32));
                const s16x4 v1 = __builtin_amdgcn_ds_read_tr16_b64_v4i16((LAS s16x4*)(vrow + dt * 32 + 16 * ATT_VSTRIDE));
                const bf16x8 vf = {v0[0], v0[1], v0[2], v0[3], v1[0], v1[1], v1[2], v1[3]};
                o[dt] = __builtin_amdgcn_mfma_f32_16x16x32_bf16(vf, pf, o[dt], 0, 0, 0); }
        }
        const float il = 1.0f / l; const int b_ = bh / HA, h = bh % HA; const size_t tg = (size_t)b_ * S + tq;
        bf16_t* orow = P_opat(p, pat) + tg * DA + h * E + 4 * g;
#pragma unroll
        for (int dt = 0; dt < 8; ++dt) { u32x2 ww; ww.x = cvt_pk(o[dt][0] * il, o[dt][1] * il); ww.y = cvt_pk(o[dt][2] * il, o[dt][3] * il); *(u32x2*)(orow + 16 * dt) = ww; }
        if (g == 0) lse[((size_t)pat * T + tg) * HA + h] = m + __logf(l);
    }
}

__device__ __forceinline__ void phase_sgu(const Params& p, unsigned char* lds_) {
    LAS unsigned char* lds = (LAS unsigned char*)lds_;
    const int tid = threadIdx.x, lane = tid & 63, w = __builtin_amdgcn_readfirstlane(tid >> 6), l15 = lane & 15, g = lane >> 4;
    const bf16_t* vsb = (const bf16_t*)(p.ws + OFF_VS); const bf16_t* usb = (const bf16_t*)(p.ws + OFF_US); bf16_t* ob = (bf16_t*)(p.ws + OFF_SGUO);
    const bf16_t* sw = (const bf16_t*)(p.ws + OFF_SGUW);
    for (int item = blockIdx.x; item < (T / 128) * HS; item += gridDim.x) {
        const int h = item & 3, t0 = (item >> 2) * 128;
        __syncthreads();
        {
            const int j = tid >> 2, part = tid & 3;
            const u32x4* src = (const u32x4*)(vsb + (size_t)(t0 + j) * DS + h * E + part * 32);
            u32x4 x[4]; float sum = 0.f;
#pragma unroll
            for (int i = 0; i < 4; ++i) { x[i] = src[i]; sum += bflo(x[i].x) + bfhi(x[i].x) + bflo(x[i].y) + bfhi(x[i].y) + bflo(x[i].z) + bfhi(x[i].z) + bflo(x[i].w) + bfhi(x[i].w); }
            sum += __shfl_xor(sum, 1); sum += __shfl_xor(sum, 2);
            const float mu = sum * (1.0f / E); float var = 0.f;
#pragma unroll
            for (int i = 0; i < 4; ++i) { float dd;
                dd = bflo(x[i].x) - mu; var += dd * dd; dd = bfhi(x[i].x) - mu; var += dd * dd; dd = bflo(x[i].y) - mu; var += dd * dd; dd = bfhi(x[i].y) - mu; var += dd * dd;
                dd = bflo(x[i].z) - mu; var += dd * dd; dd = bfhi(x[i].z) - mu; var += dd * dd; dd = bflo(x[i].w) - mu; var += dd * dd; dd = bfhi(x[i].w) - mu; var += dd * dd; }
            var += __shfl_xor(var, 1); var += __shfl_xor(var, 2);
            const float rs = rsqrtf(var * (1.0f / E) + 1e-5f);
            const float* lg = p.sgu_ln_g + h * E + part * 32; const float* lb = p.sgu_ln_b + h * E + part * 32;
#pragma unroll
            for (int i = 0; i < 4; ++i) { const float4 g0 = *(const float4*)(lg + i * 8), g1 = *(const float4*)(lg + i * 8 + 4), b0 = *(const float4*)(lb + i * 8), b1 = *(const float4*)(lb + i * 8 + 4);
                u32x4 o; o.x = cvt_pk((bflo(x[i].x) - mu) * rs * g0.x + b0.x, (bfhi(x[i].x) - mu) * rs * g0.y + b0.y); o.y = cvt_pk((bflo(x[i].y) - mu) * rs * g0.z + b0.z, (bfhi(x[i].y) - mu) * rs * g0.w + b0.w);
                o.z = cvt_pk((bflo(x[i].z) - mu) * rs * g1.x + b1.x, (bfhi(x[i].z) - mu) * rs * g1.y + b1.y); o.w = cvt_pk((bflo(x[i].w) - mu) * rs * g1.z + b1.z, (bfhi(x[i].w) - mu) * rs * g1.w + b1.w);
                *(LAS u32x4*)(lds + j * ATT_VSTRIDE + part * 64 + i * 16) = o; }
        }
        __syncthreads();
        f32x4 acc[8];
#pragma unroll
        for (int et = 0; et < 8; ++et) acc[et] = (f32x4){0.f, 0.f, 0.f, 0.f};
        const int irow = 16 * w + l15, nsteps = (16 * w + 15) / 32 + 1;
        const bf16_t* wrow = sw + ((size_t)h * 128 + irow) * 128;
        for (int st = 0; st < nsteps; ++st) {
            const u32x2 wa = *(const u32x2*)(wrow + 32 * st + 4 * g), wb = *(const u32x2*)(wrow + 32 * st + 16 + 4 * g);
            u32x4 wf4; wf4.x = wa.x; wf4.y = wa.y; wf4.z = wb.x; wf4.w = wb.y;
            const bf16x8 wf = *reinterpret_cast<const bf16x8*>(&wf4);
            LAS unsigned char* vrow = lds + (32 * st + 4 * g + (l15 >> 2)) * ATT_VSTRIDE + (l15 & 3) * 8;
#pragma unroll
            for (int et = 0; et < 8; ++et) {
                const s16x4 v0 = __builtin_amdgcn_ds_read_tr16_b64_v4i16((LAS s16x4*)(vrow + et * 32));
                const s16x4 v1 = __builtin_amdgcn_ds_read_tr16_b64_v4i16((LAS s16x4*)(vrow + et * 32 + 16 * ATT_VSTRIDE));
                const bf16x8 vf = {v0[0], v0[1], v0[2], v0[3], v1[0], v1[1], v1[2], v1[3]};
                acc[et] = __builtin_amdgcn_mfma_f32_16x16x32_bf16(vf, wf, acc[et], 0, 0, 0); }
        }
        const float bias = p.sgu_b[h * 128 + irow];
        const size_t base = (size_t)(t0 + irow) * DS + h * E + 4 * g;
#pragma unroll
        for (int et = 0; et < 8; ++et) { const u32x2 uu = *(const u32x2*)(usb + base + 16 * et);
            u32x2 oo; oo.x = cvt_pk(bflo(uu.x) * (acc[et][0] + bias), bfhi(uu.x) * (acc[et][1] + bias)); oo.y = cvt_pk(bflo(uu.y) * (acc[et][2] + bias), bfhi(uu.y) * (acc[et][3] + bias));
            *(u32x2*)(ob + base + 16 * et) = oo; }
    }
}

__device__ __forceinline__ void phase_sgu_ln_naive(const Params& p) {
    const int lane = threadIdx.x & 63, gw = blockIdx.x * NWV + (threadIdx.x >> 6), nw = gridDim.x * NWV;
    bf16_t* vsb = (bf16_t*)(p.ws + OFF_VS);
    for (int item = gw; item < T * HS; item += nw) {
        const int t = item / HS, h = item % HS;
        unsigned* ptr = (unsigned*)(vsb + (size_t)t * DS + h * E + 2 * lane);
        const unsigned w = *ptr; const float a = bflo(w), b = bfhi(w);
        const float mu = wave_sum(a + b) * (1.0f / E); const float da = a - mu, db = b - mu;
        const float var = wave_sum(da * da + db * db) * (1.0f / E); const float rs = rsqrtf(var + 1e-5f);
        const int e = 2 * lane;
        *ptr = pack2(da * rs * p.sgu_ln_g[h * E + e] + p.sgu_ln_b[h * E + e], db * rs * p.sgu_ln_g[h * E + e + 1] + p.sgu_ln_b[h * E + e + 1]);
    }
}
__device__ __forceinline__ void phase_sgu_mix_naive(const Params& p) {
    const int tid = threadIdx.x;
    const bf16_t* vnb = (const bf16_t*)(p.ws + OFF_VS); const bf16_t* usb = (const bf16_t*)(p.ws + OFF_US); bf16_t* ob = (bf16_t*)(p.ws + OFF_SGUO);
    for (int t = blockIdx.x; t < T; t += gridDim.x) {
        const int h = tid >> 7, e = tid & 127, i = t & 127, t0 = t - i;
        float acc = 0.f;
        for (int j = 0; j <= i; ++j) acc += p.sgu_w[(h * 128 + i) * 128 + j] * bf2f(vnb[(size_t)(t0 + j) * DS + tid]);
        acc += p.sgu_b[h * 128 + i];
        ob[(size_t)t * DS + tid] = f2bf(bf2f(usb[(size_t)t * DS + tid]) * acc);
        (void)e;
    }
}

__device__ __forceinline__ void phase_combine(const Params& p) {
    const int lane = threadIdx.x & 63, gw = blockIdx.x * NWV + (threadIdx.x >> 6), nw = gridDim.x * NWV;
    const float* lse = (const float*)(p.ws + OFF_LSE);
    const bf16_t* sg = (const bf16_t*)(p.ws + OFF_SGUO); bf16_t* mixed = (bf16_t*)(p.ws + OFF_QKV);
    for (int t = gw; t < T; t += nw) {
        float w0 = 0.f, w1 = 0.f, w2 = 0.f;
        if (lane < HA) { const float l0 = lse[((size_t)0 * T + t) * HA + lane], l1 = lse[((size_t)1 * T + t) * HA + lane], l2 = lse[((size_t)2 * T + t) * HA + lane];
            const float m = fmaxf(l0, fmaxf(l1, l2)); const float e0 = __expf(l0 - m), e1 = __expf(l1 - m), e2 = __expf(l2 - m); const float is = 1.0f / (e0 + e1 + e2);
            w0 = e0 * is; w1 = e1 * is; w2 = e2 * is; }
        float av[3][8]; float ss = 0.f;
#pragma unroll
        for (int i = 0; i < 3; ++i) { const int col0 = (lane + 64 * i) * 8, hh = col0 >> 7;
            const float a0 = __shfl(w0, hh), a1 = __shfl(w1, hh), a2 = __shfl(w2, hh);
            const u32x4 x0 = *(const u32x4*)(P_opat(p, 0) + (size_t)t * DA + col0), x1 = *(const u32x4*)(P_opat(p, 1) + (size_t)t * DA + col0), x2 = *(const u32x4*)(P_opat(p, 2) + (size_t)t * DA + col0);
            av[i][0] = a0 * bflo(x0.x) + a1 * bflo(x1.x) + a2 * bflo(x2.x); av[i][1] = a0 * bfhi(x0.x) + a1 * bfhi(x1.x) + a2 * bfhi(x2.x);
            av[i][2] = a0 * bflo(x0.y) + a1 * bflo(x1.y) + a2 * bflo(x2.y); av[i][3] = a0 * bfhi(x0.y) + a1 * bfhi(x1.y) + a2 * bfhi(x2.y);
            av[i][4] = a0 * bflo(x0.z) + a1 * bflo(x1.z) + a2 * bflo(x2.z); av[i][5] = a0 * bfhi(x0.z) + a1 * bfhi(x1.z) + a2 * bfhi(x2.z);
            av[i][6] = a0 * bflo(x0.w) + a1 * bflo(x1.w) + a2 * bflo(x2.w); av[i][7] = a0 * bfhi(x0.w) + a1 * bfhi(x1.w) + a2 * bfhi(x2.w);
#pragma unroll
            for (int j = 0; j < 8; ++j) ss += av[i][j] * av[i][j]; }
        ss = wave_sum(ss); const float rs = rsqrtf(ss * (1.0f / DA) + 1e-6f);
#pragma unroll
        for (int i = 0; i < 3; ++i) { const int col0 = (lane + 64 * i) * 8; const float4 g0 = *(const float4*)(p.g_attn_out + col0), g1 = *(const float4*)(p.g_attn_out + col0 + 4);
            u32x4 w; w.x = pack2(av[i][0] * rs * g0.x, av[i][1] * rs * g0.y); w.y = pack2(av[i][2] * rs * g0.z, av[i][3] * rs * g0.w);
            w.z = pack2(av[i][4] * rs * g1.x, av[i][5] * rs * g1.y); w.w = pack2(av[i][6] * rs * g1.z, av[i][7] * rs * g1.w);
            *(u32x4*)(mixed + (size_t)t * D + col0) = w; }
        { const int col0 = lane * 8; const u32x4 xs = *(const u32x4*)(sg + (size_t)t * DS + col0);
          float sv[8] = {bflo(xs.x), bfhi(xs.x), bflo(xs.y), bfhi(xs.y), bflo(xs.z), bfhi(xs.z), bflo(xs.w), bfhi(xs.w)}; float s2 = 0.f;
#pragma unroll
          for (int j = 0; j < 8; ++j) s2 += sv[j] * sv[j];
          s2 = wave_sum(s2); const float r2 = rsqrtf(s2 * (1.0f / DS) + 1e-6f);
          const float4 g0 = *(const float4*)(p.g_sgu_out + col0), g1 = *(const float4*)(p.g_sgu_out + col0 + 4);
          u32x4 w; w.x = pack2(sv[0] * r2 * g0.x, sv[1] * r2 * g0.y); w.y = pack2(sv[2] * r2 * g0.z, sv[3] * r2 * g0.w);
          w.z = pack2(sv[4] * r2 * g1.x, sv[5] * r2 * g1.y); w.w = pack2(sv[6] * r2 * g1.z, sv[7] * r2 * g1.w);
          *(u32x4*)(mixed + (size_t)t * D + DA + col0) = w; }
    }
}

__device__ __forceinline__ void phase_topk_naive(const Params& p, unsigned char* lds) {
    const int lane = threadIdx.x & 63, wave = threadIdx.x >> 6, gw = blockIdx.x * NWV + wave, nw = gridDim.x * NWV;
    float* ql = (float*)lds + wave * 256;
    const bf16_t* pq = (const bf16_t*)(p.ws + OFF_QKV + (size_t)T * D * 2);
    int* idxo = (int*)(p.ws + OFF_IDX); float* gato = (float*)(p.ws + OFF_GATE);
    const float NEG = -__builtin_inff();
    for (int item = gw; item < T * PH; item += nw) {
        const int t = item / PH, h = item % PH;
        { const u32x2 w = *(const u32x2*)(pq + (size_t)t * D + h * 256 + 4 * lane); ql[4 * lane] = bflo(w.x); ql[4 * lane + 1] = bfhi(w.x); ql[4 * lane + 2] = bflo(w.y); ql[4 * lane + 3] = bfhi(w.y); }
        __builtin_amdgcn_wave_barrier();
        float ts[2]; int ti[2];
#pragma unroll
        for (int pp = 0; pp < 2; ++pp) {
            const float* k0 = p.peer_sub_keys + ((size_t)(h * 2 + pp) * 128 + lane) * 128; const float* k1 = k0 + 64 * 128; const float* qq = ql + pp * 128;
            float s0 = 0.f, s1 = 0.f;
            for (int c = 0; c < 128; c += 4) { const float4 a = *(const float4*)(k0 + c), b = *(const float4*)(k1 + c);
                s0 += qq[c] * a.x + qq[c + 1] * a.y + qq[c + 2] * a.z + qq[c + 3] * a.w; s1 += qq[c] * b.x + qq[c + 1] * b.y + qq[c + 2] * b.z + qq[c + 3] * b.w; }
            float tsv = 0.f; int tiv = 0;
            for (int r = 0; r < PK; ++r) { const float m = wave_max(fmaxf(s0, s1));
                const int cand = (s0 == m) ? lane : ((s1 == m) ? lane + 64 : 1000); const int key = wave_min_i(cand);
                if (lane == r) { tsv = m; tiv = key; }
                if (key == lane) s0 = NEG; if (key == lane + 64) s1 = NEG; }
            ts[pp] = tsv; ti[pp] = tiv; }
        float cs[4]; const int ci = lane >> 2, cj = (lane & 3) * 4; const float a = __shfl(ts[0], ci);
#pragma unroll
        for (int m = 0; m < 4; ++m) cs[m] = a + __shfl(ts[1], cj + m);
        float bs = 0.f; int bpos = 0;
        for (int r = 0; r < PK; ++r) { const float m = wave_max(fmaxf(fmaxf(cs[0], cs[1]), fmaxf(cs[2], cs[3])));
            int cand = 1000;
#pragma unroll
            for (int mm = 3; mm >= 0; --mm) if (cs[mm] == m) cand = ci * 16 + cj + mm;
            const int pos = wave_min_i(cand);
            if (lane == r) { bs = m; bpos = pos; }
#pragma unroll
            for (int mm = 0; mm < 4; ++mm) if (pos == ci * 16 + cj + mm) cs[mm] = NEG; }
        const int e1 = __shfl(ti[0], (bpos >> 4) & 15), e2 = __shfl(ti[1], bpos & 15);
        const float m0 = __shfl(bs, 0); const float ex = lane < PK ? __expf(bs - m0) : 0.f; const float sum = wave_sum(ex);
        if (lane < PK) { idxo[(size_t)t * 128 + h * PK + lane] = e1 * 128 + e2; gato[(size_t)t * 128 + h * PK + lane] = ex / sum; }
        __builtin_amdgcn_wave_barrier();
    }
}

__device__ __forceinline__ int f2key(float f) { const int b = __float_as_int(f); return b ^ ((b >> 31) & 0x7fffffff); }
__device__ __forceinline__ float key2f(int k) { return __int_as_float(k ^ ((k >> 31) & 0x7fffffff)); }
typedef int i32x16 __attribute__((ext_vector_type(16)));
typedef float f32x16v __attribute__((ext_vector_type(16)));
#define TK_CE(v, i, l) do { const int _a = v[i], _b = v[l]; v[i] = max(_a, _b); v[l] = min(_a, _b); } while (0)
__device__ __forceinline__ i32x16 sort16_desc(i32x16 v) {
#pragma unroll
    for (int lk = 1; lk <= 4; ++lk)
#pragma unroll
        for (int lj = 3; lj >= 0; --lj) { if (lj >= lk) continue; const int k = 1 << lk, j = 1 << lj;
#pragma unroll
            for (int i = 0; i < 16; ++i) { const int l = i ^ j; if (l > i) { if ((i & k) == 0) TK_CE(v, i, l); else TK_CE(v, l, i); } } }
    return v;
}
__device__ __forceinline__ i32x16 bitonic_merge16_desc(i32x16 v) {
#pragma unroll
    for (int lj = 3; lj >= 0; --lj) { const int j = 1 << lj;
#pragma unroll
        for (int i = 0; i < 16; ++i) { const int l = i ^ j; if (l > i) TK_CE(v, i, l); } }
    return v;
}
__device__ __forceinline__ i32x16 merge_top16(i32x16 a, i32x16 b) {
#pragma unroll
    for (int i = 0; i < 16; ++i) a[i] = max(a[i], b[15 - i]);
    return bitonic_merge16_desc(a);
}
__device__ __forceinline__ i32x16 xlane_merge_top16(i32x16 a, int xr) {
    i32x16 b;
#pragma unroll
    for (int i = 0; i < 16; ++i) b[i] = __shfl_xor(a[i], xr);
    return merge_top16(a, b);
}
__device__ __forceinline__ int sel2i(bool c, int x, int y) { return c ? y : x; }
__device__ __forceinline__ int sel16(i32x16 v, int i) {
    const bool c0 = (i & 1) != 0, c1 = (i & 2) != 0, c2 = (i & 4) != 0, c3 = (i & 8) != 0;
    const int a0 = sel2i(c0, v[0], v[1]), a1 = sel2i(c0, v[2], v[3]), a2 = sel2i(c0, v[4], v[5]), a3 = sel2i(c0, v[6], v[7]);
    const int a4 = sel2i(c0, v[8], v[9]), a5 = sel2i(c0, v[10], v[11]), a6 = sel2i(c0, v[12], v[13]), a7 = sel2i(c0, v[14], v[15]);
    const int b0 = sel2i(c1, a0, a1), b1 = sel2i(c1, a2, a3), b2 = sel2i(c1, a4, a5), b3 = sel2i(c1, a6, a7);
    const int d0 = sel2i(c2, b0, b1), d1 = sel2i(c2, b2, b3);
    return sel2i(c3, d0, d1);
}
__device__ __forceinline__ int sel4i(int g, int a, int b, int c, int d) { return g == 0 ? a : (g == 1 ? b : (g == 2 ? c : d)); }
__device__ __forceinline__ float sel4f(int g, float a, float b, float c, float d) { return g == 0 ? a : (g == 1 ? b : (g == 2 ? c : d)); }
constexpr int TK_TAB[64] = {
    0x00, 0x01, 0x02, 0x03, 0x04, 0x05, 0x06, 0x07, 0x08, 0x09, 0x0A, 0x0B, 0x0C, 0x0D, 0x0E, 0x0F,
    0x10, 0x11, 0x12, 0x13, 0x14, 0x15, 0x16, 0x17, 0x40, 0x41, 0x42, 0x80, 0x90, 0xFF, 0xFF, 0xFF,
    0x20, 0x21, 0x22, 0x23, 0x24, 0x30, 0x31, 0x32, 0x33, 0x50, 0x51, 0xA0, 0xB0, 0xFF, 0xFF, 0xFF,
    0x60, 0x61, 0x70, 0x71, 0xC0, 0xD0, 0xE0, 0xF0, 0xFF, 0xFF, 0xFF, 0xFF, 0xFF, 0xFF, 0xFF, 0xFF};
template <int C> __device__ __forceinline__ int tk_make_cand(i32x16 sp0, i32x16 sp1, int g) {
    constexpr int NONE = (int)0x80000000;
    constexpr int e0 = TK_TAB[C], e1 = TK_TAB[16 + C], e2 = TK_TAB[32 + C], e3 = TK_TAB[48 + C];
    constexpr int r0 = (e0 >> 4) & 15, r1 = e1 == 0xFF ? 0 : (e1 >> 4) & 15, r2 = e2 == 0xFF ? 0 : (e2 >> 4) & 15, r3 = e3 == 0xFF ? 0 : (e3 >> 4) & 15;
    constexpr int c0 = e0 & 15, c1 = e1 == 0xFF ? 0 : e1 & 15, c2 = e2 == 0xFF ? 0 : e2 & 15, c3 = e3 == 0xFF ? 0 : e3 & 15;
    const int av = sel4i(g, sp0[r0], sp0[r1], sp0[r2], sp0[r3]);
    const int bv = sel4i(g, sp1[c0], sp1[c1], sp1[c2], sp1[c3]);
    const int code = sel4i(g, e0, e1, e2, e3);
    const float sum = key2f(av & ~127) + key2f(bv & ~127);
    return code == 0xFF ? NONE : ((f2key(sum) & ~255) | code);
}
__device__ __forceinline__ void phase_topk(const Params& p, unsigned char* lds_) {
    LAS unsigned char* lds = (LAS unsigned char*)lds_;
    const int tid = threadIdx.x, lane = tid & 63, w = __builtin_amdgcn_readfirstlane(tid >> 6), l15 = lane & 15, g = lane >> 4;
    const bf16_t* pq = (const bf16_t*)(p.ws + OFF_QKV + (size_t)T * D * 2); const bf16_t* skb = (const bf16_t*)(p.ws + OFF_SUBK);
    int* idxo = (int*)(p.ws + OFF_IDX); float* gato = (float*)(p.ws + OFF_GATE);
    int cur_h = -1;
    for (int task = blockIdx.x; task < (T / 128) * PH; task += gridDim.x) {
        const int h = task & 7, tt = task >> 3;
        if (h != cur_h) {
            __syncthreads();
#pragma unroll
            for (int i = 0; i < 8; ++i) { const int ch = i * NTHR + tid, row = ch >> 4, c = ch & 15;
                *(LAS u32x4*)(lds + row * 256 + ((c ^ (row & 15)) << 4)) = *(const u32x4*)(skb + ((size_t)h * 256 + row) * 128 + c * 8); }
            __syncthreads();
            cur_h = h;
        }
        const int t = tt * 128 + 16 * w + l15;
        i32x16 sp0, sp1;
#pragma unroll
        for (int pp = 0; pp < 2; ++pp) {
            bf16x8 bq[4];
#pragma unroll
            for (int ks = 0; ks < 4; ++ks) bq[ks] = *(const bf16x8*)(pq + (size_t)t * D + h * 256 + pp * 128 + 32 * ks + 8 * g);
            i32x16 ka, kb2;
#pragma unroll
            for (int kt = 0; kt < 8; ++kt) {
                f32x4 a = {0.f, 0.f, 0.f, 0.f};
                const int row = pp * 128 + 16 * kt + l15;
#pragma unroll
                for (int ks = 0; ks < 4; ++ks) { const bf16x8 kf = *(const LAS bf16x8*)(lds + row * 256 + (((4 * ks + g) ^ (row & 15)) << 4)); a = __builtin_amdgcn_mfma_f32_16x16x32_bf16(kf, bq[ks], a, 0, 0, 0); }
#pragma unroll
                for (int rg = 0; rg < 4; ++rg) { const int key = (f2key(a[rg]) & ~127) | (16 * kt + rg + 4 * g);
                    if (kt < 4) ka[kt * 4 + rg] = key; else kb2[(kt - 4) * 4 + rg] = key; }
            }
            ka = merge_top16(sort16_desc(ka), sort16_desc(kb2));
            ka = xlane_merge_top16(ka, 16); ka = xlane_merge_top16(ka, 32);
            if (pp == 0) sp0 = ka; else sp1 = ka;
        }
        i32x16 cd;
        cd[0] = tk_make_cand<0>(sp0, sp1, g); cd[1] = tk_make_cand<1>(sp0, sp1, g); cd[2] = tk_make_cand<2>(sp0, sp1, g); cd[3] = tk_make_cand<3>(sp0, sp1, g);
        cd[4] = tk_make_cand<4>(sp0, sp1, g); cd[5] = tk_make_cand<5>(sp0, sp1, g); cd[6] = tk_make_cand<6>(sp0, sp1, g); cd[7] = tk_make_cand<7>(sp0, sp1, g);
        cd[8] = tk_make_cand<8>(sp0, sp1, g); cd[9] = tk_make_cand<9>(sp0, sp1, g); cd[10] = tk_make_cand<10>(sp0, sp1, g); cd[11] = tk_make_cand<11>(sp0, sp1, g);
        cd[12] = tk_make_cand<12>(sp0, sp1, g); cd[13] = tk_make_cand<13>(sp0, sp1, g); cd[14] = tk_make_cand<14>(sp0, sp1, g); cd[15] = tk_make_cand<15>(sp0, sp1, g);
        cd = sort16_desc(cd); cd = xlane_merge_top16(cd, 16); cd = xlane_merge_top16(cd, 32);
        f32x16v ex; float sum = 0.f; const float m0 = key2f(cd[0] & ~255);
#pragma unroll
        for (int i = 0; i < 16; ++i) { ex[i] = __expf(key2f(cd[i] & ~255) - m0); sum += ex[i]; }
        const float is = 1.0f / sum;
        int oi[4]; float og[4];
#pragma unroll
        for (int c = 0; c < 4; ++c) {
            const int key = sel4i(g, cd[c], cd[4 + c], cd[8 + c], cd[12 + c]);
            const float e = sel4f(g, ex[c], ex[4 + c], ex[8 + c], ex[12 + c]);
            const int i1 = sel16(sp0, (key >> 4) & 15) & 127, i2 = sel16(sp1, key & 15) & 127;
            oi[c] = i1 * 128 + i2; og[c] = e * is; }
        *(int4*)(idxo + (size_t)t * 128 + h * PK + 4 * g) = make_int4(oi[0], oi[1], oi[2], oi[3]);
        *(float4*)(gato + (size_t)t * 128 + h * PK + 4 * g) = make_float4(og[0], og[1], og[2], og[3]);
    }
}

typedef float f32x2v __attribute__((ext_vector_type(2)));
typedef float f32x8v __attribute__((ext_vector_type(8)));
__device__ __forceinline__ float dot16_fp8(const u32x4 w, const float* xf) {
    float s = 0.f;
#pragma unroll
    for (int q = 0; q < 4; ++q) { const int ww = (int)w[q]; const f32x2v lo = __builtin_amdgcn_cvt_pk_f32_fp8(ww, false), hi = __builtin_amdgcn_cvt_pk_f32_fp8(ww, true);
        s = fmaf(lo.x, xf[4 * q + 0], s); s = fmaf(lo.y, xf[4 * q + 1], s); s = fmaf(hi.x, xf[4 * q + 2], s); s = fmaf(hi.y, xf[4 * q + 3], s); }
    return s;
}
__device__ __forceinline__ void axpy16_fp8(const u32x4 w, float cw, float* acc) {
#pragma unroll
    for (int q = 0; q < 4; ++q) { const int ww = (int)w[q]; const f32x2v lo = __builtin_amdgcn_cvt_pk_f32_fp8(ww, false), hi = __builtin_amdgcn_cvt_pk_f32_fp8(ww, true);
        acc[4 * q + 0] = fmaf(cw, lo.x, acc[4 * q + 0]); acc[4 * q + 1] = fmaf(cw, lo.y, acc[4 * q + 1]); acc[4 * q + 2] = fmaf(cw, hi.x, acc[4 * q + 2]); acc[4 * q + 3] = fmaf(cw, hi.y, acc[4 * q + 3]); }
}
__device__ __forceinline__ void phase_gather(const Params& p, bool dry = false) {
    const int lane = threadIdx.x & 63, gw = blockIdx.x * NWV + (threadIdx.x >> 6), nw = gridDim.x * NWV;
    const bf16_t* hn2 = (const bf16_t*)(p.ws + OFF_A); const unsigned char* ut = p.ws + OFF_UTAB; const unsigned char* vt = p.ws + OFF_VTAB;
    const float* uinv = (const float*)(p.ws + OFF_UTAB + TAB8_BYTES); const float* vinv = (const float*)(p.ws + OFF_VTAB + TAB8_BYTES);
    const int* idx = (const int*)(p.ws + OFF_IDX); const float* gate = (const float*)(p.ws + OFF_GATE);
    const int kk = lane >> 4;
    for (int t = gw; t < T; t += nw) {
        float xf[32], acc[32];
#pragma unroll
        for (int c = 0; c < 2; ++c)
#pragma unroll
            for (int hh = 0; hh < 2; ++hh) { const u32x4 w = *(const u32x4*)(hn2 + (size_t)t * D + c * 1024 + lane * 16 + hh * 8);
                xf[c * 16 + hh * 8 + 0] = bflo(w.x); xf[c * 16 + hh * 8 + 1] = bfhi(w.x); xf[c * 16 + hh * 8 + 2] = bflo(w.y); xf[c * 16 + hh * 8 + 3] = bfhi(w.y);
                xf[c * 16 + hh * 8 + 4] = bflo(w.z); xf[c * 16 + hh * 8 + 5] = bfhi(w.z); xf[c * 16 + hh * 8 + 6] = bflo(w.w); xf[c * 16 + hh * 8 + 7] = bfhi(w.w); }
#pragma unroll
        for (int j = 0; j < 32; ++j) acc[j] = 0.f;
        const int iv0 = idx[(size_t)t * 128 + lane], iv1 = idx[(size_t)t * 128 + 64 + lane];
        const float gv0 = gate[(size_t)t * 128 + lane], gv1 = gate[(size_t)t * 128 + 64 + lane];
        u32x4 ur[4][2], vr[4][2];
#pragma unroll
        for (int k = 0; k < 4; ++k) { const int e = __builtin_amdgcn_readlane(iv0, k); const unsigned char* up = ut + (size_t)e * D + lane * 16; ur[k][0] = *(const u32x4*)up; ur[k][1] = *(const u32x4*)(up + 1024); }
#pragma unroll 1
        for (int grp = 0; grp < 32; ++grp) {
            const int ivs = grp < 16 ? iv0 : iv1; const float gvs = grp < 16 ? gv0 : gv1; const int l0 = (grp & 15) * 4;
#pragma unroll
            for (int k = 0; k < 4; ++k) { const int e = __builtin_amdgcn_readlane(ivs, l0 + k); const unsigned char* vp = vt + (size_t)e * D + lane * 16; vr[k][0] = *(const u32x4*)vp; vr[k][1] = *(const u32x4*)(vp + 1024); }
            const int emine = __shfl(ivs, l0 + kk);
            const float gsc = __shfl(gvs, l0 + kk) * vinv[emine], usc = uinv[emine];
            f32x4 pd;
#pragma unroll
            for (int k = 0; k < 4; ++k) { pd[k] = dot16_fp8(ur[k][0], xf) + dot16_fp8(ur[k][1], xf + 16); __builtin_amdgcn_sched_barrier(0); }
            if (grp < 31) { const int ivn = grp + 1 < 16 ? iv0 : iv1; const int ln = ((grp + 1) & 15) * 4;
#pragma unroll
                for (int k = 0; k < 4; ++k) { const int e = __builtin_amdgcn_readlane(ivn, ln + k); const unsigned char* up = ut + (size_t)e * D + lane * 16; ur[k][0] = *(const u32x4*)up; ur[k][1] = *(const u32x4*)(up + 1024); } }
            const bool b5 = (lane & 32) != 0, b4 = (lane & 16) != 0;
            const float s0 = b5 ? pd[0] : pd[2], k0 = b5 ? pd[2] : pd[0], s1 = b5 ? pd[1] : pd[3], k1 = b5 ? pd[3] : pd[1];
            const float q0 = k0 + __shfl_xor(s0, 32), q1 = k1 + __shfl_xor(s1, 32);
            const float s2 = b4 ? q0 : q1, k2 = b4 ? q1 : q0;
            float sd = k2 + __shfl_xor(s2, 16);
            sd += __shfl_xor(sd, 8); sd += __shfl_xor(sd, 4); sd += __shfl_xor(sd, 2); sd += __shfl_xor(sd, 1);
            const float wmine = gsc * gelu_erf(sd * usc);
#pragma unroll
            for (int k = 0; k < 4; ++k) { const float cw = __int_as_float(__builtin_amdgcn_readlane(__float_as_int(wmine), 16 * k)); axpy16_fp8(vr[k][0], cw, acc); axpy16_fp8(vr[k][1], cw, acc + 16); __builtin_amdgcn_sched_barrier(0); }
        }
        asm volatile("" ::: "memory");
        const int b = t / S; int l16 = lane * 16; asm volatile("" : "+v"(l16));
        float* hrow = p.out + (size_t)t * D + l16; const long long* mrow = (const long long*)(p.ws + OFF_MOD) + b * 12288 + 5 * D + l16; const float* grow = p.g_final + l16; float ss = 0.f;
#pragma unroll
        for (int c = 0; c < 2; ++c)
#pragma unroll
            for (int q = 0; q < 4; ++q) { const int col = c * 1024 + q * 4; const float4 h0 = *(const float4*)(hrow + col); const float4 g0 = mod4q(mrow + col);
                float* a = acc + c * 16 + q * 4;
                a[0] = h0.x + g0.x * a[0]; a[1] = h0.y + g0.y * a[1]; a[2] = h0.z + g0.z * a[2]; a[3] = h0.w + g0.w * a[3];
                ss += a[0] * a[0] + a[1] * a[1] + a[2] * a[2] + a[3] * a[3]; }
        ss = wave_sum(ss); const float rs = rsqrtf(ss * (1.0f / D) + 1e-6f);
        if (dry && rs != 12345.678f) continue;
#pragma unroll
        for (int c = 0; c < 2; ++c)
#pragma unroll
            for (int q = 0; q < 4; ++q) { const int col = c * 1024 + q * 4; const float4 g0 = *(const float4*)(grow + col); const float* a = acc + c * 16 + q * 4;
                *(float4*)(hrow + col) = make_float4(a[0] * rs * g0.x, a[1] * rs * g0.y, a[2] * rs * g0.z, a[3] * rs * g0.w); }
    }
}

constexpr int LDS_BYTES = 147456;
template <int PHASE> __global__ void __launch_bounds__(NTHR, 2) k_phase(Params p) {
    extern __shared__ __attribute__((aligned(16))) unsigned char lds[];
    if (PHASE == 0) phase_conv(p, lds);
    if (PHASE == 1) phase_norm_mod(p, p.x, p.g_norm1, 0, 1, (bf16_t*)(p.ws + OFF_A));
    if (PHASE == 2) phase_gemm1_naive(p, lds);
    if (PHASE == 3) { phase_attn_naive(p, lds); phase_sgu_ln_naive(p); }
    if (PHASE == 4) phase_sgu_mix_naive(p);
    if (PHASE == 5) phase_combine(p);
    if (PHASE == 6) phase_gemm2_naive(p, lds);
    if (PHASE == 7) phase_norm_mod(p, p.out, p.g_norm2, 3, 4, (bf16_t*)(p.ws + OFF_A));
    if (PHASE == 8) phase_gemm3_naive(p, lds);
    if (PHASE == 9) phase_topk_naive(p, lds);
    if (PHASE == 10) phase_gather(p);
}

#define XB_TMO      128
#define XB_XCNT(j)  (256  + 64 * (j))
#define XB_XSUB(j)  (1280 + 64 * (j))
#define XB_XGEN(j)  (2304 + 64 * (j))
#define XB_TOP      3328
#define XB_TOPGEN   3392
#define XCD_BAR_WORDS 3456
#define XB_SPIN_CAP (1u << 18)

__device__ __forceinline__ unsigned xb_ld(unsigned* p)              { return __hip_atomic_load(p, __ATOMIC_RELAXED, __HIP_MEMORY_SCOPE_AGENT); }
__device__ __forceinline__ unsigned xb_add(unsigned* p, unsigned v) { return __hip_atomic_fetch_add(p, v, __ATOMIC_RELAXED, __HIP_MEMORY_SCOPE_AGENT); }
__device__ __forceinline__ unsigned xb_xcc_id() { return (unsigned)__builtin_amdgcn_s_getreg((3 << 11) | 20) & 0xFu; }
#define XB_SPIN(cond, bar) do { unsigned _sp = 0; while (cond) { __builtin_amdgcn_s_sleep(1); \
    if ((++_sp & 255u) == 0u) { if (xb_ld(&(bar)[XB_TMO])) break; if (_sp > XB_SPIN_CAP) { atomicAdd(&(bar)[XB_TMO], 1u); break; } } } } while (0)

struct XcdBarrier {
    unsigned* bar; unsigned x;
    volatile LAS unsigned* st;
};

__device__ __forceinline__ XcdBarrier xcd_barrier_post(unsigned* bar, volatile LAS unsigned* st) {
    XcdBarrier b; b.bar = bar; b.x = xb_xcc_id(); b.st = st;
    if (threadIdx.x == 0) (void)xb_add(&bar[XB_XCNT(b.x)], 1u);
    return b;
}
__device__ __forceinline__ void xcd_barrier_complete(unsigned* bar, unsigned x, unsigned& nloc, unsigned& nx) {
    const unsigned G = gridDim.x * gridDim.y * gridDim.z;
    unsigned sum, cnt, mine, sp = 0u;
    for (;;) {
        sum = 0u; cnt = 0u; mine = 0u;
#pragma unroll
        for (unsigned j = 0; j < 16; ++j) { const unsigned c = xb_ld(&bar[XB_XCNT(j)]); sum += c; cnt += (c > 0u) ? 1u : 0u; mine = (j == x) ? c : mine; }
        if (sum == G) break;
        __builtin_amdgcn_s_sleep(1);
        if ((++sp & 255u) == 0u) { if (xb_ld(&bar[XB_TMO])) break; if (sp > XB_SPIN_CAP) { atomicAdd(&bar[XB_TMO], 1u); break; } }
    }
    nloc = mine > 0u ? mine : 1u; nx = cnt > 0u ? cnt : 1u;
}

__device__ __forceinline__ void xcd_barrier(const XcdBarrier& b) {
    asm volatile("s_waitcnt vmcnt(0)" ::: "memory");
    __syncthreads();
    if (threadIdx.x == 0) {
        unsigned* bar = b.bar;
        __builtin_amdgcn_s_waitcnt(0);
        unsigned nloc = b.st[0], nx = b.st[1];
        if (nloc == 0u) { xcd_barrier_complete(bar, b.x, nloc, nx); b.st[0] = nloc; b.st[1] = nx; }
        const unsigned old = xb_add(&bar[XB_XSUB(b.x)], 1u);
        const unsigned gen = old / nloc;
        if (old + 1u == (gen + 1u) * nloc) {
            __builtin_amdgcn_fence(__ATOMIC_RELEASE, "agent");
            asm volatile("s_waitcnt vmcnt(0)" ::: "memory");
            const unsigned og = xb_add(&bar[XB_TOP], 1u);
            const unsigned tg = og / nx;
            if (og + 1u == (tg + 1u) * nx) xb_add(&bar[XB_TOPGEN], 1u);
            else XB_SPIN(xb_ld(&bar[XB_TOPGEN]) == tg, bar);
            __builtin_amdgcn_fence(__ATOMIC_ACQUIRE, "agent");
            xb_add(&bar[XB_XGEN(b.x)], 1u);
            asm volatile("s_waitcnt vmcnt(0)" ::: "memory");
        } else {
            XB_SPIN(xb_ld(&bar[XB_XGEN(b.x)]) == gen, bar);
            __builtin_amdgcn_fence(__ATOMIC_ACQUIRE, "agent");
            asm volatile("s_waitcnt vmcnt(0)" ::: "memory");
        }
    }
    __syncthreads();
}

#ifndef PHASE_MASK
#define PHASE_MASK 0x3FF
#endif
#ifndef PROBE_DUP
#define PROBE_DUP 0
#endif
#define GBAR() xcd_barrier(xbar)
#define RUNPH(bit, call, dupcall) do { if (PHASE_MASK & (bit)) { if (PROBE_DUP & (bit)) { dupcall; GBAR(); } call; GBAR(); } } while (0)
__global__ void __launch_bounds__(NTHR, 2) k_mega(Params p) {
    extern __shared__ __attribute__((aligned(16))) unsigned char lds[];
    cg::grid_group grid = cg::this_grid();
    volatile LAS unsigned* xst = (volatile LAS unsigned*)((LAS unsigned char*)lds + LDS_BYTES);
    if (threadIdx.x < 4) xst[threadIdx.x] = 0u;
    __syncthreads();
    XcdBarrier xbar = xcd_barrier_post((unsigned*)(p.ws + OFF_CTL), xst);
    if (PHASE_MASK & 1) { if (PROBE_DUP & 1) { phase_conv(p, lds, true); GBAR(); } phase_conv(p, lds); grid.sync(); }
    RUNPH(2, phase_norm_mod(p, p.x, p.g_norm1, 0, 1, (bf16_t*)(p.ws + OFF_A)), phase_norm_mod(p, p.x, p.g_norm1, 0, 1, (bf16_t*)(p.ws + OFF_A)));
    RUNPH(4, phase_gemm1(p, lds), phase_gemm1(p, lds));
    RUNPH(8, (phase_attn(p, lds), phase_sgu(p, lds)), (phase_attn(p, lds), phase_sgu(p, lds)));
    RUNPH(16, phase_combine(p), phase_combine(p));
    RUNPH(32, phase_gemm2(p, lds), phase_gemm2(p, lds));
    RUNPH(64, phase_norm_mod(p, p.out, p.g_norm2, 3, 4, (bf16_t*)(p.ws + OFF_A)), phase_norm_mod(p, p.out, p.g_norm2, 3, 4, (bf16_t*)(p.ws + OFF_A)));
    RUNPH(128, phase_gemm3(p, lds), phase_gemm3(p, lds));
    RUNPH(256, phase_topk(p, lds), phase_topk(p, lds));
    if (PHASE_MASK & 512) { if (PROBE_DUP & 512) { phase_gather(p, true); GBAR(); } phase_gather(p); }
}

#ifndef MEGA
#define MEGA 1
#endif
template <int PHASE> static void launch_phase(const Params& p, int grid, hipStream_t stream) {
    static bool attr = false;
    if (!attr) { (void)hipFuncSetAttribute((const void*)k_phase<PHASE>, hipFuncAttributeMaxDynamicSharedMemorySize, LDS_BYTES); attr = true; }
    hipLaunchKernelGGL(k_phase<PHASE>, dim3(grid), dim3(NTHR), LDS_BYTES, stream, p);
}

extern "C" void kernel_launch(void* const* d_in, const int* in_sizes, int n_in, void* d_out, int out_size, void* d_ws, size_t ws_size, hipStream_t stream) {
    if (n_in != 20 || out_size != T * D || ws_size < WS_END) { fprintf(stderr, "kernel_launch: unexpected problem (n_in %d out %d ws %zu, need %zu)\n", n_in, out_size, ws_size, (size_t)WS_END); return; }
    Params p{};
    p.x = (const float*)d_in[0]; p.c = (const float*)d_in[1]; p.pos = (const int*)d_in[2]; p.w_ada = (const float*)d_in[3]; p.b_ada = (const float*)d_in[4];
    p.g_norm1 = (const float*)d_in[5]; p.w_in = (const float*)d_in[6]; p.g_attn_out = (const float*)d_in[7]; p.g_sgu_out = (const float*)d_in[8];
    p.sgu_w = (const float*)d_in[9]; p.sgu_b = (const float*)d_in[10]; p.sgu_ln_g = (const float*)d_in[11]; p.sgu_ln_b = (const float*)d_in[12];
    p.w_out = (const float*)d_in[13]; p.g_norm2 = (const float*)d_in[14]; p.peer_w_q = (const float*)d_in[15]; p.peer_sub_keys = (const float*)d_in[16];
    p.peer_u = (const float*)d_in[17]; p.peer_v = (const float*)d_in[18]; p.g_final = (const float*)d_in[19];
    p.out = (float*)d_out; p.ws = (unsigned char*)d_ws;
    (void)hipMemsetAsync((char*)d_ws + OFF_CTL, 0, OFF_SGUW - OFF_CTL, stream);
#if MEGA
    static int grid_blocks = 0;
    if (!grid_blocks) {
        int dev = 0, cus = 0, per_cu = 0;
        (void)hipGetDevice(&dev); (void)hipDeviceGetAttribute(&cus, hipDeviceAttributeMultiprocessorCount, dev);
        (void)hipFuncSetAttribute((const void*)k_mega, hipFuncAttributeMaxDynamicSharedMemorySize, LDS_BYTES + 16);
        (void)hipOccupancyMaxActiveBlocksPerMultiprocessor(&per_cu, (const void*)k_mega, NTHR, LDS_BYTES + 16);
        if (per_cu < 1) { fprintf(stderr, "kernel_launch: occupancy query says %d blocks per CU\n", per_cu); per_cu = 1; }
        if (per_cu > 1) per_cu = 1;
        grid_blocks = cus * per_cu;
    }
    void* args[] = {(void*)&p};
    hipError_t e = hipLaunchCooperativeKernel((const void*)k_mega, dim3(grid_blocks), dim3(NTHR), args, LDS_BYTES + 16, stream);
    if (e != hipSuccess) fprintf(stderr, "cooperative launch failed: %s (grid %d)\n", hipGetErrorString(e), grid_blocks);
#else
    const int grid = 256;
    launch_phase<0>(p, grid, stream); launch_phase<1>(p, grid, stream); launch_phase<2>(p, grid, stream); launch_phase<3>(p, grid, stream);
    launch_phase<4>(p, grid, stream); launch_phase<5>(p, grid, stream); launch_phase<6>(p, grid, stream); launch_phase<7>(p, grid, stream);
    launch_phase<8>(p, grid, stream); launch_phase<9>(p, grid, stream); launch_phase<10>(p, grid, stream);
#endif
}
```

```cpp
#include <hip/hip_runtime.h>
#include <hip/hip_cooperative_groups.h>
#include <cstdio>
#include <cstdint>
namespace cg = cooperative_groups;

constexpr int D = 2048, NB = 4, S = 4096, T = NB * S;
constexpr int E = 128, HA = 12, HS = 4, DA = 1536, DS = 512, DIN = 5632;
constexpr int PH = 8, PK = 16, NEXP = 16384;
constexpr int NTHR = 512, NWV = 8;

typedef unsigned short bf16_t;
typedef unsigned u32x4 __attribute__((ext_vector_type(4)));
typedef unsigned u32x2 __attribute__((ext_vector_type(2)));
typedef float f32x4 __attribute__((ext_vector_type(4)));

__device__ __forceinline__ bf16_t f2bf(float f) { unsigned u = __float_as_uint(f); u += 0x7FFFu + ((u >> 16) & 1u); return (bf16_t)(u >> 16); }
__device__ __forceinline__ float bf2f(bf16_t b) { return __uint_as_float(((unsigned)b) << 16); }
__device__ __forceinline__ unsigned pack2(float lo, float hi) { return (unsigned)f2bf(lo) | ((unsigned)f2bf(hi) << 16); }
__device__ __forceinline__ float bflo(unsigned w) { return __uint_as_float(w << 16); }
__device__ __forceinline__ float bfhi(unsigned w) { return __uint_as_float(w & 0xffff0000u); }
__device__ __forceinline__ float wave_sum(float v) {
#pragma unroll
    for (int o = 32; o >= 1; o >>= 1) v += __shfl_xor(v, o);
    return v; }
__device__ __forceinline__ float wave_max(float v) {
#pragma unroll
    for (int o = 32; o >= 1; o >>= 1) v = fmaxf(v, __shfl_xor(v, o));
    return v; }
__device__ __forceinline__ int wave_min_i(int v) {
#pragma unroll
    for (int o = 32; o >= 1; o >>= 1) v = min(v, __shfl_xor(v, o));
    return v; }
__device__ __forceinline__ float gelu_erf(float v) { return 0.5f * v * (1.0f + erff(v * 0.70710678118654752f)); }

constexpr size_t OFF_CTL  = 0;
constexpr size_t OFF_MOD  = 65536;
constexpr size_t OFF_SGUW = OFF_MOD + 393216;
constexpr size_t OFF_SUBK = OFF_SGUW + 131072;
constexpr size_t OFF_LSE  = OFF_SUBK + 524288;
constexpr size_t OFF_IDX  = OFF_LSE + (size_t)3 * T * 12 * 4;
constexpr size_t OFF_GATE = OFF_IDX + (size_t)T * 128 * 4;
constexpr size_t OFF_WIN  = OFF_GATE + (size_t)T * 128 * 4;
constexpr size_t OFF_WOUT = OFF_WIN + (size_t)DIN * D * 2;
constexpr size_t OFF_WQ   = OFF_WOUT + (size_t)D * D * 2;
constexpr size_t OFF_UTAB = OFF_WQ + (size_t)D * D * 2;
constexpr size_t TAB8_BYTES = (size_t)NEXP * D;
constexpr size_t SLICE_BYTES = (size_t)NEXP * 128;
constexpr size_t OFF_QUEUE = 32768;
constexpr size_t OFF_VTAB = OFF_UTAB + (size_t)NEXP * D * 2;
constexpr size_t OFF_A    = OFF_VTAB + (size_t)NEXP * D * 2;
constexpr size_t OFF_QKV  = OFF_A + (size_t)T * D * 2;
constexpr size_t QKV_ONE  = (size_t)T * DA * 2;
constexpr size_t OFF_US   = OFF_QKV + 3 * QKV_ONE;
constexpr size_t OFF_VS   = OFF_US + (size_t)T * DS * 2;
constexpr size_t OFF_SGUO = OFF_VS + (size_t)T * DS * 2;
constexpr size_t OFF_O12  = OFF_SGUO + (size_t)T * DS * 2;
constexpr size_t WS_END   = OFF_O12 + 2 * QKV_ONE;

struct Params {
    const float* x; const float* c; const int* pos; const float* w_ada; const float* b_ada; const float* g_norm1; const float* w_in;
    const float* g_attn_out; const float* g_sgu_out; const float* sgu_w; const float* sgu_b; const float* sgu_ln_g; const float* sgu_ln_b;
    const float* w_out; const float* g_norm2; const float* peer_w_q; const float* peer_sub_keys; const float* peer_u; const float* peer_v;
    const float* g_final; float* out; unsigned char* ws;
};
__device__ __forceinline__ float fx2f(long long v) { return (float)(int)(v >> 32) + (float)(unsigned)v * 2.3283064365386963e-10f; }
__device__ __forceinline__ float mod1(const Params& p, int b, int i, int col) { return fx2f(((const long long*)(p.ws + OFF_MOD))[b * 12288 + i * D + col]); }
__device__ __forceinline__ float4 mod4q(const long long* mp) { return make_float4(fx2f(mp[0]), fx2f(mp[1]), fx2f(mp[2]), fx2f(mp[3])); }
__device__ __forceinline__ float4 mod4(const Params& p, int b, int i, int col) { return mod4q((const long long*)(p.ws + OFF_MOD) + b * 12288 + i * D + col); }
__device__ __forceinline__ bf16_t* P_opat(const Params& p, int pat) { return (bf16_t*)(pat == 0 ? p.ws + OFF_A : p.ws + OFF_O12 + (size_t)(pat - 1) * QKV_ONE); }

namespace pg8 {
#define PG8_LAS __attribute__((address_space(3)))
typedef unsigned short bf16_t;
typedef short bf16x8 __attribute__((ext_vector_type(8)));
typedef float f32x4 __attribute__((ext_vector_type(4)));
typedef unsigned u32x4 __attribute__((ext_vector_type(4)));
constexpr int BM = 256, BK = 64, HALF = 128, HTB = HALF * BK * 2  , STAGE_BYTES = 8 * HTB, NXCD = 8, WGM = 8;

__host__ __device__ __forceinline__ int lds_byte(int r, int c) { const int st = (r >> 4) * 2 + (c >> 5), rr = r & 15, cc = c & 31, ob = rr * 64 + cc * 2; return st * 1024 + (ob ^ (((ob >> 9) & 1) << 5)); }
__host__ __device__ __forceinline__ void stage_rc(int b, int& R, int& C) { const int st = b / 1024, sb = b % 1024, swz = sb ^ (((sb >> 9) & 1) << 5); R = (st >> 1) * 16 + swz / 64; C = (st & 1) * 32 + (swz % 64) / 2; }
__host__ __device__ __forceinline__ int perm32(int rho) { const int n = rho >> 4, i = rho & 15; return 8 * (i >> 2) + 4 * n + (i & 3); }

struct Unit { int pm, pn; };
struct Gemm { const bf16_t* A; const bf16_t* Bt; int M, N, K; };

struct StaticOrder {
    int nM, nN, nwg, G, c;
    __host__ __device__ void init(int M, int N, int G_, int c_) { nM = M / BM; nN = N / BM; nwg = nM * nN; G = G_; c = c_; }
    __host__ __device__ bool next(int i, Unit& u) const {
        const long L = (long)i * G + c; if (L >= nwg) return false;
        int wgid = (int)L; { const int q = nwg / NXCD, r = nwg % NXCD, xcd = wgid % NXCD, off = wgid / NXCD; wgid = (xcd < r ? xcd * (q + 1) : r * (q + 1) + (xcd - r) * q) + off; }
        const int nig = WGM * nN, gid = wgid / nig, fm = gid * WGM, gsz = (nM - fm) < WGM ? (nM - fm) : WGM;
        u.pm = fm + ((wgid % nig) % gsz); u.pn = (wgid % nig) / gsz; return true;
    }
    __device__ __forceinline__ void a_ready(const Unit&) const {}
    __device__ __forceinline__ void done(const Unit&) const {}
};

__device__ __forceinline__ unsigned cvt_pk_bf16(float lo, float hi) { unsigned r; asm volatile("v_cvt_pk_bf16_f32 %0, %1, %2" : "=v"(r) : "v"(lo), "v"(hi)); return r; }
typedef float f32x2 __attribute__((ext_vector_type(2)));
__device__ __forceinline__ f32x2 gelu_pk(f32x2 v) {
    const f32x2 av = __builtin_elementwise_abs(v), d = av * 0.2316418882f + 1.0f;
    f32x2 t; t.x = __builtin_amdgcn_rcpf(d.x); t.y = __builtin_amdgcn_rcpf(d.y);
    f32x2 q = t * 0.5307027145f + (-0.7265760135f); q = q * t + 0.7107068705f; q = q * t + (-0.142248368f); q = q * t + 0.127414796f; q = q * t;
    const f32x2 s = (v * v) * (-0.72134752044f);
    f32x2 e; e.x = __builtin_amdgcn_exp2f(s.x); e.y = __builtin_amdgcn_exp2f(s.y);
    const f32x2 m = v * (q * e), r = v - m;
    f32x2 o; o.x = v.x < 0.f ? m.x : r.x; o.y = v.y < 0.f ? m.y : r.y; return o;
}

template <class Epi, class Sched, bool ALIGN_EPI = false, bool SP2 = false>
__device__ __forceinline__ void gemm_phase(PG8_LAS unsigned char* lds, const Gemm g, const Sched& S, const Epi& E) {
    const int tid = threadIdx.x, wid = __builtin_amdgcn_readfirstlane(tid >> 6), lane = tid & 63, wr = wid >> 2, wc = wid & 3, fr = lane & 15, fq = lane >> 4;
    const int K = g.K, nt = K / BK;
    unsigned voffA[2], voffB[2];
#pragma unroll
    for (int i = 0; i < 2; ++i) { int R, C; stage_rc(tid * 16 + i * 8192, R, C); const int Rb = Epi::PERM ? ((R & ~31) + perm32(R & 31)) : R;
        voffA[i] = (unsigned)(R * K + C) * 2u; voffB[i] = (unsigned)(Rb * K + C) * 2u; }
    const size_t kstep = (size_t)(BK * 2);
    const size_t hstep = (size_t)HALF * K * 2;
    const size_t tstep = 2 * hstep;
    const unsigned ldsw = (unsigned)wid * 1024u;
    const int aoff = lds_byte(wr * 64 + fr, fq * 8), boff = lds_byte(wc * 32 + fr, fq * 8);
#define PG8_SA(b, h) (((b) * 2 + (h)) * HTB)
#define PG8_SB(b, h) ((4 + (b) * 2 + (h)) * HTB)
#define PG8_STAGE(bufoff, gbase, voff) do { _Pragma("unroll") for (int _i = 0; _i < 2; ++_i) \
        __builtin_amdgcn_global_load_lds((const unsigned*)((const char*)(gbase) + (voff)[_i]), (PG8_LAS unsigned*)(lds + (bufoff) + ldsw + _i * 8192), 16, 0, 0); } while (0)
#define PG8_LDA(dst, b, h) do { _Pragma("unroll") for (int m = 0; m < 4; ++m) _Pragma("unroll") for (int k = 0; k < 2; ++k) dst[m][k] = *(const PG8_LAS bf16x8*)(lds + PG8_SA(b, h) + aoff + m * 2048 + k * 1024); } while (0)
#define PG8_LDB(dst, b, h) do { _Pragma("unroll") for (int n = 0; n < 2; ++n) _Pragma("unroll") for (int k = 0; k < 2; ++k) dst[n][k] = *(const PG8_LAS bf16x8*)(lds + PG8_SB(b, h) + boff + n * 2048 + k * 1024); } while (0)
#define PG8_MMA(ai, bj, At, Bt) do { __builtin_amdgcn_s_setprio(1); _Pragma("unroll") for (int m = 0; m < 4; ++m) _Pragma("unroll") for (int n = 0; n < 2; ++n) _Pragma("unroll") for (int k = 0; k < 2; ++k) \
        acc[ai][bj][m][n] = __builtin_amdgcn_mfma_f32_16x16x32_bf16(Bt[n][k], At[m][k], acc[ai][bj][m][n], 0, 0, 0); __builtin_amdgcn_s_setprio(0); } while (0)
#define PG8_WAIT_V(n) asm volatile("s_waitcnt vmcnt(" #n ")" ::: "memory")
#define PG8_WAIT_L(n) asm volatile("s_waitcnt lgkmcnt(" #n ")" ::: "memory")
#define PG8_BAR __builtin_amdgcn_s_barrier()
#define PG8_SCHED __builtin_amdgcn_sched_barrier(0)
    Unit cur, nxt; int ui = 0;
    if (!S.next(0, cur)) return;
    f32x4 acc[2][2][4][2];
#pragma unroll
    for (int a = 0; a < 2; ++a)
#pragma unroll
        for (int b = 0; b < 2; ++b)
#pragma unroll
            for (int m = 0; m < 4; ++m)
#pragma unroll
                for (int n = 0; n < 2; ++n) acc[a][b][m][n] = (f32x4){0.f, 0.f, 0.f, 0.f};
    bf16x8 At[4][2], B0[2][2], B1[2][2];
    const char* cA = (const char*)g.A + (size_t)cur.pm * tstep; const char* cB = (const char*)g.Bt + (size_t)cur.pn * tstep;
    S.a_ready(cur);
    if constexpr (SP2) {
        PG8_STAGE(PG8_SB(0, 0), cB, voffB); PG8_STAGE(PG8_SB(0, 1), cB + hstep, voffB); PG8_STAGE(PG8_SA(0, 0), cA, voffA); PG8_STAGE(PG8_SA(0, 1), cA + hstep, voffA);
        if (wr == 1) PG8_BAR;
        PG8_WAIT_V(2); PG8_BAR;
        PG8_STAGE(PG8_SB(1, 0), cB + kstep, voffB); PG8_STAGE(PG8_SA(1, 0), cA + kstep, voffA); PG8_STAGE(PG8_SB(1, 1), cB + hstep + kstep, voffB);
        PG8_WAIT_V(6); PG8_BAR;
    } else {
        PG8_STAGE(PG8_SB(0, 0), cB, voffB); PG8_STAGE(PG8_SA(0, 0), cA, voffA); PG8_STAGE(PG8_SB(0, 1), cB + hstep, voffB); PG8_STAGE(PG8_SA(0, 1), cA + hstep, voffA);
        if (wr == 1) PG8_BAR;
        PG8_WAIT_V(4); PG8_BAR;
        PG8_STAGE(PG8_SB(1, 0), cB + kstep, voffB); PG8_STAGE(PG8_SA(1, 0), cA + kstep, voffA); PG8_STAGE(PG8_SB(1, 1), cB + hstep + kstep, voffB);
        PG8_WAIT_V(6); PG8_BAR;
    }
    for (;;) {
        const bool has_next = S.next(ui + 1, nxt);
        const char* nA = has_next ? (const char*)g.A + (size_t)nxt.pm * tstep : cA; const char* nB = has_next ? (const char*)g.Bt + (size_t)nxt.pn * tstep : cB;
        for (int t = 0; t < nt; t += 2) {
            const bool last = (t == nt - 2);
            const char* a1 = cA + (size_t)(t + 1) * kstep;
            const char* a2 = last ? nA : cA + (size_t)(t + 2) * kstep; const char* b2 = last ? nB : cB + (size_t)(t + 2) * kstep;
            const char* a3 = a2 + kstep; const char* b3 = b2 + kstep;
            if (last && has_next) S.a_ready(nxt);
            if constexpr (SP2) {
            PG8_LDB(B0, 0, 0); PG8_LDB(B1, 0, 1); PG8_SCHED; PG8_LDA(At, 0, 0); PG8_STAGE(PG8_SA(1, 1), a1 + hstep, voffA);
            PG8_WAIT_V(8); PG8_WAIT_L(0); PG8_BAR; PG8_MMA(0, 0, At, B0); PG8_MMA(0, 1, At, B1); PG8_BAR; PG8_SCHED;
            PG8_LDA(At, 0, 1); PG8_STAGE(PG8_SB(0, 0), b2, voffB); PG8_STAGE(PG8_SB(0, 1), b2 + hstep, voffB); PG8_STAGE(PG8_SA(0, 0), a2, voffA);
            PG8_WAIT_V(8); PG8_WAIT_L(0); PG8_BAR; PG8_MMA(1, 0, At, B0); PG8_MMA(1, 1, At, B1); PG8_BAR; PG8_SCHED;
            PG8_LDB(B0, 1, 0); PG8_LDB(B1, 1, 1); PG8_SCHED; PG8_LDA(At, 1, 0); PG8_STAGE(PG8_SA(0, 1), a2 + hstep, voffA);
            PG8_WAIT_V(8); PG8_WAIT_L(0); PG8_BAR; PG8_MMA(0, 0, At, B0); PG8_MMA(0, 1, At, B1); PG8_BAR; PG8_SCHED;
            PG8_LDA(At, 1, 1); PG8_STAGE(PG8_SB(1, 0), b3, voffB); PG8_STAGE(PG8_SB(1, 1), b3 + hstep, voffB); PG8_STAGE(PG8_SA(1, 0), a3, voffA);
            PG8_WAIT_V(8); PG8_WAIT_L(0); PG8_BAR; PG8_MMA(1, 0, At, B0); PG8_MMA(1, 1, At, B1); PG8_BAR; PG8_SCHED;
            } else {
            PG8_LDB(B0, 0, 0); PG8_SCHED; PG8_LDA(At, 0, 0); PG8_STAGE(PG8_SA(1, 1), a1 + hstep, voffA);
            PG8_WAIT_L(8); PG8_BAR; PG8_WAIT_L(0); PG8_MMA(0, 0, At, B0); PG8_BAR; PG8_SCHED;
            PG8_LDB(B1, 0, 1); PG8_STAGE(PG8_SB(0, 0), b2, voffB);
            PG8_BAR; PG8_WAIT_L(0); PG8_MMA(0, 1, At, B1); PG8_BAR;
            PG8_LDA(At, 0, 1); PG8_STAGE(PG8_SA(0, 0), a2, voffA);
            PG8_BAR; PG8_WAIT_L(0); PG8_MMA(1, 0, At, B0); PG8_BAR; PG8_SCHED;
            PG8_STAGE(PG8_SB(0, 1), b2 + hstep, voffB);
            PG8_WAIT_V(6); PG8_BAR; PG8_MMA(1, 1, At, B1); PG8_BAR;
            PG8_LDB(B0, 1, 0); PG8_SCHED; PG8_LDA(At, 1, 0); PG8_STAGE(PG8_SA(0, 1), a2 + hstep, voffA);
            PG8_WAIT_L(8); PG8_BAR; PG8_WAIT_L(0); PG8_MMA(0, 0, At, B0); PG8_BAR; PG8_SCHED;
            PG8_LDB(B1, 1, 1); PG8_STAGE(PG8_SB(1, 0), b3, voffB);
            PG8_BAR; PG8_WAIT_L(0); PG8_MMA(0, 1, At, B1); PG8_BAR;
            PG8_LDA(At, 1, 1); PG8_STAGE(PG8_SA(1, 0), a3, voffA);
            PG8_BAR; PG8_WAIT_L(0); PG8_MMA(1, 0, At, B0); PG8_BAR; PG8_SCHED;
            PG8_STAGE(PG8_SB(1, 1), b3 + hstep, voffB);
            PG8_WAIT_V(6); PG8_BAR; PG8_MMA(1, 1, At, B1); PG8_BAR;
            }
        }
        if constexpr (ALIGN_EPI) { if (wr == 0) PG8_BAR; }
        if constexpr (!Epi::AFTER_DRAIN) { E(acc, cur, wr, wc, fr, fq); S.done(cur); }
        if (!has_next) break;
#pragma unroll
        for (int a = 0; a < 2; ++a)
#pragma unroll
            for (int b = 0; b < 2; ++b)
#pragma unroll
                for (int m = 0; m < 4; ++m)
#pragma unroll
                    for (int n = 0; n < 2; ++n) acc[a][b][m][n] = (f32x4){0.f, 0.f, 0.f, 0.f};
        cur = nxt; cA = nA; cB = nB; ++ui;
        if constexpr (ALIGN_EPI) { if (wr == 1) PG8_BAR; }
    }
    PG8_WAIT_V(0);
    if constexpr (!ALIGN_EPI) { if (wr == 0) PG8_BAR; }
    PG8_BAR;
    if constexpr (Epi::AFTER_DRAIN) { E.fused(acc, cur, wr, wc, fr, fq, lds, wid, lane); S.done(cur); }
#undef PG8_SA
#undef PG8_SB
#undef PG8_STAGE
#undef PG8_LDA
#undef PG8_LDB
#undef PG8_MMA
#undef PG8_WAIT_V
#undef PG8_WAIT_L
#undef PG8_BAR
#undef PG8_SCHED
}

struct EpiProj {
    static constexpr bool PERM = true, AFTER_DRAIN = false;
    bf16_t* q; bf16_t* k; bf16_t* v; bf16_t* us; bf16_t* vs; const int* pos;
    __device__ __forceinline__ void operator()(const f32x4 (&acc)[2][2][4][2], const Unit& u, int wr, int wc, int fr, int fq) const {
        const int row0 = u.pm * BM + wr * 64 + fr, b = u.pm >> 4;
        if (u.pn < 12) {
            const bool isq = u.pn < 6; bf16_t* base = isq ? q : k;
            const int hh = 2 * (isq ? u.pn : u.pn - 6) + (wc >> 1), e0 = 32 * (wc & 1) + 8 * fq;
            const float qs = isq ? 0.08838834764831845f : 1.0f;
            float ir[8];
#pragma unroll
            for (int j = 0; j < 8; ++j) ir[j] = exp2f(-(float)(e0 + j) * (13.287712379549449f / 64.0f)) * 0.15915494309189535f;
#pragma unroll
            for (int ai = 0; ai < 2; ++ai)
#pragma unroll
                for (int m = 0; m < 4; ++m) {
                    const int t = row0 + ai * HALF + m * 16, s = t & 4095;
                    const float pf = (float)pos[t];
                    float o0[8], o1[8];
#pragma unroll
                    for (int n = 0; n < 2; ++n)
#pragma unroll
                        for (int i = 0; i < 4; ++i) { const int j = 4 * n + i;
                            const float f = __builtin_amdgcn_fractf(pf * ir[j]); const float sn = __builtin_amdgcn_sinf(f), cs = __builtin_amdgcn_cosf(f);
                            const float t1 = acc[ai][0][m][n][i], t2 = acc[ai][1][m][n][i];
                            o0[j] = (t1 * cs - t2 * sn) * qs; o1[j] = (t2 * cs + t1 * sn) * qs; }
                    bf16_t* dst = base + ((size_t)(b * 12 + hh) * 4096 + s) * 128 + e0;
                    u32x4 w0, w1;
                    w0.x = cvt_pk_bf16(o0[0], o0[1]); w0.y = cvt_pk_bf16(o0[2], o0[3]); w0.z = cvt_pk_bf16(o0[4], o0[5]); w0.w = cvt_pk_bf16(o0[6], o0[7]);
                    w1.x = cvt_pk_bf16(o1[0], o1[1]); w1.y = cvt_pk_bf16(o1[2], o1[3]); w1.z = cvt_pk_bf16(o1[4], o1[5]); w1.w = cvt_pk_bf16(o1[6], o1[7]);
                    *(u32x4*)dst = w0; *(u32x4*)(dst + 64) = w1; }
        } else if (u.pn < 18) {
            const int e0 = 32 * wc + 8 * fq;
#pragma unroll
            for (int ai = 0; ai < 2; ++ai)
#pragma unroll
                for (int m = 0; m < 4; ++m) { const int t = row0 + ai * HALF + m * 16, s = t & 4095;
#pragma unroll
                    for (int bj = 0; bj < 2; ++bj) { const int hh = 2 * (u.pn - 12) + bj; const f32x4 v0 = acc[ai][bj][m][0], v1 = acc[ai][bj][m][1];
                        u32x4 w; w.x = cvt_pk_bf16(v0[0], v0[1]); w.y = cvt_pk_bf16(v0[2], v0[3]); w.z = cvt_pk_bf16(v1[0], v1[1]); w.w = cvt_pk_bf16(v1[2], v1[3]);
                        *(u32x4*)(v + ((size_t)(b * 12 + hh) * 4096 + s) * 128 + e0) = w; } }
        } else {
            bf16_t* base = u.pn < 20 ? us : vs; const int c0 = 256 * ((u.pn - 18) & 1) + 32 * wc + 8 * fq;
#pragma unroll
            for (int ai = 0; ai < 2; ++ai)
#pragma unroll
                for (int m = 0; m < 4; ++m) { const int t = row0 + ai * HALF + m * 16;
#pragma unroll
                    for (int bj = 0; bj < 2; ++bj) { const f32x4 v0 = acc[ai][bj][m][0], v1 = acc[ai][bj][m][1];
                        const f32x2 a = gelu_pk((f32x2){v0[0], v0[1]}), bb = gelu_pk((f32x2){v0[2], v0[3]}), c = gelu_pk((f32x2){v1[0], v1[1]}), d = gelu_pk((f32x2){v1[2], v1[3]});
                        u32x4 w; w.x = cvt_pk_bf16(a.x, a.y); w.y = cvt_pk_bf16(bb.x, bb.y); w.z = cvt_pk_bf16(c.x, c.y); w.w = cvt_pk_bf16(d.x, d.y);
                        *(u32x4*)(base + (size_t)t * 512 + c0 + 128 * bj) = w; } }
        }
    }
};
struct EpiRes {
    static constexpr bool PERM = false, AFTER_DRAIN = false;
    const float* x; float* out; const long long* modq;
    __device__ __forceinline__ void operator()(const f32x4 (&acc)[2][2][4][2], const Unit& u, int wr, int wc, int fr, int fq) const {
        const int row0 = u.pm * BM + wr * 64 + fr, col0 = u.pn * BM + wc * 32 + 4 * fq, b = u.pm >> 4;
        f32x4 gt[2][2];
#pragma unroll
        for (int bj = 0; bj < 2; ++bj)
#pragma unroll
            for (int n = 0; n < 2; ++n) { const long long* mp = modq + b * 12288 + 2 * 2048 + col0 + bj * HALF + n * 16;
#pragma unroll
                for (int i = 0; i < 4; ++i) gt[bj][n][i] = (float)(int)(mp[i] >> 32) + (float)(unsigned)mp[i] * 2.3283064365386963e-10f; }
#pragma unroll
        for (int ai = 0; ai < 2; ++ai)
#pragma unroll
            for (int m = 0; m < 4; ++m) { const size_t off = (size_t)(row0 + ai * HALF + m * 16) * 2048 + col0;
#pragma unroll
                for (int bj = 0; bj < 2; ++bj)
#pragma unroll
                    for (int n = 0; n < 2; ++n) { const f32x4 xv = *(const f32x4*)(x + off + bj * HALF + n * 16); *(f32x4*)(out + off + bj * HALF + n * 16) = xv + gt[bj][n] * acc[ai][bj][m][n]; } }
    }
};
struct EpiPq {
    static constexpr bool PERM = true, AFTER_DRAIN = false;
    bf16_t* o;
    __device__ __forceinline__ void operator()(const f32x4 (&acc)[2][2][4][2], const Unit& u, int wr, int wc, int fr, int fq) const {
        const int row0 = u.pm * BM + wr * 64 + fr, col0 = u.pn * BM + wc * 32 + 8 * fq;
#pragma unroll
        for (int ai = 0; ai < 2; ++ai)
#pragma unroll
            for (int m = 0; m < 4; ++m) { bf16_t* rowp = o + (size_t)(row0 + ai * HALF + m * 16) * 2048 + col0;
#pragma unroll
                for (int bj = 0; bj < 2; ++bj) { const f32x4 v0 = acc[ai][bj][m][0], v1 = acc[ai][bj][m][1];
                    u32x4 w; w.x = cvt_pk_bf16(v0[0], v0[1]); w.y = cvt_pk_bf16(v0[2], v0[3]); w.z = cvt_pk_bf16(v1[0], v1[1]); w.w = cvt_pk_bf16(v1[2], v1[3]);
                    *(u32x4*)(rowp + bj * HALF) = w; } }
    }
};
}

__device__ __forceinline__ void phase_gemm1(const Params& p, unsigned char* lds) {
    pg8::Gemm g{(const bf16_t*)(p.ws + OFF_A), (const bf16_t*)(p.ws + OFF_WIN), T, DIN, D};
    pg8::StaticOrder So; So.init(T, DIN, (int)gridDim.x, (int)blockIdx.x);
    pg8::EpiProj Ep{(bf16_t*)(p.ws + OFF_QKV), (bf16_t*)(p.ws + OFF_QKV + QKV_ONE), (bf16_t*)(p.ws + OFF_QKV + 2 * QKV_ONE), (bf16_t*)(p.ws + OFF_US), (bf16_t*)(p.ws + OFF_VS), p.pos};
    pg8::gemm_phase<pg8::EpiProj, pg8::StaticOrder, true, true>((PG8_LAS unsigned char*)lds, g, So, Ep);
}
__device__ __forceinline__ void phase_gemm2(const Params& p, unsigned char* lds) {
    pg8::Gemm g{(const bf16_t*)(p.ws + OFF_QKV), (const bf16_t*)(p.ws + OFF_WOUT), T, D, D};
    pg8::StaticOrder So; So.init(T, D, (int)gridDim.x, (int)blockIdx.x);
    pg8::EpiRes Ep{p.x, p.out, (const long long*)(p.ws + OFF_MOD)};
    pg8::gemm_phase<pg8::EpiRes, pg8::StaticOrder, true, true>((PG8_LAS unsigned char*)lds, g, So, Ep);
}
__device__ __forceinline__ void phase_gemm3(const Params& p, unsigned char* lds) {
    pg8::Gemm g{(const bf16_t*)(p.ws + OFF_A), (const bf16_t*)(p.ws + OFF_WQ), T, D, D};
    pg8::StaticOrder So; So.init(T, D, (int)gridDim.x, (int)blockIdx.x);
    pg8::EpiPq Ep{(bf16_t*)(p.ws + OFF_QKV + (size_t)T * D * 2)};
    pg8::gemm_phase<pg8::EpiPq, pg8::StaticOrder, true, true>((PG8_LAS unsigned char*)lds, g, So, Ep);
}

__device__ __forceinline__ void conv_transpose(const float* __restrict__ W, int N, bf16_t* __restrict__ WT, int perm_limit, float* tile, int bid, int nblk, int tid) {
    const int ntiles = 32 * (N / 64);
    for (int tI = bid; tI < ntiles; tI += nblk) {
        const int tk = tI & 31, tn = tI >> 5, k0 = tk * 64, n0 = tn * 64;
        int l0 = n0;
        if (n0 < perm_limit) { const int base = n0 & ~255, pb = (n0 >> 6) & 3, bj = pb >> 1, qhi = pb & 1; l0 = base + 64 * bj + 128 * qhi; }
        __syncthreads();
#pragma unroll
        for (int pass = 0; pass < 2; ++pass) { const int r = pass * 32 + (tid >> 4), c4 = (tid & 15) * 4;
            const float4 v = *(const float4*)(W + (size_t)(k0 + r) * N + l0 + c4);
            tile[r * 65 + c4 + 0] = v.x; tile[r * 65 + c4 + 1] = v.y; tile[r * 65 + c4 + 2] = v.z; tile[r * 65 + c4 + 3] = v.w; }
        __syncthreads();
        const int n = tid >> 3, kq = (tid & 7) * 8;
        u32x4 w;
        w.x = pack2(tile[(kq + 0) * 65 + n], tile[(kq + 1) * 65 + n]); w.y = pack2(tile[(kq + 2) * 65 + n], tile[(kq + 3) * 65 + n]);
        w.z = pack2(tile[(kq + 4) * 65 + n], tile[(kq + 5) * 65 + n]); w.w = pack2(tile[(kq + 6) * 65 + n], tile[(kq + 7) * 65 + n]);
        *(u32x4*)(WT + (size_t)(n0 + n) * D + k0 + kq) = w;
    }
}
__device__ __forceinline__ void conv_flat(const float* __restrict__ src, bf16_t* __restrict__ dst, size_t n8, int bid, int nblk, int tid) {
    for (size_t i = (size_t)bid * NTHR + tid; i < n8; i += (size_t)nblk * NTHR) {
        const float4 a = ((const float4*)src)[2 * i], b = ((const float4*)src)[2 * i + 1];
        u32x4 w; w.x = pack2(a.x, a.y); w.y = pack2(a.z, a.w); w.z = pack2(b.x, b.y); w.w = pack2(b.z, b.w);
        ((u32x4*)dst)[i] = w; }
}
__device__ __forceinline__ void conv_rows_fp8(const float* __restrict__ src, unsigned char* __restrict__ dst, float* __restrict__ inv, int bid, int nblk, int tid) {
    const int lane = tid & 63, gw = bid * NWV + (tid >> 6), nw = nblk * NWV;
    for (int r = gw; r < NEXP; r += nw) {
        const float4* row = (const float4*)(src + (size_t)r * D);
        float4 v[8]; float m = 0.f;
#pragma unroll
        for (int i = 0; i < 8; ++i) { v[i] = row[i * 64 + lane]; m = fmaxf(m, fmaxf(fmaxf(fabsf(v[i].x), fabsf(v[i].y)), fmaxf(fabsf(v[i].z), fabsf(v[i].w)))); }
        m = wave_max(m);
        const int ex = (int)((__float_as_uint(m) >> 23) & 255u) - 126;
        const int k = (m > 0.f) ? max(-100, min(100, 8 - ex)) : 0;
        const float sc = __uint_as_float((unsigned)(127 + k) << 23), isc = __uint_as_float((unsigned)(127 - k) << 23);
        unsigned char* drow = dst + (size_t)(lane >> 5) * SLICE_BYTES + (size_t)r * 128 + (lane & 31) * 4;
#pragma unroll
        for (int i = 0; i < 8; ++i) { int w = __builtin_amdgcn_cvt_pk_fp8_f32(v[i].x * sc, v[i].y * sc, 0, false); w = __builtin_amdgcn_cvt_pk_fp8_f32(v[i].z * sc, v[i].w * sc, w, true); *(unsigned*)(drow + (size_t)(2 * i) * SLICE_BYTES) = (unsigned)w; }
        if (lane == 0) inv[r] = isc;
    }
}
__device__ __forceinline__ void phase_conv(const Params& p, unsigned char* lds, bool dup = false) {
    const int tid = threadIdx.x, bid = blockIdx.x, nblk = gridDim.x;
    unsigned long long* mod = (unsigned long long*)(p.ws + OFF_MOD);
    for (int it = bid; it < (dup ? 0 : 768); it += nblk) {
        const int cb = it % 6, kc = it / 6, col = cb * 2048 + tid * 4;
        float acc[4][4];
#pragma unroll
        for (int b = 0; b < 4; ++b) { acc[b][0] = 0.f; acc[b][1] = 0.f; acc[b][2] = 0.f; acc[b][3] = 0.f; }
        for (int kk = 0; kk < 16; ++kk) { const int k = kc * 16 + kk;
            const float4 w = *(const float4*)(p.w_ada + (size_t)k * 12288 + col);
#pragma unroll
            for (int b = 0; b < 4; ++b) { const float cv = p.c[b * D + k]; const float s = cv / (1.f + __expf(-cv));
                acc[b][0] += s * w.x; acc[b][1] += s * w.y; acc[b][2] += s * w.z; acc[b][3] += s * w.w; } }
        if (kc == 0) { const float4 bv = *(const float4*)(p.b_ada + col);
#pragma unroll
            for (int b = 0; b < 4; ++b) { acc[b][0] += bv.x; acc[b][1] += bv.y; acc[b][2] += bv.z; acc[b][3] += bv.w; } }
#pragma unroll
        for (int b = 0; b < 4; ++b)
#pragma unroll
            for (int j = 0; j < 4; ++j) atomicAdd(mod + b * 12288 + col + j, (unsigned long long)__double2ll_rn((double)acc[b][j] * 4294967296.0));
    }
    conv_transpose(p.w_in, DIN, (bf16_t*)(p.ws + OFF_WIN), 3072, (float*)lds, bid, nblk, tid);
    conv_transpose(p.w_out, D, (bf16_t*)(p.ws + OFF_WOUT), 0, (float*)lds, bid, nblk, tid);
    conv_transpose(p.peer_w_q, D, (bf16_t*)(p.ws + OFF_WQ), 0, (float*)lds, bid, nblk, tid);
    conv_rows_fp8(p.peer_u, p.ws + OFF_UTAB, (float*)(p.ws + OFF_UTAB + TAB8_BYTES), bid, nblk, tid);
    conv_rows_fp8(p.peer_v, p.ws + OFF_VTAB, (float*)(p.ws + OFF_VTAB + TAB8_BYTES), bid, nblk, tid);
    conv_flat(p.peer_sub_keys, (bf16_t*)(p.ws + OFF_SUBK), (size_t)8 * 2 * 128 * 128 / 8, bid, nblk, tid);
    { bf16_t* sw = (bf16_t*)(p.ws + OFF_SGUW);
      for (int i = bid * NTHR + tid; i < 4 * 128 * 128; i += nblk * NTHR) { const int jj = i & 127, ii = (i >> 7) & 127; sw[i] = f2bf(jj <= ii ? p.sgu_w[i] : 0.f); } }
}

__device__ __forceinline__ void phase_norm_mod(const Params& p, const float* __restrict__ src, const float* __restrict__ g, int sh_i, int sc_i, bf16_t* __restrict__ dst) {
    const int lane = threadIdx.x & 63, gw = blockIdx.x * NWV + (threadIdx.x >> 6), nw = gridDim.x * NWV;
    for (int t = gw; t < T; t += nw) {
        const float* row = src + (size_t)t * D; const int b = t / S;
        float4 v[8]; float ss = 0.f;
#pragma unroll
        for (int i = 0; i < 8; ++i) { v[i] = *(const float4*)(row + i * 256 + lane * 4); ss += v[i].x * v[i].x + v[i].y * v[i].y + v[i].z * v[i].z + v[i].w * v[i].w; }
        ss = wave_sum(ss); const float rstd = rsqrtf(ss * (1.0f / D) + 1e-6f);
#pragma unroll
        for (int i = 0; i < 8; ++i) { const int col = i * 256 + lane * 4;
            const float4 gg = *(const float4*)(g + col), sc = mod4(p, b, sc_i, col), sh = mod4(p, b, sh_i, col);
            u32x2 w; w.x = pack2(v[i].x * rstd * gg.x * (1.f + sc.x) + sh.x, v[i].y * rstd * gg.y * (1.f + sc.y) + sh.y);
            w.y = pack2(v[i].z * rstd * gg.z * (1.f + sc.z) + sh.z, v[i].w * rstd * gg.w * (1.f + sc.w) + sh.w);
            *(u32x2*)(dst + (size_t)t * D + col) = w; }
    }
}

#define NAIVE_GEMM_BODY(A_, W_, N_, r0_, c0_)                                                                 \
    float acc[16];                                                                                            \
    _Pragma("unroll") for (int r = 0; r < 16; ++r) acc[r] = 0.f;                                              \
    __syncthreads();                                                                                          \
    { const u32x4* srcA = (const u32x4*)((A_) + (size_t)(r0_) * D); u32x4* dstA = (u32x4*)lds;                  \
      for (int i = tid; i < 16 * D / 8; i += NTHR) dstA[i] = srcA[i]; }                                       \
    __syncthreads();                                                                                          \
    { const unsigned* la = (const unsigned*)lds;                                                              \
      for (int k2 = 0; k2 < D / 2; ++k2) {                                                                    \
          const float w0 = (W_)[(size_t)(2 * k2) * (N_) + (c0_) + tid], w1 = (W_)[(size_t)(2 * k2 + 1) * (N_) + (c0_) + tid]; \
          _Pragma("unroll") for (int r = 0; r < 16; ++r) { const unsigned a = la[r * (D / 2) + k2]; acc[r] += bflo(a) * w0 + bfhi(a) * w1; } } }

__device__ __forceinline__ void phase_gemm1_naive(const Params& p, unsigned char* lds) {
    const int tid = threadIdx.x;
    const bf16_t* A = (const bf16_t*)(p.ws + OFF_A);
    float* xch = (float*)(lds + 65536);
    bf16_t* qb = (bf16_t*)(p.ws + OFF_QKV); bf16_t* kb = (bf16_t*)(p.ws + OFF_QKV + QKV_ONE); bf16_t* vb = (bf16_t*)(p.ws + OFF_QKV + 2 * QKV_ONE);
    bf16_t* usb = (bf16_t*)(p.ws + OFF_US); bf16_t* vsb = (bf16_t*)(p.ws + OFF_VS);
    const int nitems = (T / 16) * (DIN / 512);
    for (int it = blockIdx.x; it < nitems; it += gridDim.x) {
        const int cbk = it % (DIN / 512), rb = it / (DIN / 512), r0 = rb * 16, c0 = cbk * 512;
        NAIVE_GEMM_BODY(A, p.w_in, DIN, r0, c0)
        const int n = c0 + tid;
        if (n < 3072) {
#pragma unroll
            for (int r = 0; r < 16; ++r) xch[r * 512 + tid] = acc[r];
            __syncthreads();
            const int e = n & 127, hh = (n % DA) >> 7; const bool isq = n < DA;
            const int i = e & 63; const float inv = powf(10000.0f, -(float)i / 64.0f);
#pragma unroll
            for (int r = 0; r < 16; ++r) { const int t = r0 + r, b = t / S, s = t % S;
                const float ang = (float)p.pos[t] * inv; const float cs = cosf(ang), sn = sinf(ang);
                const float other = xch[r * 512 + (tid ^ 64)];
                float val = (e < 64) ? (acc[r] * cs - other * sn) : (acc[r] * cs + other * sn);
                if (isq) val *= 0.08838834764831845f;
                (isq ? qb : kb)[((size_t)(b * HA + hh) * S + s) * E + e] = f2bf(val); }
        } else if (n < 4608) {
            const int e = n & 127, hh = (n - 3072) >> 7;
#pragma unroll
            for (int r = 0; r < 16; ++r) { const int t = r0 + r, b = t / S, s = t % S; vb[((size_t)(b * HA + hh) * S + s) * E + e] = f2bf(acc[r]); }
        } else if (n < 5120) {
#pragma unroll
            for (int r = 0; r < 16; ++r) usb[(size_t)(r0 + r) * DS + (n - 4608)] = f2bf(gelu_erf(acc[r]));
        } else {
#pragma unroll
            for (int r = 0; r < 16; ++r) vsb[(size_t)(r0 + r) * DS + (n - 5120)] = f2bf(gelu_erf(acc[r]));
        }
    }
}
__device__ __forceinline__ void phase_gemm2_naive(const Params& p, unsigned char* lds) {
    const int tid = threadIdx.x;
    const bf16_t* A = (const bf16_t*)(p.ws + OFF_QKV);
    const int nitems = (T / 16) * (D / 512);
    for (int it = blockIdx.x; it < nitems; it += gridDim.x) {
        const int cbk = it % (D / 512), rb = it / (D / 512), r0 = rb * 16, c0 = cbk * 512;
        NAIVE_GEMM_BODY(A, p.w_out, D, r0, c0)
        const int n = c0 + tid;
#pragma unroll
        for (int r = 0; r < 16; ++r) { const int t = r0 + r, b = t / S; p.out[(size_t)t * D + n] = p.x[(size_t)t * D + n] + mod1(p, b, 2, n) * acc[r]; }
    }
}
__device__ __forceinline__ void phase_gemm3_naive(const Params& p, unsigned char* lds) {
    const int tid = threadIdx.x;
    const bf16_t* A = (const bf16_t*)(p.ws + OFF_A);
    bf16_t* pq = (bf16_t*)(p.ws + OFF_QKV + (size_t)T * D * 2);
    const int nitems = (T / 16) * (D / 512);
    for (int it = blockIdx.x; it < nitems; it += gridDim.x) {
        const int cbk = it % (D / 512), rb = it / (D / 512), r0 = rb * 16, c0 = cbk * 512;
        NAIVE_GEMM_BODY(A, p.peer_w_q, D, r0, c0)
        const int n = c0 + tid;
#pragma unroll
        for (int r = 0; r < 16; ++r) pq[(size_t)(r0 + r) * D + n] = f2bf(acc[r]);
    }
}

__device__ __forceinline__ void phase_attn_naive(const Params& p, unsigned char* lds) {
    const int lane = threadIdx.x & 63, wave = threadIdx.x >> 6, gw = blockIdx.x * NWV + wave, nw = gridDim.x * NWV;
    float* ql = (float*)lds + wave * 128;
    const bf16_t* qb = (const bf16_t*)(p.ws + OFF_QKV); const bf16_t* kb = (const bf16_t*)(p.ws + OFF_QKV + QKV_ONE); const bf16_t* vb = (const bf16_t*)(p.ws + OFF_QKV + 2 * QKV_ONE);
    float* lse = (float*)(p.ws + OFF_LSE);
    for (int item = gw; item < NB * HA * S; item += nw) {
        const int t = item % S, h = (item / S) % HA, b = item / (S * HA);
        const size_t hb = (size_t)(b * HA + h) * S;
        { const unsigned w = *(const unsigned*)(qb + (hb + t) * E + 2 * lane); ql[2 * lane] = bflo(w); ql[2 * lane + 1] = bfhi(w); }
        __builtin_amdgcn_wave_barrier();
#pragma unroll 1
        for (int pat = 0; pat < 3; ++pat) {
            const int d = pat == 0 ? 1 : (pat == 1 ? 4 : 16);
            const int imax = min(128, t / d);
            float sc[3];
#pragma unroll
            for (int sl = 0; sl < 3; ++sl) { const int i = sl * 64 + lane; float s = -__builtin_inff();
                if (i <= imax) { const u32x4* kr = (const u32x4*)(kb + (hb + (t - i * d)) * E); s = 0.f;
                    for (int c8 = 0; c8 < 16; ++c8) { const u32x4 kk = kr[c8]; const float* qq = ql + c8 * 8;
                        s += qq[0] * bflo(kk.x) + qq[1] * bfhi(kk.x) + qq[2] * bflo(kk.y) + qq[3] * bfhi(kk.y) + qq[4] * bflo(kk.z) + qq[5] * bfhi(kk.z) + qq[6] * bflo(kk.w) + qq[7] * bfhi(kk.w); } }
                sc[sl] = s; }
            const float m = wave_max(fmaxf(sc[0], fmaxf(sc[1], sc[2])));
            float pr[3]; float l = 0.f;
#pragma unroll
            for (int sl = 0; sl < 3; ++sl) { pr[sl] = __expf(sc[sl] - m); l += pr[sl]; }
            l = wave_sum(l);
            float o0 = 0.f, o1 = 0.f;
            for (int i = 0; i <= imax; ++i) { const float pv = __shfl(i < 64 ? pr[0] : (i < 128 ? pr[1] : pr[2]), i & 63);
                const unsigned w = *(const unsigned*)(vb + (hb + (t - i * d)) * E + 2 * lane); o0 += pv * bflo(w); o1 += pv * bfhi(w); }
            const float il = 1.0f / l; const size_t tg = (size_t)b * S + t;
            *(unsigned*)(P_opat(p, pat) + tg * DA + h * E + 2 * lane) = pack2(o0 * il, o1 * il);
            if (lane == 0) lse[((size_t)pat * T + tg) * HA + h] = m + __logf(l);
        }
        __builtin_amdgcn_wave_barrier();
    }
}

#define LAS __attribute__((address_space(3)))
typedef short bf16x8 __attribute__((ext_vector_type(8)));
typedef short s16x4 __attribute__((ext_vector_type(4)));
constexpr int ATT_VOFF = 65536, ATT_VSTRIDE = 288;
__device__ __forceinline__ unsigned cvt_pk(float lo, float hi) { unsigned r; asm volatile("v_cvt_pk_bf16_f32 %0, %1, %2" : "=v"(r) : "v"(lo), "v"(hi)); return r; }
__device__ __forceinline__ void phase_attn(const Params& p, unsigned char* lds_) {
    LAS unsigned char* lds = (LAS unsigned char*)lds_;
    const int tid = threadIdx.x, lane = tid & 63, w = __builtin_amdgcn_readfirstlane(tid >> 6), l15 = lane & 15, g = lane >> 4;
    const bf16_t* qb = (const bf16_t*)(p.ws + OFF_QKV); const bf16_t* kb = (const bf16_t*)(p.ws + OFF_QKV + QKV_ONE); const bf16_t* vb = (const bf16_t*)(p.ws + OFF_QKV + 2 * QKV_ONE);
    float* lse = (float*)(p.ws + OFF_LSE);
    const int G = gridDim.x, vcu = (G % 8 == 0) ? (int)(blockIdx.x & 7) * (G >> 3) + (int)(blockIdx.x >> 3) : (int)blockIdx.x;
    const float NEG = -__builtin_inff();
    for (int item = vcu; item < 3 * 48 * 32; item += G) {
        const int pat = item / 1536, rem = item % 1536, bh = rem >> 5, ci = rem & 31;
        const int dsh = 2 * pat, d = 1 << dsh, nblk = 32 >> dsh, r = ci / nblk, n = ci % nblk;
        const size_t hb = (size_t)bh * S;
        __syncthreads();
#pragma unroll
        for (int i = 0; i < 8; ++i) { const int ch = i * NTHR + tid, kk = ch >> 4, c = ch & 15;
            if (n > 0 || kk >= 128) { const int tp = (((n - 1) * 128 + kk) << dsh) + r;
                const u32x4 kv = *(const u32x4*)(kb + (hb + tp) * E + c * 8), vv = *(const u32x4*)(vb + (hb + tp) * E + c * 8);
                *(LAS u32x4*)(lds + kk * 256 + ((c ^ (kk & 15)) << 4)) = kv;
                *(LAS u32x4*)(lds + ATT_VOFF + kk * ATT_VSTRIDE + c * 16) = vv; } }
        const int jj = 16 * w + l15, tq = ((n * 128 + jj) << dsh) + r;
        bf16x8 qf[4];
#pragma unroll
        for (int ks = 0; ks < 4; ++ks) qf[ks] = *(const bf16x8*)(qb + (hb + tq) * E + 32 * ks + 8 * g);
        __syncthreads();
        const int s0 = w >> 1;
        f32x4 sA[5], sB[5];
#pragma unroll
        for (int si = 0; si < 5; ++si) {
            const int step = s0 + si;
            if (n == 0 && step < 4) { sA[si] = (f32x4){NEG, NEG, NEG, NEG}; sB[si] = (f32x4){NEG, NEG, NEG, NEG}; continue; }
            f32x4 a = {0.f, 0.f, 0.f, 0.f}, b = {0.f, 0.f, 0.f, 0.f};
            const int keyA = 32 * step + l15, keyB = keyA + 16;
#pragma unroll
            for (int ks = 0; ks < 4; ++ks) {
                const bf16x8 kA = *(const LAS bf16x8*)(lds + keyA * 256 + (((4 * ks + g) ^ (keyA & 15)) << 4));
                const bf16x8 kB = *(const LAS bf16x8*)(lds + keyB * 256 + (((4 * ks + g) ^ (keyB & 15)) << 4));
                a = __builtin_amdgcn_mfma_f32_16x16x32_bf16(kA, qf[ks], a, 0, 0, 0);
                b = __builtin_amdgcn_mfma_f32_16x16x32_bf16(kB, qf[ks], b, 0, 0, 0); }
#pragma unroll
            for (int rg = 0; rg < 4; ++rg) { const int ka = 32 * step + 4 * g + rg, kb2 = ka + 16;
                const bool oka = (unsigned)(ka - jj) <= 128u && (n > 0 || ka >= 128), okb = (unsigned)(kb2 - jj) <= 128u && (n > 0 || kb2 >= 128);
                a[rg] = oka ? a[rg] : NEG; b[rg] = okb ? b[rg] : NEG; }
            sA[si] = a; sB[si] = b;
        }
        float m = NEG;
#pragma unroll
        for (int si = 0; si < 5; ++si)
#pragma unroll
            for (int rg = 0; rg < 4; ++rg) m = fmaxf(m, fmaxf(sA[si][rg], sB[si][rg]));
        m = fmaxf(m, __shfl_xor(m, 16)); m = fmaxf(m, __shfl_xor(m, 32));
        float l = 0.f; const float mL = m * 1.4426950408889634f;
#pragma unroll
        for (int si = 0; si < 5; ++si)
#pragma unroll
            for (int rg = 0; rg < 4; ++rg) { sA[si][rg] = __builtin_amdgcn_exp2f(sA[si][rg] * 1.4426950408889634f - mL); sB[si][rg] = __builtin_amdgcn_exp2f(sB[si][rg] * 1.4426950408889634f - mL); l += sA[si][rg] + sB[si][rg]; }
        l += __shfl_xor(l, 16); l += __shfl_xor(l, 32);
        f32x4 o[8];
#pragma unroll
        for (int dt = 0; dt < 8; ++dt) o[dt] = (f32x4){0.f, 0.f, 0.f, 0.f};
#pragma unroll
        for (int si = 0; si < 5; ++si) {
            const int step = s0 + si;
            if (n == 0 && step < 4) continue;
            u32x4 pw; pw.x = cvt_pk(sA[si][0], sA[si][1]); pw.y = cvt_pk(sA[si][2], sA[si][3]); pw.z = cvt_pk(sB[si][0], sB[si][1]); pw.w = cvt_pk(sB[si][2], sB[si][3]);
            const bf16x8 pf = *reinterpret_cast<const bf16x8*>(&pw);
            LAS unsigned char* vrow = lds + ATT_VOFF + (32 * step + 4 * g + (l15 >> 2)) * ATT_VSTRIDE + (l15 & 3) * 8;
#pragma unroll
            for (int dt = 0; dt < 8; ++dt) {
                const s16x4 v0 = __builtin_amdgcn_ds_read_tr16_b64_v4i16((LAS s16x4*)(vrow + dt * 32));
                const s16x4 v1 = __builtin_amdgcn_ds_read_tr16_b64_v4i16((LAS s16x4*)(vrow + dt * 32 + 16 * ATT_VSTRIDE));
                const bf16x8 vf = {v0[0], v0[1], v0[2], v0[3], v1[0], v1[1], v1[2], v1[3]};
                o[dt] = __builtin_amdgcn_mfma_f32_16x16x32_bf16(vf, pf, o[dt], 0, 0, 0); }
        }
        const float il = 1.0f / l; const int b_ = bh / HA, h = bh % HA; const size_t tg = (size_t)b_ * S + tq;
        bf16_t* orow = P_opat(p, pat) + tg * DA + h * E + 4 * g;
#pragma unroll
        for (int dt = 0; dt < 8; ++dt) { u32x2 ww; ww.x = cvt_pk(o[dt][0] * il, o[dt][1] * il); ww.y = cvt_pk(o[dt][2] * il, o[dt][3] * il); *(u32x2*)(orow + 16 * dt) = ww; }
        if (g == 0) lse[((size_t)pat * T + tg) * HA + h] = m + __logf(l);
    }
}

__device__ __forceinline__ void phase_sgu(const Params& p, unsigned char* lds_) {
    LAS unsigned char* lds = (LAS unsigned char*)lds_;
    const int tid = threadIdx.x, lane = tid & 63, w = __builtin_amdgcn_readfirstlane(tid >> 6), l15 = lane & 15, g = lane >> 4;
    const bf16_t* vsb = (const bf16_t*)(p.ws + OFF_VS); const bf16_t* usb = (const bf16_t*)(p.ws + OFF_US); bf16_t* ob = (bf16_t*)(p.ws + OFF_SGUO);
    const bf16_t* sw = (const bf16_t*)(p.ws + OFF_SGUW);
    for (int item = blockIdx.x; item < (T / 128) * HS; item += gridDim.x) {
        const int h = item & 3, t0 = (item >> 2) * 128;
        __syncthreads();
        {
            const int j = tid >> 2, part = tid & 3;
            const u32x4* src = (const u32x4*)(vsb + (size_t)(t0 + j) * DS + h * E + part * 32);
            u32x4 x[4]; float sum = 0.f;
#pragma unroll
            for (int i = 0; i < 4; ++i) { x[i] = src[i]; sum += bflo(x[i].x) + bfhi(x[i].x) + bflo(x[i].y) + bfhi(x[i].y) + bflo(x[i].z) + bfhi(x[i].z) + bflo(x[i].w) + bfhi(x[i].w); }
            sum += __shfl_xor(sum, 1); sum += __shfl_xor(sum, 2);
            const float mu = sum * (1.0f / E); float var = 0.f;
#pragma unroll
            for (int i = 0; i < 4; ++i) { float dd;
                dd = bflo(x[i].x) - mu; var += dd * dd; dd = bfhi(x[i].x) - mu; var += dd * dd; dd = bflo(x[i].y) - mu; var += dd * dd; dd = bfhi(x[i].y) - mu; var += dd * dd;
                dd = bflo(x[i].z) - mu; var += dd * dd; dd = bfhi(x[i].z) - mu; var += dd * dd; dd = bflo(x[i].w) - mu; var += dd * dd; dd = bfhi(x[i].w) - mu; var += dd * dd; }
            var += __shfl_xor(var, 1); var += __shfl_xor(var, 2);
            const float rs = rsqrtf(var * (1.0f / E) + 1e-5f);
            const float* lg = p.sgu_ln_g + h * E + part * 32; const float* lb = p.sgu_ln_b + h * E + part * 32;
#pragma unroll
            for (int i = 0; i < 4; ++i) { const float4 g0 = *(const float4*)(lg + i * 8), g1 = *(const float4*)(lg + i * 8 + 4), b0 = *(const float4*)(lb + i * 8), b1 = *(const float4*)(lb + i * 8 + 4);
                u32x4 o; o.x = cvt_pk((bflo(x[i].x) - mu) * rs * g0.x + b0.x, (bfhi(x[i].x) - mu) * rs * g0.y + b0.y); o.y = cvt_pk((bflo(x[i].y) - mu) * rs * g0.z + b0.z, (bfhi(x[i].y) - mu) * rs * g0.w + b0.w);
                o.z = cvt_pk((bflo(x[i].z) - mu) * rs * g1.x + b1.x, (bfhi(x[i].z) - mu) * rs * g1.y + b1.y); o.w = cvt_pk((bflo(x[i].w) - mu) * rs * g1.z + b1.z, (bfhi(x[i].w) - mu) * rs * g1.w + b1.w);
                *(LAS u32x4*)(lds + j * ATT_VSTRIDE + part * 64 + i * 16) = o; }
        }
        __syncthreads();
        f32x4 acc[8];
#pragma unroll
        for (int et = 0; et < 8; ++et) acc[et] = (f32x4){0.f, 0.f, 0.f, 0.f};
        const int irow = 16 * w + l15, nsteps = (16 * w + 15) / 32 + 1;
        const bf16_t* wrow = sw + ((size_t)h * 128 + irow) * 128;
        for (int st = 0; st < nsteps; ++st) {
            const u32x2 wa = *(const u32x2*)(wrow + 32 * st + 4 * g), wb = *(const u32x2*)(wrow + 32 * st + 16 + 4 * g);
            u32x4 wf4; wf4.x = wa.x; wf4.y = wa.y; wf4.z = wb.x; wf4.w = wb.y;
            const bf16x8 wf = *reinterpret_cast<const bf16x8*>(&wf4);
            LAS unsigned char* vrow = lds + (32 * st + 4 * g + (l15 >> 2)) * ATT_VSTRIDE + (l15 & 3) * 8;
#pragma unroll
            for (int et = 0; et < 8; ++et) {
                const s16x4 v0 = __builtin_amdgcn_ds_read_tr16_b64_v4i16((LAS s16x4*)(vrow + et * 32));
                const s16x4 v1 = __builtin_amdgcn_ds_read_tr16_b64_v4i16((LAS s16x4*)(vrow + et * 32 + 16 * ATT_VSTRIDE));
                const bf16x8 vf = {v0[0], v0[1], v0[2], v0[3], v1[0], v1[1], v1[2], v1[3]};
                acc[et] = __builtin_amdgcn_mfma_f32_16x16x32_bf16(vf, wf, acc[et], 0, 0, 0); }
        }
        const float bias = p.sgu_b[h * 128 + irow];
        const size_t base = (size_t)(t0 + irow) * DS + h * E + 4 * g;
#pragma unroll
        for (int et = 0; et < 8; ++et) { const u32x2 uu = *(const u32x2*)(usb + base + 16 * et);
            u32x2 oo; oo.x = cvt_pk(bflo(uu.x) * (acc[et][0] + bias), bfhi(uu.x) * (acc[et][1] + bias)); oo.y = cvt_pk(bflo(uu.y) * (acc[et][2] + bias), bfhi(uu.y) * (acc[et][3] + bias));
            *(u32x2*)(ob + base + 16 * et) = oo; }
    }
}

__device__ __forceinline__ void phase_sgu_ln_naive(const Params& p) {
    const int lane = threadIdx.x & 63, gw = blockIdx.x * NWV + (threadIdx.x >> 6), nw = gridDim.x * NWV;
    bf16_t* vsb = (bf16_t*)(p.ws + OFF_VS);
    for (int item = gw; item < T * HS; item += nw) {
        const int t = item / HS, h = item % HS;
        unsigned* ptr = (unsigned*)(vsb + (size_t)t * DS + h * E + 2 * lane);
        const unsigned w = *ptr; const float a = bflo(w), b = bfhi(w);
        const float mu = wave_sum(a + b) * (1.0f / E); const float da = a - mu, db = b - mu;
        const float var = wave_sum(da * da + db * db) * (1.0f / E); const float rs = rsqrtf(var + 1e-5f);
        const int e = 2 * lane;
        *ptr = pack2(da * rs * p.sgu_ln_g[h * E + e] + p.sgu_ln_b[h * E + e], db * rs * p.sgu_ln_g[h * E + e + 1] + p.sgu_ln_b[h * E + e + 1]);
    }
}
__device__ __forceinline__ void phase_sgu_mix_naive(const Params& p) {
    const int tid = threadIdx.x;
    const bf16_t* vnb = (const bf16_t*)(p.ws + OFF_VS); const bf16_t* usb = (const bf16_t*)(p.ws + OFF_US); bf16_t* ob = (bf16_t*)(p.ws + OFF_SGUO);
    for (int t = blockIdx.x; t < T; t += gridDim.x) {
        const int h = tid >> 7, e = tid & 127, i = t & 127, t0 = t - i;
        float acc = 0.f;
        for (int j = 0; j <= i; ++j) acc += p.sgu_w[(h * 128 + i) * 128 + j] * bf2f(vnb[(size_t)(t0 + j) * DS + tid]);
        acc += p.sgu_b[h * 128 + i];
        ob[(size_t)t * DS + tid] = f2bf(bf2f(usb[(size_t)t * DS + tid]) * acc);
        (void)e;
    }
}

__device__ __forceinline__ void phase_combine(const Params& p) {
    const int lane = threadIdx.x & 63, gw = blockIdx.x * NWV + (threadIdx.x >> 6), nw = gridDim.x * NWV;
    const float* lse = (const float*)(p.ws + OFF_LSE);
    const bf16_t* sg = (const bf16_t*)(p.ws + OFF_SGUO); bf16_t* mixed = (bf16_t*)(p.ws + OFF_QKV);
    for (int t = gw; t < T; t += nw) {
        float w0 = 0.f, w1 = 0.f, w2 = 0.f;
        if (lane < HA) { const float l0 = lse[((size_t)0 * T + t) * HA + lane], l1 = lse[((size_t)1 * T + t) * HA + lane], l2 = lse[((size_t)2 * T + t) * HA + lane];
            const float m = fmaxf(l0, fmaxf(l1, l2)); const float e0 = __expf(l0 - m), e1 = __expf(l1 - m), e2 = __expf(l2 - m); const float is = 1.0f / (e0 + e1 + e2);
            w0 = e0 * is; w1 = e1 * is; w2 = e2 * is; }
        float av[3][8]; float ss = 0.f;
#pragma unroll
        for (int i = 0; i < 3; ++i) { const int col0 = (lane + 64 * i) * 8, hh = col0 >> 7;
            const float a0 = __shfl(w0, hh), a1 = __shfl(w1, hh), a2 = __shfl(w2, hh);
            const u32x4 x0 = *(const u32x4*)(P_opat(p, 0) + (size_t)t * DA + col0), x1 = *(const u32x4*)(P_opat(p, 1) + (size_t)t * DA + col0), x2 = *(const u32x4*)(P_opat(p, 2) + (size_t)t * DA + col0);
            av[i][0] = a0 * bflo(x0.x) + a1 * bflo(x1.x) + a2 * bflo(x2.x); av[i][1] = a0 * bfhi(x0.x) + a1 * bfhi(x1.x) + a2 * bfhi(x2.x);
            av[i][2] = a0 * bflo(x0.y) + a1 * bflo(x1.y) + a2 * bflo(x2.y); av[i][3] = a0 * bfhi(x0.y) + a1 * bfhi(x1.y) + a2 * bfhi(x2.y);
            av[i][4] = a0 * bflo(x0.z) + a1 * bflo(x1.z) + a2 * bflo(x2.z); av[i][5] = a0 * bfhi(x0.z) + a1 * bfhi(x1.z) + a2 * bfhi(x2.z);
            av[i][6] = a0 * bflo(x0.w) + a1 * bflo(x1.w) + a2 * bflo(x2.w); av[i][7] = a0 * bfhi(x0.w) + a1 * bfhi(x1.w) + a2 * bfhi(x2.w);
#pragma unroll
            for (int j = 0; j < 8; ++j) ss += av[i][j] * av[i][j]; }
        ss = wave_sum(ss); const float rs = rsqrtf(ss * (1.0f / DA) + 1e-6f);
#pragma unroll
        for (int i = 0; i < 3; ++i) { const int col0 = (lane + 64 * i) * 8; const float4 g0 = *(const float4*)(p.g_attn_out + col0), g1 = *(const float4*)(p.g_attn_out + col0 + 4);
            u32x4 w; w.x = pack2(av[i][0] * rs * g0.x, av[i][1] * rs * g0.y); w.y = pack2(av[i][2] * rs * g0.z, av[i][3] * rs * g0.w);
            w.z = pack2(av[i][4] * rs * g1.x, av[i][5] * rs * g1.y); w.w = pack2(av[i][6] * rs * g1.z, av[i][7] * rs * g1.w);
            *(u32x4*)(mixed + (size_t)t * D + col0) = w; }
        { const int col0 = lane * 8; const u32x4 xs = *(const u32x4*)(sg + (size_t)t * DS + col0);
          float sv[8] = {bflo(xs.x), bfhi(xs.x), bflo(xs.y), bfhi(xs.y), bflo(xs.z), bfhi(xs.z), bflo(xs.w), bfhi(xs.w)}; float s2 = 0.f;
#pragma unroll
          for (int j = 0; j < 8; ++j) s2 += sv[j] * sv[j];
          s2 = wave_sum(s2); const float r2 = rsqrtf(s2 * (1.0f / DS) + 1e-6f);
          const float4 g0 = *(const float4*)(p.g_sgu_out + col0), g1 = *(const float4*)(p.g_sgu_out + col0 + 4);
          u32x4 w; w.x = pack2(sv[0] * r2 * g0.x, sv[1] * r2 * g0.y); w.y = pack2(sv[2] * r2 * g0.z, sv[3] * r2 * g0.w);
          w.z = pack2(sv[4] * r2 * g1.x, sv[5] * r2 * g1.y); w.w = pack2(sv[6] * r2 * g1.z, sv[7] * r2 * g1.w);
          *(u32x4*)(mixed + (size_t)t * D + DA + col0) = w; }
    }
}

__device__ __forceinline__ void phase_topk_naive(const Params& p, unsigned char* lds) {
    const int lane = threadIdx.x & 63, wave = threadIdx.x >> 6, gw = blockIdx.x * NWV + wave, nw = gridDim.x * NWV;
    float* ql = (float*)lds + wave * 256;
    const bf16_t* pq = (const bf16_t*)(p.ws + OFF_QKV + (size_t)T * D * 2);
    int* idxo = (int*)(p.ws + OFF_IDX); float* gato = (float*)(p.ws + OFF_GATE);
    const float NEG = -__builtin_inff();
    for (int item = gw; item < T * PH; item += nw) {
        const int t = item / PH, h = item % PH;
        { const u32x2 w = *(const u32x2*)(pq + (size_t)t * D + h * 256 + 4 * lane); ql[4 * lane] = bflo(w.x); ql[4 * lane + 1] = bfhi(w.x); ql[4 * lane + 2] = bflo(w.y); ql[4 * lane + 3] = bfhi(w.y); }
        __builtin_amdgcn_wave_barrier();
        float ts[2]; int ti[2];
#pragma unroll
        for (int pp = 0; pp < 2; ++pp) {
            const float* k0 = p.peer_sub_keys + ((size_t)(h * 2 + pp) * 128 + lane) * 128; const float* k1 = k0 + 64 * 128; const float* qq = ql + pp * 128;
            float s0 = 0.f, s1 = 0.f;
            for (int c = 0; c < 128; c += 4) { const float4 a = *(const float4*)(k0 + c), b = *(const float4*)(k1 + c);
                s0 += qq[c] * a.x + qq[c + 1] * a.y + qq[c + 2] * a.z + qq[c + 3] * a.w; s1 += qq[c] * b.x + qq[c + 1] * b.y + qq[c + 2] * b.z + qq[c + 3] * b.w; }
            float tsv = 0.f; int tiv = 0;
            for (int r = 0; r < PK; ++r) { const float m = wave_max(fmaxf(s0, s1));
                const int cand = (s0 == m) ? lane : ((s1 == m) ? lane + 64 : 1000); const int key = wave_min_i(cand);
                if (lane == r) { tsv = m; tiv = key; }
                if (key == lane) s0 = NEG; if (key == lane + 64) s1 = NEG; }
            ts[pp] = tsv; ti[pp] = tiv; }
        float cs[4]; const int ci = lane >> 2, cj = (lane & 3) * 4; const float a = __shfl(ts[0], ci);
#pragma unroll
        for (int m = 0; m < 4; ++m) cs[m] = a + __shfl(ts[1], cj + m);
        float bs = 0.f; int bpos = 0;
        for (int r = 0; r < PK; ++r) { const float m = wave_max(fmaxf(fmaxf(cs[0], cs[1]), fmaxf(cs[2], cs[3])));
            int cand = 1000;
#pragma unroll
            for (int mm = 3; mm >= 0; --mm) if (cs[mm] == m) cand = ci * 16 + cj + mm;
            const int pos = wave_min_i(cand);
            if (lane == r) { bs = m; bpos = pos; }
#pragma unroll
            for (int mm = 0; mm < 4; ++mm) if (pos == ci * 16 + cj + mm) cs[mm] = NEG; }
        const int e1 = __shfl(ti[0], (bpos >> 4) & 15), e2 = __shfl(ti[1], bpos & 15);
        const float m0 = __shfl(bs, 0); const float ex = lane < PK ? __expf(bs - m0) : 0.f; const float sum = wave_sum(ex);
        if (lane < PK) { idxo[(size_t)t * 128 + h * PK + lane] = e1 * 128 + e2; gato[(size_t)t * 128 + h * PK + lane] = ex / sum; }
        __builtin_amdgcn_wave_barrier();
    }
}

__device__ __forceinline__ int f2key(float f) { const int b = __float_as_int(f); return b ^ ((b >> 31) & 0x7fffffff); }
__device__ __forceinline__ float key2f(int k) { return __int_as_float(k ^ ((k >> 31) & 0x7fffffff)); }
typedef int i32x16 __attribute__((ext_vector_type(16)));
typedef float f32x16v __attribute__((ext_vector_type(16)));
#define TK_CE(v, i, l) do { const int _a = v[i], _b = v[l]; v[i] = max(_a, _b); v[l] = min(_a, _b); } while (0)
__device__ __forceinline__ i32x16 sort16_desc(i32x16 v) {
#pragma unroll
    for (int lk = 1; lk <= 4; ++lk)
#pragma unroll
        for (int lj = 3; lj >= 0; --lj) { if (lj >= lk) continue; const int k = 1 << lk, j = 1 << lj;
#pragma unroll
            for (int i = 0; i < 16; ++i) { const int l = i ^ j; if (l > i) { if ((i & k) == 0) TK_CE(v, i, l); else TK_CE(v, l, i); } } }
    return v;
}
__device__ __forceinline__ i32x16 bitonic_merge16_desc(i32x16 v) {
#pragma unroll
    for (int lj = 3; lj >= 0; --lj) { const int j = 1 << lj;
#pragma unroll
        for (int i = 0; i < 16; ++i) { const int l = i ^ j; if (l > i) TK_CE(v, i, l); } }
    return v;
}
__device__ __forceinline__ i32x16 merge_top16(i32x16 a, i32x16 b) {
#pragma unroll
    for (int i = 0; i < 16; ++i) a[i] = max(a[i], b[15 - i]);
    return bitonic_merge16_desc(a);
}
__device__ __forceinline__ i32x16 xlane_merge_top16(i32x16 a, int xr) {
    i32x16 b;
#pragma unroll
    for (int i = 0; i < 16; ++i) b[i] = __shfl_xor(a[i], xr);
    return merge_top16(a, b);
}
__device__ __forceinline__ int sel2i(bool c, int x, int y) { return c ? y : x; }
__device__ __forceinline__ int sel16(i32x16 v, int i) {
    const bool c0 = (i & 1) != 0, c1 = (i & 2) != 0, c2 = (i & 4) != 0, c3 = (i & 8) != 0;
    const int a0 = sel2i(c0, v[0], v[1]), a1 = sel2i(c0, v[2], v[3]), a2 = sel2i(c0, v[4], v[5]), a3 = sel2i(c0, v[6], v[7]);
    const int a4 = sel2i(c0, v[8], v[9]), a5 = sel2i(c0, v[10], v[11]), a6 = sel2i(c0, v[12], v[13]), a7 = sel2i(c0, v[14], v[15]);
    const int b0 = sel2i(c1, a0, a1), b1 = sel2i(c1, a2, a3), b2 = sel2i(c1, a4, a5), b3 = sel2i(c1, a6, a7);
    const int d0 = sel2i(c2, b0, b1), d1 = sel2i(c2, b2, b3);
    return sel2i(c3, d0, d1);
}
__device__ __forceinline__ int sel4i(int g, int a, int b, int c, int d) { return g == 0 ? a : (g == 1 ? b : (g == 2 ? c : d)); }
__device__ __forceinline__ float sel4f(int g, float a, float b, float c, float d) { return g == 0 ? a : (g == 1 ? b : (g == 2 ? c : d)); }
constexpr int TK_TAB[64] = {
    0x00, 0x01, 0x02, 0x03, 0x04, 0x05, 0x06, 0x07, 0x08, 0x09, 0x0A, 0x0B, 0x0C, 0x0D, 0x0E, 0x0F,
    0x10, 0x11, 0x12, 0x13, 0x14, 0x15, 0x16, 0x17, 0x40, 0x41, 0x42, 0x80, 0x90, 0xFF, 0xFF, 0xFF,
    0x20, 0x21, 0x22, 0x23, 0x24, 0x30, 0x31, 0x32, 0x33, 0x50, 0x51, 0xA0, 0xB0, 0xFF, 0xFF, 0xFF,
    0x60, 0x61, 0x70, 0x71, 0xC0, 0xD0, 0xE0, 0xF0, 0xFF, 0xFF, 0xFF, 0xFF, 0xFF, 0xFF, 0xFF, 0xFF};
template <int C> __device__ __forceinline__ int tk_make_cand(i32x16 sp0, i32x16 sp1, int g) {
    constexpr int NONE = (int)0x80000000;
    constexpr int e0 = TK_TAB[C], e1 = TK_TAB[16 + C], e2 = TK_TAB[32 + C], e3 = TK_TAB[48 + C];
    constexpr int r0 = (e0 >> 4) & 15, r1 = e1 == 0xFF ? 0 : (e1 >> 4) & 15, r2 = e2 == 0xFF ? 0 : (e2 >> 4) & 15, r3 = e3 == 0xFF ? 0 : (e3 >> 4) & 15;
    constexpr int c0 = e0 & 15, c1 = e1 == 0xFF ? 0 : e1 & 15, c2 = e2 == 0xFF ? 0 : e2 & 15, c3 = e3 == 0xFF ? 0 : e3 & 15;
    const int av = sel4i(g, sp0[r0], sp0[r1], sp0[r2], sp0[r3]);
    const int bv = sel4i(g, sp1[c0], sp1[c1], sp1[c2], sp1[c3]);
    const int code = sel4i(g, e0, e1, e2, e3);
    const float sum = key2f(av & ~127) + key2f(bv & ~127);
    return code == 0xFF ? NONE : ((f2key(sum) & ~255) | code);
}
__device__ __forceinline__ void phase_topk(const Params& p, unsigned char* lds_) {
    LAS unsigned char* lds = (LAS unsigned char*)lds_;
    const int tid = threadIdx.x, lane = tid & 63, w = __builtin_amdgcn_readfirstlane(tid >> 6), l15 = lane & 15, g = lane >> 4;
    const bf16_t* pq = (const bf16_t*)(p.ws + OFF_QKV + (size_t)T * D * 2); const bf16_t* skb = (const bf16_t*)(p.ws + OFF_SUBK);
    int* idxo = (int*)(p.ws + OFF_IDX); float* gato = (float*)(p.ws + OFF_GATE);
    int cur_h = -1;
    for (int task = blockIdx.x; task < (T / 128) * PH; task += gridDim.x) {
        const int h = task & 7, tt = task >> 3;
        if (h != cur_h) {
            __syncthreads();
#pragma unroll
            for (int i = 0; i < 8; ++i) { const int ch = i * NTHR + tid, row = ch >> 4, c = ch & 15;
                *(LAS u32x4*)(lds + row * 256 + ((c ^ (row & 15)) << 4)) = *(const u32x4*)(skb + ((size_t)h * 256 + row) * 128 + c * 8); }
            __syncthreads();
            cur_h = h;
        }
        const int t = tt * 128 + 16 * w + l15;
        i32x16 sp0, sp1;
#pragma unroll
        for (int pp = 0; pp < 2; ++pp) {
            bf16x8 bq[4];
#pragma unroll
            for (int ks = 0; ks < 4; ++ks) bq[ks] = *(const bf16x8*)(pq + (size_t)t * D + h * 256 + pp * 128 + 32 * ks + 8 * g);
            i32x16 ka, kb2;
#pragma unroll
            for (int kt = 0; kt < 8; ++kt) {
                f32x4 a = {0.f, 0.f, 0.f, 0.f};
                const int row = pp * 128 + 16 * kt + l15;
#pragma unroll
                for (int ks = 0; ks < 4; ++ks) { const bf16x8 kf = *(const LAS bf16x8*)(lds + row * 256 + (((4 * ks + g) ^ (row & 15)) << 4)); a = __builtin_amdgcn_mfma_f32_16x16x32_bf16(kf, bq[ks], a, 0, 0, 0); }
#pragma unroll
                for (int rg = 0; rg < 4; ++rg) { const int key = (f2key(a[rg]) & ~127) | (16 * kt + rg + 4 * g);
                    if (kt < 4) ka[kt * 4 + rg] = key; else kb2[(kt - 4) * 4 + rg] = key; }
            }
            ka = merge_top16(sort16_desc(ka), sort16_desc(kb2));
            ka = xlane_merge_top16(ka, 16); ka = xlane_merge_top16(ka, 32);
            if (pp == 0) sp0 = ka; else sp1 = ka;
        }
        i32x16 cd;
        cd[0] = tk_make_cand<0>(sp0, sp1, g); cd[1] = tk_make_cand<1>(sp0, sp1, g); cd[2] = tk_make_cand<2>(sp0, sp1, g); cd[3] = tk_make_cand<3>(sp0, sp1, g);
        cd[4] = tk_make_cand<4>(sp0, sp1, g); cd[5] = tk_make_cand<5>(sp0, sp1, g); cd[6] = tk_make_cand<6>(sp0, sp1, g); cd[7] = tk_make_cand<7>(sp0, sp1, g);
        cd[8] = tk_make_cand<8>(sp0, sp1, g); cd[9] = tk_make_cand<9>(sp0, sp1, g); cd[10] = tk_make_cand<10>(sp0, sp1, g); cd[11] = tk_make_cand<11>(sp0, sp1, g);
        cd[12] = tk_make_cand<12>(sp0, sp1, g); cd[13] = tk_make_cand<13>(sp0, sp1, g); cd[14] = tk_make_cand<14>(sp0, sp1, g); cd[15] = tk_make_cand<15>(sp0, sp1, g);
        cd = sort16_desc(cd); cd = xlane_merge_top16(cd, 16); cd = xlane_merge_top16(cd, 32);
        f32x16v ex; float sum = 0.f; const float m0 = key2f(cd[0] & ~255);
#pragma unroll
        for (int i = 0; i < 16; ++i) { ex[i] = __expf(key2f(cd[i] & ~255) - m0); sum += ex[i]; }
        const float is = 1.0f / sum;
        int oi[4]; float og[4];
#pragma unroll
        for (int c = 0; c < 4; ++c) {
            const int key = sel4i(g, cd[c], cd[4 + c], cd[8 + c], cd[12 + c]);
            const float e = sel4f(g, ex[c], ex[4 + c], ex[8 + c], ex[12 + c]);
            const int i1 = sel16(sp0, (key >> 4) & 15) & 127, i2 = sel16(sp1, key & 15) & 127;
            oi[c] = i1 * 128 + i2; og[c] = e * is; }
        *(int4*)(idxo + (size_t)t * 128 + h * PK + 4 * g) = make_int4(oi[0], oi[1], oi[2], oi[3]);
        *(float4*)(gato + (size_t)t * 128 + h * PK + 4 * g) = make_float4(og[0], og[1], og[2], og[3]);
    }
}

typedef float f32x2v __attribute__((ext_vector_type(2)));
typedef float f32x8v __attribute__((ext_vector_type(8)));
__device__ __forceinline__ float dot16_fp8(const u32x4 w, const float* xf) {
    float s = 0.f;
#pragma unroll
    for (int q = 0; q < 4; ++q) { const int ww = (int)w[q]; const f32x2v lo = __builtin_amdgcn_cvt_pk_f32_fp8(ww, false), hi = __builtin_amdgcn_cvt_pk_f32_fp8(ww, true);
        s = fmaf(lo.x, xf[4 * q + 0], s); s = fmaf(lo.y, xf[4 * q + 1], s); s = fmaf(hi.x, xf[4 * q + 2], s); s = fmaf(hi.y, xf[4 * q + 3], s); }
    return s;
}
__device__ __forceinline__ void axpy16_fp8(const u32x4 w, float cw, float* acc) {
#pragma unroll
    for (int q = 0; q < 4; ++q) { const int ww = (int)w[q]; const f32x2v lo = __builtin_amdgcn_cvt_pk_f32_fp8(ww, false), hi = __builtin_amdgcn_cvt_pk_f32_fp8(ww, true);
        acc[4 * q + 0] = fmaf(cw, lo.x, acc[4 * q + 0]); acc[4 * q + 1] = fmaf(cw, lo.y, acc[4 * q + 1]); acc[4 * q + 2] = fmaf(cw, hi.x, acc[4 * q + 2]); acc[4 * q + 3] = fmaf(cw, hi.y, acc[4 * q + 3]); }
}
__device__ __forceinline__ float red8_piece(f32x8v r, int lane) {
    const bool b2 = (lane & 4) != 0, b1 = (lane & 2) != 0, b0 = (lane & 1) != 0;
    f32x4 q; f32x2v pp;
#pragma unroll
    for (int k = 0; k < 4; ++k) { const float lo = r[k], hi = r[k + 4]; const float kp = b2 ? hi : lo, sn = b2 ? lo : hi; q[k] = kp + __shfl_xor(sn, 4); }
#pragma unroll
    for (int k = 0; k < 2; ++k) { const float lo = q[k], hi = q[k + 2]; const float kp = b1 ? hi : lo, sn = b1 ? lo : hi; pp[k] = kp + __shfl_xor(sn, 2); }
    const float lo = pp[0], hi = pp[1]; const float kp = b0 ? hi : lo, sn = b0 ? lo : hi;
    return kp + __shfl_xor(sn, 1);
}
template <int WHICH> __device__ __forceinline__ void peer_chunk(const Params& p, int t0, int s, int lane) {
    const int sub = lane >> 3, piece = lane & 7;
    const int* idx = (const int*)(p.ws + OFF_IDX) + sub * 16;
    const unsigned char* tab = p.ws + (WHICH == 0 ? OFF_UTAB : OFF_VTAB) + (size_t)s * SLICE_BYTES + piece * 16;
    const bf16_t* xbase = (const bf16_t*)(p.ws + OFF_A) + s * 128 + piece * 16;
    const float* wbase = (const float*)(p.ws + OFF_GATE) + sub * 16;
    int4 ec[4], en[4];
    u32x4 wA[8], wB[8];
    u32x4 xr[2]; float4 cwv[4];
#define PEER_LD8(dst, ev0, ev1) do { dst[0] = *(const u32x4*)(tab + (size_t)ev0.x * 128); dst[1] = *(const u32x4*)(tab + (size_t)ev0.y * 128); dst[2] = *(const u32x4*)(tab + (size_t)ev0.z * 128); dst[3] = *(const u32x4*)(tab + (size_t)ev0.w * 128); \
                                     dst[4] = *(const u32x4*)(tab + (size_t)ev1.x * 128); dst[5] = *(const u32x4*)(tab + (size_t)ev1.y * 128); dst[6] = *(const u32x4*)(tab + (size_t)ev1.z * 128); dst[7] = *(const u32x4*)(tab + (size_t)ev1.w * 128); } while (0)
#pragma unroll
    for (int q = 0; q < 4; ++q) ec[q] = *(const int4*)(idx + (size_t)t0 * 128 + 4 * q);
    PEER_LD8(wA, ec[0], ec[1]);
    if (WHICH == 0) { xr[0] = *(const u32x4*)(xbase + (size_t)t0 * D); xr[1] = *(const u32x4*)(xbase + (size_t)t0 * D + 8); }
    else {
#pragma unroll
        for (int q = 0; q < 4; ++q) cwv[q] = *(const float4*)(wbase + (size_t)t0 * 128 + 4 * q); }
#pragma unroll
    for (int q = 0; q < 4; ++q) en[q] = *(const int4*)(idx + (size_t)(t0 + 1) * 128 + 4 * q);
#pragma unroll 1
    for (int k = 0; k < 8; ++k) {
        const int t = t0 + k;
        PEER_LD8(wB, ec[2], ec[3]);
        if (WHICH == 0) {
            float xf[16];
#pragma unroll
            for (int hh = 0; hh < 2; ++hh) { const u32x4 w = xr[hh];
                xf[hh * 8 + 0] = bflo(w.x); xf[hh * 8 + 1] = bfhi(w.x); xf[hh * 8 + 2] = bflo(w.y); xf[hh * 8 + 3] = bfhi(w.y); xf[hh * 8 + 4] = bflo(w.z); xf[hh * 8 + 5] = bfhi(w.z); xf[hh * 8 + 6] = bflo(w.w); xf[hh * 8 + 7] = bfhi(w.w); }
            f32x8v r0, r1;
#pragma unroll
            for (int i = 0; i < 8; ++i) r0[i] = dot16_fp8(wA[i], xf);
            if (k < 7) { PEER_LD8(wA, en[0], en[1]); xr[0] = *(const u32x4*)(xbase + (size_t)(t + 1) * D); xr[1] = *(const u32x4*)(xbase + (size_t)(t + 1) * D + 8); }
#pragma unroll
            for (int i = 0; i < 8; ++i) r1[i] = dot16_fp8(wB[i], xf);
            const float v0 = red8_piece(r0, lane), v1 = red8_piece(r1, lane);
            float* part = (float*)(p.ws + OFF_QKV) + ((size_t)s * T + t) * 128 + sub * 16 + piece;
            part[0] = v0; part[8] = v1;
        } else {
            float acc[16];
#pragma unroll
            for (int j = 0; j < 16; ++j) acc[j] = 0.f;
            const float4 c0 = cwv[0], c1 = cwv[1], c2 = cwv[2], c3 = cwv[3];
            axpy16_fp8(wA[0], c0.x, acc); axpy16_fp8(wA[1], c0.y, acc); axpy16_fp8(wA[2], c0.z, acc); axpy16_fp8(wA[3], c0.w, acc);
            axpy16_fp8(wA[4], c1.x, acc); axpy16_fp8(wA[5], c1.y, acc); axpy16_fp8(wA[6], c1.z, acc); axpy16_fp8(wA[7], c1.w, acc);
            if (k < 7) { PEER_LD8(wA, en[0], en[1]);
#pragma unroll
                for (int q = 0; q < 4; ++q) cwv[q] = *(const float4*)(wbase + (size_t)(t + 1) * 128 + 4 * q); }
            axpy16_fp8(wB[0], c2.x, acc); axpy16_fp8(wB[1], c2.y, acc); axpy16_fp8(wB[2], c2.z, acc); axpy16_fp8(wB[3], c2.w, acc);
            axpy16_fp8(wB[4], c3.x, acc); axpy16_fp8(wB[5], c3.y, acc); axpy16_fp8(wB[6], c3.z, acc); axpy16_fp8(wB[7], c3.w, acc);
            f32x16v a16;
#pragma unroll
            for (int j = 0; j < 16; ++j) a16[j] = acc[j];
            const bool b5 = (lane & 32) != 0, b4 = (lane & 16) != 0, b3 = (lane & 8) != 0;
            f32x8v q8; f32x4 q4; f32x2v q2;
#pragma unroll
            for (int j = 0; j < 8; ++j) { const float lo = a16[j], hi = a16[j + 8]; const float kp = b5 ? hi : lo, sn = b5 ? lo : hi; q8[j] = kp + __shfl_xor(sn, 32); }
#pragma unroll
            for (int j = 0; j < 4; ++j) { const float lo = q8[j], hi = q8[j + 4]; const float kp = b4 ? hi : lo, sn = b4 ? lo : hi; q4[j] = kp + __shfl_xor(sn, 16); }
#pragma unroll
            for (int j = 0; j < 2; ++j) { const float lo = q4[j], hi = q4[j + 2]; const float kp = b3 ? hi : lo, sn = b3 ? lo : hi; q2[j] = kp + __shfl_xor(sn, 8); }
            bf16_t* po = (bf16_t*)(p.ws + OFF_O12) + (size_t)t * D + s * 128 + piece * 16 + 2 * sub;
            *(unsigned*)po = cvt_pk(q2[0], q2[1]);
        }
#pragma unroll
        for (int q = 0; q < 4; ++q) ec[q] = en[q];
        if (k < 6) {
#pragma unroll
            for (int q = 0; q < 4; ++q) en[q] = *(const int4*)(idx + (size_t)(t + 2) * 128 + 4 * q); }
    }
#undef PEER_LD8
}
template <int WHICH> __device__ __forceinline__ void phase_peer_sliced(const Params& p, unsigned xcc) {
    unsigned* qh = (unsigned*)(p.ws + OFF_CTL + OFF_QUEUE) + WHICH * 16 * 64;
    const int lane = threadIdx.x & 63;
    for (int rnd = 0; rnd < 16; ++rnd) {
        const int s = (int)((xcc + 8u * (unsigned)(rnd & 1) + (unsigned)(rnd >> 1)) & 15u);
        unsigned c = 0; if (lane == 0) c = atomicAdd(qh + s * 64, 1u);
        c = __builtin_amdgcn_readfirstlane(c);
        while (c < (unsigned)(T / 8)) {
            unsigned cn = 0; if (lane == 0) cn = atomicAdd(qh + s * 64, 1u);
            peer_chunk<WHICH>(p, (int)c * 8, s, lane);
            c = __builtin_amdgcn_readfirstlane(cn);
        }
    }
}
__device__ __forceinline__ void phase_peer_w(const Params& p) {
    const int lane = threadIdx.x & 63, gw = blockIdx.x * NWV + (threadIdx.x >> 6), nw = gridDim.x * NWV;
    const float* part = (const float*)(p.ws + OFF_QKV); const int* idx = (const int*)(p.ws + OFF_IDX); float* gate = (float*)(p.ws + OFF_GATE);
    const float* uinv = (const float*)(p.ws + OFF_UTAB + TAB8_BYTES); const float* vinv = (const float*)(p.ws + OFF_VTAB + TAB8_BYTES);
    for (int t = gw; t < T; t += nw) {
        float a0 = 0.f, a1 = 0.f;
#pragma unroll
        for (int s = 0; s < 16; ++s) { const float* pr = part + ((size_t)s * T + t) * 128; a0 += pr[lane]; a1 += pr[64 + lane]; }
        const int e0 = idx[(size_t)t * 128 + lane], e1 = idx[(size_t)t * 128 + 64 + lane];
        const float g0 = gate[(size_t)t * 128 + lane], g1 = gate[(size_t)t * 128 + 64 + lane];
        gate[(size_t)t * 128 + lane] = g0 * gelu_erf(a0 * uinv[e0]) * vinv[e0];
        gate[(size_t)t * 128 + 64 + lane] = g1 * gelu_erf(a1 * uinv[e1]) * vinv[e1];
    }
}
__device__ __forceinline__ void phase_peer_final(const Params& p) {
    const int lane = threadIdx.x & 63, gw = blockIdx.x * NWV + (threadIdx.x >> 6), nw = gridDim.x * NWV;
    const bf16_t* peer = (const bf16_t*)(p.ws + OFF_O12);
    for (int t = gw; t < T; t += nw) {
        const int b = t / S; float* hrow = p.out + (size_t)t * D; float v[32]; float ss = 0.f;
#pragma unroll
        for (int i = 0; i < 4; ++i) { const int col = i * 512 + lane * 8;
            const u32x4 pw = *(const u32x4*)(peer + (size_t)t * D + col); const float4 h0 = *(const float4*)(hrow + col), h1 = *(const float4*)(hrow + col + 4);
            const float4 g0 = mod4(p, b, 5, col), g1 = mod4(p, b, 5, col + 4);
            v[i * 8 + 0] = h0.x + g0.x * bflo(pw.x); v[i * 8 + 1] = h0.y + g0.y * bfhi(pw.x); v[i * 8 + 2] = h0.z + g0.z * bflo(pw.y); v[i * 8 + 3] = h0.w + g0.w * bfhi(pw.y);
            v[i * 8 + 4] = h1.x + g1.x * bflo(pw.z); v[i * 8 + 5] = h1.y + g1.y * bfhi(pw.z); v[i * 8 + 6] = h1.z + g1.z * bflo(pw.w); v[i * 8 + 7] = h1.w + g1.w * bfhi(pw.w);
#pragma unroll
            for (int j = 0; j < 8; ++j) ss += v[i * 8 + j] * v[i * 8 + j]; }
        ss = wave_sum(ss); const float rs = rsqrtf(ss * (1.0f / D) + 1e-6f);
#pragma unroll
        for (int i = 0; i < 4; ++i) { const int col = i * 512 + lane * 8; const float4 g0 = *(const float4*)(p.g_final + col), g1 = *(const float4*)(p.g_final + col + 4);
            *(float4*)(hrow + col) = make_float4(v[i * 8 + 0] * rs * g0.x, v[i * 8 + 1] * rs * g0.y, v[i * 8 + 2] * rs * g0.z, v[i * 8 + 3] * rs * g0.w);
            *(float4*)(hrow + col + 4) = make_float4(v[i * 8 + 4] * rs * g1.x, v[i * 8 + 5] * rs * g1.y, v[i * 8 + 6] * rs * g1.z, v[i * 8 + 7] * rs * g1.w); }
    }
}

constexpr int LDS_BYTES = 147456;

#define XB_TMO      128
#define XB_XCNT(j)  (256  + 64 * (j))
#define XB_XSUB(j)  (1280 + 64 * (j))
#define XB_XGEN(j)  (2304 + 64 * (j))
#define XB_TOP      3328
#define XB_TOPGEN   3392
#define XCD_BAR_WORDS 3456
#define XB_SPIN_CAP (1u << 18)

__device__ __forceinline__ unsigned xb_ld(unsigned* p)              { return __hip_atomic_load(p, __ATOMIC_RELAXED, __HIP_MEMORY_SCOPE_AGENT); }
__device__ __forceinline__ unsigned xb_add(unsigned* p, unsigned v) { return __hip_atomic_fetch_add(p, v, __ATOMIC_RELAXED, __HIP_MEMORY_SCOPE_AGENT); }
__device__ __forceinline__ unsigned xb_xcc_id() { return (unsigned)__builtin_amdgcn_s_getreg((3 << 11) | 20) & 0xFu; }
#define XB_SPIN(cond, bar) do { unsigned _sp = 0; while (cond) { __builtin_amdgcn_s_sleep(1); \
    if ((++_sp & 255u) == 0u) { if (xb_ld(&(bar)[XB_TMO])) break; if (_sp > XB_SPIN_CAP) { atomicAdd(&(bar)[XB_TMO], 1u); break; } } } } while (0)

struct XcdBarrier {
    unsigned* bar; unsigned x;
    volatile LAS unsigned* st;
};

__device__ __forceinline__ XcdBarrier xcd_barrier_post(unsigned* bar, volatile LAS unsigned* st) {
    XcdBarrier b; b.bar = bar; b.x = xb_xcc_id(); b.st = st;
    if (threadIdx.x == 0) (void)xb_add(&bar[XB_XCNT(b.x)], 1u);
    return b;
}
__device__ __forceinline__ void xcd_barrier_complete(unsigned* bar, unsigned x, unsigned& nloc, unsigned& nx) {
    const unsigned G = gridDim.x * gridDim.y * gridDim.z;
    unsigned sum, cnt, mine, sp = 0u;
    for (;;) {
        sum = 0u; cnt = 0u; mine = 0u;
#pragma unroll
        for (unsigned j = 0; j < 16; ++j) { const unsigned c = xb_ld(&bar[XB_XCNT(j)]); sum += c; cnt += (c > 0u) ? 1u : 0u; mine = (j == x) ? c : mine; }
        if (sum == G) break;
        __builtin_amdgcn_s_sleep(1);
        if ((++sp & 255u) == 0u) { if (xb_ld(&bar[XB_TMO])) break; if (sp > XB_SPIN_CAP) { atomicAdd(&bar[XB_TMO], 1u); break; } }
    }
    nloc = mine > 0u ? mine : 1u; nx = cnt > 0u ? cnt : 1u;
}

__device__ __forceinline__ void xcd_barrier(const XcdBarrier& b) {
    asm volatile("s_waitcnt vmcnt(0)" ::: "memory");
    __syncthreads();
    if (threadIdx.x == 0) {
        unsigned* bar = b.bar;
        __builtin_amdgcn_s_waitcnt(0);
        unsigned nloc = b.st[0], nx = b.st[1];
        if (nloc == 0u) { xcd_barrier_complete(bar, b.x, nloc, nx); b.st[0] = nloc; b.st[1] = nx; }
        const unsigned old = xb_add(&bar[XB_XSUB(b.x)], 1u);
        const unsigned gen = old / nloc;
        if (old + 1u == (gen + 1u) * nloc) {
            __builtin_amdgcn_fence(__ATOMIC_RELEASE, "agent");
            asm volatile("s_waitcnt vmcnt(0)" ::: "memory");
            const unsigned og = xb_add(&bar[XB_TOP], 1u);
            const unsigned tg = og / nx;
            if (og + 1u == (tg + 1u) * nx) xb_add(&bar[XB_TOPGEN], 1u);
            else XB_SPIN(xb_ld(&bar[XB_TOPGEN]) == tg, bar);
            __builtin_amdgcn_fence(__ATOMIC_ACQUIRE, "agent");
            xb_add(&bar[XB_XGEN(b.x)], 1u);
            asm volatile("s_waitcnt vmcnt(0)" ::: "memory");
        } else {
            XB_SPIN(xb_ld(&bar[XB_XGEN(b.x)]) == gen, bar);
            __builtin_amdgcn_fence(__ATOMIC_ACQUIRE, "agent");
            asm volatile("s_waitcnt vmcnt(0)" ::: "memory");
        }
    }
    __syncthreads();
}

#ifndef PHASE_MASK
#define PHASE_MASK 0x3FF
#endif
#ifndef PROBE_DUP
#define PROBE_DUP 0
#endif
#define GBAR() xcd_barrier(xbar)
#define RUNPH(bit, call, dupcall) do { if (PHASE_MASK & (bit)) { if (PROBE_DUP & (bit)) { dupcall; GBAR(); } call; GBAR(); } } while (0)
__global__ void __launch_bounds__(NTHR, 2) k_mega(Params p) {
    extern __shared__ __attribute__((aligned(16))) unsigned char lds[];
    cg::grid_group grid = cg::this_grid();
    volatile LAS unsigned* xst = (volatile LAS unsigned*)((LAS unsigned char*)lds + LDS_BYTES);
    if (threadIdx.x < 4) xst[threadIdx.x] = 0u;
    __syncthreads();
    XcdBarrier xbar = xcd_barrier_post((unsigned*)(p.ws + OFF_CTL), xst);
    if (PHASE_MASK & 1) { if (PROBE_DUP & 1) { phase_conv(p, lds, true); GBAR(); } phase_conv(p, lds); grid.sync(); }
    RUNPH(2, phase_norm_mod(p, p.x, p.g_norm1, 0, 1, (bf16_t*)(p.ws + OFF_A)), phase_norm_mod(p, p.x, p.g_norm1, 0, 1, (bf16_t*)(p.ws + OFF_A)));
    RUNPH(4, phase_gemm1(p, lds), phase_gemm1(p, lds));
    RUNPH(8, (phase_attn(p, lds), phase_sgu(p, lds)), (phase_attn(p, lds), phase_sgu(p, lds)));
    RUNPH(16, phase_combine(p), phase_combine(p));
    RUNPH(32, phase_gemm2(p, lds), phase_gemm2(p, lds));
    RUNPH(64, phase_norm_mod(p, p.out, p.g_norm2, 3, 4, (bf16_t*)(p.ws + OFF_A)), phase_norm_mod(p, p.out, p.g_norm2, 3, 4, (bf16_t*)(p.ws + OFF_A)));
    RUNPH(128, phase_gemm3(p, lds), phase_gemm3(p, lds));
    RUNPH(256, phase_topk(p, lds), phase_topk(p, lds));
    if (PHASE_MASK & 512) {
        phase_peer_sliced<0>(p, xbar.x); GBAR();
        phase_peer_w(p); GBAR();
        phase_peer_sliced<1>(p, xbar.x); GBAR();
        phase_peer_final(p);
    }
}

#ifndef MEGA
#define MEGA 1
#endif
extern "C" void kernel_launch(void* const* d_in, const int* in_sizes, int n_in, void* d_out, int out_size, void* d_ws, size_t ws_size, hipStream_t stream) {
    if (n_in != 20 || out_size != T * D || ws_size < WS_END) { fprintf(stderr, "kernel_launch: unexpected problem (n_in %d out %d ws %zu, need %zu)\n", n_in, out_size, ws_size, (size_t)WS_END); return; }
    Params p{};
    p.x = (const float*)d_in[0]; p.c = (const float*)d_in[1]; p.pos = (const int*)d_in[2]; p.w_ada = (const float*)d_in[3]; p.b_ada = (const float*)d_in[4];
    p.g_norm1 = (const float*)d_in[5]; p.w_in = (const float*)d_in[6]; p.g_attn_out = (const float*)d_in[7]; p.g_sgu_out = (const float*)d_in[8];
    p.sgu_w = (const float*)d_in[9]; p.sgu_b = (const float*)d_in[10]; p.sgu_ln_g = (const float*)d_in[11]; p.sgu_ln_b = (const float*)d_in[12];
    p.w_out = (const float*)d_in[13]; p.g_norm2 = (const float*)d_in[14]; p.peer_w_q = (const float*)d_in[15]; p.peer_sub_keys = (const float*)d_in[16];
    p.peer_u = (const float*)d_in[17]; p.peer_v = (const float*)d_in[18]; p.g_final = (const float*)d_in[19];
    p.out = (float*)d_out; p.ws = (unsigned char*)d_ws;
    (void)hipMemsetAsync((char*)d_ws + OFF_CTL, 0, OFF_SGUW - OFF_CTL, stream);
#if MEGA
    static int grid_blocks = 0;
    if (!grid_blocks) {
        int dev = 0, cus = 0, per_cu = 0;
        (void)hipGetDevice(&dev); (void)hipDeviceGetAttribute(&cus, hipDeviceAttributeMultiprocessorCount, dev);
        (void)hipFuncSetAttribute((const void*)k_mega, hipFuncAttributeMaxDynamicSharedMemorySize, LDS_BYTES + 16);
        (void)hipOccupancyMaxActiveBlocksPerMultiprocessor(&per_cu, (const void*)k_mega, NTHR, LDS_BYTES + 16);
        if (per_cu < 1) { fprintf(stderr, "kernel_launch: occupancy query says %d blocks per CU\n", per_cu); per_cu = 1; }
        if (per_cu > 1) per_cu = 1;
        grid_blocks = cus * per_cu;
    }
    void* args[] = {(void*)&p};
    hipError_t e = hipLaunchCooperativeKernel((const void*)k_mega, dim3(grid_blocks), dim3(NTHR), args, LDS_BYTES + 16, stream);
    if (e != hipSuccess) fprintf(stderr, "cooperative launch failed: %s (grid %d)\n", hipGetErrorString(e), grid_blocks);
#endif
}
```

```cpp
#include <hip/hip_runtime.h>
#include <hip/hip_cooperative_groups.h>
#include <cstdio>
#include <cstdint>
namespace cg = cooperative_groups;

constexpr int D = 2048, NB = 4, S = 4096, T = NB * S;
constexpr int E = 128, HA = 12, HS = 4, DA = 1536, DS = 512, DIN = 5632;
constexpr int PH = 8, PK = 16, NEXP = 16384;
constexpr int NTHR = 512, NWV = 8;

typedef unsigned short bf16_t;
typedef unsigned u32x4 __attribute__((ext_vector_type(4)));
typedef unsigned u32x2 __attribute__((ext_vector_type(2)));
typedef float f32x4 __attribute__((ext_vector_type(4)));

__device__ __forceinline__ bf16_t f2bf(float f) { unsigned u = __float_as_uint(f); u += 0x7FFFu + ((u >> 16) & 1u); return (bf16_t)(u >> 16); }
__device__ __forceinline__ float bf2f(bf16_t b) { return __uint_as_float(((unsigned)b) << 16); }
__device__ __forceinline__ unsigned pack2(float lo, float hi) { return (unsigned)f2bf(lo) | ((unsigned)f2bf(hi) << 16); }
__device__ __forceinline__ float bflo(unsigned w) { return __uint_as_float(w << 16); }
__device__ __forceinline__ float bfhi(unsigned w) { return __uint_as_float(w & 0xffff0000u); }
__device__ __forceinline__ float wave_sum(float v) {
#pragma unroll
    for (int o = 32; o >= 1; o >>= 1) v += __shfl_xor(v, o);
    return v; }
__device__ __forceinline__ float wave_max(float v) {
#pragma unroll
    for (int o = 32; o >= 1; o >>= 1) v = fmaxf(v, __shfl_xor(v, o));
    return v; }
__device__ __forceinline__ int wave_min_i(int v) {
#pragma unroll
    for (int o = 32; o >= 1; o >>= 1) v = min(v, __shfl_xor(v, o));
    return v; }
__device__ __forceinline__ float gelu_erf(float v) { return 0.5f * v * (1.0f + erff(v * 0.70710678118654752f)); }

constexpr size_t OFF_CTL  = 0;
constexpr size_t OFF_MOD  = 65536;
constexpr size_t OFF_SGUW = OFF_MOD + 393216;
constexpr size_t OFF_SUBK = OFF_SGUW + 131072;
constexpr size_t OFF_LSE  = OFF_SUBK + 524288;
constexpr size_t OFF_IDX  = OFF_LSE + (size_t)3 * T * 12 * 4;
constexpr size_t OFF_GATE = OFF_IDX + (size_t)T * 128 * 4;
constexpr size_t OFF_WIN  = OFF_GATE + (size_t)T * 128 * 4;
constexpr size_t OFF_WOUT = OFF_WIN + (size_t)DIN * D * 2;
constexpr size_t OFF_WQ   = OFF_WOUT + (size_t)D * D * 2;
constexpr size_t OFF_UTAB = OFF_WQ + (size_t)D * D * 2;
constexpr size_t TAB8_BYTES = (size_t)NEXP * D;
constexpr size_t SLICE_BYTES = (size_t)NEXP * 128;
constexpr size_t OFF_QUEUE = 32768;
constexpr size_t OFF_VTAB = OFF_UTAB + (size_t)NEXP * D * 2;
constexpr size_t OFF_A    = OFF_VTAB + (size_t)NEXP * D * 2;
constexpr size_t OFF_QKV  = OFF_A + (size_t)T * D * 2;
constexpr size_t QKV_ONE  = (size_t)T * DA * 2;
constexpr size_t OFF_US   = OFF_QKV + 3 * QKV_ONE;
constexpr size_t OFF_VS   = OFF_US + (size_t)T * DS * 2;
constexpr size_t OFF_SGUO = OFF_VS + (size_t)T * DS * 2;
constexpr size_t OFF_O12  = OFF_SGUO + (size_t)T * DS * 2;
constexpr size_t WS_END   = OFF_O12 + 2 * QKV_ONE;

struct Params {
    const float* x; const float* c; const int* pos; const float* w_ada; const float* b_ada; const float* g_norm1; const float* w_in;
    const float* g_attn_out; const float* g_sgu_out; const float* sgu_w; const float* sgu_b; const float* sgu_ln_g; const float* sgu_ln_b;
    const float* w_out; const float* g_norm2; const float* peer_w_q; const float* peer_sub_keys; const float* peer_u; const float* peer_v;
    const float* g_final; float* out; unsigned char* ws;
};
__device__ __forceinline__ float fx2f(long long v) { return (float)(int)(v >> 32) + (float)(unsigned)v * 2.3283064365386963e-10f; }
__device__ __forceinline__ float mod1(const Params& p, int b, int i, int col) { return fx2f(((const long long*)(p.ws + OFF_MOD))[b * 12288 + i * D + col]); }
__device__ __forceinline__ float4 mod4q(const long long* mp) { return make_float4(fx2f(mp[0]), fx2f(mp[1]), fx2f(mp[2]), fx2f(mp[3])); }
__device__ __forceinline__ float4 mod4(const Params& p, int b, int i, int col) { return mod4q((const long long*)(p.ws + OFF_MOD) + b * 12288 + i * D + col); }
__device__ __forceinline__ bf16_t* P_opat(const Params& p, int pat) { return (bf16_t*)(pat == 0 ? p.ws + OFF_A : p.ws + OFF_O12 + (size_t)(pat - 1) * QKV_ONE); }

namespace pg8 {
#define PG8_LAS __attribute__((address_space(3)))
typedef unsigned short bf16_t;
typedef short bf16x8 __attribute__((ext_vector_type(8)));
typedef float f32x4 __attribute__((ext_vector_type(4)));
typedef unsigned u32x4 __attribute__((ext_vector_type(4)));
constexpr int BM = 256, BK = 64, HALF = 128, HTB = HALF * BK * 2  , STAGE_BYTES = 8 * HTB, NXCD = 8, WGM = 8;

__host__ __device__ __forceinline__ int lds_byte(int r, int c) { const int st = (r >> 4) * 2 + (c >> 5), rr = r & 15, cc = c & 31, ob = rr * 64 + cc * 2; return st * 1024 + (ob ^ (((ob >> 9) & 1) << 5)); }
__host__ __device__ __forceinline__ void stage_rc(int b, int& R, int& C) { const int st = b / 1024, sb = b % 1024, swz = sb ^ (((sb >> 9) & 1) << 5); R = (st >> 1) * 16 + swz / 64; C = (st & 1) * 32 + (swz % 64) / 2; }
__host__ __device__ __forceinline__ int perm32(int rho) { const int n = rho >> 4, i = rho & 15; return 8 * (i >> 2) + 4 * n + (i & 3); }

struct Unit { int pm, pn; };
struct Gemm { const bf16_t* A; const bf16_t* Bt; int M, N, K; };

struct StaticOrder {
    int nM, nN, nwg, G, c;
    __host__ __device__ void init(int M, int N, int G_, int c_) { nM = M / BM; nN = N / BM; nwg = nM * nN; G = G_; c = c_; }
    __host__ __device__ bool next(int i, Unit& u) const {
        const long L = (long)i * G + c; if (L >= nwg) return false;
        int wgid = (int)L; { const int q = nwg / NXCD, r = nwg % NXCD, xcd = wgid % NXCD, off = wgid / NXCD; wgid = (xcd < r ? xcd * (q + 1) : r * (q + 1) + (xcd - r) * q) + off; }
        const int nig = WGM * nN, gid = wgid / nig, fm = gid * WGM, gsz = (nM - fm) < WGM ? (nM - fm) : WGM;
        u.pm = fm + ((wgid % nig) % gsz); u.pn = (wgid % nig) / gsz; return true;
    }
    __device__ __forceinline__ void a_ready(const Unit&) const {}
    __device__ __forceinline__ void done(const Unit&) const {}
};

__device__ __forceinline__ unsigned cvt_pk_bf16(float lo, float hi) { unsigned r; asm volatile("v_cvt_pk_bf16_f32 %0, %1, %2" : "=v"(r) : "v"(lo), "v"(hi)); return r; }
typedef float f32x2 __attribute__((ext_vector_type(2)));
__device__ __forceinline__ f32x2 gelu_pk(f32x2 v) {
    const f32x2 av = __builtin_elementwise_abs(v), d = av * 0.2316418882f + 1.0f;
    f32x2 t; t.x = __builtin_amdgcn_rcpf(d.x); t.y = __builtin_amdgcn_rcpf(d.y);
    f32x2 q = t * 0.5307027145f + (-0.7265760135f); q = q * t + 0.7107068705f; q = q * t + (-0.142248368f); q = q * t + 0.127414796f; q = q * t;
    const f32x2 s = (v * v) * (-0.72134752044f);
    f32x2 e; e.x = __builtin_amdgcn_exp2f(s.x); e.y = __builtin_amdgcn_exp2f(s.y);
    const f32x2 m = v * (q * e), r = v - m;
    f32x2 o; o.x = v.x < 0.f ? m.x : r.x; o.y = v.y < 0.f ? m.y : r.y; return o;
}

template <class Epi, class Sched, bool ALIGN_EPI = false, bool SP2 = false>
__device__ __forceinline__ void gemm_phase(PG8_LAS unsigned char* lds, const Gemm g, const Sched& S, const Epi& E) {
    const int tid = threadIdx.x, wid = __builtin_amdgcn_readfirstlane(tid >> 6), lane = tid & 63, wr = wid >> 2, wc = wid & 3, fr = lane & 15, fq = lane >> 4;
    const int K = g.K, nt = K / BK;
    unsigned voffA[2], voffB[2];
#pragma unroll
    for (int i = 0; i < 2; ++i) { int R, C; stage_rc(tid * 16 + i * 8192, R, C); const int Rb = Epi::PERM ? ((R & ~31) + perm32(R & 31)) : R;
        voffA[i] = (unsigned)(R * K + C) * 2u; voffB[i] = (unsigned)(Rb * K + C) * 2u; }
    const size_t kstep = (size_t)(BK * 2);
    const size_t hstep = (size_t)HALF * K * 2;
    const size_t tstep = 2 * hstep;
    const unsigned ldsw = (unsigned)wid * 1024u;
    const int aoff = lds_byte(wr * 64 + fr, fq * 8), boff = lds_byte(wc * 32 + fr, fq * 8);
#define PG8_SA(b, h) (((b) * 2 + (h)) * HTB)
#define PG8_SB(b, h) ((4 + (b) * 2 + (h)) * HTB)
#define PG8_STAGE(bufoff, gbase, voff) do { _Pragma("unroll") for (int _i = 0; _i < 2; ++_i) \
        __builtin_amdgcn_global_load_lds((const unsigned*)((const char*)(gbase) + (voff)[_i]), (PG8_LAS unsigned*)(lds + (bufoff) + ldsw + _i * 8192), 16, 0, 0); } while (0)
#define PG8_LDA(dst, b, h) do { _Pragma("unroll") for (int m = 0; m < 4; ++m) _Pragma("unroll") for (int k = 0; k < 2; ++k) dst[m][k] = *(const PG8_LAS bf16x8*)(lds + PG8_SA(b, h) + aoff + m * 2048 + k * 1024); } while (0)
#define PG8_LDB(dst, b, h) do { _Pragma("unroll") for (int n = 0; n < 2; ++n) _Pragma("unroll") for (int k = 0; k < 2; ++k) dst[n][k] = *(const PG8_LAS bf16x8*)(lds + PG8_SB(b, h) + boff + n * 2048 + k * 1024); } while (0)
#define PG8_MMA(ai, bj, At, Bt) do { __builtin_amdgcn_s_setprio(1); _Pragma("unroll") for (int m = 0; m < 4; ++m) _Pragma("unroll") for (int n = 0; n < 2; ++n) _Pragma("unroll") for (int k = 0; k < 2; ++k) \
        acc[ai][bj][m][n] = __builtin_amdgcn_mfma_f32_16x16x32_bf16(Bt[n][k], At[m][k], acc[ai][bj][m][n], 0, 0, 0); __builtin_amdgcn_s_setprio(0); } while (0)
#define PG8_WAIT_V(n) asm volatile("s_waitcnt vmcnt(" #n ")" ::: "memory")
#define PG8_WAIT_L(n) asm volatile("s_waitcnt lgkmcnt(" #n ")" ::: "memory")
#define PG8_BAR __builtin_amdgcn_s_barrier()
#define PG8_SCHED __builtin_amdgcn_sched_barrier(0)
    Unit cur, nxt; int ui = 0;
    if (!S.next(0, cur)) return;
    f32x4 acc[2][2][4][2];
#pragma unroll
    for (int a = 0; a < 2; ++a)
#pragma unroll
        for (int b = 0; b < 2; ++b)
#pragma unroll
            for (int m = 0; m < 4; ++m)
#pragma unroll
                for (int n = 0; n < 2; ++n) acc[a][b][m][n] = (f32x4){0.f, 0.f, 0.f, 0.f};
    bf16x8 At[4][2], B0[2][2], B1[2][2];
    const char* cA = (const char*)g.A + (size_t)cur.pm * tstep; const char* cB = (const char*)g.Bt + (size_t)cur.pn * tstep;
    S.a_ready(cur);
    if constexpr (SP2) {
        PG8_STAGE(PG8_SB(0, 0), cB, voffB); PG8_STAGE(PG8_SB(0, 1), cB + hstep, voffB); PG8_STAGE(PG8_SA(0, 0), cA, voffA); PG8_STAGE(PG8_SA(0, 1), cA + hstep, voffA);
        if (wr == 1) PG8_BAR;
        PG8_WAIT_V(2); PG8_BAR;
        PG8_STAGE(PG8_SB(1, 0), cB + kstep, voffB); PG8_STAGE(PG8_SA(1, 0), cA + kstep, voffA); PG8_STAGE(PG8_SB(1, 1), cB + hstep + kstep, voffB);
        PG8_WAIT_V(6); PG8_BAR;
    } else {
        PG8_STAGE(PG8_SB(0, 0), cB, voffB); PG8_STAGE(PG8_SA(0, 0), cA, voffA); PG8_STAGE(PG8_SB(0, 1), cB + hstep, voffB); PG8_STAGE(PG8_SA(0, 1), cA + hstep, voffA);
        if (wr == 1) PG8_BAR;
        PG8_WAIT_V(4); PG8_BAR;
        PG8_STAGE(PG8_SB(1, 0), cB + kstep, voffB); PG8_STAGE(PG8_SA(1, 0), cA + kstep, voffA); PG8_STAGE(PG8_SB(1, 1), cB + hstep + kstep, voffB);
        PG8_WAIT_V(6); PG8_BAR;
    }
    for (;;) {
        const bool has_next = S.next(ui + 1, nxt);
        const char* nA = has_next ? (const char*)g.A + (size_t)nxt.pm * tstep : cA; const char* nB = has_next ? (const char*)g.Bt + (size_t)nxt.pn * tstep : cB;
        for (int t = 0; t < nt; t += 2) {
            const bool last = (t == nt - 2);
            const char* a1 = cA + (size_t)(t + 1) * kstep;
            const char* a2 = last ? nA : cA + (size_t)(t + 2) * kstep; const char* b2 = last ? nB : cB + (size_t)(t + 2) * kstep;
            const char* a3 = a2 + kstep; const char* b3 = b2 + kstep;
            if (last && has_next) S.a_ready(nxt);
            if constexpr (SP2) {
            PG8_LDB(B0, 0, 0); PG8_LDB(B1, 0, 1); PG8_SCHED; PG8_LDA(At, 0, 0); PG8_STAGE(PG8_SA(1, 1), a1 + hstep, voffA);
            PG8_WAIT_V(8); PG8_WAIT_L(0); PG8_BAR; PG8_MMA(0, 0, At, B0); PG8_MMA(0, 1, At, B1); PG8_BAR; PG8_SCHED;
            PG8_LDA(At, 0, 1); PG8_STAGE(PG8_SB(0, 0), b2, voffB); PG8_STAGE(PG8_SB(0, 1), b2 + hstep, voffB); PG8_STAGE(PG8_SA(0, 0), a2, voffA);
            PG8_WAIT_V(8); PG8_WAIT_L(0); PG8_BAR; PG8_MMA(1, 0, At, B0); PG8_MMA(1, 1, At, B1); PG8_BAR; PG8_SCHED;
            PG8_LDB(B0, 1, 0); PG8_LDB(B1, 1, 1); PG8_SCHED; PG8_LDA(At, 1, 0); PG8_STAGE(PG8_SA(0, 1), a2 + hstep, voffA);
            PG8_WAIT_V(8); PG8_WAIT_L(0); PG8_BAR; PG8_MMA(0, 0, At, B0); PG8_MMA(0, 1, At, B1); PG8_BAR; PG8_SCHED;
            PG8_LDA(At, 1, 1); PG8_STAGE(PG8_SB(1, 0), b3, voffB); PG8_STAGE(PG8_SB(1, 1), b3 + hstep, voffB); PG8_STAGE(PG8_SA(1, 0), a3, voffA);
            PG8_WAIT_V(8); PG8_WAIT_L(0); PG8_BAR; PG8_MMA(1, 0, At, B0); PG8_MMA(1, 1, At, B1); PG8_BAR; PG8_SCHED;
            } else {
            PG8_LDB(B0, 0, 0); PG8_SCHED; PG8_LDA(At, 0, 0); PG8_STAGE(PG8_SA(1, 1), a1 + hstep, voffA);
            PG8_WAIT_L(8); PG8_BAR; PG8_WAIT_L(0); PG8_MMA(0, 0, At, B0); PG8_BAR; PG8_SCHED;
            PG8_LDB(B1, 0, 1); PG8_STAGE(PG8_SB(0, 0), b2, voffB);
            PG8_BAR; PG8_WAIT_L(0); PG8_MMA(0, 1, At, B1); PG8_BAR;
            PG8_LDA(At, 0, 1); PG8_STAGE(PG8_SA(0, 0), a2, voffA);
            PG8_BAR; PG8_WAIT_L(0); PG8_MMA(1, 0, At, B0); PG8_BAR; PG8_SCHED;
            PG8_STAGE(PG8_SB(0, 1), b2 + hstep, voffB);
            PG8_WAIT_V(6); PG8_BAR; PG8_MMA(1, 1, At, B1); PG8_BAR;
            PG8_LDB(B0, 1, 0); PG8_SCHED; PG8_LDA(At, 1, 0); PG8_STAGE(PG8_SA(0, 1), a2 + hstep, voffA);
            PG8_WAIT_L(8); PG8_BAR; PG8_WAIT_L(0); PG8_MMA(0, 0, At, B0); PG8_BAR; PG8_SCHED;
            PG8_LDB(B1, 1, 1); PG8_STAGE(PG8_SB(1, 0), b3, voffB);
            PG8_BAR; PG8_WAIT_L(0); PG8_MMA(0, 1, At, B1); PG8_BAR;
            PG8_LDA(At, 1, 1); PG8_STAGE(PG8_SA(1, 0), a3, voffA);
            PG8_BAR; PG8_WAIT_L(0); PG8_MMA(1, 0, At, B0); PG8_BAR; PG8_SCHED;
            PG8_STAGE(PG8_SB(1, 1), b3 + hstep, voffB);
            PG8_WAIT_V(6); PG8_BAR; PG8_MMA(1, 1, At, B1); PG8_BAR;
            }
        }
        if constexpr (ALIGN_EPI) { if (wr == 0) PG8_BAR; }
        if constexpr (!Epi::AFTER_DRAIN) { E(acc, cur, wr, wc, fr, fq); S.done(cur); }
        if (!has_next) break;
#pragma unroll
        for (int a = 0; a < 2; ++a)
#pragma unroll
            for (int b = 0; b < 2; ++b)
#pragma unroll
                for (int m = 0; m < 4; ++m)
#pragma unroll
                    for (int n = 0; n < 2; ++n) acc[a][b][m][n] = (f32x4){0.f, 0.f, 0.f, 0.f};
        cur = nxt; cA = nA; cB = nB; ++ui;
        if constexpr (ALIGN_EPI) { if (wr == 1) PG8_BAR; }
    }
    PG8_WAIT_V(0);
    if constexpr (!ALIGN_EPI) { if (wr == 0) PG8_BAR; }
    PG8_BAR;
    if constexpr (Epi::AFTER_DRAIN) { E.fused(acc, cur, wr, wc, fr, fq, lds, wid, lane); S.done(cur); }
#undef PG8_SA
#undef PG8_SB
#undef PG8_STAGE
#undef PG8_LDA
#undef PG8_LDB
#undef PG8_MMA
#undef PG8_WAIT_V
#undef PG8_WAIT_L
#undef PG8_BAR
#undef PG8_SCHED
}

struct EpiProj {
    static constexpr bool PERM = true, AFTER_DRAIN = false;
    bf16_t* q; bf16_t* k; bf16_t* v; bf16_t* us; bf16_t* vs; const int* pos;
    __device__ __forceinline__ void operator()(const f32x4 (&acc)[2][2][4][2], const Unit& u, int wr, int wc, int fr, int fq) const {
        const int row0 = u.pm * BM + wr * 64 + fr, b = u.pm >> 4;
        if (u.pn < 12) {
            const bool isq = u.pn < 6; bf16_t* base = isq ? q : k;
            const int hh = 2 * (isq ? u.pn : u.pn - 6) + (wc >> 1), e0 = 32 * (wc & 1) + 8 * fq;
            const float qs = isq ? 0.08838834764831845f : 1.0f;
            float ir[8];
#pragma unroll
            for (int j = 0; j < 8; ++j) ir[j] = exp2f(-(float)(e0 + j) * (13.287712379549449f / 64.0f)) * 0.15915494309189535f;
#pragma unroll
            for (int ai = 0; ai < 2; ++ai)
#pragma unroll
                for (int m = 0; m < 4; ++m) {
                    const int t = row0 + ai * HALF + m * 16, s = t & 4095;
                    const float pf = (float)pos[t];
                    float o0[8], o1[8];
#pragma unroll
                    for (int n = 0; n < 2; ++n)
#pragma unroll
                        for (int i = 0; i < 4; ++i) { const int j = 4 * n + i;
                            const float f = __builtin_amdgcn_fractf(pf * ir[j]); const float sn = __builtin_amdgcn_sinf(f), cs = __builtin_amdgcn_cosf(f);
                            const float t1 = acc[ai][0][m][n][i], t2 = acc[ai][1][m][n][i];
                            o0[j] = (t1 * cs - t2 * sn) * qs; o1[j] = (t2 * cs + t1 * sn) * qs; }
                    bf16_t* dst = base + ((size_t)(b * 12 + hh) * 4096 + s) * 128 + e0;
                    u32x4 w0, w1;
                    w0.x = cvt_pk_bf16(o0[0], o0[1]); w0.y = cvt_pk_bf16(o0[2], o0[3]); w0.z = cvt_pk_bf16(o0[4], o0[5]); w0.w = cvt_pk_bf16(o0[6], o0[7]);
                    w1.x = cvt_pk_bf16(o1[0], o1[1]); w1.y = cvt_pk_bf16(o1[2], o1[3]); w1.z = cvt_pk_bf16(o1[4], o1[5]); w1.w = cvt_pk_bf16(o1[6], o1[7]);
                    *(u32x4*)dst = w0; *(u32x4*)(dst + 64) = w1; }
        } else if (u.pn < 18) {
            const int e0 = 32 * wc + 8 * fq;
#pragma unroll
            for (int ai = 0; ai < 2; ++ai)
#pragma unroll
                for (int m = 0; m < 4; ++m) { const int t = row0 + ai * HALF + m * 16, s = t & 4095;
#pragma unroll
                    for (int bj = 0; bj < 2; ++bj) { const int hh = 2 * (u.pn - 12) + bj; const f32x4 v0 = acc[ai][bj][m][0], v1 = acc[ai][bj][m][1];
                        u32x4 w; w.x = cvt_pk_bf16(v0[0], v0[1]); w.y = cvt_pk_bf16(v0[2], v0[3]); w.z = cvt_pk_bf16(v1[0], v1[1]); w.w = cvt_pk_bf16(v1[2], v1[3]);
                        *(u32x4*)(v + ((size_t)(b * 12 + hh) * 4096 + s) * 128 + e0) = w; } }
        } else {
            bf16_t* base = u.pn < 20 ? us : vs; const int c0 = 256 * ((u.pn - 18) & 1) + 32 * wc + 8 * fq;
#pragma unroll
            for (int ai = 0; ai < 2; ++ai)
#pragma unroll
                for (int m = 0; m < 4; ++m) { const int t = row0 + ai * HALF + m * 16;
#pragma unroll
                    for (int bj = 0; bj < 2; ++bj) { const f32x4 v0 = acc[ai][bj][m][0], v1 = acc[ai][bj][m][1];
                        const f32x2 a = gelu_pk((f32x2){v0[0], v0[1]}), bb = gelu_pk((f32x2){v0[2], v0[3]}), c = gelu_pk((f32x2){v1[0], v1[1]}), d = gelu_pk((f32x2){v1[2], v1[3]});
                        u32x4 w; w.x = cvt_pk_bf16(a.x, a.y); w.y = cvt_pk_bf16(bb.x, bb.y); w.z = cvt_pk_bf16(c.x, c.y); w.w = cvt_pk_bf16(d.x, d.y);
                        *(u32x4*)(base + (size_t)t * 512 + c0 + 128 * bj) = w; } }
        }
    }
};
struct EpiRes {
    static constexpr bool PERM = false, AFTER_DRAIN = false;
    const float* x; float* out; const long long* modq;
    __device__ __forceinline__ void operator()(const f32x4 (&acc)[2][2][4][2], const Unit& u, int wr, int wc, int fr, int fq) const {
        const int row0 = u.pm * BM + wr * 64 + fr, col0 = u.pn * BM + wc * 32 + 4 * fq, b = u.pm >> 4;
        f32x4 gt[2][2];
#pragma unroll
        for (int bj = 0; bj < 2; ++bj)
#pragma unroll
            for (int n = 0; n < 2; ++n) { const long long* mp = modq + b * 12288 + 2 * 2048 + col0 + bj * HALF + n * 16;
#pragma unroll
                for (int i = 0; i < 4; ++i) gt[bj][n][i] = (float)(int)(mp[i] >> 32) + (float)(unsigned)mp[i] * 2.3283064365386963e-10f; }
#pragma unroll
        for (int ai = 0; ai < 2; ++ai)
#pragma unroll
            for (int m = 0; m < 4; ++m) { const size_t off = (size_t)(row0 + ai * HALF + m * 16) * 2048 + col0;
#pragma unroll
                for (int bj = 0; bj < 2; ++bj)
#pragma unroll
                    for (int n = 0; n < 2; ++n) { const f32x4 xv = *(const f32x4*)(x + off + bj * HALF + n * 16); *(f32x4*)(out + off + bj * HALF + n * 16) = xv + gt[bj][n] * acc[ai][bj][m][n]; } }
    }
};
struct EpiPq {
    static constexpr bool PERM = true, AFTER_DRAIN = false;
    bf16_t* o;
    __device__ __forceinline__ void operator()(const f32x4 (&acc)[2][2][4][2], const Unit& u, int wr, int wc, int fr, int fq) const {
        const int row0 = u.pm * BM + wr * 64 + fr, col0 = u.pn * BM + wc * 32 + 8 * fq;
#pragma unroll
        for (int ai = 0; ai < 2; ++ai)
#pragma unroll
            for (int m = 0; m < 4; ++m) { bf16_t* rowp = o + (size_t)(row0 + ai * HALF + m * 16) * 2048 + col0;
#pragma unroll
                for (int bj = 0; bj < 2; ++bj) { const f32x4 v0 = acc[ai][bj][m][0], v1 = acc[ai][bj][m][1];
                    u32x4 w; w.x = cvt_pk_bf16(v0[0], v0[1]); w.y = cvt_pk_bf16(v0[2], v0[3]); w.z = cvt_pk_bf16(v1[0], v1[1]); w.w = cvt_pk_bf16(v1[2], v1[3]);
                    *(u32x4*)(rowp + bj * HALF) = w; } }
    }
};
}

__device__ __forceinline__ void phase_gemm1(const Params& p, unsigned char* lds) {
    pg8::Gemm g{(const bf16_t*)(p.ws + OFF_A), (const bf16_t*)(p.ws + OFF_WIN), T, DIN, D};
    pg8::StaticOrder So; So.init(T, DIN, (int)gridDim.x, (int)blockIdx.x);
    pg8::EpiProj Ep{(bf16_t*)(p.ws + OFF_QKV), (bf16_t*)(p.ws + OFF_QKV + QKV_ONE), (bf16_t*)(p.ws + OFF_QKV + 2 * QKV_ONE), (bf16_t*)(p.ws + OFF_US), (bf16_t*)(p.ws + OFF_VS), p.pos};
    pg8::gemm_phase<pg8::EpiProj, pg8::StaticOrder, true, true>((PG8_LAS unsigned char*)lds, g, So, Ep);
}
__device__ __forceinline__ void phase_gemm2(const Params& p, unsigned char* lds) {
    pg8::Gemm g{(const bf16_t*)(p.ws + OFF_QKV), (const bf16_t*)(p.ws + OFF_WOUT), T, D, D};
    pg8::StaticOrder So; So.init(T, D, (int)gridDim.x, (int)blockIdx.x);
    pg8::EpiRes Ep{p.x, p.out, (const long long*)(p.ws + OFF_MOD)};
    pg8::gemm_phase<pg8::EpiRes, pg8::StaticOrder, true, true>((PG8_LAS unsigned char*)lds, g, So, Ep);
}
__device__ __forceinline__ void phase_gemm3(const Params& p, unsigned char* lds) {
    pg8::Gemm g{(const bf16_t*)(p.ws + OFF_A), (const bf16_t*)(p.ws + OFF_WQ), T, D, D};
    pg8::StaticOrder So; So.init(T, D, (int)gridDim.x, (int)blockIdx.x);
    pg8::EpiPq Ep{(bf16_t*)(p.ws + OFF_QKV + (size_t)T * D * 2)};
    pg8::gemm_phase<pg8::EpiPq, pg8::StaticOrder, true, true>((PG8_LAS unsigned char*)lds, g, So, Ep);
}

__device__ __forceinline__ void conv_transpose(const float* __restrict__ W, int N, bf16_t* __restrict__ WT, int perm_limit, float* tile, int bid, int nblk, int tid) {
    const int ntiles = 32 * (N / 64);
    for (int tI = bid; tI < ntiles; tI += nblk) {
        const int tk = tI & 31, tn = tI >> 5, k0 = tk * 64, n0 = tn * 64;
        int l0 = n0;
        if (n0 < perm_limit) { const int base = n0 & ~255, pb = (n0 >> 6) & 3, bj = pb >> 1, qhi = pb & 1; l0 = base + 64 * bj + 128 * qhi; }
        __syncthreads();
#pragma unroll
        for (int pass = 0; pass < 2; ++pass) { const int r = pass * 32 + (tid >> 4), c4 = (tid & 15) * 4;
            const float4 v = *(const float4*)(W + (size_t)(k0 + r) * N + l0 + c4);
            tile[r * 65 + c4 + 0] = v.x; tile[r * 65 + c4 + 1] = v.y; tile[r * 65 + c4 + 2] = v.z; tile[r * 65 + c4 + 3] = v.w; }
        __syncthreads();
        const int n = tid >> 3, kq = (tid & 7) * 8;
        u32x4 w;
        w.x = pack2(tile[(kq + 0) * 65 + n], tile[(kq + 1) * 65 + n]); w.y = pack2(tile[(kq + 2) * 65 + n], tile[(kq + 3) * 65 + n]);
        w.z = pack2(tile[(kq + 4) * 65 + n], tile[(kq + 5) * 65 + n]); w.w = pack2(tile[(kq + 6) * 65 + n], tile[(kq + 7) * 65 + n]);
        *(u32x4*)(WT + (size_t)(n0 + n) * D + k0 + kq) = w;
    }
}
__device__ __forceinline__ void conv_flat(const float* __restrict__ src, bf16_t* __restrict__ dst, size_t n8, int bid, int nblk, int tid) {
    for (size_t i = (size_t)bid * NTHR + tid; i < n8; i += (size_t)nblk * NTHR) {
        const float4 a = ((const float4*)src)[2 * i], b = ((const float4*)src)[2 * i + 1];
        u32x4 w; w.x = pack2(a.x, a.y); w.y = pack2(a.z, a.w); w.z = pack2(b.x, b.y); w.w = pack2(b.z, b.w);
        ((u32x4*)dst)[i] = w; }
}
__device__ __forceinline__ unsigned q8pack(float a, float b, float c, float d, int bias) {
    const int qa = (int)rintf(a) + bias, qb = (int)rintf(b) + bias, qc = (int)rintf(c) + bias, qd = (int)rintf(d) + bias;
    return (unsigned)(qa & 255) | ((unsigned)(qb & 255) << 8) | ((unsigned)(qc & 255) << 16) | ((unsigned)(qd & 255) << 24);
}
template <int BIAS> __device__ __forceinline__ void conv_rows_i8(const float* __restrict__ src, unsigned char* __restrict__ dst, float* __restrict__ inv, int bid, int nblk, int tid) {
    const int lane = tid & 63, gw = bid * NWV + (tid >> 6), nw = nblk * NWV;
    for (int r = gw; r < NEXP; r += nw) {
        const float4* row = (const float4*)(src + (size_t)r * D);
        float4 v[8]; float m = 0.f;
#pragma unroll
        for (int i = 0; i < 8; ++i) { v[i] = row[i * 64 + lane]; m = fmaxf(m, fmaxf(fmaxf(fabsf(v[i].x), fabsf(v[i].y)), fmaxf(fabsf(v[i].z), fabsf(v[i].w)))); }
        m = wave_max(m);
        const float sc = m > 0.f ? 127.0f / m : 0.f, isc = m * (1.0f / 127.0f);
        unsigned char* drow = dst + (size_t)(lane >> 5) * SLICE_BYTES + (size_t)r * 128 + (lane & 31) * 4;
#pragma unroll
        for (int i = 0; i < 8; ++i) *(unsigned*)(drow + (size_t)(2 * i) * SLICE_BYTES) = q8pack(v[i].x * sc, v[i].y * sc, v[i].z * sc, v[i].w * sc, BIAS);
        if (lane == 0) inv[r] = isc;
    }
}
__device__ __forceinline__ void phase_conv(const Params& p, unsigned char* lds, bool dup = false) {
    const int tid = threadIdx.x, bid = blockIdx.x, nblk = gridDim.x;
    unsigned long long* mod = (unsigned long long*)(p.ws + OFF_MOD);
    for (int it = bid; it < (dup ? 0 : 768); it += nblk) {
        const int cb = it % 6, kc = it / 6, col = cb * 2048 + tid * 4;
        float acc[4][4];
#pragma unroll
        for (int b = 0; b < 4; ++b) { acc[b][0] = 0.f; acc[b][1] = 0.f; acc[b][2] = 0.f; acc[b][3] = 0.f; }
        for (int kk = 0; kk < 16; ++kk) { const int k = kc * 16 + kk;
            const float4 w = *(const float4*)(p.w_ada + (size_t)k * 12288 + col);
#pragma unroll
            for (int b = 0; b < 4; ++b) { const float cv = p.c[b * D + k]; const float s = cv / (1.f + __expf(-cv));
                acc[b][0] += s * w.x; acc[b][1] += s * w.y; acc[b][2] += s * w.z; acc[b][3] += s * w.w; } }
        if (kc == 0) { const float4 bv = *(const float4*)(p.b_ada + col);
#pragma unroll
            for (int b = 0; b < 4; ++b) { acc[b][0] += bv.x; acc[b][1] += bv.y; acc[b][2] += bv.z; acc[b][3] += bv.w; } }
#pragma unroll
        for (int b = 0; b < 4; ++b)
#pragma unroll
            for (int j = 0; j < 4; ++j) atomicAdd(mod + b * 12288 + col + j, (unsigned long long)__double2ll_rn((double)acc[b][j] * 4294967296.0));
    }
    conv_transpose(p.w_in, DIN, (bf16_t*)(p.ws + OFF_WIN), 3072, (float*)lds, bid, nblk, tid);
    conv_transpose(p.w_out, D, (bf16_t*)(p.ws + OFF_WOUT), 0, (float*)lds, bid, nblk, tid);
    conv_transpose(p.peer_w_q, D, (bf16_t*)(p.ws + OFF_WQ), 0, (float*)lds, bid, nblk, tid);
    conv_rows_i8<0>(p.peer_u, p.ws + OFF_UTAB, (float*)(p.ws + OFF_UTAB + TAB8_BYTES), bid, nblk, tid);
    conv_rows_i8<128>(p.peer_v, p.ws + OFF_VTAB, (float*)(p.ws + OFF_VTAB + TAB8_BYTES), bid, nblk, tid);
    conv_flat(p.peer_sub_keys, (bf16_t*)(p.ws + OFF_SUBK), (size_t)8 * 2 * 128 * 128 / 8, bid, nblk, tid);
    { bf16_t* sw = (bf16_t*)(p.ws + OFF_SGUW);
      for (int i = bid * NTHR + tid; i < 4 * 128 * 128; i += nblk * NTHR) { const int jj = i & 127, ii = (i >> 7) & 127; sw[i] = f2bf(jj <= ii ? p.sgu_w[i] : 0.f); } }
}

template <bool Q8> __device__ __forceinline__ void phase_norm_mod(const Params& p, const float* __restrict__ src, const float* __restrict__ g, int sh_i, int sc_i, bf16_t* __restrict__ dst) {
    const int lane = threadIdx.x & 63, gw = blockIdx.x * NWV + (threadIdx.x >> 6), nw = gridDim.x * NWV;
    for (int t = gw; t < T; t += nw) {
        const float* row = src + (size_t)t * D; const int b = t / S;
        float4 v[8]; float ss = 0.f;
#pragma unroll
        for (int i = 0; i < 8; ++i) { v[i] = *(const float4*)(row + i * 256 + lane * 4); ss += v[i].x * v[i].x + v[i].y * v[i].y + v[i].z * v[i].z + v[i].w * v[i].w; }
        ss = wave_sum(ss); const float rstd = rsqrtf(ss * (1.0f / D) + 1e-6f);
        float m = 0.f;
#pragma unroll
        for (int i = 0; i < 8; ++i) { const int col = i * 256 + lane * 4;
            const float4 gg = *(const float4*)(g + col), sc = mod4(p, b, sc_i, col), sh = mod4(p, b, sh_i, col);
            v[i].x = v[i].x * rstd * gg.x * (1.f + sc.x) + sh.x; v[i].y = v[i].y * rstd * gg.y * (1.f + sc.y) + sh.y; v[i].z = v[i].z * rstd * gg.z * (1.f + sc.z) + sh.z; v[i].w = v[i].w * rstd * gg.w * (1.f + sc.w) + sh.w;
            u32x2 w; w.x = pack2(v[i].x, v[i].y); w.y = pack2(v[i].z, v[i].w);
            *(u32x2*)(dst + (size_t)t * D + col) = w;
            if (Q8) m = fmaxf(m, fmaxf(fmaxf(fabsf(v[i].x), fabsf(v[i].y)), fmaxf(fabsf(v[i].z), fabsf(v[i].w)))); }
        if (Q8) {
            m = wave_max(m); const float sc8 = m > 0.f ? 127.0f / m : 0.f;
            unsigned* x8 = (unsigned*)(p.ws + OFF_US + (size_t)t * D);
#pragma unroll
            for (int i = 0; i < 8; ++i) x8[i * 64 + lane] = q8pack(v[i].x * sc8, v[i].y * sc8, v[i].z * sc8, v[i].w * sc8, 0);
            if (lane == 0) ((float*)(p.ws + OFF_SGUO))[t] = m * (1.0f / 127.0f);
        }
    }
}

#define NAIVE_GEMM_BODY(A_, W_, N_, r0_, c0_)                                                                 \
    float acc[16];                                                                                            \
    _Pragma("unroll") for (int r = 0; r < 16; ++r) acc[r] = 0.f;                                              \
    __syncthreads();                                                                                          \
    { const u32x4* srcA = (const u32x4*)((A_) + (size_t)(r0_) * D); u32x4* dstA = (u32x4*)lds;                  \
      for (int i = tid; i < 16 * D / 8; i += NTHR) dstA[i] = srcA[i]; }                                       \
    __syncthreads();                                                                                          \
    { const unsigned* la = (const unsigned*)lds;                                                              \
      for (int k2 = 0; k2 < D / 2; ++k2) {                                                                    \
          const float w0 = (W_)[(size_t)(2 * k2) * (N_) + (c0_) + tid], w1 = (W_)[(size_t)(2 * k2 + 1) * (N_) + (c0_) + tid]; \
          _Pragma("unroll") for (int r = 0; r < 16; ++r) { const unsigned a = la[r * (D / 2) + k2]; acc[r] += bflo(a) * w0 + bfhi(a) * w1; } } }

__device__ __forceinline__ void phase_gemm1_naive(const Params& p, unsigned char* lds) {
    const int tid = threadIdx.x;
    const bf16_t* A = (const bf16_t*)(p.ws + OFF_A);
    float* xch = (float*)(lds + 65536);
    bf16_t* qb = (bf16_t*)(p.ws + OFF_QKV); bf16_t* kb = (bf16_t*)(p.ws + OFF_QKV + QKV_ONE); bf16_t* vb = (bf16_t*)(p.ws + OFF_QKV + 2 * QKV_ONE);
    bf16_t* usb = (bf16_t*)(p.ws + OFF_US); bf16_t* vsb = (bf16_t*)(p.ws + OFF_VS);
    const int nitems = (T / 16) * (DIN / 512);
    for (int it = blockIdx.x; it < nitems; it += gridDim.x) {
        const int cbk = it % (DIN / 512), rb = it / (DIN / 512), r0 = rb * 16, c0 = cbk * 512;
        NAIVE_GEMM_BODY(A, p.w_in, DIN, r0, c0)
        const int n = c0 + tid;
        if (n < 3072) {
#pragma unroll
            for (int r = 0; r < 16; ++r) xch[r * 512 + tid] = acc[r];
            __syncthreads();
            const int e = n & 127, hh = (n % DA) >> 7; const bool isq = n < DA;
            const int i = e & 63; const float inv = powf(10000.0f, -(float)i / 64.0f);
#pragma unroll
            for (int r = 0; r < 16; ++r) { const int t = r0 + r, b = t / S, s = t % S;
                const float ang = (float)p.pos[t] * inv; const float cs = cosf(ang), sn = sinf(ang);
                const float other = xch[r * 512 + (tid ^ 64)];
                float val = (e < 64) ? (acc[r] * cs - other * sn) : (acc[r] * cs + other * sn);
                if (isq) val *= 0.08838834764831845f;
                (isq ? qb : kb)[((size_t)(b * HA + hh) * S + s) * E + e] = f2bf(val); }
        } else if (n < 4608) {
            const int e = n & 127, hh = (n - 3072) >> 7;
#pragma unroll
            for (int r = 0; r < 16; ++r) { const int t = r0 + r, b = t / S, s = t % S; vb[((size_t)(b * HA + hh) * S + s) * E + e] = f2bf(acc[r]); }
        } else if (n < 5120) {
#pragma unroll
            for (int r = 0; r < 16; ++r) usb[(size_t)(r0 + r) * DS + (n - 4608)] = f2bf(gelu_erf(acc[r]));
        } else {
#pragma unroll
            for (int r = 0; r < 16; ++r) vsb[(size_t)(r0 + r) * DS + (n - 5120)] = f2bf(gelu_erf(acc[r]));
        }
    }
}
__device__ __forceinline__ void phase_gemm2_naive(const Params& p, unsigned char* lds) {
    const int tid = threadIdx.x;
    const bf16_t* A = (const bf16_t*)(p.ws + OFF_QKV);
    const int nitems = (T / 16) * (D / 512);
    for (int it = blockIdx.x; it < nitems; it += gridDim.x) {
        const int cbk = it % (D / 512), rb = it / (D / 512), r0 = rb * 16, c0 = cbk * 512;
        NAIVE_GEMM_BODY(A, p.w_out, D, r0, c0)
        const int n = c0 + tid;
#pragma unroll
        for (int r = 0; r < 16; ++r) { const int t = r0 + r, b = t / S; p.out[(size_t)t * D + n] = p.x[(size_t)t * D + n] + mod1(p, b, 2, n) * acc[r]; }
    }
}
__device__ __forceinline__ void phase_gemm3_naive(const Params& p, unsigned char* lds) {
    const int tid = threadIdx.x;
    const bf16_t* A = (const bf16_t*)(p.ws + OFF_A);
    bf16_t* pq = (bf16_t*)(p.ws + OFF_QKV + (size_t)T * D * 2);
    const int nitems = (T / 16) * (D / 512);
    for (int it = blockIdx.x; it < nitems; it += gridDim.x) {
        const int cbk = it % (D / 512), rb = it / (D / 512), r0 = rb * 16, c0 = cbk * 512;
        NAIVE_GEMM_BODY(A, p.peer_w_q, D, r0, c0)
        const int n = c0 + tid;
#pragma unroll
        for (int r = 0; r < 16; ++r) pq[(size_t)(r0 + r) * D + n] = f2bf(acc[r]);
    }
}

__device__ __forceinline__ void phase_attn_naive(const Params& p, unsigned char* lds) {
    const int lane = threadIdx.x & 63, wave = threadIdx.x >> 6, gw = blockIdx.x * NWV + wave, nw = gridDim.x * NWV;
    float* ql = (float*)lds + wave * 128;
    const bf16_t* qb = (const bf16_t*)(p.ws + OFF_QKV); const bf16_t* kb = (const bf16_t*)(p.ws + OFF_QKV + QKV_ONE); const bf16_t* vb = (const bf16_t*)(p.ws + OFF_QKV + 2 * QKV_ONE);
    float* lse = (float*)(p.ws + OFF_LSE);
    for (int item = gw; item < NB * HA * S; item += nw) {
        const int t = item % S, h = (item / S) % HA, b = item / (S * HA);
        const size_t hb = (size_t)(b * HA + h) * S;
        { const unsigned w = *(const unsigned*)(qb + (hb + t) * E + 2 * lane); ql[2 * lane] = bflo(w); ql[2 * lane + 1] = bfhi(w); }
        __builtin_amdgcn_wave_barrier();
#pragma unroll 1
        for (int pat = 0; pat < 3; ++pat) {
            const int d = pat == 0 ? 1 : (pat == 1 ? 4 : 16);
            const int imax = min(128, t / d);
            float sc[3];
#pragma unroll
            for (int sl = 0; sl < 3; ++sl) { const int i = sl * 64 + lane; float s = -__builtin_inff();
                if (i <= imax) { const u32x4* kr = (const u32x4*)(kb + (hb + (t - i * d)) * E); s = 0.f;
                    for (int c8 = 0; c8 < 16; ++c8) { const u32x4 kk = kr[c8]; const float* qq = ql + c8 * 8;
                        s += qq[0] * bflo(kk.x) + qq[1] * bfhi(kk.x) + qq[2] * bflo(kk.y) + qq[3] * bfhi(kk.y) + qq[4] * bflo(kk.z) + qq[5] * bfhi(kk.z) + qq[6] * bflo(kk.w) + qq[7] * bfhi(kk.w); } }
                sc[sl] = s; }
            const float m = wave_max(fmaxf(sc[0], fmaxf(sc[1], sc[2])));
            float pr[3]; float l = 0.f;
#pragma unroll
            for (int sl = 0; sl < 3; ++sl) { pr[sl] = __expf(sc[sl] - m); l += pr[sl]; }
            l = wave_sum(l);
            float o0 = 0.f, o1 = 0.f;
            for (int i = 0; i <= imax; ++i) { const float pv = __shfl(i < 64 ? pr[0] : (i < 128 ? pr[1] : pr[2]), i & 63);
                const unsigned w = *(const unsigned*)(vb + (hb + (t - i * d)) * E + 2 * lane); o0 += pv * bflo(w); o1 += pv * bfhi(w); }
            const float il = 1.0f / l; const size_t tg = (size_t)b * S + t;
            *(unsigned*)(P_opat(p, pat) + tg * DA + h * E + 2 * lane) = pack2(o0 * il, o1 * il);
            if (lane == 0) lse[((size_t)pat * T + tg) * HA + h] = m + __logf(l);
        }
        __builtin_amdgcn_wave_barrier();
    }
}

#define LAS __attribute__((address_space(3)))
typedef short bf16x8 __attribute__((ext_vector_type(8)));
typedef short s16x4 __attribute__((ext_vector_type(4)));
constexpr int ATT_VOFF = 65536, ATT_VSTRIDE = 288;
__device__ __forceinline__ unsigned cvt_pk(float lo, float hi) { unsigned r; asm volatile("v_cvt_pk_bf16_f32 %0, %1, %2" : "=v"(r) : "v"(lo), "v"(hi)); return r; }
struct AttnItem { int pat, bh, r, n, dsh; };
__device__ __forceinline__ AttnItem attn_decode(int item) {
    AttnItem a; a.pat = item / 1536; const int rem = item % 1536; a.bh = rem >> 5; const int ci = rem & 31;
    a.dsh = 2 * a.pat; const int nblk = 32 >> a.dsh; a.r = ci / nblk; a.n = ci % nblk; return a;
}
__device__ __forceinline__ void attn_issue(const AttnItem& a, const bf16_t* qb, const bf16_t* kb, const bf16_t* vb, int tid, int w, int l15, int g, u32x4 (&kr)[8], u32x4 (&vr)[8], bf16x8 (&qf)[4]) {
    const size_t hb = (size_t)a.bh * S;
#pragma unroll
    for (int i = 0; i < 8; ++i) { const int ch = i * NTHR + tid, kk = ch >> 4, c = ch & 15;
        if (a.n > 0 || kk >= 128) { const int tp = (((a.n - 1) * 128 + kk) << a.dsh) + a.r;
            kr[i] = *(const u32x4*)(kb + (hb + tp) * E + c * 8); vr[i] = *(const u32x4*)(vb + (hb + tp) * E + c * 8); } }
    const int tq = ((a.n * 128 + 16 * w + l15) << a.dsh) + a.r;
#pragma unroll
    for (int ks = 0; ks < 4; ++ks) qf[ks] = *(const bf16x8*)(qb + (hb + tq) * E + 32 * ks + 8 * g);
}
__device__ __forceinline__ void phase_attn(const Params& p, unsigned char* lds_) {
    LAS unsigned char* lds = (LAS unsigned char*)lds_;
    const int tid = threadIdx.x, lane = tid & 63, w = __builtin_amdgcn_readfirstlane(tid >> 6), l15 = lane & 15, g = lane >> 4;
    const bf16_t* qb = (const bf16_t*)(p.ws + OFF_QKV); const bf16_t* kb = (const bf16_t*)(p.ws + OFF_QKV + QKV_ONE); const bf16_t* vb = (const bf16_t*)(p.ws + OFF_QKV + 2 * QKV_ONE);
    float* lse = (float*)(p.ws + OFF_LSE);
    const int G = gridDim.x, vcu = (G % 8 == 0) ? (int)(blockIdx.x & 7) * (G >> 3) + (int)(blockIdx.x >> 3) : (int)blockIdx.x;
    const float NEG = -__builtin_inff();
    constexpr int NITEMS = 3 * 48 * 32;
    u32x4 kr[8], vr[8]; bf16x8 qn[4];
    if (vcu < NITEMS) attn_issue(attn_decode(vcu), qb, kb, vb, tid, w, l15, g, kr, vr, qn);
    for (int item = vcu; item < NITEMS; item += G) {
        const AttnItem a = attn_decode(item);
        const int pat = a.pat, bh = a.bh, r = a.r, n = a.n, dsh = a.dsh;
        __syncthreads();
#pragma unroll
        for (int i = 0; i < 8; ++i) { const int ch = i * NTHR + tid, kk = ch >> 4, c = ch & 15;
            if (n > 0 || kk >= 128) { *(LAS u32x4*)(lds + kk * 256 + ((c ^ (kk & 15)) << 4)) = kr[i]; *(LAS u32x4*)(lds + ATT_VOFF + kk * ATT_VSTRIDE + c * 16) = vr[i]; } }
        bf16x8 qf[4];
#pragma unroll
        for (int ks = 0; ks < 4; ++ks) { qf[ks] = qn[ks]; asm volatile("" : "+v"(qf[ks])); }
        __syncthreads();
        if (item + G < NITEMS) attn_issue(attn_decode(item + G), qb, kb, vb, tid, w, l15, g, kr, vr, qn);
        const int jj = 16 * w + l15, tq = ((n * 128 + jj) << dsh) + r;
        const int s0 = w >> 1;
        f32x4 sA[5], sB[5];
#define ATT_LDK(dst, step_, kp_) do { const int _kA = 32 * (step_) + l15, _kB = _kA + 16; _Pragma("unroll") for (int q = 0; q < 2; ++q) { const int ks = 2 * (kp_) + q; \
            dst[2 * q] = *(const LAS bf16x8*)(lds + _kA * 256 + (((4 * ks + g) ^ (_kA & 15)) << 4)); dst[2 * q + 1] = *(const LAS bf16x8*)(lds + _kB * 256 + (((4 * ks + g) ^ (_kB & 15)) << 4)); } } while (0)
        bf16x8 kc[4], kn[4];
        ATT_LDK(kc, s0, 0);
#pragma unroll
        for (int gi = 0; gi < 10; ++gi) {
            const int si = gi >> 1, kp = gi & 1, step = s0 + si;
            if (gi < 9) ATT_LDK(kn, s0 + ((gi + 1) >> 1), (gi + 1) & 1);
            __builtin_amdgcn_sched_barrier(0);
            if (kp == 0) { sA[si] = (f32x4){0.f, 0.f, 0.f, 0.f}; sB[si] = (f32x4){0.f, 0.f, 0.f, 0.f}; }
            if (!(n == 0 && step < 4)) {
#pragma unroll
                for (int q = 0; q < 2; ++q) { sA[si] = __builtin_amdgcn_mfma_f32_16x16x32_bf16(kc[2 * q], qf[2 * kp + q], sA[si], 0, 0, 0); sB[si] = __builtin_amdgcn_mfma_f32_16x16x32_bf16(kc[2 * q + 1], qf[2 * kp + q], sB[si], 0, 0, 0); } }
            if (kp == 1) {
#pragma unroll
                for (int rg = 0; rg < 4; ++rg) { const int ka = 32 * step + 4 * g + rg, kb2 = ka + 16;
                    const bool oka = (unsigned)(ka - jj) <= 128u && (n > 0 || ka >= 128), okb = (unsigned)(kb2 - jj) <= 128u && (n > 0 || kb2 >= 128);
                    sA[si][rg] = oka ? sA[si][rg] : NEG; sB[si][rg] = okb ? sB[si][rg] : NEG; } }
            if (gi < 9) {
#pragma unroll
                for (int q = 0; q < 4; ++q) kc[q] = kn[q]; }
        }
#undef ATT_LDK
        float m = NEG;
#pragma unroll
        for (int si = 0; si < 5; ++si)
#pragma unroll
            for (int rg = 0; rg < 4; ++rg) m = fmaxf(m, fmaxf(sA[si][rg], sB[si][rg]));
        m = fmaxf(m, __shfl_xor(m, 16)); m = fmaxf(m, __shfl_xor(m, 32));
        float l = 0.f; const float mL = m * 1.4426950408889634f;
#pragma unroll
        for (int si = 0; si < 5; ++si)
#pragma unroll
            for (int rg = 0; rg < 4; ++rg) { sA[si][rg] = __builtin_amdgcn_exp2f(sA[si][rg] * 1.4426950408889634f - mL); sB[si][rg] = __builtin_amdgcn_exp2f(sB[si][rg] * 1.4426950408889634f - mL); l += sA[si][rg] + sB[si][rg]; }
        l += __shfl_xor(l, 16); l += __shfl_xor(l, 32);
        f32x4 o[8];
#pragma unroll
        for (int dt = 0; dt < 8; ++dt) o[dt] = (f32x4){0.f, 0.f, 0.f, 0.f};
#define ATT_LDV(dst, step_, hf_) do { LAS unsigned char* _vr = lds + ATT_VOFF + (32 * (step_) + 4 * g + (l15 >> 2)) * ATT_VSTRIDE + (l15 & 3) * 8 + (hf_) * 128; _Pragma("unroll") for (int q = 0; q < 4; ++q) { \
            dst[2 * q] = __builtin_amdgcn_ds_read_tr16_b64_v4i16((LAS s16x4*)(_vr + q * 32)); dst[2 * q + 1] = __builtin_amdgcn_ds_read_tr16_b64_v4i16((LAS s16x4*)(_vr + q * 32 + 16 * ATT_VSTRIDE)); } } while (0)
        bf16x8 pfa[5];
#pragma unroll
        for (int si = 0; si < 5; ++si) { u32x4 pw; pw.x = cvt_pk(sA[si][0], sA[si][1]); pw.y = cvt_pk(sA[si][2], sA[si][3]); pw.z = cvt_pk(sB[si][0], sB[si][1]); pw.w = cvt_pk(sB[si][2], sB[si][3]); pfa[si] = *reinterpret_cast<const bf16x8*>(&pw); }
        s16x4 vc[8], vn[8];
        ATT_LDV(vc, s0, 0);
#pragma unroll
        for (int gi = 0; gi < 10; ++gi) {
            const int si = gi >> 1, hf = gi & 1, step = s0 + si;
            if (gi < 9) ATT_LDV(vn, s0 + ((gi + 1) >> 1), (gi + 1) & 1);
            __builtin_amdgcn_sched_barrier(0);
            if (!(n == 0 && step < 4)) {
#pragma unroll
                for (int q = 0; q < 4; ++q) { const s16x4 v0 = vc[2 * q], v1 = vc[2 * q + 1];
                    const bf16x8 vf = {v0[0], v0[1], v0[2], v0[3], v1[0], v1[1], v1[2], v1[3]};
                    o[4 * hf + q] = __builtin_amdgcn_mfma_f32_16x16x32_bf16(vf, pfa[si], o[4 * hf + q], 0, 0, 0); } }
            if (gi < 9) {
#pragma unroll
                for (int q = 0; q < 8; ++q) vc[q] = vn[q]; }
        }
#undef ATT_LDV
        const float il = 1.0f / l; const int b_ = bh / HA, h = bh % HA; const size_t tg = (size_t)b_ * S + tq;
        bf16_t* orow = P_opat(p, pat) + tg * DA + h * E + 4 * g;
#pragma unroll
        for (int dt = 0; dt < 8; ++dt) { u32x2 ww; ww.x = cvt_pk(o[dt][0] * il, o[dt][1] * il); ww.y = cvt_pk(o[dt][2] * il, o[dt][3] * il); *(u32x2*)(orow + 16 * dt) = ww; }
        if (g == 0) lse[((size_t)pat * T + tg) * HA + h] = m + __logf(l);
    }
}

__device__ __forceinline__ void phase_sgu(const Params& p, unsigned char* lds_) {
    LAS unsigned char* lds = (LAS unsigned char*)lds_;
    const int tid = threadIdx.x, lane = tid & 63, w = __builtin_amdgcn_readfirstlane(tid >> 6), l15 = lane & 15, g = lane >> 4;
    const bf16_t* vsb = (const bf16_t*)(p.ws + OFF_VS); const bf16_t* usb = (const bf16_t*)(p.ws + OFF_US); bf16_t* ob = (bf16_t*)(p.ws + OFF_SGUO);
    const bf16_t* sw = (const bf16_t*)(p.ws + OFF_SGUW);
    for (int item = blockIdx.x; item < (T / 128) * HS; item += gridDim.x) {
        const int h = item & 3, t0 = (item >> 2) * 128;
        __syncthreads();
        {
            const int j = tid >> 2, part = tid & 3;
            const u32x4* src = (const u32x4*)(vsb + (size_t)(t0 + j) * DS + h * E + part * 32);
            u32x4 x[4]; float sum = 0.f;
#pragma unroll
            for (int i = 0; i < 4; ++i) { x[i] = src[i]; sum += bflo(x[i].x) + bfhi(x[i].x) + bflo(x[i].y) + bfhi(x[i].y) + bflo(x[i].z) + bfhi(x[i].z) + bflo(x[i].w) + bfhi(x[i].w); }
            sum += __shfl_xor(sum, 1); sum += __shfl_xor(sum, 2);
            const float mu = sum * (1.0f / E); float var = 0.f;
#pragma unroll
            for (int i = 0; i < 4; ++i) { float dd;
                dd = bflo(x[i].x) - mu; var += dd * dd; dd = bfhi(x[i].x) - mu; var += dd * dd; dd = bflo(x[i].y) - mu; var += dd * dd; dd = bfhi(x[i].y) - mu; var += dd * dd;
                dd = bflo(x[i].z) - mu; var += dd * dd; dd = bfhi(x[i].z) - mu; var += dd * dd; dd = bflo(x[i].w) - mu; var += dd * dd; dd = bfhi(x[i].w) - mu; var += dd * dd; }
            var += __shfl_xor(var, 1); var += __shfl_xor(var, 2);
            const float rs = rsqrtf(var * (1.0f / E) + 1e-5f);
            const float* lg = p.sgu_ln_g + h * E + part * 32; const float* lb = p.sgu_ln_b + h * E + part * 32;
#pragma unroll
            for (int i = 0; i < 4; ++i) { const float4 g0 = *(const float4*)(lg + i * 8), g1 = *(const float4*)(lg + i * 8 + 4), b0 = *(const float4*)(lb + i * 8), b1 = *(const float4*)(lb + i * 8 + 4);
                u32x4 o; o.x = cvt_pk((bflo(x[i].x) - mu) * rs * g0.x + b0.x, (bfhi(x[i].x) - mu) * rs * g0.y + b0.y); o.y = cvt_pk((bflo(x[i].y) - mu) * rs * g0.z + b0.z, (bfhi(x[i].y) - mu) * rs * g0.w + b0.w);
                o.z = cvt_pk((bflo(x[i].z) - mu) * rs * g1.x + b1.x, (bfhi(x[i].z) - mu) * rs * g1.y + b1.y); o.w = cvt_pk((bflo(x[i].w) - mu) * rs * g1.z + b1.z, (bfhi(x[i].w) - mu) * rs * g1.w + b1.w);
                *(LAS u32x4*)(lds + j * ATT_VSTRIDE + part * 64 + i * 16) = o; }
        }
        __syncthreads();
        f32x4 acc[8];
#pragma unroll
        for (int et = 0; et < 8; ++et) acc[et] = (f32x4){0.f, 0.f, 0.f, 0.f};
        const int irow = 16 * w + l15, nsteps = (16 * w + 15) / 32 + 1;
        const bf16_t* wrow = sw + ((size_t)h * 128 + irow) * 128;
        for (int st = 0; st < nsteps; ++st) {
            const u32x2 wa = *(const u32x2*)(wrow + 32 * st + 4 * g), wb = *(const u32x2*)(wrow + 32 * st + 16 + 4 * g);
            u32x4 wf4; wf4.x = wa.x; wf4.y = wa.y; wf4.z = wb.x; wf4.w = wb.y;
            const bf16x8 wf = *reinterpret_cast<const bf16x8*>(&wf4);
            LAS unsigned char* vrow = lds + (32 * st + 4 * g + (l15 >> 2)) * ATT_VSTRIDE + (l15 & 3) * 8;
#pragma unroll
            for (int et = 0; et < 8; ++et) {
                const s16x4 v0 = __builtin_amdgcn_ds_read_tr16_b64_v4i16((LAS s16x4*)(vrow + et * 32));
                const s16x4 v1 = __builtin_amdgcn_ds_read_tr16_b64_v4i16((LAS s16x4*)(vrow + et * 32 + 16 * ATT_VSTRIDE));
                const bf16x8 vf = {v0[0], v0[1], v0[2], v0[3], v1[0], v1[1], v1[2], v1[3]};
                acc[et] = __builtin_amdgcn_mfma_f32_16x16x32_bf16(vf, wf, acc[et], 0, 0, 0); }
        }
        const float bias = p.sgu_b[h * 128 + irow];
        const size_t base = (size_t)(t0 + irow) * DS + h * E + 4 * g;
#pragma unroll
        for (int et = 0; et < 8; ++et) { const u32x2 uu = *(const u32x2*)(usb + base + 16 * et);
            u32x2 oo; oo.x = cvt_pk(bflo(uu.x) * (acc[et][0] + bias), bfhi(uu.x) * (acc[et][1] + bias)); oo.y = cvt_pk(bflo(uu.y) * (acc[et][2] + bias), bfhi(uu.y) * (acc[et][3] + bias));
            *(u32x2*)(ob + base + 16 * et) = oo; }
    }
}

__device__ __forceinline__ void phase_sgu_ln_naive(const Params& p) {
    const int lane = threadIdx.x & 63, gw = blockIdx.x * NWV + (threadIdx.x >> 6), nw = gridDim.x * NWV;
    bf16_t* vsb = (bf16_t*)(p.ws + OFF_VS);
    for (int item = gw; item < T * HS; item += nw) {
        const int t = item / HS, h = item % HS;
        unsigned* ptr = (unsigned*)(vsb + (size_t)t * DS + h * E + 2 * lane);
        const unsigned w = *ptr; const float a = bflo(w), b = bfhi(w);
        const float mu = wave_sum(a + b) * (1.0f / E); const float da = a - mu, db = b - mu;
        const float var = wave_sum(da * da + db * db) * (1.0f / E); const float rs = rsqrtf(var + 1e-5f);
        const int e = 2 * lane;
        *ptr = pack2(da * rs * p.sgu_ln_g[h * E + e] + p.sgu_ln_b[h * E + e], db * rs * p.sgu_ln_g[h * E + e + 1] + p.sgu_ln_b[h * E + e + 1]);
    }
}
__device__ __forceinline__ void phase_sgu_mix_naive(const Params& p) {
    const int tid = threadIdx.x;
    const bf16_t* vnb = (const bf16_t*)(p.ws + OFF_VS); const bf16_t* usb = (const bf16_t*)(p.ws + OFF_US); bf16_t* ob = (bf16_t*)(p.ws + OFF_SGUO);
    for (int t = blockIdx.x; t < T; t += gridDim.x) {
        const int h = tid >> 7, e = tid & 127, i = t & 127, t0 = t - i;
        float acc = 0.f;
        for (int j = 0; j <= i; ++j) acc += p.sgu_w[(h * 128 + i) * 128 + j] * bf2f(vnb[(size_t)(t0 + j) * DS + tid]);
        acc += p.sgu_b[h * 128 + i];
        ob[(size_t)t * DS + tid] = f2bf(bf2f(usb[(size_t)t * DS + tid]) * acc);
        (void)e;
    }
}

__device__ __forceinline__ void phase_combine(const Params& p) {
    const int lane = threadIdx.x & 63, gw = blockIdx.x * NWV + (threadIdx.x >> 6), nw = gridDim.x * NWV;
    const float* lse = (const float*)(p.ws + OFF_LSE);
    const bf16_t* sg = (const bf16_t*)(p.ws + OFF_SGUO); bf16_t* mixed = (bf16_t*)(p.ws + OFF_QKV);
    for (int t = gw; t < T; t += nw) {
        float w0 = 0.f, w1 = 0.f, w2 = 0.f;
        if (lane < HA) { const float l0 = lse[((size_t)0 * T + t) * HA + lane], l1 = lse[((size_t)1 * T + t) * HA + lane], l2 = lse[((size_t)2 * T + t) * HA + lane];
            const float m = fmaxf(l0, fmaxf(l1, l2)); const float e0 = __expf(l0 - m), e1 = __expf(l1 - m), e2 = __expf(l2 - m); const float is = 1.0f / (e0 + e1 + e2);
            w0 = e0 * is; w1 = e1 * is; w2 = e2 * is; }
        float av[3][8]; float ss = 0.f;
#pragma unroll
        for (int i = 0; i < 3; ++i) { const int col0 = (lane + 64 * i) * 8, hh = col0 >> 7;
            const float a0 = __shfl(w0, hh), a1 = __shfl(w1, hh), a2 = __shfl(w2, hh);
            const u32x4 x0 = *(const u32x4*)(P_opat(p, 0) + (size_t)t * DA + col0), x1 = *(const u32x4*)(P_opat(p, 1) + (size_t)t * DA + col0), x2 = *(const u32x4*)(P_opat(p, 2) + (size_t)t * DA + col0);
            av[i][0] = a0 * bflo(x0.x) + a1 * bflo(x1.x) + a2 * bflo(x2.x); av[i][1] = a0 * bfhi(x0.x) + a1 * bfhi(x1.x) + a2 * bfhi(x2.x);
            av[i][2] = a0 * bflo(x0.y) + a1 * bflo(x1.y) + a2 * bflo(x2.y); av[i][3] = a0 * bfhi(x0.y) + a1 * bfhi(x1.y) + a2 * bfhi(x2.y);
            av[i][4] = a0 * bflo(x0.z) + a1 * bflo(x1.z) + a2 * bflo(x2.z); av[i][5] = a0 * bfhi(x0.z) + a1 * bfhi(x1.z) + a2 * bfhi(x2.z);
            av[i][6] = a0 * bflo(x0.w) + a1 * bflo(x1.w) + a2 * bflo(x2.w); av[i][7] = a0 * bfhi(x0.w) + a1 * bfhi(x1.w) + a2 * bfhi(x2.w);
#pragma unroll
            for (int j = 0; j < 8; ++j) ss += av[i][j] * av[i][j]; }
        ss = wave_sum(ss); const float rs = rsqrtf(ss * (1.0f / DA) + 1e-6f);
#pragma unroll
        for (int i = 0; i < 3; ++i) { const int col0 = (lane + 64 * i) * 8; const float4 g0 = *(const float4*)(p.g_attn_out + col0), g1 = *(const float4*)(p.g_attn_out + col0 + 4);
            u32x4 w; w.x = pack2(av[i][0] * rs * g0.x, av[i][1] * rs * g0.y); w.y = pack2(av[i][2] * rs * g0.z, av[i][3] * rs * g0.w);
            w.z = pack2(av[i][4] * rs * g1.x, av[i][5] * rs * g1.y); w.w = pack2(av[i][6] * rs * g1.z, av[i][7] * rs * g1.w);
            *(u32x4*)(mixed + (size_t)t * D + col0) = w; }
        { const int col0 = lane * 8; const u32x4 xs = *(const u32x4*)(sg + (size_t)t * DS + col0);
          float sv[8] = {bflo(xs.x), bfhi(xs.x), bflo(xs.y), bfhi(xs.y), bflo(xs.z), bfhi(xs.z), bflo(xs.w), bfhi(xs.w)}; float s2 = 0.f;
#pragma unroll
          for (int j = 0; j < 8; ++j) s2 += sv[j] * sv[j];
          s2 = wave_sum(s2); const float r2 = rsqrtf(s2 * (1.0f / DS) + 1e-6f);
          const float4 g0 = *(const float4*)(p.g_sgu_out + col0), g1 = *(const float4*)(p.g_sgu_out + col0 + 4);
          u32x4 w; w.x = pack2(sv[0] * r2 * g0.x, sv[1] * r2 * g0.y); w.y = pack2(sv[2] * r2 * g0.z, sv[3] * r2 * g0.w);
          w.z = pack2(sv[4] * r2 * g1.x, sv[5] * r2 * g1.y); w.w = pack2(sv[6] * r2 * g1.z, sv[7] * r2 * g1.w);
          *(u32x4*)(mixed + (size_t)t * D + DA + col0) = w; }
    }
}

__device__ __forceinline__ void phase_topk_naive(const Params& p, unsigned char* lds) {
    const int lane = threadIdx.x & 63, wave = threadIdx.x >> 6, gw = blockIdx.x * NWV + wave, nw = gridDim.x * NWV;
    float* ql = (float*)lds + wave * 256;
    const bf16_t* pq = (const bf16_t*)(p.ws + OFF_QKV + (size_t)T * D * 2);
    int* idxo = (int*)(p.ws + OFF_IDX); float* gato = (float*)(p.ws + OFF_GATE);
    const float NEG = -__builtin_inff();
    for (int item = gw; item < T * PH; item += nw) {
        const int t = item / PH, h = item % PH;
        { const u32x2 w = *(const u32x2*)(pq + (size_t)t * D + h * 256 + 4 * lane); ql[4 * lane] = bflo(w.x); ql[4 * lane + 1] = bfhi(w.x); ql[4 * lane + 2] = bflo(w.y); ql[4 * lane + 3] = bfhi(w.y); }
        __builtin_amdgcn_wave_barrier();
        float ts[2]; int ti[2];
#pragma unroll
        for (int pp = 0; pp < 2; ++pp) {
            const float* k0 = p.peer_sub_keys + ((size_t)(h * 2 + pp) * 128 + lane) * 128; const float* k1 = k0 + 64 * 128; const float* qq = ql + pp * 128;
            float s0 = 0.f, s1 = 0.f;
            for (int c = 0; c < 128; c += 4) { const float4 a = *(const float4*)(k0 + c), b = *(const float4*)(k1 + c);
                s0 += qq[c] * a.x + qq[c + 1] * a.y + qq[c + 2] * a.z + qq[c + 3] * a.w; s1 += qq[c] * b.x + qq[c + 1] * b.y + qq[c + 2] * b.z + qq[c + 3] * b.w; }
            float tsv = 0.f; int tiv = 0;
            for (int r = 0; r < PK; ++r) { const float m = wave_max(fmaxf(s0, s1));
                const int cand = (s0 == m) ? lane : ((s1 == m) ? lane + 64 : 1000); const int key = wave_min_i(cand);
                if (lane == r) { tsv = m; tiv = key; }
                if (key == lane) s0 = NEG; if (key == lane + 64) s1 = NEG; }
            ts[pp] = tsv; ti[pp] = tiv; }
        float cs[4]; const int ci = lane >> 2, cj = (lane & 3) * 4; const float a = __shfl(ts[0], ci);
#pragma unroll
        for (int m = 0; m < 4; ++m) cs[m] = a + __shfl(ts[1], cj + m);
        float bs = 0.f; int bpos = 0;
        for (int r = 0; r < PK; ++r) { const float m = wave_max(fmaxf(fmaxf(cs[0], cs[1]), fmaxf(cs[2], cs[3])));
            int cand = 1000;
#pragma unroll
            for (int mm = 3; mm >= 0; --mm) if (cs[mm] == m) cand = ci * 16 + cj + mm;
            const int pos = wave_min_i(cand);
            if (lane == r) { bs = m; bpos = pos; }
#pragma unroll
            for (int mm = 0; mm < 4; ++mm) if (pos == ci * 16 + cj + mm) cs[mm] = NEG; }
        const int e1 = __shfl(ti[0], (bpos >> 4) & 15), e2 = __shfl(ti[1], bpos & 15);
        const float m0 = __shfl(bs, 0); const float ex = lane < PK ? __expf(bs - m0) : 0.f; const float sum = wave_sum(ex);
        if (lane < PK) { idxo[(size_t)t * 128 + h * PK + lane] = e1 * 128 + e2; gato[(size_t)t * 128 + h * PK + lane] = ex / sum; }
        __builtin_amdgcn_wave_barrier();
    }
}

__device__ __forceinline__ int f2key(float f) { const int b = __float_as_int(f); return b ^ ((b >> 31) & 0x7fffffff); }
__device__ __forceinline__ float key2f(int k) { return __int_as_float(k ^ ((k >> 31) & 0x7fffffff)); }
typedef int i32x16 __attribute__((ext_vector_type(16)));
typedef float f32x16v __attribute__((ext_vector_type(16)));
#define TK_CE(v, i, l) do { const int _a = v[i], _b = v[l]; v[i] = max(_a, _b); v[l] = min(_a, _b); } while (0)
__device__ __forceinline__ i32x16 sort16_desc(i32x16 v) {
#pragma unroll
    for (int lk = 1; lk <= 4; ++lk)
#pragma unroll
        for (int lj = 3; lj >= 0; --lj) { if (lj >= lk) continue; const int k = 1 << lk, j = 1 << lj;
#pragma unroll
            for (int i = 0; i < 16; ++i) { const int l = i ^ j; if (l > i) { if ((i & k) == 0) TK_CE(v, i, l); else TK_CE(v, l, i); } } }
    return v;
}
__device__ __forceinline__ i32x16 bitonic_merge16_desc(i32x16 v) {
#pragma unroll
    for (int lj = 3; lj >= 0; --lj) { const int j = 1 << lj;
#pragma unroll
        for (int i = 0; i < 16; ++i) { const int l = i ^ j; if (l > i) TK_CE(v, i, l); } }
    return v;
}
__device__ __forceinline__ i32x16 merge_top16(i32x16 a, i32x16 b) {
#pragma unroll
    for (int i = 0; i < 16; ++i) a[i] = max(a[i], b[15 - i]);
    return bitonic_merge16_desc(a);
}
__device__ __forceinline__ i32x16 xlane_merge_top16(i32x16 a, int xr) {
    i32x16 b;
#pragma unroll
    for (int i = 0; i < 16; ++i) b[i] = __shfl_xor(a[i], xr);
    return merge_top16(a, b);
}
__device__ __forceinline__ int sel2i(bool c, int x, int y) { return c ? y : x; }
__device__ __forceinline__ int sel16(i32x16 v, int i) {
    const bool c0 = (i & 1) != 0, c1 = (i & 2) != 0, c2 = (i & 4) != 0, c3 = (i & 8) != 0;
    const int a0 = sel2i(c0, v[0], v[1]), a1 = sel2i(c0, v[2], v[3]), a2 = sel2i(c0, v[4], v[5]), a3 = sel2i(c0, v[6], v[7]);
    const int a4 = sel2i(c0, v[8], v[9]), a5 = sel2i(c0, v[10], v[11]), a6 = sel2i(c0, v[12], v[13]), a7 = sel2i(c0, v[14], v[15]);
    const int b0 = sel2i(c1, a0, a1), b1 = sel2i(c1, a2, a3), b2 = sel2i(c1, a4, a5), b3 = sel2i(c1, a6, a7);
    const int d0 = sel2i(c2, b0, b1), d1 = sel2i(c2, b2, b3);
    return sel2i(c3, d0, d1);
}
__device__ __forceinline__ int sel4i(int g, int a, int b, int c, int d) { return g == 0 ? a : (g == 1 ? b : (g == 2 ? c : d)); }
__device__ __forceinline__ float sel4f(int g, float a, float b, float c, float d) { return g == 0 ? a : (g == 1 ? b : (g == 2 ? c : d)); }
constexpr int TK_TAB[64] = {
    0x00, 0x01, 0x02, 0x03, 0x04, 0x05, 0x06, 0x07, 0x08, 0x09, 0x0A, 0x0B, 0x0C, 0x0D, 0x0E, 0x0F,
    0x10, 0x11, 0x12, 0x13, 0x14, 0x15, 0x16, 0x17, 0x40, 0x41, 0x42, 0x80, 0x90, 0xFF, 0xFF, 0xFF,
    0x20, 0x21, 0x22, 0x23, 0x24, 0x30, 0x31, 0x32, 0x33, 0x50, 0x51, 0xA0, 0xB0, 0xFF, 0xFF, 0xFF,
    0x60, 0x61, 0x70, 0x71, 0xC0, 0xD0, 0xE0, 0xF0, 0xFF, 0xFF, 0xFF, 0xFF, 0xFF, 0xFF, 0xFF, 0xFF};
template <int C> __device__ __forceinline__ int tk_make_cand(i32x16 sp0, i32x16 sp1, int g) {
    constexpr int NONE = (int)0x80000000;
    constexpr int e0 = TK_TAB[C], e1 = TK_TAB[16 + C], e2 = TK_TAB[32 + C], e3 = TK_TAB[48 + C];
    constexpr int r0 = (e0 >> 4) & 15, r1 = e1 == 0xFF ? 0 : (e1 >> 4) & 15, r2 = e2 == 0xFF ? 0 : (e2 >> 4) & 15, r3 = e3 == 0xFF ? 0 : (e3 >> 4) & 15;
    constexpr int c0 = e0 & 15, c1 = e1 == 0xFF ? 0 : e1 & 15, c2 = e2 == 0xFF ? 0 : e2 & 15, c3 = e3 == 0xFF ? 0 : e3 & 15;
    const int av = sel4i(g, sp0[r0], sp0[r1], sp0[r2], sp0[r3]);
    const int bv = sel4i(g, sp1[c0], sp1[c1], sp1[c2], sp1[c3]);
    const int code = sel4i(g, e0, e1, e2, e3);
    const float sum = key2f(av & ~127) + key2f(bv & ~127);
    return code == 0xFF ? NONE : ((f2key(sum) & ~255) | code);
}
__device__ __forceinline__ void phase_topk(const Params& p, unsigned char* lds_) {
    LAS unsigned char* lds = (LAS unsigned char*)lds_;
    const int tid = threadIdx.x, lane = tid & 63, w = __builtin_amdgcn_readfirstlane(tid >> 6), l15 = lane & 15, g = lane >> 4;
    const bf16_t* pq = (const bf16_t*)(p.ws + OFF_QKV + (size_t)T * D * 2); const bf16_t* skb = (const bf16_t*)(p.ws + OFF_SUBK);
    int* idxo = (int*)(p.ws + OFF_IDX); float* gato = (float*)(p.ws + OFF_GATE);
    int cur_h = -1;
    for (int task = blockIdx.x; task < (T / 128) * PH; task += gridDim.x) {
        const int h = task & 7, tt = task >> 3;
        if (h != cur_h) {
            __syncthreads();
#pragma unroll
            for (int i = 0; i < 8; ++i) { const int ch = i * NTHR + tid, row = ch >> 4, c = ch & 15;
                *(LAS u32x4*)(lds + row * 256 + ((c ^ (row & 15)) << 4)) = *(const u32x4*)(skb + ((size_t)h * 256 + row) * 128 + c * 8); }
            __syncthreads();
            cur_h = h;
        }
        const int t = tt * 128 + 16 * w + l15;
        i32x16 sp0, sp1;
#pragma unroll
        for (int pp = 0; pp < 2; ++pp) {
            bf16x8 bq[4];
#pragma unroll
            for (int ks = 0; ks < 4; ++ks) bq[ks] = *(const bf16x8*)(pq + (size_t)t * D + h * 256 + pp * 128 + 32 * ks + 8 * g);
            i32x16 ka, kb2;
#pragma unroll
            for (int kt = 0; kt < 8; ++kt) {
                f32x4 a = {0.f, 0.f, 0.f, 0.f};
                const int row = pp * 128 + 16 * kt + l15;
#pragma unroll
                for (int ks = 0; ks < 4; ++ks) { const bf16x8 kf = *(const LAS bf16x8*)(lds + row * 256 + (((4 * ks + g) ^ (row & 15)) << 4)); a = __builtin_amdgcn_mfma_f32_16x16x32_bf16(kf, bq[ks], a, 0, 0, 0); }
#pragma unroll
                for (int rg = 0; rg < 4; ++rg) { const int key = (f2key(a[rg]) & ~127) | (16 * kt + rg + 4 * g);
                    if (kt < 4) ka[kt * 4 + rg] = key; else kb2[(kt - 4) * 4 + rg] = key; }
            }
            ka = merge_top16(sort16_desc(ka), sort16_desc(kb2));
            ka = xlane_merge_top16(ka, 16); ka = xlane_merge_top16(ka, 32);
            if (pp == 0) sp0 = ka; else sp1 = ka;
        }
        i32x16 cd;
        cd[0] = tk_make_cand<0>(sp0, sp1, g); cd[1] = tk_make_cand<1>(sp0, sp1, g); cd[2] = tk_make_cand<2>(sp0, sp1, g); cd[3] = tk_make_cand<3>(sp0, sp1, g);
        cd[4] = tk_make_cand<4>(sp0, sp1, g); cd[5] = tk_make_cand<5>(sp0, sp1, g); cd[6] = tk_make_cand<6>(sp0, sp1, g); cd[7] = tk_make_cand<7>(sp0, sp1, g);
        cd[8] = tk_make_cand<8>(sp0, sp1, g); cd[9] = tk_make_cand<9>(sp0, sp1, g); cd[10] = tk_make_cand<10>(sp0, sp1, g); cd[11] = tk_make_cand<11>(sp0, sp1, g);
        cd[12] = tk_make_cand<12>(sp0, sp1, g); cd[13] = tk_make_cand<13>(sp0, sp1, g); cd[14] = tk_make_cand<14>(sp0, sp1, g); cd[15] = tk_make_cand<15>(sp0, sp1, g);
        cd = sort16_desc(cd); cd = xlane_merge_top16(cd, 16); cd = xlane_merge_top16(cd, 32);
        f32x16v ex; float sum = 0.f; const float m0 = key2f(cd[0] & ~255);
#pragma unroll
        for (int i = 0; i < 16; ++i) { ex[i] = __expf(key2f(cd[i] & ~255) - m0); sum += ex[i]; }
        const float is = 1.0f / sum;
        int oi[4]; float og[4];
#pragma unroll
        for (int c = 0; c < 4; ++c) {
            const int key = sel4i(g, cd[c], cd[4 + c], cd[8 + c], cd[12 + c]);
            const float e = sel4f(g, ex[c], ex[4 + c], ex[8 + c], ex[12 + c]);
            const int i1 = sel16(sp0, (key >> 4) & 15) & 127, i2 = sel16(sp1, key & 15) & 127;
            oi[c] = i1 * 128 + i2; og[c] = e * is; }
        *(int4*)(idxo + (size_t)t * 128 + h * PK + 4 * g) = make_int4(oi[0], oi[1], oi[2], oi[3]);
        *(float4*)(gato + (size_t)t * 128 + h * PK + 4 * g) = make_float4(og[0], og[1], og[2], og[3]);
    }
}

typedef float f32x2v __attribute__((ext_vector_type(2)));
typedef float f32x8v __attribute__((ext_vector_type(8)));
__device__ __forceinline__ int dot16_i8(const u32x4 w, const u32x4 x) {
    int s = __builtin_amdgcn_sdot4((int)w.x, (int)x.x, 0, false); s = __builtin_amdgcn_sdot4((int)w.y, (int)x.y, s, false);
    s = __builtin_amdgcn_sdot4((int)w.z, (int)x.z, s, false); return __builtin_amdgcn_sdot4((int)w.w, (int)x.w, s, false);
}
__device__ __forceinline__ void axpy16_u8(const u32x4 w, float cw, float* acc) {
    float f[16];
#pragma unroll
    for (int q = 0; q < 4; ++q) { const unsigned ww = w[q];
        f[4 * q + 0] = __uint_as_float(__builtin_amdgcn_perm(0x47000000u, ww, 0x07060004u)); f[4 * q + 1] = __uint_as_float(__builtin_amdgcn_perm(0x47000000u, ww, 0x07060104u));
        f[4 * q + 2] = __uint_as_float(__builtin_amdgcn_perm(0x47000000u, ww, 0x07060204u)); f[4 * q + 3] = __uint_as_float(__builtin_amdgcn_perm(0x47000000u, ww, 0x07060304u)); }
    __builtin_amdgcn_sched_barrier(0);
#pragma unroll
    for (int j = 0; j < 16; ++j) acc[j] = fmaf(cw, f[j], acc[j]);
    __builtin_amdgcn_sched_barrier(0);
}
typedef _Float16 h2v __attribute__((ext_vector_type(2)));
__device__ __forceinline__ void axpy16x2_u8(const u32x4 wa, const u32x4 wb, h2v cwp, float* acc) {
#pragma unroll
    for (int q = 0; q < 4; ++q) { const unsigned ua = wa[q], ub = wb[q];
        unsigned p0 = __builtin_amdgcn_perm(ub, ua, 0x0C040C00u), p1 = __builtin_amdgcn_perm(ub, ua, 0x0C050C01u), p2 = __builtin_amdgcn_perm(ub, ua, 0x0C060C02u), p3 = __builtin_amdgcn_perm(ub, ua, 0x0C070C03u);
        acc[4 * q + 0] = __builtin_amdgcn_fdot2(*reinterpret_cast<h2v*>(&p0), cwp, acc[4 * q + 0], false); acc[4 * q + 1] = __builtin_amdgcn_fdot2(*reinterpret_cast<h2v*>(&p1), cwp, acc[4 * q + 1], false);
        acc[4 * q + 2] = __builtin_amdgcn_fdot2(*reinterpret_cast<h2v*>(&p2), cwp, acc[4 * q + 2], false); acc[4 * q + 3] = __builtin_amdgcn_fdot2(*reinterpret_cast<h2v*>(&p3), cwp, acc[4 * q + 3], false); }
}
typedef int i32x8v __attribute__((ext_vector_type(8)));
typedef int i32x4v __attribute__((ext_vector_type(4)));
typedef int i32x2v __attribute__((ext_vector_type(2)));
__device__ __forceinline__ int red8_piece(i32x8v r, int lane) {
    const bool b2 = (lane & 4) != 0, b1 = (lane & 2) != 0, b0 = (lane & 1) != 0;
    i32x4v q; i32x2v pp;
#pragma unroll
    for (int k = 0; k < 4; ++k) { const int lo = r[k], hi = r[k + 4]; const int kp = b2 ? hi : lo, sn = b2 ? lo : hi; q[k] = kp + __shfl_xor(sn, 4); }
#pragma unroll
    for (int k = 0; k < 2; ++k) { const int lo = q[k], hi = q[k + 2]; const int kp = b1 ? hi : lo, sn = b1 ? lo : hi; pp[k] = kp + __shfl_xor(sn, 2); }
    const int lo = pp[0], hi = pp[1]; const int kp = b0 ? hi : lo, sn = b0 ? lo : hi;
    return kp + __shfl_xor(sn, 1);
}
template <int WHICH, int MODE = 0> __device__ __forceinline__ void peer_chunk(const Params& p, int t0, int s, int lane) {
    const int sub = lane >> 3, piece = lane & 7;
    const int* idx = (const int*)(p.ws + OFF_IDX) + sub * 16;
    const unsigned char* tab = p.ws + (WHICH == 0 ? OFF_UTAB : OFF_VTAB) + (size_t)s * SLICE_BYTES + piece * 16;
    const unsigned char* xbase = p.ws + OFF_US + s * 128 + piece * 16;
    const float* wbase = (const float*)(p.ws + OFF_GATE) + sub * 16;
    int4 ec[4], en[4];
    u32x4 wA[8], wB[8];
    u32x4 xr; float4 cwv[4];
#define PEER_LD8(dst, ev0, ev1) do { if (MODE == 2) { dst[0] = (u32x4){(unsigned)ev0.x, (unsigned)ev0.y, 0x38383838u, 0x30303030u}; dst[1] = dst[0]; dst[2] = dst[0]; dst[3] = dst[0]; dst[4] = (u32x4){(unsigned)ev1.x, (unsigned)ev1.y, 0x38383838u, 0x30303030u}; dst[5] = dst[4]; dst[6] = dst[4]; dst[7] = dst[4]; break; } dst[0] = *(const u32x4*)(tab + (size_t)ev0.x * 128); dst[1] = *(const u32x4*)(tab + (size_t)ev0.y * 128); dst[2] = *(const u32x4*)(tab + (size_t)ev0.z * 128); dst[3] = *(const u32x4*)(tab + (size_t)ev0.w * 128); \
                                     dst[4] = *(const u32x4*)(tab + (size_t)ev1.x * 128); dst[5] = *(const u32x4*)(tab + (size_t)ev1.y * 128); dst[6] = *(const u32x4*)(tab + (size_t)ev1.z * 128); dst[7] = *(const u32x4*)(tab + (size_t)ev1.w * 128); } while (0)
#pragma unroll
    for (int q = 0; q < 4; ++q) ec[q] = *(const int4*)(idx + (size_t)t0 * 128 + 4 * q);
    PEER_LD8(wA, ec[0], ec[1]);
    if (WHICH == 0) { xr = *(const u32x4*)(xbase + (size_t)t0 * D); }
    else {
#pragma unroll
        for (int q = 0; q < 4; ++q) cwv[q] = *(const float4*)(wbase + (size_t)t0 * 128 + 4 * q); }
#pragma unroll
    for (int q = 0; q < 4; ++q) en[q] = *(const int4*)(idx + (size_t)(t0 + 1) * 128 + 4 * q);
#pragma unroll 1
    for (int k = 0; k < 8; ++k) {
        const int t = t0 + k;
        PEER_LD8(wB, ec[2], ec[3]);
        if (WHICH == 0) {
            const u32x4 xc = xr;
            i32x8v r0, r1;
#pragma unroll
            for (int i = 0; i < 8; ++i) r0[i] = MODE == 1 ? (int)(wA[i].x ^ wA[i].y ^ wA[i].z ^ wA[i].w ^ xc.x) : dot16_i8(wA[i], xc);
            if (k < 7) { PEER_LD8(wA, en[0], en[1]); xr = *(const u32x4*)(xbase + (size_t)(t + 1) * D); }
#pragma unroll
            for (int i = 0; i < 8; ++i) r1[i] = MODE == 1 ? (int)(wB[i].x ^ wB[i].y ^ wB[i].z ^ wB[i].w ^ xc.y) : dot16_i8(wB[i], xc);
            const int v0 = red8_piece(r0, lane), v1 = red8_piece(r1, lane);
            int* part = (int*)(p.ws + OFF_QKV) + ((size_t)s * T + t) * 128 + sub * 16 + piece;
            part[0] = v0; part[8] = v1;
        } else {
            float acc[16];
#pragma unroll
            for (int j = 0; j < 16; ++j) acc[j] = 0.f;
            const float4 c0 = cwv[0], c1 = cwv[1], c2 = cwv[2], c3 = cwv[3];
            h2v cp[8];
            cp[0].x = (_Float16)(c0.x * 256.f); cp[0].y = (_Float16)(c0.y * 256.f); cp[1].x = (_Float16)(c0.z * 256.f); cp[1].y = (_Float16)(c0.w * 256.f);
            cp[2].x = (_Float16)(c1.x * 256.f); cp[2].y = (_Float16)(c1.y * 256.f); cp[3].x = (_Float16)(c1.z * 256.f); cp[3].y = (_Float16)(c1.w * 256.f);
            cp[4].x = (_Float16)(c2.x * 256.f); cp[4].y = (_Float16)(c2.y * 256.f); cp[5].x = (_Float16)(c2.z * 256.f); cp[5].y = (_Float16)(c2.w * 256.f);
            cp[6].x = (_Float16)(c3.x * 256.f); cp[6].y = (_Float16)(c3.y * 256.f); cp[7].x = (_Float16)(c3.z * 256.f); cp[7].y = (_Float16)(c3.w * 256.f);
            float cwsum = 0.f;
#pragma unroll
            for (int q = 0; q < 8; ++q) cwsum += (float)cp[q].x + (float)cp[q].y;
            axpy16x2_u8(wA[0], wA[1], cp[0], acc); axpy16x2_u8(wA[2], wA[3], cp[1], acc); axpy16x2_u8(wA[4], wA[5], cp[2], acc); axpy16x2_u8(wA[6], wA[7], cp[3], acc);
            if (k < 7) { PEER_LD8(wA, en[0], en[1]);
#pragma unroll
                for (int q = 0; q < 4; ++q) cwv[q] = *(const float4*)(wbase + (size_t)(t + 1) * 128 + 4 * q); }
            axpy16x2_u8(wB[0], wB[1], cp[4], acc); axpy16x2_u8(wB[2], wB[3], cp[5], acc); axpy16x2_u8(wB[4], wB[5], cp[6], acc); axpy16x2_u8(wB[6], wB[7], cp[7], acc);
            f32x16v a16;
#pragma unroll
            for (int j = 0; j < 16; ++j) a16[j] = fmaf(acc[j], 65536.0f, -0.5f * cwsum);
            const bool b5 = (lane & 32) != 0, b4 = (lane & 16) != 0, b3 = (lane & 8) != 0;
            f32x8v q8; f32x4 q4; f32x2v q2;
#pragma unroll
            for (int j = 0; j < 8; ++j) { const float lo = a16[j], hi = a16[j + 8]; const float kp = b5 ? hi : lo, sn = b5 ? lo : hi; q8[j] = kp + __shfl_xor(sn, 32); }
#pragma unroll
            for (int j = 0; j < 4; ++j) { const float lo = q8[j], hi = q8[j + 4]; const float kp = b4 ? hi : lo, sn = b4 ? lo : hi; q4[j] = kp + __shfl_xor(sn, 16); }
#pragma unroll
            for (int j = 0; j < 2; ++j) { const float lo = q4[j], hi = q4[j + 2]; const float kp = b3 ? hi : lo, sn = b3 ? lo : hi; q2[j] = kp + __shfl_xor(sn, 8); }
            bf16_t* po = (bf16_t*)(p.ws + OFF_O12) + (size_t)t * D + s * 128 + piece * 16 + 2 * sub;
            *(unsigned*)po = cvt_pk(q2[0], q2[1]);
        }
#pragma unroll
        for (int q = 0; q < 4; ++q) ec[q] = en[q];
        if (k < 6) {
#pragma unroll
            for (int q = 0; q < 4; ++q) en[q] = *(const int4*)(idx + (size_t)(t + 2) * 128 + 4 * q); }
    }
#undef PEER_LD8
}
template <int WHICH, int MODE = 0, int QSET = WHICH> __device__ __forceinline__ void phase_peer_sliced(const Params& p, unsigned xcc) {
    unsigned* qh = (unsigned*)(p.ws + OFF_CTL + OFF_QUEUE) + QSET * 16 * 64;
    const int lane = threadIdx.x & 63;
    for (int rnd = 0; rnd < 16; ++rnd) {
        const int s = (int)((xcc + 8u * (unsigned)(rnd & 1) + (unsigned)(rnd >> 1)) & 15u);
        unsigned c = 0; if (lane == 0) c = atomicAdd(qh + s * 64, 1u);
        c = __builtin_amdgcn_readfirstlane(c);
        while (c < (unsigned)(T / 8)) {
            unsigned cn = 0; if (lane == 0) cn = atomicAdd(qh + s * 64, 1u);
            peer_chunk<WHICH, MODE>(p, (int)c * 8, s, lane);
            c = __builtin_amdgcn_readfirstlane(cn);
        }
    }
}
__device__ __forceinline__ void phase_peer_w(const Params& p) {
    const int lane = threadIdx.x & 63, gw = blockIdx.x * NWV + (threadIdx.x >> 6), nw = gridDim.x * NWV;
    const int* part = (const int*)(p.ws + OFF_QKV); const int* idx = (const int*)(p.ws + OFF_IDX); float* gate = (float*)(p.ws + OFF_GATE);
    const float* uinv = (const float*)(p.ws + OFF_UTAB + TAB8_BYTES); const float* vinv = (const float*)(p.ws + OFF_VTAB + TAB8_BYTES); const float* xs = (const float*)(p.ws + OFF_SGUO);
    for (int t = gw; t < T; t += nw) {
        int a0 = 0, a1 = 0;
#pragma unroll
        for (int s = 0; s < 16; ++s) { const int* pr = part + ((size_t)s * T + t) * 128; a0 += pr[lane]; a1 += pr[64 + lane]; }
        const int e0 = idx[(size_t)t * 128 + lane], e1 = idx[(size_t)t * 128 + 64 + lane];
        const float g0 = gate[(size_t)t * 128 + lane], g1 = gate[(size_t)t * 128 + 64 + lane]; const float xsc = xs[t];
        gate[(size_t)t * 128 + lane] = g0 * gelu_erf((float)a0 * (xsc * uinv[e0])) * vinv[e0];
        gate[(size_t)t * 128 + 64 + lane] = g1 * gelu_erf((float)a1 * (xsc * uinv[e1])) * vinv[e1];
    }
}
__device__ __forceinline__ void phase_peer_final(const Params& p) {
    const int lane = threadIdx.x & 63, gw = blockIdx.x * NWV + (threadIdx.x >> 6), nw = gridDim.x * NWV;
    const bf16_t* peer = (const bf16_t*)(p.ws + OFF_O12);
    for (int t = gw; t < T; t += nw) {
        const int b = t / S; float* hrow = p.out + (size_t)t * D; float v[32]; float ss = 0.f;
#pragma unroll
        for (int i = 0; i < 4; ++i) { const int col = i * 512 + lane * 8;
            const u32x4 pw = *(const u32x4*)(peer + (size_t)t * D + col); const float4 h0 = *(const float4*)(hrow + col), h1 = *(const float4*)(hrow + col + 4);
            const float4 g0 = mod4(p, b, 5, col), g1 = mod4(p, b, 5, col + 4);
            v[i * 8 + 0] = h0.x + g0.x * bflo(pw.x); v[i * 8 + 1] = h0.y + g0.y * bfhi(pw.x); v[i * 8 + 2] = h0.z + g0.z * bflo(pw.y); v[i * 8 + 3] = h0.w + g0.w * bfhi(pw.y);
            v[i * 8 + 4] = h1.x + g1.x * bflo(pw.z); v[i * 8 + 5] = h1.y + g1.y * bfhi(pw.z); v[i * 8 + 6] = h1.z + g1.z * bflo(pw.w); v[i * 8 + 7] = h1.w + g1.w * bfhi(pw.w);
#pragma unroll
            for (int j = 0; j < 8; ++j) ss += v[i * 8 + j] * v[i * 8 + j]; }
        ss = wave_sum(ss); const float rs = rsqrtf(ss * (1.0f / D) + 1e-6f);
#pragma unroll
        for (int i = 0; i < 4; ++i) { const int col = i * 512 + lane * 8; const float4 g0 = *(const float4*)(p.g_final + col), g1 = *(const float4*)(p.g_final + col + 4);
            *(float4*)(hrow + col) = make_float4(v[i * 8 + 0] * rs * g0.x, v[i * 8 + 1] * rs * g0.y, v[i * 8 + 2] * rs * g0.z, v[i * 8 + 3] * rs * g0.w);
            *(float4*)(hrow + col + 4) = make_float4(v[i * 8 + 4] * rs * g1.x, v[i * 8 + 5] * rs * g1.y, v[i * 8 + 6] * rs * g1.z, v[i * 8 + 7] * rs * g1.w); }
    }
}

constexpr int LDS_BYTES = 147456;

#define XB_TMO      128
#define XB_XCNT(j)  (256  + 64 * (j))
#define XB_XSUB(j)  (1280 + 64 * (j))
#define XB_XGEN(j)  (2304 + 64 * (j))
#define XB_TOP      3328
#define XB_TOPGEN   3392
#define XCD_BAR_WORDS 3456
#define XB_SPIN_CAP (1u << 18)

__device__ __forceinline__ unsigned xb_ld(unsigned* p)              { return __hip_atomic_load(p, __ATOMIC_RELAXED, __HIP_MEMORY_SCOPE_AGENT); }
__device__ __forceinline__ unsigned xb_add(unsigned* p, unsigned v) { return __hip_atomic_fetch_add(p, v, __ATOMIC_RELAXED, __HIP_MEMORY_SCOPE_AGENT); }
__device__ __forceinline__ unsigned xb_xcc_id() { return (unsigned)__builtin_amdgcn_s_getreg((3 << 11) | 20) & 0xFu; }
#define XB_SPIN(cond, bar) do { unsigned _sp = 0; while (cond) { __builtin_amdgcn_s_sleep(1); \
    if ((++_sp & 255u) == 0u) { if (xb_ld(&(bar)[XB_TMO])) break; if (_sp > XB_SPIN_CAP) { atomicAdd(&(bar)[XB_TMO], 1u); break; } } } } while (0)

struct XcdBarrier {
    unsigned* bar; unsigned x;
    volatile LAS unsigned* st;
};

__device__ __forceinline__ XcdBarrier xcd_barrier_post(unsigned* bar, volatile LAS unsigned* st) {
    XcdBarrier b; b.bar = bar; b.x = xb_xcc_id(); b.st = st;
    if (threadIdx.x == 0) (void)xb_add(&bar[XB_XCNT(b.x)], 1u);
    return b;
}
__device__ __forceinline__ void xcd_barrier_complete(unsigned* bar, unsigned x, unsigned& nloc, unsigned& nx) {
    const unsigned G = gridDim.x * gridDim.y * gridDim.z;
    unsigned sum, cnt, mine, sp = 0u;
    for (;;) {
        sum = 0u; cnt = 0u; mine = 0u;
#pragma unroll
        for (unsigned j = 0; j < 16; ++j) { const unsigned c = xb_ld(&bar[XB_XCNT(j)]); sum += c; cnt += (c > 0u) ? 1u : 0u; mine = (j == x) ? c : mine; }
        if (sum == G) break;
        __builtin_amdgcn_s_sleep(1);
        if ((++sp & 255u) == 0u) { if (xb_ld(&bar[XB_TMO])) break; if (sp > XB_SPIN_CAP) { atomicAdd(&bar[XB_TMO], 1u); break; } }
    }
    nloc = mine > 0u ? mine : 1u; nx = cnt > 0u ? cnt : 1u;
}

__device__ __forceinline__ void xcd_barrier(const XcdBarrier& b) {
    asm volatile("s_waitcnt vmcnt(0)" ::: "memory");
    __syncthreads();
    if (threadIdx.x == 0) {
        unsigned* bar = b.bar;
        __builtin_amdgcn_s_waitcnt(0);
        unsigned nloc = b.st[0], nx = b.st[1];
        if (nloc == 0u) { xcd_barrier_complete(bar, b.x, nloc, nx); b.st[0] = nloc; b.st[1] = nx; }
        const unsigned old = xb_add(&bar[XB_XSUB(b.x)], 1u);
        const unsigned gen = old / nloc;
        if (old + 1u == (gen + 1u) * nloc) {
            __builtin_amdgcn_fence(__ATOMIC_RELEASE, "agent");
            asm volatile("s_waitcnt vmcnt(0)" ::: "memory");
            const unsigned og = xb_add(&bar[XB_TOP], 1u);
            const unsigned tg = og / nx;
            if (og + 1u == (tg + 1u) * nx) xb_add(&bar[XB_TOPGEN], 1u);
            else XB_SPIN(xb_ld(&bar[XB_TOPGEN]) == tg, bar);
            __builtin_amdgcn_fence(__ATOMIC_ACQUIRE, "agent");
            xb_add(&bar[XB_XGEN(b.x)], 1u);
            asm volatile("s_waitcnt vmcnt(0)" ::: "memory");
        } else {
            XB_SPIN(xb_ld(&bar[XB_XGEN(b.x)]) == gen, bar);
            __builtin_amdgcn_fence(__ATOMIC_ACQUIRE, "agent");
            asm volatile("s_waitcnt vmcnt(0)" ::: "memory");
        }
    }
    __syncthreads();
}

#ifndef PHASE_MASK
#define PHASE_MASK 0x3FF
#endif
#ifndef PROBE_DUP
#define PROBE_DUP 0
#endif
#define GBAR() xcd_barrier(xbar)
#define RUNPH(bit, call, dupcall) do { if (PHASE_MASK & (bit)) { if (PROBE_DUP & (bit)) { dupcall; GBAR(); } call; GBAR(); } } while (0)
__global__ void __launch_bounds__(NTHR, 2) k_mega(Params p) {
    extern __shared__ __attribute__((aligned(16))) unsigned char lds[];
    cg::grid_group grid = cg::this_grid();
    volatile LAS unsigned* xst = (volatile LAS unsigned*)((LAS unsigned char*)lds + LDS_BYTES);
    if (threadIdx.x < 4) xst[threadIdx.x] = 0u;
    __syncthreads();
    XcdBarrier xbar = xcd_barrier_post((unsigned*)(p.ws + OFF_CTL), xst);
    if (PHASE_MASK & 1) { if (PROBE_DUP & 1) { phase_conv(p, lds, true); GBAR(); } phase_conv(p, lds); grid.sync(); }
    RUNPH(2, phase_norm_mod<false>(p, p.x, p.g_norm1, 0, 1, (bf16_t*)(p.ws + OFF_A)), phase_norm_mod<false>(p, p.x, p.g_norm1, 0, 1, (bf16_t*)(p.ws + OFF_A)));
    RUNPH(4, phase_gemm1(p, lds), phase_gemm1(p, lds));
    if (PROBE_DUP & 1024) { phase_sgu(p, lds); GBAR(); }
    RUNPH(8, (phase_attn(p, lds), phase_sgu(p, lds)), phase_attn(p, lds));
    RUNPH(16, phase_combine(p), phase_combine(p));
    RUNPH(32, phase_gemm2(p, lds), phase_gemm2(p, lds));
    RUNPH(64, phase_norm_mod<true>(p, p.out, p.g_norm2, 3, 4, (bf16_t*)(p.ws + OFF_A)), phase_norm_mod<true>(p, p.out, p.g_norm2, 3, 4, (bf16_t*)(p.ws + OFF_A)));
    RUNPH(128, phase_gemm3(p, lds), phase_gemm3(p, lds));
    RUNPH(256, phase_topk(p, lds), phase_topk(p, lds));
    if (PHASE_MASK & 512) {
        if (PROBE_DUP == 2048) { phase_peer_sliced<0, 0, 2>(p, xbar.x); GBAR(); }
        if (PROBE_DUP == 4096) { phase_peer_sliced<0, 1, 2>(p, xbar.x); GBAR(); }
        if (PROBE_DUP == 8192) { phase_peer_sliced<0, 2, 2>(p, xbar.x); GBAR(); }
        phase_peer_sliced<0>(p, xbar.x); GBAR();
        phase_peer_w(p); GBAR();
        if (PROBE_DUP == 16384) { phase_peer_sliced<1, 0, 3>(p, xbar.x); GBAR(); }
        phase_peer_sliced<1>(p, xbar.x); GBAR();
        phase_peer_final(p);
    }
}

#ifndef MEGA
#define MEGA 1
#endif
extern "C" void kernel_launch(void* const* d_in, const int* in_sizes, int n_in, void* d_out, int out_size, void* d_ws, size_t ws_size, hipStream_t stream) {
    if (n_in != 20 || out_size != T * D || ws_size < WS_END) { fprintf(stderr, "kernel_launch: unexpected problem (n_in %d out %d ws %zu, need %zu)\n", n_in, out_size, ws_size, (size_t)WS_END); return; }
    Params p{};
    p.x = (const float*)d_in[0]; p.c = (const float*)d_in[1]; p.pos = (const int*)d_in[2]; p.w_ada = (const float*)d_in[3]; p.b_ada = (const float*)d_in[4];
    p.g_norm1 = (const float*)d_in[5]; p.w_in = (const float*)d_in[6]; p.g_attn_out = (const float*)d_in[7]; p.g_sgu_out = (const float*)d_in[8];
    p.sgu_w = (const float*)d_in[9]; p.sgu_b = (const float*)d_in[10]; p.sgu_ln_g = (const float*)d_in[11]; p.sgu_ln_b = (const float*)d_in[12];
    p.w_out = (const float*)d_in[13]; p.g_norm2 = (const float*)d_in[14]; p.peer_w_q = (const float*)d_in[15]; p.peer_sub_keys = (const float*)d_in[16];
    p.peer_u = (const float*)d_in[17]; p.peer_v = (const float*)d_in[18]; p.g_final = (const float*)d_in[19];
    p.out = (float*)d_out; p.ws = (unsigned char*)d_ws;
    (void)hipMemsetAsync((char*)d_ws + OFF_CTL, 0, OFF_SGUW - OFF_CTL, stream);
#if MEGA
    static int grid_blocks = 0;
    if (!grid_blocks) {
        int dev = 0, cus = 0, per_cu = 0;
        (void)hipGetDevice(&dev); (void)hipDeviceGetAttribute(&cus, hipDeviceAttributeMultiprocessorCount, dev);
        (void)hipFuncSetAttribute((const void*)k_mega, hipFuncAttributeMaxDynamicSharedMemorySize, LDS_BYTES + 16);
        (void)hipOccupancyMaxActiveBlocksPerMultiprocessor(&per_cu, (const void*)k_mega, NTHR, LDS_BYTES + 16);
        if (per_cu < 1) { fprintf(stderr, "kernel_launch: occupancy query says %d blocks per CU\n", per_cu); per_cu = 1; }
        if (per_cu > 1) per_cu = 1;
        grid_blocks = cus * per_cu;
    }
    void* args[] = {(void*)&p};
    hipError_t e = hipLaunchCooperativeKernel((const void*)k_mega, dim3(grid_blocks), dim3(NTHR), args, LDS_BYTES + 16, stream);
    if (e != hipSuccess) fprintf(stderr, "cooperative launch failed: %s (grid %d)\n", hipGetErrorString(e), grid_blocks);
#endif
}
```

```cpp
#include <hip/hip_runtime.h>
#include <hip/hip_cooperative_groups.h>
#include <cstdio>
#include <cstdint>
namespace cg = cooperative_groups;
#ifndef CONV_TS
#define CONV_TS -1
#endif
#define CSTAMP(k) do { if (CONV_TS >= 0) { __syncthreads(); const unsigned long long _t = __builtin_amdgcn_s_memrealtime(); if (CONV_TS + 1 == (k)) { const unsigned long long _d = _t - cts; while (__builtin_amdgcn_s_memrealtime() - _t < _d) __builtin_amdgcn_s_sleep(8); } cts = __builtin_amdgcn_s_memrealtime(); } } while (0)

constexpr int D = 2048, NB = 4, S = 4096, T = NB * S;
constexpr int E = 128, HA = 12, HS = 4, DA = 1536, DS = 512, DIN = 5632;
constexpr int PH = 8, PK = 16, NEXP = 16384;
constexpr int NTHR = 512, NWV = 8;

typedef unsigned short bf16_t;
typedef unsigned u32x4 __attribute__((ext_vector_type(4)));
typedef unsigned u32x2 __attribute__((ext_vector_type(2)));
typedef float f32x4 __attribute__((ext_vector_type(4)));

__device__ __forceinline__ bf16_t f2bf(float f) { unsigned u = __float_as_uint(f); u += 0x7FFFu + ((u >> 16) & 1u); return (bf16_t)(u >> 16); }
__device__ __forceinline__ float bf2f(bf16_t b) { return __uint_as_float(((unsigned)b) << 16); }
__device__ __forceinline__ unsigned pack2(float lo, float hi) { return (unsigned)f2bf(lo) | ((unsigned)f2bf(hi) << 16); }
__device__ __forceinline__ float bflo(unsigned w) { return __uint_as_float(w << 16); }
__device__ __forceinline__ float bfhi(unsigned w) { return __uint_as_float(w & 0xffff0000u); }
__device__ __forceinline__ float wave_sum(float v) {
#pragma unroll
    for (int o = 32; o >= 1; o >>= 1) v += __shfl_xor(v, o);
    return v; }
__device__ __forceinline__ float wave_max(float v) {
#pragma unroll
    for (int o = 32; o >= 1; o >>= 1) v = fmaxf(v, __shfl_xor(v, o));
    return v; }
__device__ __forceinline__ int wave_min_i(int v) {
#pragma unroll
    for (int o = 32; o >= 1; o >>= 1) v = min(v, __shfl_xor(v, o));
    return v; }
__device__ __forceinline__ float gelu_erf(float v) { return 0.5f * v * (1.0f + erff(v * 0.70710678118654752f)); }

constexpr size_t OFF_CTL  = 0;
constexpr size_t OFF_MOD  = 65536;
constexpr size_t OFF_SGUW = OFF_MOD + 393216;
constexpr size_t OFF_SUBK = OFF_SGUW + 131072;
constexpr size_t OFF_LSE  = OFF_SUBK + 524288;
constexpr size_t OFF_IDX  = OFF_LSE + (size_t)3 * T * 12 * 4;
constexpr size_t OFF_GATE = OFF_IDX + (size_t)T * 128 * 4;
constexpr size_t OFF_WIN  = OFF_GATE + (size_t)T * 128 * 4;
constexpr size_t OFF_WOUT = OFF_WIN + (size_t)DIN * D * 2;
constexpr size_t OFF_WQ   = OFF_WOUT + (size_t)D * D * 2;
constexpr size_t OFF_UTAB = OFF_WQ + (size_t)D * D * 2;
constexpr size_t TAB8_BYTES = (size_t)NEXP * D;
constexpr size_t SLICE_BYTES = (size_t)NEXP * 128;
constexpr size_t OFF_QUEUE = 32768;
constexpr size_t OFF_VTAB = OFF_UTAB + (size_t)NEXP * D * 2;
constexpr size_t OFF_A    = OFF_VTAB + (size_t)NEXP * D * 2;
constexpr size_t OFF_QKV  = OFF_A + (size_t)T * D * 2;
constexpr size_t QKV_ONE  = (size_t)T * DA * 2;
constexpr size_t OFF_US   = OFF_QKV + 3 * QKV_ONE;
constexpr size_t OFF_VS   = OFF_US + (size_t)T * DS * 2;
constexpr size_t OFF_SGUO = OFF_VS + (size_t)T * DS * 2;
constexpr size_t OFF_O12  = OFF_SGUO + (size_t)T * DS * 2;
constexpr size_t WS_END   = OFF_O12 + 2 * QKV_ONE;

struct Params {
    const float* x; const float* c; const int* pos; const float* w_ada; const float* b_ada; const float* g_norm1; const float* w_in;
    const float* g_attn_out; const float* g_sgu_out; const float* sgu_w; const float* sgu_b; const float* sgu_ln_g; const float* sgu_ln_b;
    const float* w_out; const float* g_norm2; const float* peer_w_q; const float* peer_sub_keys; const float* peer_u; const float* peer_v;
    const float* g_final; float* out; unsigned char* ws;
};
__device__ __forceinline__ float fx2f(long long v) { return (float)(int)(v >> 32) + (float)(unsigned)v * 2.3283064365386963e-10f; }
__device__ __forceinline__ float mod1(const Params& p, int b, int i, int col) { return fx2f(((const long long*)(p.ws + OFF_MOD))[b * 12288 + i * D + col]); }
__device__ __forceinline__ float4 mod4q(const long long* mp) { return make_float4(fx2f(mp[0]), fx2f(mp[1]), fx2f(mp[2]), fx2f(mp[3])); }
__device__ __forceinline__ float4 mod4(const Params& p, int b, int i, int col) { return mod4q((const long long*)(p.ws + OFF_MOD) + b * 12288 + i * D + col); }
__device__ __forceinline__ bf16_t* P_opat(const Params& p, int pat) { return (bf16_t*)(pat == 0 ? p.ws + OFF_A : p.ws + OFF_O12 + (size_t)(pat - 1) * QKV_ONE); }

namespace pg8 {
#define PG8_LAS __attribute__((address_space(3)))
typedef unsigned short bf16_t;
typedef short bf16x8 __attribute__((ext_vector_type(8)));
typedef float f32x4 __attribute__((ext_vector_type(4)));
typedef unsigned u32x4 __attribute__((ext_vector_type(4)));
constexpr int BM = 256, BK = 64, HALF = 128, HTB = HALF * BK * 2  , STAGE_BYTES = 8 * HTB, NXCD = 8, WGM = 8;

__host__ __device__ __forceinline__ int lds_byte(int r, int c) { const int st = (r >> 4) * 2 + (c >> 5), rr = r & 15, cc = c & 31, ob = rr * 64 + cc * 2; return st * 1024 + (ob ^ (((ob >> 9) & 1) << 5)); }
__host__ __device__ __forceinline__ void stage_rc(int b, int& R, int& C) { const int st = b / 1024, sb = b % 1024, swz = sb ^ (((sb >> 9) & 1) << 5); R = (st >> 1) * 16 + swz / 64; C = (st & 1) * 32 + (swz % 64) / 2; }
__host__ __device__ __forceinline__ int perm32(int rho) { const int n = rho >> 4, i = rho & 15; return 8 * (i >> 2) + 4 * n + (i & 3); }

struct Unit { int pm, pn; };
struct Gemm { const bf16_t* A; const bf16_t* Bt; int M, N, K; };

struct StaticOrder {
    int nM, nN, nwg, G, c;
    __host__ __device__ void init(int M, int N, int G_, int c_) { nM = M / BM; nN = N / BM; nwg = nM * nN; G = G_; c = c_; }
    __host__ __device__ bool next(int i, Unit& u) const {
        const long L = (long)i * G + c; if (L >= nwg) return false;
        int wgid = (int)L; { const int q = nwg / NXCD, r = nwg % NXCD, xcd = wgid % NXCD, off = wgid / NXCD; wgid = (xcd < r ? xcd * (q + 1) : r * (q + 1) + (xcd - r) * q) + off; }
        const int nig = WGM * nN, gid = wgid / nig, fm = gid * WGM, gsz = (nM - fm) < WGM ? (nM - fm) : WGM;
        u.pm = fm + ((wgid % nig) % gsz); u.pn = (wgid % nig) / gsz; return true;
    }
    __device__ __forceinline__ void a_ready(const Unit&) const {}
    __device__ __forceinline__ void done(const Unit&) const {}
};

__device__ __forceinline__ unsigned cvt_pk_bf16(float lo, float hi) { unsigned r; asm volatile("v_cvt_pk_bf16_f32 %0, %1, %2" : "=v"(r) : "v"(lo), "v"(hi)); return r; }
typedef float f32x2 __attribute__((ext_vector_type(2)));
__device__ __forceinline__ f32x2 gelu_pk(f32x2 v) {
    const f32x2 av = __builtin_elementwise_abs(v), d = av * 0.2316418882f + 1.0f;
    f32x2 t; t.x = __builtin_amdgcn_rcpf(d.x); t.y = __builtin_amdgcn_rcpf(d.y);
    f32x2 q = t * 0.5307027145f + (-0.7265760135f); q = q * t + 0.7107068705f; q = q * t + (-0.142248368f); q = q * t + 0.127414796f; q = q * t;
    const f32x2 s = (v * v) * (-0.72134752044f);
    f32x2 e; e.x = __builtin_amdgcn_exp2f(s.x); e.y = __builtin_amdgcn_exp2f(s.y);
    const f32x2 m = v * (q * e), r = v - m;
    f32x2 o; o.x = v.x < 0.f ? m.x : r.x; o.y = v.y < 0.f ? m.y : r.y; return o;
}

template <class Epi, class Sched, bool ALIGN_EPI = false, bool SP2 = false>
__device__ __forceinline__ void gemm_phase(PG8_LAS unsigned char* lds, const Gemm g, const Sched& S, const Epi& E) {
    const int tid = threadIdx.x, wid = __builtin_amdgcn_readfirstlane(tid >> 6), lane = tid & 63, wr = wid >> 2, wc = wid & 3, fr = lane & 15, fq = lane >> 4;
    const int K = g.K, nt = K / BK;
    unsigned voffA[2], voffB[2];
#pragma unroll
    for (int i = 0; i < 2; ++i) { int R, C; stage_rc(tid * 16 + i * 8192, R, C); const int Rb = Epi::PERM ? ((R & ~31) + perm32(R & 31)) : R;
        voffA[i] = (unsigned)(R * K + C) * 2u; voffB[i] = (unsigned)(Rb * K + C) * 2u; }
    const size_t kstep = (size_t)(BK * 2);
    const size_t hstep = (size_t)HALF * K * 2;
    const size_t tstep = 2 * hstep;
    const unsigned ldsw = (unsigned)wid * 1024u;
    const int aoff = lds_byte(wr * 64 + fr, fq * 8), boff = lds_byte(wc * 32 + fr, fq * 8);
#define PG8_SA(b, h) (((b) * 2 + (h)) * HTB)
#define PG8_SB(b, h) ((4 + (b) * 2 + (h)) * HTB)
#define PG8_STAGE(bufoff, gbase, voff) do { _Pragma("unroll") for (int _i = 0; _i < 2; ++_i) \
        __builtin_amdgcn_global_load_lds((const unsigned*)((const char*)(gbase) + (voff)[_i]), (PG8_LAS unsigned*)(lds + (bufoff) + ldsw + _i * 8192), 16, 0, 0); } while (0)
#define PG8_LDA(dst, b, h) do { _Pragma("unroll") for (int m = 0; m < 4; ++m) _Pragma("unroll") for (int k = 0; k < 2; ++k) dst[m][k] = *(const PG8_LAS bf16x8*)(lds + PG8_SA(b, h) + aoff + m * 2048 + k * 1024); } while (0)
#define PG8_LDB(dst, b, h) do { _Pragma("unroll") for (int n = 0; n < 2; ++n) _Pragma("unroll") for (int k = 0; k < 2; ++k) dst[n][k] = *(const PG8_LAS bf16x8*)(lds + PG8_SB(b, h) + boff + n * 2048 + k * 1024); } while (0)
#define PG8_MMA(ai, bj, At, Bt) do { __builtin_amdgcn_s_setprio(1); _Pragma("unroll") for (int m = 0; m < 4; ++m) _Pragma("unroll") for (int n = 0; n < 2; ++n) _Pragma("unroll") for (int k = 0; k < 2; ++k) \
        acc[ai][bj][m][n] = __builtin_amdgcn_mfma_f32_16x16x32_bf16(Bt[n][k], At[m][k], acc[ai][bj][m][n], 0, 0, 0); __builtin_amdgcn_s_setprio(0); } while (0)
#define PG8_WAIT_V(n) asm volatile("s_waitcnt vmcnt(" #n ")" ::: "memory")
#define PG8_WAIT_L(n) asm volatile("s_waitcnt lgkmcnt(" #n ")" ::: "memory")
#define PG8_BAR __builtin_amdgcn_s_barrier()
#define PG8_SCHED __builtin_amdgcn_sched_barrier(0)
    Unit cur, nxt; int ui = 0;
    if (!S.next(0, cur)) return;
    f32x4 acc[2][2][4][2];
#pragma unroll
    for (int a = 0; a < 2; ++a)
#pragma unroll
        for (int b = 0; b < 2; ++b)
#pragma unroll
            for (int m = 0; m < 4; ++m)
#pragma unroll
                for (int n = 0; n < 2; ++n) acc[a][b][m][n] = (f32x4){0.f, 0.f, 0.f, 0.f};
    bf16x8 At[4][2], B0[2][2], B1[2][2];
    const char* cA = (const char*)g.A + (size_t)cur.pm * tstep; const char* cB = (const char*)g.Bt + (size_t)cur.pn * tstep;
    S.a_ready(cur);
    if constexpr (SP2) {
        PG8_STAGE(PG8_SB(0, 0), cB, voffB); PG8_STAGE(PG8_SB(0, 1), cB + hstep, voffB); PG8_STAGE(PG8_SA(0, 0), cA, voffA); PG8_STAGE(PG8_SA(0, 1), cA + hstep, voffA);
        if (wr == 1) PG8_BAR;
        PG8_WAIT_V(2); PG8_BAR;
        PG8_STAGE(PG8_SB(1, 0), cB + kstep, voffB); PG8_STAGE(PG8_SA(1, 0), cA + kstep, voffA); PG8_STAGE(PG8_SB(1, 1), cB + hstep + kstep, voffB);
        PG8_WAIT_V(6); PG8_BAR;
    } else {
        PG8_STAGE(PG8_SB(0, 0), cB, voffB); PG8_STAGE(PG8_SA(0, 0), cA, voffA); PG8_STAGE(PG8_SB(0, 1), cB + hstep, voffB); PG8_STAGE(PG8_SA(0, 1), cA + hstep, voffA);
        if (wr == 1) PG8_BAR;
        PG8_WAIT_V(4); PG8_BAR;
        PG8_STAGE(PG8_SB(1, 0), cB + kstep, voffB); PG8_STAGE(PG8_SA(1, 0), cA + kstep, voffA); PG8_STAGE(PG8_SB(1, 1), cB + hstep + kstep, voffB);
        PG8_WAIT_V(6); PG8_BAR;
    }
    for (;;) {
        const bool has_next = S.next(ui + 1, nxt);
        const char* nA = has_next ? (const char*)g.A + (size_t)nxt.pm * tstep : cA; const char* nB = has_next ? (const char*)g.Bt + (size_t)nxt.pn * tstep : cB;
        for (int t = 0; t < nt; t += 2) {
            const bool last = (t == nt - 2);
            const char* a1 = cA + (size_t)(t + 1) * kstep;
            const char* a2 = last ? nA : cA + (size_t)(t + 2) * kstep; const char* b2 = last ? nB : cB + (size_t)(t + 2) * kstep;
            const char* a3 = a2 + kstep; const char* b3 = b2 + kstep;
            if (last && has_next) S.a_ready(nxt);
            if constexpr (SP2) {
            PG8_LDB(B0, 0, 0); PG8_LDB(B1, 0, 1); PG8_SCHED; PG8_LDA(At, 0, 0); PG8_STAGE(PG8_SA(1, 1), a1 + hstep, voffA);
            PG8_WAIT_V(8); PG8_WAIT_L(0); PG8_BAR; PG8_MMA(0, 0, At, B0); PG8_MMA(0, 1, At, B1); PG8_BAR; PG8_SCHED;
            PG8_LDA(At, 0, 1); PG8_STAGE(PG8_SB(0, 0), b2, voffB); PG8_STAGE(PG8_SB(0, 1), b2 + hstep, voffB); PG8_STAGE(PG8_SA(0, 0), a2, voffA);
            PG8_WAIT_V(8); PG8_WAIT_L(0); PG8_BAR; PG8_MMA(1, 0, At, B0); PG8_MMA(1, 1, At, B1); PG8_BAR; PG8_SCHED;
            PG8_LDB(B0, 1, 0); PG8_LDB(B1, 1, 1); PG8_SCHED; PG8_LDA(At, 1, 0); PG8_STAGE(PG8_SA(0, 1), a2 + hstep, voffA);
            PG8_WAIT_V(8); PG8_WAIT_L(0); PG8_BAR; PG8_MMA(0, 0, At, B0); PG8_MMA(0, 1, At, B1); PG8_BAR; PG8_SCHED;
            PG8_LDA(At, 1, 1); PG8_STAGE(PG8_SB(1, 0), b3, voffB); PG8_STAGE(PG8_SB(1, 1), b3 + hstep, voffB); PG8_STAGE(PG8_SA(1, 0), a3, voffA);
            PG8_WAIT_V(8); PG8_WAIT_L(0); PG8_BAR; PG8_MMA(1, 0, At, B0); PG8_MMA(1, 1, At, B1); PG8_BAR; PG8_SCHED;
            } else {
            PG8_LDB(B0, 0, 0); PG8_SCHED; PG8_LDA(At, 0, 0); PG8_STAGE(PG8_SA(1, 1), a1 + hstep, voffA);
            PG8_WAIT_L(8); PG8_BAR; PG8_WAIT_L(0); PG8_MMA(0, 0, At, B0); PG8_BAR; PG8_SCHED;
            PG8_LDB(B1, 0, 1); PG8_STAGE(PG8_SB(0, 0), b2, voffB);
            PG8_BAR; PG8_WAIT_L(0); PG8_MMA(0, 1, At, B1); PG8_BAR;
            PG8_LDA(At, 0, 1); PG8_STAGE(PG8_SA(0, 0), a2, voffA);
            PG8_BAR; PG8_WAIT_L(0); PG8_MMA(1, 0, At, B0); PG8_BAR; PG8_SCHED;
            PG8_STAGE(PG8_SB(0, 1), b2 + hstep, voffB);
            PG8_WAIT_V(6); PG8_BAR; PG8_MMA(1, 1, At, B1); PG8_BAR;
            PG8_LDB(B0, 1, 0); PG8_SCHED; PG8_LDA(At, 1, 0); PG8_STAGE(PG8_SA(0, 1), a2 + hstep, voffA);
            PG8_WAIT_L(8); PG8_BAR; PG8_WAIT_L(0); PG8_MMA(0, 0, At, B0); PG8_BAR; PG8_SCHED;
            PG8_LDB(B1, 1, 1); PG8_STAGE(PG8_SB(1, 0), b3, voffB);
            PG8_BAR; PG8_WAIT_L(0); PG8_MMA(0, 1, At, B1); PG8_BAR;
            PG8_LDA(At, 1, 1); PG8_STAGE(PG8_SA(1, 0), a3, voffA);
            PG8_BAR; PG8_WAIT_L(0); PG8_MMA(1, 0, At, B0); PG8_BAR; PG8_SCHED;
            PG8_STAGE(PG8_SB(1, 1), b3 + hstep, voffB);
            PG8_WAIT_V(6); PG8_BAR; PG8_MMA(1, 1, At, B1); PG8_BAR;
            }
        }
        if constexpr (ALIGN_EPI) { if (wr == 0) PG8_BAR; }
        if constexpr (!Epi::AFTER_DRAIN) { E(acc, cur, wr, wc, fr, fq); S.done(cur); }
        if (!has_next) break;
#pragma unroll
        for (int a = 0; a < 2; ++a)
#pragma unroll
            for (int b = 0; b < 2; ++b)
#pragma unroll
                for (int m = 0; m < 4; ++m)
#pragma unroll
                    for (int n = 0; n < 2; ++n) acc[a][b][m][n] = (f32x4){0.f, 0.f, 0.f, 0.f};
        cur = nxt; cA = nA; cB = nB; ++ui;
        if constexpr (ALIGN_EPI) { if (wr == 1) PG8_BAR; }
    }
    PG8_WAIT_V(0);
    if constexpr (!ALIGN_EPI) { if (wr == 0) PG8_BAR; }
    PG8_BAR;
    if constexpr (Epi::AFTER_DRAIN) { E.fused(acc, cur, wr, wc, fr, fq, lds, wid, lane); S.done(cur); }
#undef PG8_SA
#undef PG8_SB
#undef PG8_STAGE
#undef PG8_LDA
#undef PG8_LDB
#undef PG8_MMA
#undef PG8_WAIT_V
#undef PG8_WAIT_L
#undef PG8_BAR
#undef PG8_SCHED
}

struct EpiProj {
    static constexpr bool PERM = true, AFTER_DRAIN = false;
    bf16_t* q; bf16_t* k; bf16_t* v; bf16_t* us; bf16_t* vs; const int* pos;
    __device__ __forceinline__ void operator()(const f32x4 (&acc)[2][2][4][2], const Unit& u, int wr, int wc, int fr, int fq) const {
        const int row0 = u.pm * BM + wr * 64 + fr, b = u.pm >> 4;
        if (u.pn < 12) {
            const bool isq = u.pn < 6; bf16_t* base = isq ? q : k;
            const int hh = 2 * (isq ? u.pn : u.pn - 6) + (wc >> 1), e0 = 32 * (wc & 1) + 8 * fq;
            const float qs = isq ? 0.08838834764831845f : 1.0f;
            float ir[8];
#pragma unroll
            for (int j = 0; j < 8; ++j) ir[j] = exp2f(-(float)(e0 + j) * (13.287712379549449f / 64.0f)) * 0.15915494309189535f;
#pragma unroll
            for (int ai = 0; ai < 2; ++ai)
#pragma unroll
                for (int m = 0; m < 4; ++m) {
                    const int t = row0 + ai * HALF + m * 16, s = t & 4095;
                    const float pf = (float)pos[t];
                    float o0[8], o1[8];
#pragma unroll
                    for (int n = 0; n < 2; ++n)
#pragma unroll
                        for (int i = 0; i < 4; ++i) { const int j = 4 * n + i;
                            const float f = __builtin_amdgcn_fractf(pf * ir[j]); const float sn = __builtin_amdgcn_sinf(f), cs = __builtin_amdgcn_cosf(f);
                            const float t1 = acc[ai][0][m][n][i], t2 = acc[ai][1][m][n][i];
                            o0[j] = (t1 * cs - t2 * sn) * qs; o1[j] = (t2 * cs + t1 * sn) * qs; }
                    bf16_t* dst = base + ((size_t)(b * 12 + hh) * 4096 + s) * 128 + e0;
                    u32x4 w0, w1;
                    w0.x = cvt_pk_bf16(o0[0], o0[1]); w0.y = cvt_pk_bf16(o0[2], o0[3]); w0.z = cvt_pk_bf16(o0[4], o0[5]); w0.w = cvt_pk_bf16(o0[6], o0[7]);
                    w1.x = cvt_pk_bf16(o1[0], o1[1]); w1.y = cvt_pk_bf16(o1[2], o1[3]); w1.z = cvt_pk_bf16(o1[4], o1[5]); w1.w = cvt_pk_bf16(o1[6], o1[7]);
                    *(u32x4*)dst = w0; *(u32x4*)(dst + 64) = w1; }
        } else if (u.pn < 18) {
            const int e0 = 32 * wc + 8 * fq;
#pragma unroll
            for (int ai = 0; ai < 2; ++ai)
#pragma unroll
                for (int m = 0; m < 4; ++m) { const int t = row0 + ai * HALF + m * 16, s = t & 4095;
#pragma unroll
                    for (int bj = 0; bj < 2; ++bj) { const int hh = 2 * (u.pn - 12) + bj; const f32x4 v0 = acc[ai][bj][m][0], v1 = acc[ai][bj][m][1];
                        u32x4 w; w.x = cvt_pk_bf16(v0[0], v0[1]); w.y = cvt_pk_bf16(v0[2], v0[3]); w.z = cvt_pk_bf16(v1[0], v1[1]); w.w = cvt_pk_bf16(v1[2], v1[3]);
                        *(u32x4*)(v + ((size_t)(b * 12 + hh) * 4096 + s) * 128 + e0) = w; } }
        } else {
            bf16_t* base = u.pn < 20 ? us : vs; const int c0 = 256 * ((u.pn - 18) & 1) + 32 * wc + 8 * fq;
#pragma unroll
            for (int ai = 0; ai < 2; ++ai)
#pragma unroll
                for (int m = 0; m < 4; ++m) { const int t = row0 + ai * HALF + m * 16;
#pragma unroll
                    for (int bj = 0; bj < 2; ++bj) { const f32x4 v0 = acc[ai][bj][m][0], v1 = acc[ai][bj][m][1];
                        const f32x2 a = gelu_pk((f32x2){v0[0], v0[1]}), bb = gelu_pk((f32x2){v0[2], v0[3]}), c = gelu_pk((f32x2){v1[0], v1[1]}), d = gelu_pk((f32x2){v1[2], v1[3]});
                        u32x4 w; w.x = cvt_pk_bf16(a.x, a.y); w.y = cvt_pk_bf16(bb.x, bb.y); w.z = cvt_pk_bf16(c.x, c.y); w.w = cvt_pk_bf16(d.x, d.y);
                        *(u32x4*)(base + (size_t)t * 512 + c0 + 128 * bj) = w; } }
        }
    }
};
struct EpiRes {
    static constexpr bool PERM = true, AFTER_DRAIN = false;
    const float* x; bf16_t* hb; const long long* modq;
    __device__ __forceinline__ void operator()(const f32x4 (&acc)[2][2][4][2], const Unit& u, int wr, int wc, int fr, int fq) const {
        const int row0 = u.pm * BM + wr * 64 + fr, col0 = u.pn * BM + wc * 32 + 8 * fq, b = u.pm >> 4;
        f32x4 gt[2][2];
#pragma unroll
        for (int bj = 0; bj < 2; ++bj)
#pragma unroll
            for (int n = 0; n < 2; ++n) { const long long* mp = modq + b * 12288 + 2 * 2048 + col0 + bj * HALF + n * 4;
#pragma unroll
                for (int i = 0; i < 4; ++i) gt[bj][n][i] = (float)(int)(mp[i] >> 32) + (float)(unsigned)mp[i] * 2.3283064365386963e-10f; }
#pragma unroll
        for (int ai = 0; ai < 2; ++ai)
#pragma unroll
            for (int m = 0; m < 4; ++m) { const size_t off = (size_t)(row0 + ai * HALF + m * 16) * 2048 + col0;
#pragma unroll
                for (int bj = 0; bj < 2; ++bj) { const f32x4 x0 = *(const f32x4*)(x + off + bj * HALF), x1 = *(const f32x4*)(x + off + bj * HALF + 4);
                    const f32x4 v0 = x0 + gt[bj][0] * acc[ai][bj][m][0], v1 = x1 + gt[bj][1] * acc[ai][bj][m][1];
                    u32x4 w; w.x = cvt_pk_bf16(v0[0], v0[1]); w.y = cvt_pk_bf16(v0[2], v0[3]); w.z = cvt_pk_bf16(v1[0], v1[1]); w.w = cvt_pk_bf16(v1[2], v1[3]);
                    *(u32x4*)(hb + off + bj * HALF) = w; } }
    }
};
struct EpiPq {
    static constexpr bool PERM = true, AFTER_DRAIN = false;
    bf16_t* o;
    __device__ __forceinline__ void operator()(const f32x4 (&acc)[2][2][4][2], const Unit& u, int wr, int wc, int fr, int fq) const {
        const int row0 = u.pm * BM + wr * 64 + fr, col0 = u.pn * BM + wc * 32 + 8 * fq;
#pragma unroll
        for (int ai = 0; ai < 2; ++ai)
#pragma unroll
            for (int m = 0; m < 4; ++m) { bf16_t* rowp = o + (size_t)(row0 + ai * HALF + m * 16) * 2048 + col0;
#pragma unroll
                for (int bj = 0; bj < 2; ++bj) { const f32x4 v0 = acc[ai][bj][m][0], v1 = acc[ai][bj][m][1];
                    u32x4 w; w.x = cvt_pk_bf16(v0[0], v0[1]); w.y = cvt_pk_bf16(v0[2], v0[3]); w.z = cvt_pk_bf16(v1[0], v1[1]); w.w = cvt_pk_bf16(v1[2], v1[3]);
                    *(u32x4*)(rowp + bj * HALF) = w; } }
    }
};
}

__device__ __forceinline__ void phase_gemm1(const Params& p, unsigned char* lds) {
    pg8::Gemm g{(const bf16_t*)(p.ws + OFF_A), (const bf16_t*)(p.ws + OFF_WIN), T, DIN, D};
    pg8::StaticOrder So; So.init(T, DIN, (int)gridDim.x, (int)blockIdx.x);
    pg8::EpiProj Ep{(bf16_t*)(p.ws + OFF_QKV), (bf16_t*)(p.ws + OFF_QKV + QKV_ONE), (bf16_t*)(p.ws + OFF_QKV + 2 * QKV_ONE), (bf16_t*)(p.ws + OFF_US), (bf16_t*)(p.ws + OFF_VS), p.pos};
    pg8::gemm_phase<pg8::EpiProj, pg8::StaticOrder, true, true>((PG8_LAS unsigned char*)lds, g, So, Ep);
}
__device__ __forceinline__ void phase_gemm2(const Params& p, unsigned char* lds) {
    pg8::Gemm g{(const bf16_t*)(p.ws + OFF_QKV), (const bf16_t*)(p.ws + OFF_WOUT), T, D, D};
    pg8::StaticOrder So; So.init(T, D, (int)gridDim.x, (int)blockIdx.x);
    pg8::EpiRes Ep{p.x, (bf16_t*)(p.ws + OFF_O12), (const long long*)(p.ws + OFF_MOD)};
    pg8::gemm_phase<pg8::EpiRes, pg8::StaticOrder, false, true>((PG8_LAS unsigned char*)lds, g, So, Ep);
}
__device__ __forceinline__ void phase_gemm3(const Params& p, unsigned char* lds) {
    pg8::Gemm g{(const bf16_t*)(p.ws + OFF_A), (const bf16_t*)(p.ws + OFF_WQ), T, D, D};
    pg8::StaticOrder So; So.init(T, D, (int)gridDim.x, (int)blockIdx.x);
    pg8::EpiPq Ep{(bf16_t*)(p.ws + OFF_QKV + (size_t)T * D * 2)};
    pg8::gemm_phase<pg8::EpiPq, pg8::StaticOrder, true, true>((PG8_LAS unsigned char*)lds, g, So, Ep);
}

__device__ __forceinline__ void conv_transpose(const float* __restrict__ W, int N, bf16_t* __restrict__ WT, int perm_limit, float* tile, int bid, int nblk, int tid) {
    const int ntiles = 32 * (N / 64);
    for (int tI = bid; tI < ntiles; tI += nblk) {
        const int tk = tI & 31, tn = tI >> 5, k0 = tk * 64, n0 = tn * 64;
        int l0 = n0;
        if (n0 < perm_limit) { const int base = n0 & ~255, pb = (n0 >> 6) & 3, bj = pb >> 1, qhi = pb & 1; l0 = base + 64 * bj + 128 * qhi; }
        __syncthreads();
#pragma unroll
        for (int pass = 0; pass < 2; ++pass) { const int r = pass * 32 + (tid >> 4), c4 = (tid & 15) * 4;
            const float4 v = *(const float4*)(W + (size_t)(k0 + r) * N + l0 + c4);
            tile[r * 65 + c4 + 0] = v.x; tile[r * 65 + c4 + 1] = v.y; tile[r * 65 + c4 + 2] = v.z; tile[r * 65 + c4 + 3] = v.w; }
        __syncthreads();
        const int n = tid >> 3, kq = (tid & 7) * 8;
        u32x4 w;
        w.x = pack2(tile[(kq + 0) * 65 + n], tile[(kq + 1) * 65 + n]); w.y = pack2(tile[(kq + 2) * 65 + n], tile[(kq + 3) * 65 + n]);
        w.z = pack2(tile[(kq + 4) * 65 + n], tile[(kq + 5) * 65 + n]); w.w = pack2(tile[(kq + 6) * 65 + n], tile[(kq + 7) * 65 + n]);
        *(u32x4*)(WT + (size_t)(n0 + n) * D + k0 + kq) = w;
    }
}
__device__ __forceinline__ void conv_flat(const float* __restrict__ src, bf16_t* __restrict__ dst, size_t n8, int bid, int nblk, int tid) {
    for (size_t i = (size_t)bid * NTHR + tid; i < n8; i += (size_t)nblk * NTHR) {
        const float4 a = ((const float4*)src)[2 * i], b = ((const float4*)src)[2 * i + 1];
        u32x4 w; w.x = pack2(a.x, a.y); w.y = pack2(a.z, a.w); w.z = pack2(b.x, b.y); w.w = pack2(b.z, b.w);
        ((u32x4*)dst)[i] = w; }
}
__device__ __forceinline__ unsigned q8pack(float a, float b, float c, float d, int bias) {
    const int qa = (int)rintf(a) + bias, qb = (int)rintf(b) + bias, qc = (int)rintf(c) + bias, qd = (int)rintf(d) + bias;
    return (unsigned)(qa & 255) | ((unsigned)(qb & 255) << 8) | ((unsigned)(qc & 255) << 16) | ((unsigned)(qd & 255) << 24);
}
template <int BIAS> __device__ __forceinline__ void conv_rows_i8(const float* __restrict__ src, unsigned char* __restrict__ dst, float* __restrict__ inv, int bid, int nblk, int tid) {
    const int lane = tid & 63, gw = bid * NWV + (tid >> 6), nw = nblk * NWV;
    for (int r = gw; r < NEXP; r += nw) {
        const float4* row = (const float4*)(src + (size_t)r * D);
        float4 v[8]; float m = 0.f;
#pragma unroll
        for (int i = 0; i < 8; ++i) { v[i] = row[i * 64 + lane]; m = fmaxf(m, fmaxf(fmaxf(fabsf(v[i].x), fabsf(v[i].y)), fmaxf(fabsf(v[i].z), fabsf(v[i].w)))); }
        m = wave_max(m);
        const float sc = m > 0.f ? 127.0f / m : 0.f, isc = m * (1.0f / 127.0f);
        unsigned char* drow = dst + (size_t)(lane >> 5) * SLICE_BYTES + (size_t)r * 128 + (lane & 31) * 4;
#pragma unroll
        for (int i = 0; i < 8; ++i) *(unsigned*)(drow + (size_t)(2 * i) * SLICE_BYTES) = q8pack(v[i].x * sc, v[i].y * sc, v[i].z * sc, v[i].w * sc, BIAS);
        if (lane == 0) inv[r] = isc;
    }
}
__device__ __forceinline__ void phase_conv(const Params& p, unsigned char* lds, bool dup = false) {
    const int tid = threadIdx.x, bid = blockIdx.x, nblk = gridDim.x;
    unsigned long long* mod = (unsigned long long*)(p.ws + OFF_MOD);
    unsigned long long cts = 0; CSTAMP(0);
    for (int it = bid; it < (dup ? 0 : 192); it += nblk) {
        const int cb = it % 48, kg = it / 48, lane = tid & 63, wv = tid >> 6;
        float* sc = (float*)lds;
        float* red = (float*)lds + 2048;
        __syncthreads();
        for (int i = tid; i < 2048; i += NTHR) { const int b = i >> 9, kk = i & 511; const float cv = p.c[b * D + kg * 512 + kk]; sc[i] = cv / (1.f + __expf(-cv)); }
        __syncthreads();
        float acc[4][4];
#pragma unroll
        for (int b = 0; b < 4; ++b) { acc[b][0] = 0.f; acc[b][1] = 0.f; acc[b][2] = 0.f; acc[b][3] = 0.f; }
        const float* wp = p.w_ada + (size_t)(kg * 512 + wv * 64) * 12288 + cb * 256 + lane * 4;
#pragma unroll 1
        for (int k0 = 0; k0 < 64; k0 += 16) {
            float4 w[16];
#pragma unroll
            for (int kk = 0; kk < 16; ++kk) w[kk] = *(const float4*)(wp + (size_t)(k0 + kk) * 12288);
#pragma unroll
            for (int kk = 0; kk < 16; ++kk)
#pragma unroll
                for (int b = 0; b < 4; ++b) { const float sv = sc[b * 512 + wv * 64 + k0 + kk];
                    acc[b][0] += sv * w[kk].x; acc[b][1] += sv * w[kk].y; acc[b][2] += sv * w[kk].z; acc[b][3] += sv * w[kk].w; }
        }
#pragma unroll
        for (int b = 0; b < 4; ++b) *(float4*)(red + (wv * 4 + b) * 256 + lane * 4) = make_float4(acc[b][0], acc[b][1], acc[b][2], acc[b][3]);
        __syncthreads();
        if (tid < 256) {
#pragma unroll
            for (int b = 0; b < 4; ++b) { float sum = 0.f;
#pragma unroll
                for (int w8 = 0; w8 < 8; ++w8) sum += red[(w8 * 4 + b) * 256 + tid];
                const int col = cb * 256 + tid;
                if (kg == 0) sum += p.b_ada[col];
                atomicAdd(mod + b * 12288 + col, (unsigned long long)__double2ll_rn((double)sum * 4294967296.0)); }
        }
    }
    CSTAMP(1);
    conv_transpose(p.w_in, DIN, (bf16_t*)(p.ws + OFF_WIN), 3072, (float*)lds, bid, nblk, tid);
    conv_transpose(p.w_out, D, (bf16_t*)(p.ws + OFF_WOUT), 0, (float*)lds, bid, nblk, tid);
    conv_transpose(p.peer_w_q, D, (bf16_t*)(p.ws + OFF_WQ), 0, (float*)lds, bid, nblk, tid);
    CSTAMP(2);
    conv_rows_i8<0>(p.peer_u, p.ws + OFF_UTAB, (float*)(p.ws + OFF_UTAB + TAB8_BYTES), bid, nblk, tid);
    conv_rows_i8<128>(p.peer_v, p.ws + OFF_VTAB, (float*)(p.ws + OFF_VTAB + TAB8_BYTES), bid, nblk, tid);
    conv_flat(p.peer_sub_keys, (bf16_t*)(p.ws + OFF_SUBK), (size_t)8 * 2 * 128 * 128 / 8, bid, nblk, tid);
    CSTAMP(3);
    { bf16_t* sw = (bf16_t*)(p.ws + OFF_SGUW);
      for (int i = bid * NTHR + tid; i < 4 * 128 * 128; i += nblk * NTHR) { const int jj = i & 127, ii = (i >> 7) & 127; sw[i] = f2bf(jj <= ii ? p.sgu_w[i] : 0.f); } }
}

template <bool Q8, bool SRC16> __device__ __forceinline__ void phase_norm_mod(const Params& p, const void* __restrict__ src_, const float* __restrict__ g, int sh_i, int sc_i, bf16_t* __restrict__ dst) {
    const int lane = threadIdx.x & 63, gw = blockIdx.x * NWV + __builtin_amdgcn_readfirstlane(threadIdx.x >> 6), nw = gridDim.x * NWV;
    const int wpb = nw >> 2;
    const int b = gw / wpb, r0 = gw - b * wpb;
    if (b >= NB) return;
    float4 ca[8], cb[8];
#pragma unroll
    for (int i = 0; i < 8; ++i) { const int col = i * 256 + lane * 4; const float4 gg = *(const float4*)(g + col), sc = mod4(p, b, sc_i, col), sh = mod4(p, b, sh_i, col);
        ca[i] = make_float4(gg.x * (1.f + sc.x), gg.y * (1.f + sc.y), gg.z * (1.f + sc.z), gg.w * (1.f + sc.w)); cb[i] = sh; }
    float4 vf[8]; u32x2 vh[8];
#define NM_LOAD(tt) do { _Pragma("unroll") for (int i = 0; i < 8; ++i) { if (SRC16) vh[i] = *(const u32x2*)((const bf16_t*)src_ + (size_t)(tt) * D + i * 256 + lane * 4); else vf[i] = *(const float4*)((const float*)src_ + (size_t)(tt) * D + i * 256 + lane * 4); } } while (0)
    if (r0 < S) NM_LOAD(b * S + r0);
    for (int r = r0; r < S; r += wpb) {
        const int t = b * S + r;
        float4 v[8]; float ss = 0.f;
#pragma unroll
        for (int i = 0; i < 8; ++i) { v[i] = SRC16 ? make_float4(bflo(vh[i].x), bfhi(vh[i].x), bflo(vh[i].y), bfhi(vh[i].y)) : vf[i];
            ss += v[i].x * v[i].x + v[i].y * v[i].y + v[i].z * v[i].z + v[i].w * v[i].w; }
        if (r + wpb < S) NM_LOAD(t + wpb);
        ss = wave_sum(ss); const float rstd = rsqrtf(ss * (1.0f / D) + 1e-6f);
        float m = 0.f;
#pragma unroll
        for (int i = 0; i < 8; ++i) { const int col = i * 256 + lane * 4;
            v[i].x = v[i].x * rstd * ca[i].x + cb[i].x; v[i].y = v[i].y * rstd * ca[i].y + cb[i].y; v[i].z = v[i].z * rstd * ca[i].z + cb[i].z; v[i].w = v[i].w * rstd * ca[i].w + cb[i].w;
            u32x2 w; w.x = pack2(v[i].x, v[i].y); w.y = pack2(v[i].z, v[i].w);
            *(u32x2*)(dst + (size_t)t * D + col) = w;
            if (Q8) m = fmaxf(m, fmaxf(fmaxf(fabsf(v[i].x), fabsf(v[i].y)), fmaxf(fabsf(v[i].z), fabsf(v[i].w)))); }
        if (Q8) {
            m = wave_max(m); const float sc8 = m > 0.f ? 127.0f / m : 0.f;
            unsigned* x8 = (unsigned*)(p.ws + OFF_US + (size_t)t * D);
#pragma unroll
            for (int i = 0; i < 8; ++i) x8[i * 64 + lane] = q8pack(v[i].x * sc8, v[i].y * sc8, v[i].z * sc8, v[i].w * sc8, 0);
            if (lane == 0) ((float*)(p.ws + OFF_SGUO))[t] = m * (1.0f / 127.0f);
        }
    }
#undef NM_LOAD
}

#define LAS __attribute__((address_space(3)))
typedef short bf16x8 __attribute__((ext_vector_type(8)));
typedef short s16x4 __attribute__((ext_vector_type(4)));
constexpr int ATT_VOFF = 65536, ATT_VSTRIDE = 288;
__device__ __forceinline__ unsigned cvt_pk(float lo, float hi) { unsigned r; asm volatile("v_cvt_pk_bf16_f32 %0, %1, %2" : "=v"(r) : "v"(lo), "v"(hi)); return r; }
struct AttnItem { int pat, bh, r, n, dsh; };
__device__ __forceinline__ AttnItem attn_decode(int item) {
    AttnItem a; a.pat = item / 1536; const int rem = item % 1536; a.bh = rem >> 5; const int ci = rem & 31;
    a.dsh = 2 * a.pat; const int nblk = 32 >> a.dsh; a.r = ci / nblk; a.n = ci % nblk; return a;
}
__device__ __forceinline__ void attn_issue(const AttnItem& a, const bf16_t* qb, const bf16_t* kb, const bf16_t* vb, int tid, int w, int l15, int g, u32x4 (&kr)[8], u32x4 (&vr)[8], bf16x8 (&qf)[4]) {
    const size_t hb = (size_t)a.bh * S;
#pragma unroll
    for (int i = 0; i < 8; ++i) { const int ch = i * NTHR + tid, kk = ch >> 4, c = ch & 15;
        if (a.n > 0 || kk >= 128) { const int tp = (((a.n - 1) * 128 + kk) << a.dsh) + a.r;
            kr[i] = *(const u32x4*)(kb + (hb + tp) * E + c * 8); vr[i] = *(const u32x4*)(vb + (hb + tp) * E + c * 8); } }
    const int tq = ((a.n * 128 + 16 * w + l15) << a.dsh) + a.r;
#pragma unroll
    for (int ks = 0; ks < 4; ++ks) qf[ks] = *(const bf16x8*)(qb + (hb + tq) * E + 32 * ks + 8 * g);
}
__device__ __forceinline__ void phase_attn(const Params& p, unsigned char* lds_) {
    LAS unsigned char* lds = (LAS unsigned char*)lds_;
    const int tid = threadIdx.x, lane = tid & 63, w = __builtin_amdgcn_readfirstlane(tid >> 6), l15 = lane & 15, g = lane >> 4;
    const bf16_t* qb = (const bf16_t*)(p.ws + OFF_QKV); const bf16_t* kb = (const bf16_t*)(p.ws + OFF_QKV + QKV_ONE); const bf16_t* vb = (const bf16_t*)(p.ws + OFF_QKV + 2 * QKV_ONE);
    float* lse = (float*)(p.ws + OFF_LSE);
    const int G = gridDim.x, vcu = (G % 8 == 0) ? (int)(blockIdx.x & 7) * (G >> 3) + (int)(blockIdx.x >> 3) : (int)blockIdx.x;
    const float NEG = -__builtin_inff();
    constexpr int NITEMS = 3 * 48 * 32;
    u32x4 kr[8], vr[8]; bf16x8 qn[4];
    if (vcu < NITEMS) attn_issue(attn_decode(vcu), qb, kb, vb, tid, w, l15, g, kr, vr, qn);
    for (int item = vcu; item < NITEMS; item += G) {
        const AttnItem a = attn_decode(item);
        const int pat = a.pat, bh = a.bh, r = a.r, n = a.n, dsh = a.dsh;
        __syncthreads();
#pragma unroll
        for (int i = 0; i < 8; ++i) { const int ch = i * NTHR + tid, kk = ch >> 4, c = ch & 15;
            if (n > 0 || kk >= 128) { *(LAS u32x4*)(lds + kk * 256 + ((c ^ (kk & 15)) << 4)) = kr[i]; *(LAS u32x4*)(lds + ATT_VOFF + kk * ATT_VSTRIDE + c * 16) = vr[i]; } }
        bf16x8 qf[4];
#pragma unroll
        for (int ks = 0; ks < 4; ++ks) { qf[ks] = qn[ks]; asm volatile("" : "+v"(qf[ks])); }
        __syncthreads();
        if (item + G < NITEMS) attn_issue(attn_decode(item + G), qb, kb, vb, tid, w, l15, g, kr, vr, qn);
        const int jj = 16 * w + l15, tq = ((n * 128 + jj) << dsh) + r;
        const int s0 = w >> 1;
        f32x4 sA[5], sB[5];
#define ATT_LDK(dst, step_, kp_) do { const int _kA = 32 * (step_) + l15, _kB = _kA + 16; _Pragma("unroll") for (int q = 0; q < 2; ++q) { const int ks = 2 * (kp_) + q; \
            dst[2 * q] = *(const LAS bf16x8*)(lds + _kA * 256 + (((4 * ks + g) ^ (_kA & 15)) << 4)); dst[2 * q + 1] = *(const LAS bf16x8*)(lds + _kB * 256 + (((4 * ks + g) ^ (_kB & 15)) << 4)); } } while (0)
        bf16x8 kc[4], kn[4];
        ATT_LDK(kc, s0, 0);
#pragma unroll
        for (int gi = 0; gi < 10; ++gi) {
            const int si = gi >> 1, kp = gi & 1, step = s0 + si;
            if (gi < 9) ATT_LDK(kn, s0 + ((gi + 1) >> 1), (gi + 1) & 1);
            __builtin_amdgcn_sched_barrier(0);
            if (kp == 0) { sA[si] = (f32x4){0.f, 0.f, 0.f, 0.f}; sB[si] = (f32x4){0.f, 0.f, 0.f, 0.f}; }
            if (!(n == 0 && step < 4)) {
#pragma unroll
                for (int q = 0; q < 2; ++q) { sA[si] = __builtin_amdgcn_mfma_f32_16x16x32_bf16(kc[2 * q], qf[2 * kp + q], sA[si], 0, 0, 0); sB[si] = __builtin_amdgcn_mfma_f32_16x16x32_bf16(kc[2 * q + 1], qf[2 * kp + q], sB[si], 0, 0, 0); } }
            if (kp == 1 && (n == 0 && step < 4)) { sA[si] = (f32x4){NEG, NEG, NEG, NEG}; sB[si] = (f32x4){NEG, NEG, NEG, NEG}; }
            if (kp == 1 && (si == 0 || si == 4)) {
#pragma unroll
                for (int rg = 0; rg < 4; ++rg) { const int ka = 32 * step + 4 * g + rg, kb2 = ka + 16;
                    const bool oka = (unsigned)(ka - jj) <= 128u, okb = (unsigned)(kb2 - jj) <= 128u;
                    sA[si][rg] = oka ? sA[si][rg] : NEG; sB[si][rg] = okb ? sB[si][rg] : NEG; } }
            if (gi < 9) {
#pragma unroll
                for (int q = 0; q < 4; ++q) kc[q] = kn[q]; }
        }
#undef ATT_LDK
        float m = NEG;
#pragma unroll
        for (int si = 0; si < 5; ++si)
#pragma unroll
            for (int rg = 0; rg < 4; ++rg) m = fmaxf(m, fmaxf(sA[si][rg], sB[si][rg]));
        m = fmaxf(m, __shfl_xor(m, 16)); m = fmaxf(m, __shfl_xor(m, 32));
        float l = 0.f; const float mL = m * 1.4426950408889634f;
#pragma unroll
        for (int si = 0; si < 5; ++si)
#pragma unroll
            for (int rg = 0; rg < 4; ++rg) { sA[si][rg] = __builtin_amdgcn_exp2f(sA[si][rg] * 1.4426950408889634f - mL); sB[si][rg] = __builtin_amdgcn_exp2f(sB[si][rg] * 1.4426950408889634f - mL); l += sA[si][rg] + sB[si][rg]; }
        l += __shfl_xor(l, 16); l += __shfl_xor(l, 32);
        f32x4 o[8];
#pragma unroll
        for (int dt = 0; dt < 8; ++dt) o[dt] = (f32x4){0.f, 0.f, 0.f, 0.f};
#define ATT_LDV(dst, step_, hf_) do { LAS unsigned char* _vr = lds + ATT_VOFF + (32 * (step_) + 4 * g + (l15 >> 2)) * ATT_VSTRIDE + (l15 & 3) * 8 + (hf_) * 128; _Pragma("unroll") for (int q = 0; q < 4; ++q) { \
            dst[2 * q] = __builtin_amdgcn_ds_read_tr16_b64_v4i16((LAS s16x4*)(_vr + q * 32)); dst[2 * q + 1] = __builtin_amdgcn_ds_read_tr16_b64_v4i16((LAS s16x4*)(_vr + q * 32 + 16 * ATT_VSTRIDE)); } } while (0)
        bf16x8 pfa[5];
#pragma unroll
        for (int si = 0; si < 5; ++si) { u32x4 pw; pw.x = cvt_pk(sA[si][0], sA[si][1]); pw.y = cvt_pk(sA[si][2], sA[si][3]); pw.z = cvt_pk(sB[si][0], sB[si][1]); pw.w = cvt_pk(sB[si][2], sB[si][3]); pfa[si] = *reinterpret_cast<const bf16x8*>(&pw); }
        s16x4 vc[8], vn[8];
        ATT_LDV(vc, s0, 0);
#pragma unroll
        for (int gi = 0; gi < 10; ++gi) {
            const int si = gi >> 1, hf = gi & 1, step = s0 + si;
            if (gi < 9) ATT_LDV(vn, s0 + ((gi + 1) >> 1), (gi + 1) & 1);
            __builtin_amdgcn_sched_barrier(0);
            if (!(n == 0 && step < 4)) {
#pragma unroll
                for (int q = 0; q < 4; ++q) { const s16x4 v0 = vc[2 * q], v1 = vc[2 * q + 1];
                    const bf16x8 vf = {v0[0], v0[1], v0[2], v0[3], v1[0], v1[1], v1[2], v1[3]};
                    o[4 * hf + q] = __builtin_amdgcn_mfma_f32_16x16x32_bf16(vf, pfa[si], o[4 * hf + q], 0, 0, 0); } }
            if (gi < 9) {
#pragma unroll
                for (int q = 0; q < 8; ++q) vc[q] = vn[q]; }
        }
#undef ATT_LDV
        const float il = 1.0f / l; const int b_ = bh / HA, h = bh % HA; const size_t tg = (size_t)b_ * S + tq;
        bf16_t* orow = P_opat(p, pat) + tg * DA + h * E + 4 * g;
#pragma unroll
        for (int dt = 0; dt < 8; ++dt) { u32x2 ww; ww.x = cvt_pk(o[dt][0] * il, o[dt][1] * il); ww.y = cvt_pk(o[dt][2] * il, o[dt][3] * il); *(u32x2*)(orow + 16 * dt) = ww; }
        if (g == 0) lse[((size_t)pat * T + tg) * HA + h] = m + __logf(l);
    }
}

__device__ __forceinline__ void phase_sgu(const Params& p, unsigned char* lds_) {
    LAS unsigned char* lds = (LAS unsigned char*)lds_;
    const int tid = threadIdx.x, lane = tid & 63, w = __builtin_amdgcn_readfirstlane(tid >> 6), l15 = lane & 15, g = lane >> 4;
    const bf16_t* vsb = (const bf16_t*)(p.ws + OFF_VS); const bf16_t* usb = (const bf16_t*)(p.ws + OFF_US); bf16_t* ob = (bf16_t*)(p.ws + OFF_SGUO);
    const bf16_t* sw = (const bf16_t*)(p.ws + OFF_SGUW);
    for (int item = blockIdx.x; item < (T / 128) * HS; item += gridDim.x) {
        const int h = item & 3, t0 = (item >> 2) * 128;
        __syncthreads();
        {
            const int j = tid >> 2, part = tid & 3;
            const u32x4* src = (const u32x4*)(vsb + (size_t)(t0 + j) * DS + h * E + part * 32);
            u32x4 x[4]; float sum = 0.f;
#pragma unroll
            for (int i = 0; i < 4; ++i) { x[i] = src[i]; sum += bflo(x[i].x) + bfhi(x[i].x) + bflo(x[i].y) + bfhi(x[i].y) + bflo(x[i].z) + bfhi(x[i].z) + bflo(x[i].w) + bfhi(x[i].w); }
            sum += __shfl_xor(sum, 1); sum += __shfl_xor(sum, 2);
            const float mu = sum * (1.0f / E); float var = 0.f;
#pragma unroll
            for (int i = 0; i < 4; ++i) { float dd;
                dd = bflo(x[i].x) - mu; var += dd * dd; dd = bfhi(x[i].x) - mu; var += dd * dd; dd = bflo(x[i].y) - mu; var += dd * dd; dd = bfhi(x[i].y) - mu; var += dd * dd;
                dd = bflo(x[i].z) - mu; var += dd * dd; dd = bfhi(x[i].z) - mu; var += dd * dd; dd = bflo(x[i].w) - mu; var += dd * dd; dd = bfhi(x[i].w) - mu; var += dd * dd; }
            var += __shfl_xor(var, 1); var += __shfl_xor(var, 2);
            const float rs = rsqrtf(var * (1.0f / E) + 1e-5f);
            const float* lg = p.sgu_ln_g + h * E + part * 32; const float* lb = p.sgu_ln_b + h * E + part * 32;
#pragma unroll
            for (int i = 0; i < 4; ++i) { const float4 g0 = *(const float4*)(lg + i * 8), g1 = *(const float4*)(lg + i * 8 + 4), b0 = *(const float4*)(lb + i * 8), b1 = *(const float4*)(lb + i * 8 + 4);
                u32x4 o; o.x = cvt_pk((bflo(x[i].x) - mu) * rs * g0.x + b0.x, (bfhi(x[i].x) - mu) * rs * g0.y + b0.y); o.y = cvt_pk((bflo(x[i].y) - mu) * rs * g0.z + b0.z, (bfhi(x[i].y) - mu) * rs * g0.w + b0.w);
                o.z = cvt_pk((bflo(x[i].z) - mu) * rs * g1.x + b1.x, (bfhi(x[i].z) - mu) * rs * g1.y + b1.y); o.w = cvt_pk((bflo(x[i].w) - mu) * rs * g1.z + b1.z, (bfhi(x[i].w) - mu) * rs * g1.w + b1.w);
                *(LAS u32x4*)(lds + j * ATT_VSTRIDE + part * 64 + i * 16) = o; }
        }
        __syncthreads();
        f32x4 acc[8];
#pragma unroll
        for (int et = 0; et < 8; ++et) acc[et] = (f32x4){0.f, 0.f, 0.f, 0.f};
        const int irow = 16 * w + l15, nsteps = (16 * w + 15) / 32 + 1;
        const bf16_t* wrow = sw + ((size_t)h * 128 + irow) * 128;
        for (int st = 0; st < nsteps; ++st) {
            const u32x2 wa = *(const u32x2*)(wrow + 32 * st + 4 * g), wb = *(const u32x2*)(wrow + 32 * st + 16 + 4 * g);
            u32x4 wf4; wf4.x = wa.x; wf4.y = wa.y; wf4.z = wb.x; wf4.w = wb.y;
            const bf16x8 wf = *reinterpret_cast<const bf16x8*>(&wf4);
            LAS unsigned char* vrow = lds + (32 * st + 4 * g + (l15 >> 2)) * ATT_VSTRIDE + (l15 & 3) * 8;
#pragma unroll
            for (int et = 0; et < 8; ++et) {
                const s16x4 v0 = __builtin_amdgcn_ds_read_tr16_b64_v4i16((LAS s16x4*)(vrow + et * 32));
                const s16x4 v1 = __builtin_amdgcn_ds_read_tr16_b64_v4i16((LAS s16x4*)(vrow + et * 32 + 16 * ATT_VSTRIDE));
                const bf16x8 vf = {v0[0], v0[1], v0[2], v0[3], v1[0], v1[1], v1[2], v1[3]};
                acc[et] = __builtin_amdgcn_mfma_f32_16x16x32_bf16(vf, wf, acc[et], 0, 0, 0); }
        }
        const float bias = p.sgu_b[h * 128 + irow];
        const size_t base = (size_t)(t0 + irow) * DS + h * E + 4 * g;
#pragma unroll
        for (int et = 0; et < 8; ++et) { const u32x2 uu = *(const u32x2*)(usb + base + 16 * et);
            u32x2 oo; oo.x = cvt_pk(bflo(uu.x) * (acc[et][0] + bias), bfhi(uu.x) * (acc[et][1] + bias)); oo.y = cvt_pk(bflo(uu.y) * (acc[et][2] + bias), bfhi(uu.y) * (acc[et][3] + bias));
            *(u32x2*)(ob + base + 16 * et) = oo; }
    }
}

__device__ __forceinline__ void phase_combine(const Params& p) {
    const int lane = threadIdx.x & 63, gw = blockIdx.x * NWV + __builtin_amdgcn_readfirstlane(threadIdx.x >> 6), nw = gridDim.x * NWV;
    const float* lse = (const float*)(p.ws + OFF_LSE);
    const bf16_t* sg = (const bf16_t*)(p.ws + OFF_SGUO); bf16_t* mixed = (bf16_t*)(p.ws + OFF_QKV);
    const bf16_t* o0 = P_opat(p, 0); const bf16_t* o1 = P_opat(p, 1); const bf16_t* o2 = P_opat(p, 2);
    float ga[24], gs[8];
#pragma unroll
    for (int i = 0; i < 3; ++i) { const int col0 = (lane + 64 * i) * 8; const float4 g0 = *(const float4*)(p.g_attn_out + col0), g1 = *(const float4*)(p.g_attn_out + col0 + 4);
        ga[i * 8 + 0] = g0.x; ga[i * 8 + 1] = g0.y; ga[i * 8 + 2] = g0.z; ga[i * 8 + 3] = g0.w; ga[i * 8 + 4] = g1.x; ga[i * 8 + 5] = g1.y; ga[i * 8 + 6] = g1.z; ga[i * 8 + 7] = g1.w; }
    { const float4 g0 = *(const float4*)(p.g_sgu_out + lane * 8), g1 = *(const float4*)(p.g_sgu_out + lane * 8 + 4);
      gs[0] = g0.x; gs[1] = g0.y; gs[2] = g0.z; gs[3] = g0.w; gs[4] = g1.x; gs[5] = g1.y; gs[6] = g1.z; gs[7] = g1.w; }
    u32x4 xa[3], xb[3], xc[3], xs; float l0 = 0.f, l1 = 0.f, l2 = 0.f;
#define CB_LOAD(tt) do { _Pragma("unroll") for (int i = 0; i < 3; ++i) { const size_t o = (size_t)(tt) * DA + (lane + 64 * i) * 8; xa[i] = *(const u32x4*)(o0 + o); xb[i] = *(const u32x4*)(o1 + o); xc[i] = *(const u32x4*)(o2 + o); } \
        xs = *(const u32x4*)(sg + (size_t)(tt) * DS + lane * 8); \
        if (lane < HA) { l0 = lse[((size_t)0 * T + (tt)) * HA + lane]; l1 = lse[((size_t)1 * T + (tt)) * HA + lane]; l2 = lse[((size_t)2 * T + (tt)) * HA + lane]; } } while (0)
    if (gw < T) CB_LOAD(gw);
    for (int t = gw; t < T; t += nw) {
        float w0 = 0.f, w1 = 0.f, w2 = 0.f;
        if (lane < HA) { const float m = fmaxf(l0, fmaxf(l1, l2)); const float e0 = __expf(l0 - m), e1 = __expf(l1 - m), e2 = __expf(l2 - m); const float is = 1.0f / (e0 + e1 + e2);
            w0 = e0 * is; w1 = e1 * is; w2 = e2 * is; }
        float av[3][8]; float ss = 0.f;
#pragma unroll
        for (int i = 0; i < 3; ++i) { const int hh = ((lane + 64 * i) * 8) >> 7;
            const float a0 = __shfl(w0, hh), a1 = __shfl(w1, hh), a2 = __shfl(w2, hh);
            const u32x4 x0 = xa[i], x1 = xb[i], x2 = xc[i];
            av[i][0] = a0 * bflo(x0.x) + a1 * bflo(x1.x) + a2 * bflo(x2.x); av[i][1] = a0 * bfhi(x0.x) + a1 * bfhi(x1.x) + a2 * bfhi(x2.x);
            av[i][2] = a0 * bflo(x0.y) + a1 * bflo(x1.y) + a2 * bflo(x2.y); av[i][3] = a0 * bfhi(x0.y) + a1 * bfhi(x1.y) + a2 * bfhi(x2.y);
            av[i][4] = a0 * bflo(x0.z) + a1 * bflo(x1.z) + a2 * bflo(x2.z); av[i][5] = a0 * bfhi(x0.z) + a1 * bfhi(x1.z) + a2 * bfhi(x2.z);
            av[i][6] = a0 * bflo(x0.w) + a1 * bflo(x1.w) + a2 * bflo(x2.w); av[i][7] = a0 * bfhi(x0.w) + a1 * bfhi(x1.w) + a2 * bfhi(x2.w);
#pragma unroll
            for (int j = 0; j < 8; ++j) ss += av[i][j] * av[i][j]; }
        float sv[8] = {bflo(xs.x), bfhi(xs.x), bflo(xs.y), bfhi(xs.y), bflo(xs.z), bfhi(xs.z), bflo(xs.w), bfhi(xs.w)}; float s2 = 0.f;
#pragma unroll
        for (int j = 0; j < 8; ++j) s2 += sv[j] * sv[j];
        if (t + nw < T) CB_LOAD(t + nw);
        ss = wave_sum(ss); const float rs = rsqrtf(ss * (1.0f / DA) + 1e-6f);
#pragma unroll
        for (int i = 0; i < 3; ++i) { const int col0 = (lane + 64 * i) * 8;
            u32x4 w; w.x = pack2(av[i][0] * rs * ga[i * 8 + 0], av[i][1] * rs * ga[i * 8 + 1]); w.y = pack2(av[i][2] * rs * ga[i * 8 + 2], av[i][3] * rs * ga[i * 8 + 3]);
            w.z = pack2(av[i][4] * rs * ga[i * 8 + 4], av[i][5] * rs * ga[i * 8 + 5]); w.w = pack2(av[i][6] * rs * ga[i * 8 + 6], av[i][7] * rs * ga[i * 8 + 7]);
            *(u32x4*)(mixed + (size_t)t * D + col0) = w; }
        s2 = wave_sum(s2); const float r2 = rsqrtf(s2 * (1.0f / DS) + 1e-6f);
        { u32x4 w; w.x = pack2(sv[0] * r2 * gs[0], sv[1] * r2 * gs[1]); w.y = pack2(sv[2] * r2 * gs[2], sv[3] * r2 * gs[3]);
          w.z = pack2(sv[4] * r2 * gs[4], sv[5] * r2 * gs[5]); w.w = pack2(sv[6] * r2 * gs[6], sv[7] * r2 * gs[7]);
          *(u32x4*)(mixed + (size_t)t * D + DA + lane * 8) = w; }
    }
#undef CB_LOAD
}

__device__ __forceinline__ int f2key(float f) { const int b = __float_as_int(f); return b ^ ((b >> 31) & 0x7fffffff); }
__device__ __forceinline__ float key2f(int k) { return __int_as_float(k ^ ((k >> 31) & 0x7fffffff)); }
typedef int i32x16 __attribute__((ext_vector_type(16)));
typedef float f32x16v __attribute__((ext_vector_type(16)));
#define TK_CE(v, i, l) do { const int _a = v[i], _b = v[l]; v[i] = max(_a, _b); v[l] = min(_a, _b); } while (0)
__device__ __forceinline__ i32x16 sort16_desc(i32x16 v) {
#pragma unroll
    for (int lk = 1; lk <= 4; ++lk)
#pragma unroll
        for (int lj = 3; lj >= 0; --lj) { if (lj >= lk) continue; const int k = 1 << lk, j = 1 << lj;
#pragma unroll
            for (int i = 0; i < 16; ++i) { const int l = i ^ j; if (l > i) { if ((i & k) == 0) TK_CE(v, i, l); else TK_CE(v, l, i); } } }
    return v;
}
__device__ __forceinline__ i32x16 bitonic_merge16_desc(i32x16 v) {
#pragma unroll
    for (int lj = 3; lj >= 0; --lj) { const int j = 1 << lj;
#pragma unroll
        for (int i = 0; i < 16; ++i) { const int l = i ^ j; if (l > i) TK_CE(v, i, l); } }
    return v;
}
__device__ __forceinline__ i32x16 merge_top16(i32x16 a, i32x16 b) {
#pragma unroll
    for (int i = 0; i < 16; ++i) a[i] = max(a[i], b[15 - i]);
    return bitonic_merge16_desc(a);
}
__device__ __forceinline__ i32x16 xlane_merge_top16(i32x16 a, int xr) {
    i32x16 b;
#pragma unroll
    for (int i = 0; i < 16; ++i) b[i] = __shfl_xor(a[i], xr);
    return merge_top16(a, b);
}
__device__ __forceinline__ int sel2i(bool c, int x, int y) { return c ? y : x; }
__device__ __forceinline__ int sel16(i32x16 v, int i) {
    const bool c0 = (i & 1) != 0, c1 = (i & 2) != 0, c2 = (i & 4) != 0, c3 = (i & 8) != 0;
    const int a0 = sel2i(c0, v[0], v[1]), a1 = sel2i(c0, v[2], v[3]), a2 = sel2i(c0, v[4], v[5]), a3 = sel2i(c0, v[6], v[7]);
    const int a4 = sel2i(c0, v[8], v[9]), a5 = sel2i(c0, v[10], v[11]), a6 = sel2i(c0, v[12], v[13]), a7 = sel2i(c0, v[14], v[15]);
    const int b0 = sel2i(c1, a0, a1), b1 = sel2i(c1, a2, a3), b2 = sel2i(c1, a4, a5), b3 = sel2i(c1, a6, a7);
    const int d0 = sel2i(c2, b0, b1), d1 = sel2i(c2, b2, b3);
    return sel2i(c3, d0, d1);
}
__device__ __forceinline__ int sel4i(int g, int a, int b, int c, int d) { return g == 0 ? a : (g == 1 ? b : (g == 2 ? c : d)); }
__device__ __forceinline__ float sel4f(int g, float a, float b, float c, float d) { return g == 0 ? a : (g == 1 ? b : (g == 2 ? c : d)); }
constexpr int TK_TAB[64] = {
    0x00, 0x01, 0x02, 0x03, 0x04, 0x05, 0x06, 0x07, 0x08, 0x09, 0x0A, 0x0B, 0x0C, 0x0D, 0x0E, 0x0F,
    0x10, 0x11, 0x12, 0x13, 0x14, 0x15, 0x16, 0x17, 0x40, 0x41, 0x42, 0x80, 0x90, 0xFF, 0xFF, 0xFF,
    0x20, 0x21, 0x22, 0x23, 0x24, 0x30, 0x31, 0x32, 0x33, 0x50, 0x51, 0xA0, 0xB0, 0xFF, 0xFF, 0xFF,
    0x60, 0x61, 0x70, 0x71, 0xC0, 0xD0, 0xE0, 0xF0, 0xFF, 0xFF, 0xFF, 0xFF, 0xFF, 0xFF, 0xFF, 0xFF};
template <int C> __device__ __forceinline__ int tk_make_cand(i32x16 sp0, i32x16 sp1, int g) {
    constexpr int NONE = (int)0x80000000;
    constexpr int e0 = TK_TAB[C], e1 = TK_TAB[16 + C], e2 = TK_TAB[32 + C], e3 = TK_TAB[48 + C];
    constexpr int r0 = (e0 >> 4) & 15, r1 = e1 == 0xFF ? 0 : (e1 >> 4) & 15, r2 = e2 == 0xFF ? 0 : (e2 >> 4) & 15, r3 = e3 == 0xFF ? 0 : (e3 >> 4) & 15;
    constexpr int c0 = e0 & 15, c1 = e1 == 0xFF ? 0 : e1 & 15, c2 = e2 == 0xFF ? 0 : e2 & 15, c3 = e3 == 0xFF ? 0 : e3 & 15;
    const int av = sel4i(g, sp0[r0], sp0[r1], sp0[r2], sp0[r3]);
    const int bv = sel4i(g, sp1[c0], sp1[c1], sp1[c2], sp1[c3]);
    const int code = sel4i(g, e0, e1, e2, e3);
    const float sum = key2f(av & ~127) + key2f(bv & ~127);
    return code == 0xFF ? NONE : ((f2key(sum) & ~255) | code);
}
__device__ __forceinline__ void phase_topk(const Params& p, unsigned char* lds_) {
    LAS unsigned char* lds = (LAS unsigned char*)lds_;
    const int tid = threadIdx.x, lane = tid & 63, w = __builtin_amdgcn_readfirstlane(tid >> 6), l15 = lane & 15, g = lane >> 4;
    const bf16_t* pq = (const bf16_t*)(p.ws + OFF_QKV + (size_t)T * D * 2); const bf16_t* skb = (const bf16_t*)(p.ws + OFF_SUBK);
    int* idxo = (int*)(p.ws + OFF_IDX); float* gato = (float*)(p.ws + OFF_GATE);
    int cur_h = -1;
    for (int task = blockIdx.x; task < (T / 128) * PH; task += gridDim.x) {
        const int h = task & 7, tt = task >> 3;
        if (h != cur_h) {
            __syncthreads();
#pragma unroll
            for (int i = 0; i < 8; ++i) { const int ch = i * NTHR + tid, row = ch >> 4, c = ch & 15;
                *(LAS u32x4*)(lds + row * 256 + ((c ^ (row & 15)) << 4)) = *(const u32x4*)(skb + ((size_t)h * 256 + row) * 128 + c * 8); }
            __syncthreads();
            cur_h = h;
        }
        const int t = tt * 128 + 16 * w + l15;
        i32x16 sp0, sp1;
#pragma unroll
        for (int pp = 0; pp < 2; ++pp) {
            bf16x8 bq[4];
#pragma unroll
            for (int ks = 0; ks < 4; ++ks) bq[ks] = *(const bf16x8*)(pq + (size_t)t * D + h * 256 + pp * 128 + 32 * ks + 8 * g);
            i32x16 ka, kb2;
#pragma unroll
            for (int kt = 0; kt < 8; ++kt) {
                f32x4 a = {0.f, 0.f, 0.f, 0.f};
                const int row = pp * 128 + 16 * kt + l15;
#pragma unroll
                for (int ks = 0; ks < 4; ++ks) { const bf16x8 kf = *(const LAS bf16x8*)(lds + row * 256 + (((4 * ks + g) ^ (row & 15)) << 4)); a = __builtin_amdgcn_mfma_f32_16x16x32_bf16(kf, bq[ks], a, 0, 0, 0); }
#pragma unroll
                for (int rg = 0; rg < 4; ++rg) { const int key = (f2key(a[rg]) & ~127) | (16 * kt + rg + 4 * g);
                    if (kt < 4) ka[kt * 4 + rg] = key; else kb2[(kt - 4) * 4 + rg] = key; }
            }
            ka = merge_top16(sort16_desc(ka), sort16_desc(kb2));
            ka = xlane_merge_top16(ka, 16); ka = xlane_merge_top16(ka, 32);
            if (pp == 0) sp0 = ka; else sp1 = ka;
        }
        i32x16 cd;
        cd[0] = tk_make_cand<0>(sp0, sp1, g); cd[1] = tk_make_cand<1>(sp0, sp1, g); cd[2] = tk_make_cand<2>(sp0, sp1, g); cd[3] = tk_make_cand<3>(sp0, sp1, g);
        cd[4] = tk_make_cand<4>(sp0, sp1, g); cd[5] = tk_make_cand<5>(sp0, sp1, g); cd[6] = tk_make_cand<6>(sp0, sp1, g); cd[7] = tk_make_cand<7>(sp0, sp1, g);
        cd[8] = tk_make_cand<8>(sp0, sp1, g); cd[9] = tk_make_cand<9>(sp0, sp1, g); cd[10] = tk_make_cand<10>(sp0, sp1, g); cd[11] = tk_make_cand<11>(sp0, sp1, g);
        cd[12] = tk_make_cand<12>(sp0, sp1, g); cd[13] = tk_make_cand<13>(sp0, sp1, g); cd[14] = tk_make_cand<14>(sp0, sp1, g); cd[15] = tk_make_cand<15>(sp0, sp1, g);
        cd = sort16_desc(cd); cd = xlane_merge_top16(cd, 16); cd = xlane_merge_top16(cd, 32);
        f32x16v ex; float sum = 0.f; const float m0 = key2f(cd[0] & ~255);
#pragma unroll
        for (int i = 0; i < 16; ++i) { ex[i] = __expf(key2f(cd[i] & ~255) - m0); sum += ex[i]; }
        const float is = 1.0f / sum;
        int oi[4]; float og[4];
#pragma unroll
        for (int c = 0; c < 4; ++c) {
            const int key = sel4i(g, cd[c], cd[4 + c], cd[8 + c], cd[12 + c]);
            const float e = sel4f(g, ex[c], ex[4 + c], ex[8 + c], ex[12 + c]);
            const int i1 = sel16(sp0, (key >> 4) & 15) & 127, i2 = sel16(sp1, key & 15) & 127;
            oi[c] = i1 * 128 + i2; og[c] = e * is; }
        *(int4*)(idxo + (size_t)t * 128 + h * PK + 4 * g) = make_int4(oi[0], oi[1], oi[2], oi[3]);
        *(float4*)(gato + (size_t)t * 128 + h * PK + 4 * g) = make_float4(og[0], og[1], og[2], og[3]);
    }
}

typedef float f32x2v __attribute__((ext_vector_type(2)));
typedef float f32x8v __attribute__((ext_vector_type(8)));
__device__ __forceinline__ int dot16_i8(const u32x4 w, const u32x4 x) {
    int s = __builtin_amdgcn_sdot4((int)w.x, (int)x.x, 0, false); s = __builtin_amdgcn_sdot4((int)w.y, (int)x.y, s, false);
    s = __builtin_amdgcn_sdot4((int)w.z, (int)x.z, s, false); return __builtin_amdgcn_sdot4((int)w.w, (int)x.w, s, false);
}
__device__ __forceinline__ void axpy16_u8(const u32x4 w, float cw, float* acc) {
    float f[16];
#pragma unroll
    for (int q = 0; q < 4; ++q) { const unsigned ww = w[q];
        f[4 * q + 0] = __uint_as_float(__builtin_amdgcn_perm(0x47000000u, ww, 0x07060004u)); f[4 * q + 1] = __uint_as_float(__builtin_amdgcn_perm(0x47000000u, ww, 0x07060104u));
        f[4 * q + 2] = __uint_as_float(__builtin_amdgcn_perm(0x47000000u, ww, 0x07060204u)); f[4 * q + 3] = __uint_as_float(__builtin_amdgcn_perm(0x47000000u, ww, 0x07060304u)); }
    __builtin_amdgcn_sched_barrier(0);
#pragma unroll
    for (int j = 0; j < 16; ++j) acc[j] = fmaf(cw, f[j], acc[j]);
    __builtin_amdgcn_sched_barrier(0);
}
typedef _Float16 h2v __attribute__((ext_vector_type(2)));
__device__ __forceinline__ void axpy16x2_u8(const u32x4 wa, const u32x4 wb, h2v cwp, float* acc) {
#pragma unroll
    for (int q = 0; q < 4; ++q) { const unsigned ua = wa[q], ub = wb[q];
        unsigned p0 = __builtin_amdgcn_perm(ub, ua, 0x0C040C00u), p1 = __builtin_amdgcn_perm(ub, ua, 0x0C050C01u), p2 = __builtin_amdgcn_perm(ub, ua, 0x0C060C02u), p3 = __builtin_amdgcn_perm(ub, ua, 0x0C070C03u);
        acc[4 * q + 0] = __builtin_amdgcn_fdot2(*reinterpret_cast<h2v*>(&p0), cwp, acc[4 * q + 0], false); acc[4 * q + 1] = __builtin_amdgcn_fdot2(*reinterpret_cast<h2v*>(&p1), cwp, acc[4 * q + 1], false);
        acc[4 * q + 2] = __builtin_amdgcn_fdot2(*reinterpret_cast<h2v*>(&p2), cwp, acc[4 * q + 2], false); acc[4 * q + 3] = __builtin_amdgcn_fdot2(*reinterpret_cast<h2v*>(&p3), cwp, acc[4 * q + 3], false); }
}
typedef int i32x8v __attribute__((ext_vector_type(8)));
typedef int i32x4v __attribute__((ext_vector_type(4)));
typedef int i32x2v __attribute__((ext_vector_type(2)));
__device__ __forceinline__ int red8_piece(i32x8v r, int lane) {
    const bool b2 = (lane & 4) != 0, b1 = (lane & 2) != 0, b0 = (lane & 1) != 0;
    i32x4v q; i32x2v pp;
#pragma unroll
    for (int k = 0; k < 4; ++k) { const int lo = r[k], hi = r[k + 4]; const int kp = b2 ? hi : lo, sn = b2 ? lo : hi; q[k] = kp + __shfl_xor(sn, 4); }
#pragma unroll
    for (int k = 0; k < 2; ++k) { const int lo = q[k], hi = q[k + 2]; const int kp = b1 ? hi : lo, sn = b1 ? lo : hi; pp[k] = kp + __shfl_xor(sn, 2); }
    const int lo = pp[0], hi = pp[1]; const int kp = b0 ? hi : lo, sn = b0 ? lo : hi;
    return kp + __shfl_xor(sn, 1);
}
constexpr int PEER_CHUNK = 16;
template <int WHICH, int MODE = 0> __device__ __forceinline__ void peer_chunk(const Params& p, int t0, int s, int lane) {
    const int sub = lane >> 3, piece = lane & 7;
    const int* idx = (const int*)(p.ws + OFF_IDX) + sub * 16;
    const unsigned char* tab = p.ws + (WHICH == 0 ? OFF_UTAB : OFF_VTAB) + (size_t)s * SLICE_BYTES;
    const unsigned pof = (unsigned)piece * 16u;
    const unsigned char* xbase = p.ws + OFF_US + s * 128 + piece * 16;
    const unsigned* wbase = (const unsigned*)(p.ws + OFF_GATE) + sub * 8;
    int4 ec[4], en[4];
    u32x4 wA[8], wB[8];
    u32x4 xr; u32x4 cwv[2]; float cws = 0.f;
#define PEER_RD(ev) (*(const u32x4*)(tab + (((unsigned)(ev) << 7) + pof)))
#define PEER_LD8(dst, ev0, ev1) do { if (MODE == 2) { dst[0] = (u32x4){(unsigned)ev0.x, (unsigned)ev0.y, 0x38383838u, 0x30303030u}; dst[1] = dst[0]; dst[2] = dst[0]; dst[3] = dst[0]; dst[4] = (u32x4){(unsigned)ev1.x, (unsigned)ev1.y, 0x38383838u, 0x30303030u}; dst[5] = dst[4]; dst[6] = dst[4]; dst[7] = dst[4]; break; } \
        dst[0] = PEER_RD(ev0.x); dst[1] = PEER_RD(ev0.y); dst[2] = PEER_RD(ev0.z); dst[3] = PEER_RD(ev0.w); dst[4] = PEER_RD(ev1.x); dst[5] = PEER_RD(ev1.y); dst[6] = PEER_RD(ev1.z); dst[7] = PEER_RD(ev1.w); } while (0)
#pragma unroll
    for (int q = 0; q < 4; ++q) ec[q] = *(const int4*)(idx + (size_t)t0 * 128 + 4 * q);
    PEER_LD8(wA, ec[0], ec[1]);
    if (WHICH == 0) { xr = *(const u32x4*)(xbase + (size_t)t0 * D); }
    else {
#pragma unroll
        for (int q = 0; q < 2; ++q) cwv[q] = *(const u32x4*)(wbase + (size_t)t0 * 128 + 4 * q);
        cws = __uint_as_float(wbase[(size_t)t0 * 128 + 64 - sub * 7]); }
#pragma unroll
    for (int q = 0; q < 4; ++q) en[q] = *(const int4*)(idx + (size_t)(t0 + 1) * 128 + 4 * q);
#pragma unroll 1
    for (int k = 0; k < PEER_CHUNK; ++k) {
        const int t = t0 + k;
        PEER_LD8(wB, ec[2], ec[3]);
        if (WHICH == 0) {
            const u32x4 xc = xr;
            i32x8v r0, r1;
#pragma unroll
            for (int i = 0; i < 8; ++i) r0[i] = MODE == 1 ? (int)(wA[i].x ^ wA[i].y ^ wA[i].z ^ wA[i].w ^ xc.x) : dot16_i8(wA[i], xc);
            if (k < PEER_CHUNK - 1) { PEER_LD8(wA, en[0], en[1]); xr = *(const u32x4*)(xbase + (size_t)(t + 1) * D); }
#pragma unroll
            for (int i = 0; i < 8; ++i) r1[i] = MODE == 1 ? (int)(wB[i].x ^ wB[i].y ^ wB[i].z ^ wB[i].w ^ xc.y) : dot16_i8(wB[i], xc);
            const int v0 = red8_piece(r0, lane), v1 = red8_piece(r1, lane);
            int* part = (int*)(p.ws + OFF_QKV) + ((size_t)s * T + t) * 128 + sub * 16 + piece;
            part[0] = v0; part[8] = v1;
        } else {
            float acc[16];
#pragma unroll
            for (int j = 0; j < 16; ++j) acc[j] = 0.f;
            const u32x4 c0 = cwv[0], c1 = cwv[1]; const float cwsum = cws;
            h2v cp[8];
            { unsigned u0 = c0.x, u1 = c0.y, u2 = c0.z, u3 = c0.w, u4 = c1.x, u5 = c1.y, u6 = c1.z, u7 = c1.w;
              cp[0] = *reinterpret_cast<h2v*>(&u0); cp[1] = *reinterpret_cast<h2v*>(&u1); cp[2] = *reinterpret_cast<h2v*>(&u2); cp[3] = *reinterpret_cast<h2v*>(&u3);
              cp[4] = *reinterpret_cast<h2v*>(&u4); cp[5] = *reinterpret_cast<h2v*>(&u5); cp[6] = *reinterpret_cast<h2v*>(&u6); cp[7] = *reinterpret_cast<h2v*>(&u7); }
            axpy16x2_u8(wA[0], wA[1], cp[0], acc); axpy16x2_u8(wA[2], wA[3], cp[1], acc); axpy16x2_u8(wA[4], wA[5], cp[2], acc); axpy16x2_u8(wA[6], wA[7], cp[3], acc);
            if (k < PEER_CHUNK - 1) { PEER_LD8(wA, en[0], en[1]);
#pragma unroll
                for (int q = 0; q < 2; ++q) cwv[q] = *(const u32x4*)(wbase + (size_t)(t + 1) * 128 + 4 * q);
                cws = __uint_as_float(wbase[(size_t)(t + 1) * 128 + 64 - sub * 7]); }
            axpy16x2_u8(wB[0], wB[1], cp[4], acc); axpy16x2_u8(wB[2], wB[3], cp[5], acc); axpy16x2_u8(wB[4], wB[5], cp[6], acc); axpy16x2_u8(wB[6], wB[7], cp[7], acc);
            f32x16v a16;
#pragma unroll
            for (int j = 0; j < 16; ++j) a16[j] = fmaf(acc[j], 65536.0f, -0.5f * cwsum);
            const bool b3 = (lane & 8) != 0;
            f32x8v q8; f32x4 q4; f32x2v q2;
#pragma unroll
            for (int j = 0; j < 8; ++j) { const auto sw = __builtin_amdgcn_permlane32_swap(__float_as_uint(a16[j]), __float_as_uint(a16[j + 8]), false, false); q8[j] = __uint_as_float(sw[0]) + __uint_as_float(sw[1]); }
#pragma unroll
            for (int j = 0; j < 4; ++j) { const auto sw = __builtin_amdgcn_permlane16_swap(__float_as_uint(q8[j]), __float_as_uint(q8[j + 4]), false, false); q4[j] = __uint_as_float(sw[0]) + __uint_as_float(sw[1]); }
#pragma unroll
            for (int j = 0; j < 2; ++j) { const float lo = q4[j], hi = q4[j + 2]; const float kp = b3 ? hi : lo, sn = b3 ? lo : hi; q2[j] = kp + __shfl_xor(sn, 8); }
            bf16_t* po = (bf16_t*)(p.ws + OFF_A) + (size_t)t * D + s * 128 + piece * 16 + 2 * sub;
            *(unsigned*)po = cvt_pk(q2[0], q2[1]);
        }
#pragma unroll
        for (int q = 0; q < 4; ++q) ec[q] = en[q];
        if (k < PEER_CHUNK - 2) {
#pragma unroll
            for (int q = 0; q < 4; ++q) en[q] = *(const int4*)(idx + (size_t)(t + 2) * 128 + 4 * q); }
    }
#undef PEER_LD8
#undef PEER_RD
}
template <int WHICH, int MODE = 0, int QSET = WHICH> __device__ __forceinline__ void phase_peer_sliced(const Params& p, unsigned xcc) {
    unsigned* qh = (unsigned*)(p.ws + OFF_CTL + OFF_QUEUE) + QSET * 16 * 64;
    const int lane = threadIdx.x & 63;
    for (int rnd = 0; rnd < 16; ++rnd) {
        const int s = (int)((xcc + 8u * (unsigned)(rnd & 1) + (unsigned)(rnd >> 1)) & 15u);
        unsigned c = 0; if (lane == 0) c = atomicAdd(qh + s * 64, 1u);
        c = __builtin_amdgcn_readfirstlane(c);
        while (c < (unsigned)(T / PEER_CHUNK)) {
            unsigned cn = 0; if (lane == 0) cn = atomicAdd(qh + s * 64, 1u);
            peer_chunk<WHICH, MODE>(p, (int)c * PEER_CHUNK, s, lane);
            c = __builtin_amdgcn_readfirstlane(cn);
        }
    }
}
__device__ __forceinline__ void phase_peer_w(const Params& p) {
    const int lane = threadIdx.x & 63, gw = blockIdx.x * NWV + __builtin_amdgcn_readfirstlane(threadIdx.x >> 6), nw = gridDim.x * NWV;
    const int* part = (const int*)(p.ws + OFF_QKV); const int* idx = (const int*)(p.ws + OFF_IDX); float* gate = (float*)(p.ws + OFF_GATE);
    const float* uinv = (const float*)(p.ws + OFF_UTAB + TAB8_BYTES); const float* vinv = (const float*)(p.ws + OFF_VTAB + TAB8_BYTES); const float* xs = (const float*)(p.ws + OFF_SGUO);
    int2 pv[16], e = make_int2(0, 0); float2 g = make_float2(0.f, 0.f); float xsc = 0.f, ui0 = 0.f, ui1 = 0.f, vi0 = 0.f, vi1 = 0.f;
#define PW_LOAD(tt) do { _Pragma("unroll") for (int s = 0; s < 16; ++s) pv[s] = *(const int2*)(part + ((size_t)s * T + (tt)) * 128 + 2 * lane); \
        e = *(const int2*)(idx + (size_t)(tt) * 128 + 2 * lane); g = *(const float2*)(gate + (size_t)(tt) * 128 + 2 * lane); xsc = xs[(tt)]; \
        ui0 = uinv[e.x]; ui1 = uinv[e.y]; vi0 = vinv[e.x]; vi1 = vinv[e.y]; } while (0)
    if (gw < T) PW_LOAD(gw);
    for (int t = gw; t < T; t += nw) {
        int a0 = 0, a1 = 0;
#pragma unroll
        for (int s = 0; s < 16; ++s) { a0 += pv[s].x; a1 += pv[s].y; }
        const float w0 = g.x * gelu_erf((float)a0 * (xsc * ui0)) * vi0, w1 = g.y * gelu_erf((float)a1 * (xsc * ui1)) * vi1;
        if (t + nw < T) PW_LOAD(t + nw);
        h2v hp; hp.x = (_Float16)(w0 * 256.f); hp.y = (_Float16)(w1 * 256.f);
        float sm = (float)hp.x + (float)hp.y;
        sm += __shfl_xor(sm, 1); sm += __shfl_xor(sm, 2); sm += __shfl_xor(sm, 4);
        ((unsigned*)gate)[(size_t)t * 128 + lane] = *reinterpret_cast<unsigned*>(&hp);
        if ((lane & 7) == 0) gate[(size_t)t * 128 + 64 + (lane >> 3)] = sm;
    }
#undef PW_LOAD
}
__device__ __forceinline__ void phase_peer_final(const Params& p) {
    const int lane = threadIdx.x & 63, gw = blockIdx.x * NWV + __builtin_amdgcn_readfirstlane(threadIdx.x >> 6), nw = gridDim.x * NWV;
    const bf16_t* peer = (const bf16_t*)(p.ws + OFF_A); const bf16_t* hb = (const bf16_t*)(p.ws + OFF_O12);
    const int wpb = nw >> 2, b = gw / wpb, r0 = gw - b * wpb;
    if (b >= NB) return;
    float gt[32], gf[32];
#pragma unroll
    for (int i = 0; i < 4; ++i) { const int col = i * 512 + lane * 8; const float4 g0 = mod4(p, b, 5, col), g1 = mod4(p, b, 5, col + 4), f0 = *(const float4*)(p.g_final + col), f1 = *(const float4*)(p.g_final + col + 4);
        gt[i * 8 + 0] = g0.x; gt[i * 8 + 1] = g0.y; gt[i * 8 + 2] = g0.z; gt[i * 8 + 3] = g0.w; gt[i * 8 + 4] = g1.x; gt[i * 8 + 5] = g1.y; gt[i * 8 + 6] = g1.z; gt[i * 8 + 7] = g1.w;
        gf[i * 8 + 0] = f0.x; gf[i * 8 + 1] = f0.y; gf[i * 8 + 2] = f0.z; gf[i * 8 + 3] = f0.w; gf[i * 8 + 4] = f1.x; gf[i * 8 + 5] = f1.y; gf[i * 8 + 6] = f1.z; gf[i * 8 + 7] = f1.w; }
    u32x4 pw[4], hw[4];
#define PF_LOAD(tt) do { _Pragma("unroll") for (int i = 0; i < 4; ++i) { pw[i] = *(const u32x4*)(peer + (size_t)(tt) * D + i * 512 + lane * 8); hw[i] = *(const u32x4*)(hb + (size_t)(tt) * D + i * 512 + lane * 8); } } while (0)
    if (r0 < S) PF_LOAD(b * S + r0);
    for (int r = r0; r < S; r += wpb) {
        const int t = b * S + r; float* orow = p.out + (size_t)t * D; float v[32]; float ss = 0.f;
#pragma unroll
        for (int i = 0; i < 4; ++i) {
            v[i * 8 + 0] = bflo(hw[i].x) + gt[i * 8 + 0] * bflo(pw[i].x); v[i * 8 + 1] = bfhi(hw[i].x) + gt[i * 8 + 1] * bfhi(pw[i].x); v[i * 8 + 2] = bflo(hw[i].y) + gt[i * 8 + 2] * bflo(pw[i].y); v[i * 8 + 3] = bfhi(hw[i].y) + gt[i * 8 + 3] * bfhi(pw[i].y);
            v[i * 8 + 4] = bflo(hw[i].z) + gt[i * 8 + 4] * bflo(pw[i].z); v[i * 8 + 5] = bfhi(hw[i].z) + gt[i * 8 + 5] * bfhi(pw[i].z); v[i * 8 + 6] = bflo(hw[i].w) + gt[i * 8 + 6] * bflo(pw[i].w); v[i * 8 + 7] = bfhi(hw[i].w) + gt[i * 8 + 7] * bfhi(pw[i].w);
#pragma unroll
            for (int j = 0; j < 8; ++j) ss += v[i * 8 + j] * v[i * 8 + j]; }
        if (r + wpb < S) PF_LOAD(t + wpb);
        ss = wave_sum(ss); const float rs = rsqrtf(ss * (1.0f / D) + 1e-6f);
#pragma unroll
        for (int i = 0; i < 4; ++i) { const int col = i * 512 + lane * 8;
            *(float4*)(orow + col) = make_float4(v[i * 8 + 0] * rs * gf[i * 8 + 0], v[i * 8 + 1] * rs * gf[i * 8 + 1], v[i * 8 + 2] * rs * gf[i * 8 + 2], v[i * 8 + 3] * rs * gf[i * 8 + 3]);
            *(float4*)(orow + col + 4) = make_float4(v[i * 8 + 4] * rs * gf[i * 8 + 4], v[i * 8 + 5] * rs * gf[i * 8 + 5], v[i * 8 + 6] * rs * gf[i * 8 + 6], v[i * 8 + 7] * rs * gf[i * 8 + 7]); }
    }
#undef PF_LOAD
}

constexpr int LDS_BYTES = 147456;

#define XB_TMO      128
#define XB_XCNT(j)  (256  + 64 * (j))
#define XB_XSUB(j)  (1280 + 64 * (j))
#define XB_XGEN(j)  (2304 + 64 * (j))
#define XB_TOP      3328
#define XB_TOPGEN   3392
#define XCD_BAR_WORDS 3456
#define XB_SPIN_CAP (1u << 18)

__device__ __forceinline__ unsigned xb_ld(unsigned* p)              { return __hip_atomic_load(p, __ATOMIC_RELAXED, __HIP_MEMORY_SCOPE_AGENT); }
__device__ __forceinline__ unsigned xb_add(unsigned* p, unsigned v) { return __hip_atomic_fetch_add(p, v, __ATOMIC_RELAXED, __HIP_MEMORY_SCOPE_AGENT); }
__device__ __forceinline__ unsigned xb_xcc_id() { return (unsigned)__builtin_amdgcn_s_getreg((3 << 11) | 20) & 0xFu; }
#define XB_SPIN(cond, bar) do { unsigned _sp = 0; while (cond) { __builtin_amdgcn_s_sleep(1); \
    if ((++_sp & 255u) == 0u) { if (xb_ld(&(bar)[XB_TMO])) break; if (_sp > XB_SPIN_CAP) { atomicAdd(&(bar)[XB_TMO], 1u); break; } } } } while (0)

struct XcdBarrier {
    unsigned* bar; unsigned x;
    volatile LAS unsigned* st;
};

__device__ __forceinline__ XcdBarrier xcd_barrier_post(unsigned* bar, volatile LAS unsigned* st) {
    XcdBarrier b; b.bar = bar; b.x = xb_xcc_id(); b.st = st;
    if (threadIdx.x == 0) (void)xb_add(&bar[XB_XCNT(b.x)], 1u);
    return b;
}
__device__ __forceinline__ void xcd_barrier_complete(unsigned* bar, unsigned x, unsigned& nloc, unsigned& nx) {
    const unsigned G = gridDim.x * gridDim.y * gridDim.z;
    unsigned sum, cnt, mine, sp = 0u;
    for (;;) {
        sum = 0u; cnt = 0u; mine = 0u;
#pragma unroll
        for (unsigned j = 0; j < 16; ++j) { const unsigned c = xb_ld(&bar[XB_XCNT(j)]); sum += c; cnt += (c > 0u) ? 1u : 0u; mine = (j == x) ? c : mine; }
        if (sum == G) break;
        __builtin_amdgcn_s_sleep(1);
        if ((++sp & 255u) == 0u) { if (xb_ld(&bar[XB_TMO])) break; if (sp > XB_SPIN_CAP) { atomicAdd(&bar[XB_TMO], 1u); break; } }
    }
    nloc = mine > 0u ? mine : 1u; nx = cnt > 0u ? cnt : 1u;
}

__device__ __forceinline__ void xcd_barrier(const XcdBarrier& b) {
    asm volatile("s_waitcnt vmcnt(0)" ::: "memory");
    __syncthreads();
    if (threadIdx.x == 0) {
        unsigned* bar = b.bar;
        __builtin_amdgcn_s_waitcnt(0);
        unsigned nloc = b.st[0], nx = b.st[1];
        if (nloc == 0u) { xcd_barrier_complete(bar, b.x, nloc, nx); b.st[0] = nloc; b.st[1] = nx; }
        const unsigned old = xb_add(&bar[XB_XSUB(b.x)], 1u);
        const unsigned gen = old / nloc;
        if (old + 1u == (gen + 1u) * nloc) {
            __builtin_amdgcn_fence(__ATOMIC_RELEASE, "agent");
            asm volatile("s_waitcnt vmcnt(0)" ::: "memory");
            const unsigned og = xb_add(&bar[XB_TOP], 1u);
            const unsigned tg = og / nx;
            if (og + 1u == (tg + 1u) * nx) xb_add(&bar[XB_TOPGEN], 1u);
            else XB_SPIN(xb_ld(&bar[XB_TOPGEN]) == tg, bar);
            __builtin_amdgcn_fence(__ATOMIC_ACQUIRE, "agent");
            xb_add(&bar[XB_XGEN(b.x)], 1u);
            asm volatile("s_waitcnt vmcnt(0)" ::: "memory");
        } else {
            XB_SPIN(xb_ld(&bar[XB_XGEN(b.x)]) == gen, bar);
            __builtin_amdgcn_fence(__ATOMIC_ACQUIRE, "agent");
            asm volatile("s_waitcnt vmcnt(0)" ::: "memory");
        }
    }
    __syncthreads();
}

#ifndef PHASE_MASK
#define PHASE_MASK 0x3FF
#endif
#ifndef PROBE_DUP
#define PROBE_DUP 0
#endif
#ifndef TS_SEL
#define TS_SEL -1
#endif
#define TSTAMP(k) do { if (TS_SEL >= 0) { const unsigned long long _t = __builtin_amdgcn_s_memrealtime(); if (TS_SEL + 1 == (k)) { const unsigned long long _d = _t - ts_a; while (__builtin_amdgcn_s_memrealtime() - _t < _d) __builtin_amdgcn_s_sleep(8); } ts_a = __builtin_amdgcn_s_memrealtime(); } } while (0)
#define GBAR() xcd_barrier(xbar)
#define RUNPH(bit, call, dupcall) do { if (PHASE_MASK & (bit)) { if (PROBE_DUP & (bit)) { dupcall; GBAR(); } call; GBAR(); } } while (0)
__global__ void __launch_bounds__(NTHR, 2) k_mega(Params p) {
    extern __shared__ __attribute__((aligned(16))) unsigned char lds[];
    cg::grid_group grid = cg::this_grid();
    volatile LAS unsigned* xst = (volatile LAS unsigned*)((LAS unsigned char*)lds + LDS_BYTES);
    if (threadIdx.x < 4) xst[threadIdx.x] = 0u;
    __syncthreads();
    XcdBarrier xbar = xcd_barrier_post((unsigned*)(p.ws + OFF_CTL), xst);
    unsigned long long ts_a = 0; TSTAMP(0);
    if (p.ws == nullptr) grid.sync();
    if (PHASE_MASK & 1) { if (PROBE_DUP & 1) { phase_conv(p, lds, true); GBAR(); } phase_conv(p, lds); GBAR(); }
    TSTAMP(1);
    RUNPH(2, (phase_norm_mod<false, false>(p, p.x, p.g_norm1, 0, 1, (bf16_t*)(p.ws + OFF_A))), (phase_norm_mod<false, false>(p, p.x, p.g_norm1, 0, 1, (bf16_t*)(p.ws + OFF_A))));
    TSTAMP(2);
    RUNPH(4, phase_gemm1(p, lds), phase_gemm1(p, lds));
    TSTAMP(3);
    if (PROBE_DUP & 1024) { phase_sgu(p, lds); GBAR(); }
    RUNPH(8, (phase_attn(p, lds), phase_sgu(p, lds)), phase_attn(p, lds));
    TSTAMP(4);
    RUNPH(16, phase_combine(p), phase_combine(p));
    TSTAMP(5);
    RUNPH(32, phase_gemm2(p, lds), phase_gemm2(p, lds));
    TSTAMP(6);
    RUNPH(64, (phase_norm_mod<true, true>(p, p.ws + OFF_O12, p.g_norm2, 3, 4, (bf16_t*)(p.ws + OFF_A))), (phase_norm_mod<true, true>(p, p.ws + OFF_O12, p.g_norm2, 3, 4, (bf16_t*)(p.ws + OFF_A))));
    TSTAMP(7);
    RUNPH(128, phase_gemm3(p, lds), phase_gemm3(p, lds));
    TSTAMP(8);
    RUNPH(256, phase_topk(p, lds), phase_topk(p, lds));
    TSTAMP(9);
    if (PHASE_MASK & 512) {
        if (PROBE_DUP == 2048) { phase_peer_sliced<0, 0, 2>(p, xbar.x); GBAR(); }
        if (PROBE_DUP == 4096) { phase_peer_sliced<0, 1, 2>(p, xbar.x); GBAR(); }
        if (PROBE_DUP == 8192) { phase_peer_sliced<0, 2, 2>(p, xbar.x); GBAR(); }
        phase_peer_sliced<0>(p, xbar.x); GBAR();
        TSTAMP(10);
        phase_peer_w(p); GBAR();
        TSTAMP(11);
        if (PROBE_DUP == 16384) { phase_peer_sliced<1, 0, 3>(p, xbar.x); GBAR(); }
        phase_peer_sliced<1>(p, xbar.x); GBAR();
        TSTAMP(12);
        phase_peer_final(p);
        TSTAMP(13);
    }
}

#ifndef MEGA
#define MEGA 1
#endif
extern "C" void kernel_launch(void* const* d_in, const int* in_sizes, int n_in, void* d_out, int out_size, void* d_ws, size_t ws_size, hipStream_t stream) {
    if (n_in != 20 || out_size != T * D || ws_size < WS_END) { fprintf(stderr, "kernel_launch: unexpected problem (n_in %d out %d ws %zu, need %zu)\n", n_in, out_size, ws_size, (size_t)WS_END); return; }
    Params p{};
    p.x = (const float*)d_in[0]; p.c = (const float*)d_in[1]; p.pos = (const int*)d_in[2]; p.w_ada = (const float*)d_in[3]; p.b_ada = (const float*)d_in[4];
    p.g_norm1 = (const float*)d_in[5]; p.w_in = (const float*)d_in[6]; p.g_attn_out = (const float*)d_in[7]; p.g_sgu_out = (const float*)d_in[8];
    p.sgu_w = (const float*)d_in[9]; p.sgu_b = (const float*)d_in[10]; p.sgu_ln_g = (const float*)d_in[11]; p.sgu_ln_b = (const float*)d_in[12];
    p.w_out = (const float*)d_in[13]; p.g_norm2 = (const float*)d_in[14]; p.peer_w_q = (const float*)d_in[15]; p.peer_sub_keys = (const float*)d_in[16];
    p.peer_u = (const float*)d_in[17]; p.peer_v = (const float*)d_in[18]; p.g_final = (const float*)d_in[19];
    p.out = (float*)d_out; p.ws = (unsigned char*)d_ws;
    (void)hipMemsetAsync((char*)d_ws + OFF_CTL, 0, OFF_SGUW - OFF_CTL, stream);
#if MEGA
    static int grid_blocks = 0;
    if (!grid_blocks) {
        int dev = 0, cus = 0, per_cu = 0;
        (void)hipGetDevice(&dev); (void)hipDeviceGetAttribute(&cus, hipDeviceAttributeMultiprocessorCount, dev);
        (void)hipFuncSetAttribute((const void*)k_mega, hipFuncAttributeMaxDynamicSharedMemorySize, LDS_BYTES + 16);
        (void)hipOccupancyMaxActiveBlocksPerMultiprocessor(&per_cu, (const void*)k_mega, NTHR, LDS_BYTES + 16);
        if (per_cu < 1) { fprintf(stderr, "kernel_launch: occupancy query says %d blocks per CU\n", per_cu); per_cu = 1; }
        if (per_cu > 1) per_cu = 1;
        grid_blocks = cus * per_cu;
    }
    void* args[] = {(void*)&p};
    hipError_t e = hipLaunchCooperativeKernel((const void*)k_mega, dim3(grid_blocks), dim3(NTHR), args, LDS_BYTES + 16, stream);
    if (e != hipSuccess) fprintf(stderr, "cooperative launch failed: %s (grid %d)\n", hipGetErrorString(e), grid_blocks);
#endif
}
```

```cpp
#include <hip/hip_runtime.h>
#include <hip/hip_cooperative_groups.h>
#include <cstdio>
#include <cstdint>
namespace cg = cooperative_groups;
#ifndef CONV_TS
#define CONV_TS -1
#endif
#define CSTAMP(k) do { if (CONV_TS >= 0) { __syncthreads(); const unsigned long long _t = __builtin_amdgcn_s_memrealtime(); if (CONV_TS + 1 == (k)) { const unsigned long long _d = _t - cts; while (__builtin_amdgcn_s_memrealtime() - _t < _d) __builtin_amdgcn_s_sleep(8); } cts = __builtin_amdgcn_s_memrealtime(); } } while (0)

constexpr int D = 2048, NB = 4, S = 4096, T = NB * S;
constexpr int E = 128, HA = 12, HS = 4, DA = 1536, DS = 512, DIN = 5632;
constexpr int PH = 8, PK = 16, NEXP = 16384;
constexpr int NTHR = 512, NWV = 8;

typedef unsigned short bf16_t;
typedef unsigned u32x4 __attribute__((ext_vector_type(4)));
typedef unsigned u32x2 __attribute__((ext_vector_type(2)));
typedef float f32x4 __attribute__((ext_vector_type(4)));

__device__ __forceinline__ bf16_t f2bf(float f) { unsigned u = __float_as_uint(f); u += 0x7FFFu + ((u >> 16) & 1u); return (bf16_t)(u >> 16); }
__device__ __forceinline__ float bf2f(bf16_t b) { return __uint_as_float(((unsigned)b) << 16); }
__device__ __forceinline__ unsigned pack2(float lo, float hi) { return (unsigned)f2bf(lo) | ((unsigned)f2bf(hi) << 16); }
__device__ __forceinline__ float bflo(unsigned w) { return __uint_as_float(w << 16); }
__device__ __forceinline__ float bfhi(unsigned w) { return __uint_as_float(w & 0xffff0000u); }
__device__ __forceinline__ float wave_sum(float v) {
#pragma unroll
    for (int o = 32; o >= 1; o >>= 1) v += __shfl_xor(v, o);
    return v; }
__device__ __forceinline__ float wave_max(float v) {
#pragma unroll
    for (int o = 32; o >= 1; o >>= 1) v = fmaxf(v, __shfl_xor(v, o));
    return v; }
__device__ __forceinline__ int wave_min_i(int v) {
#pragma unroll
    for (int o = 32; o >= 1; o >>= 1) v = min(v, __shfl_xor(v, o));
    return v; }
__device__ __forceinline__ float gelu_erf(float v) { return 0.5f * v * (1.0f + erff(v * 0.70710678118654752f)); }

constexpr size_t OFF_CTL  = 0;
constexpr size_t OFF_MOD  = 65536;
constexpr size_t OFF_SCL  = OFF_MOD + 393216;
constexpr int SCL_HS = 0, SCL_MS = T, SCL_WS = 2 * T, SCL_PM = 2 * T + 9728, WS_IN = 0, WS_OUT = 5632, WS_Q = 7680, NWCOL = 9728;
constexpr size_t OFF_SGUW = OFF_SCL + 524288;
constexpr size_t OFF_SUBK = OFF_SGUW + 131072;
constexpr size_t OFF_LSE  = OFF_SUBK + 524288;
constexpr size_t OFF_IDX  = OFF_LSE + (size_t)3 * T * 12 * 4;
constexpr size_t OFF_GATE = OFF_IDX + (size_t)T * 128 * 4;
constexpr size_t OFF_WIN  = OFF_GATE + (size_t)T * 128 * 4;
constexpr size_t OFF_WOUT = OFF_WIN + (size_t)DIN * D * 2;
constexpr size_t OFF_WQ   = OFF_WOUT + (size_t)D * D * 2;
constexpr size_t OFF_UTAB = OFF_WQ + (size_t)D * D * 2;
constexpr size_t TAB8_BYTES = (size_t)NEXP * D;
constexpr size_t SLICE_BYTES = (size_t)NEXP * 128;
constexpr size_t OFF_QUEUE = 32768;
constexpr size_t OFF_VTAB = OFF_UTAB + (size_t)NEXP * D * 2;
constexpr size_t OFF_A    = OFF_VTAB + (size_t)NEXP * D * 2;
constexpr size_t OFF_QKV  = OFF_A + (size_t)T * D * 2;
constexpr size_t QKV_ONE  = (size_t)T * DA * 2;
constexpr size_t OFF_US   = OFF_QKV + 3 * QKV_ONE;
constexpr size_t OFF_VS   = OFF_US + (size_t)T * DS * 2;
constexpr size_t OFF_SGUO = OFF_VS + (size_t)T * DS * 2;
constexpr size_t OFF_O12  = OFF_SGUO + (size_t)T * DS * 2;
constexpr size_t WS_END   = OFF_O12 + 2 * QKV_ONE;

struct Params {
    const float* x; const float* c; const int* pos; const float* w_ada; const float* b_ada; const float* g_norm1; const float* w_in;
    const float* g_attn_out; const float* g_sgu_out; const float* sgu_w; const float* sgu_b; const float* sgu_ln_g; const float* sgu_ln_b;
    const float* w_out; const float* g_norm2; const float* peer_w_q; const float* peer_sub_keys; const float* peer_u; const float* peer_v;
    const float* g_final; float* out; unsigned char* ws;
};
__device__ __forceinline__ float fx2f(long long v) { return (float)(int)(v >> 32) + (float)(unsigned)v * 2.3283064365386963e-10f; }
__device__ __forceinline__ float mod1(const Params& p, int b, int i, int col) { return fx2f(((const long long*)(p.ws + OFF_MOD))[b * 12288 + i * D + col]); }
__device__ __forceinline__ float4 mod4q(const long long* mp) { return make_float4(fx2f(mp[0]), fx2f(mp[1]), fx2f(mp[2]), fx2f(mp[3])); }
__device__ __forceinline__ float4 mod4(const Params& p, int b, int i, int col) { return mod4q((const long long*)(p.ws + OFF_MOD) + b * 12288 + i * D + col); }
__device__ __forceinline__ bf16_t* P_opat(const Params& p, int pat) { return (bf16_t*)(pat == 0 ? p.ws + OFF_A : p.ws + OFF_O12 + (size_t)(pat - 1) * QKV_ONE); }

namespace pg8 {
#define PG8_LAS __attribute__((address_space(3)))
typedef unsigned short bf16_t;
typedef short bf16x8 __attribute__((ext_vector_type(8)));
typedef float f32x4 __attribute__((ext_vector_type(4)));
typedef unsigned u32x4 __attribute__((ext_vector_type(4)));
constexpr int BM = 256, BK = 64, HALF = 128, HTB = HALF * BK * 2  , STAGE_BYTES = 8 * HTB, NXCD = 8, WGM = 8;

__host__ __device__ __forceinline__ int lds_byte(int r, int c) { const int st = (r >> 4) * 2 + (c >> 5), rr = r & 15, cc = c & 31, ob = rr * 64 + cc * 2; return st * 1024 + (ob ^ (((ob >> 9) & 1) << 5)); }
__host__ __device__ __forceinline__ void stage_rc(int b, int& R, int& C) { const int st = b / 1024, sb = b % 1024, swz = sb ^ (((sb >> 9) & 1) << 5); R = (st >> 1) * 16 + swz / 64; C = (st & 1) * 32 + (swz % 64) / 2; }
__host__ __device__ __forceinline__ int perm32(int rho) { const int n = rho >> 4, i = rho & 15; return 8 * (i >> 2) + 4 * n + (i & 3); }

struct Unit { int pm, pn; };
struct Gemm { const bf16_t* A; const bf16_t* Bt; int M, N, K; };

struct StaticOrder {
    int nM, nN, nwg, G, c;
    __host__ __device__ void init(int M, int N, int G_, int c_) { nM = M / BM; nN = N / BM; nwg = nM * nN; G = G_; c = c_; }
    __host__ __device__ bool next(int i, Unit& u) const {
        const long L = (long)i * G + c; if (L >= nwg) return false;
        int wgid = (int)L; { const int q = nwg / NXCD, r = nwg % NXCD, xcd = wgid % NXCD, off = wgid / NXCD; wgid = (xcd < r ? xcd * (q + 1) : r * (q + 1) + (xcd - r) * q) + off; }
        const int nig = WGM * nN, gid = wgid / nig, fm = gid * WGM, gsz = (nM - fm) < WGM ? (nM - fm) : WGM;
        u.pm = fm + ((wgid % nig) % gsz); u.pn = (wgid % nig) / gsz; return true;
    }
    __device__ __forceinline__ void a_ready(const Unit&) const {}
    __device__ __forceinline__ void done(const Unit&) const {}
};

__device__ __forceinline__ unsigned cvt_pk_bf16(float lo, float hi) { unsigned r; asm volatile("v_cvt_pk_bf16_f32 %0, %1, %2" : "=v"(r) : "v"(lo), "v"(hi)); return r; }
typedef float f32x2 __attribute__((ext_vector_type(2)));
__device__ __forceinline__ f32x2 gelu_pk(f32x2 v) {
    const f32x2 av = __builtin_elementwise_abs(v), d = av * 0.2316418882f + 1.0f;
    f32x2 t; t.x = __builtin_amdgcn_rcpf(d.x); t.y = __builtin_amdgcn_rcpf(d.y);
    f32x2 q = t * 0.5307027145f + (-0.7265760135f); q = q * t + 0.7107068705f; q = q * t + (-0.142248368f); q = q * t + 0.127414796f; q = q * t;
    const f32x2 s = (v * v) * (-0.72134752044f);
    f32x2 e; e.x = __builtin_amdgcn_exp2f(s.x); e.y = __builtin_amdgcn_exp2f(s.y);
    const f32x2 m = v * (q * e), r = v - m;
    f32x2 o; o.x = v.x < 0.f ? m.x : r.x; o.y = v.y < 0.f ? m.y : r.y; return o;
}

typedef int i32x4 __attribute__((ext_vector_type(4)));
__device__ __forceinline__ f32x4 mma1(bf16x8 b, bf16x8 a, f32x4 c) { return __builtin_amdgcn_mfma_f32_16x16x32_bf16(b, a, c, 0, 0, 0); }
__device__ __forceinline__ i32x4 mma1(bf16x8 b, bf16x8 a, i32x4 c) { return __builtin_amdgcn_mfma_i32_16x16x64_i8(__builtin_bit_cast(i32x4, b), __builtin_bit_cast(i32x4, a), c, 0, 0, 0); }
template <class Epi, class Sched, bool ALIGN_EPI = false, bool SP2 = false>
__device__ __forceinline__ void gemm_phase(PG8_LAS unsigned char* lds, const Gemm g, const Sched& S, const Epi& E) {
    const int tid = threadIdx.x, wid = __builtin_amdgcn_readfirstlane(tid >> 6), lane = tid & 63, wr = wid >> 2, wc = wid & 3, fr = lane & 15, fq = lane >> 4;
    const int K = g.K, nt = K / BK;
    unsigned voffA[2], voffB[2];
#pragma unroll
    for (int i = 0; i < 2; ++i) { int R, C; stage_rc(tid * 16 + i * 8192, R, C); const int Rb = Epi::PERM ? ((R & ~31) + perm32(R & 31)) : R;
        voffA[i] = (unsigned)(R * K + C) * 2u; voffB[i] = (unsigned)(Rb * K + C) * 2u; }
    const size_t kstep = (size_t)(BK * 2);
    const size_t hstep = (size_t)HALF * K * 2;
    const size_t tstep = 2 * hstep;
    const unsigned ldsw = (unsigned)wid * 1024u;
    const int aoff = lds_byte(wr * 64 + fr, fq * 8), boff = lds_byte(wc * 32 + fr, fq * 8);
#define PG8_SA(b, h) (((b) * 2 + (h)) * HTB)
#define PG8_SB(b, h) ((4 + (b) * 2 + (h)) * HTB)
#define PG8_STAGE(bufoff, gbase, voff) do { _Pragma("unroll") for (int _i = 0; _i < 2; ++_i) \
        __builtin_amdgcn_global_load_lds((const unsigned*)((const char*)(gbase) + (voff)[_i]), (PG8_LAS unsigned*)(lds + (bufoff) + ldsw + _i * 8192), 16, 0, 0); } while (0)
#define PG8_LDA(dst, b, h) do { _Pragma("unroll") for (int m = 0; m < 4; ++m) _Pragma("unroll") for (int k = 0; k < 2; ++k) dst[m][k] = *(const PG8_LAS bf16x8*)(lds + PG8_SA(b, h) + aoff + m * 2048 + k * 1024); } while (0)
#define PG8_LDB(dst, b, h) do { _Pragma("unroll") for (int n = 0; n < 2; ++n) _Pragma("unroll") for (int k = 0; k < 2; ++k) dst[n][k] = *(const PG8_LAS bf16x8*)(lds + PG8_SB(b, h) + boff + n * 2048 + k * 1024); } while (0)
#define PG8_MMA(ai, bj, At, Bt) do { __builtin_amdgcn_s_setprio(1); _Pragma("unroll") for (int m = 0; m < 4; ++m) _Pragma("unroll") for (int n = 0; n < 2; ++n) _Pragma("unroll") for (int k = 0; k < 2; ++k) \
        acc[ai][bj][m][n] = mma1(Bt[n][k], At[m][k], acc[ai][bj][m][n]); __builtin_amdgcn_s_setprio(0); } while (0)
#define PG8_WAIT_V(n) asm volatile("s_waitcnt vmcnt(" #n ")" ::: "memory")
#define PG8_WAIT_L(n) asm volatile("s_waitcnt lgkmcnt(" #n ")" ::: "memory")
#define PG8_BAR __builtin_amdgcn_s_barrier()
#define PG8_SCHED __builtin_amdgcn_sched_barrier(0)
    Unit cur, nxt; int ui = 0;
    if (!S.next(0, cur)) return;
    typedef typename Epi::AccT AccT;
    AccT acc[2][2][4][2];
#pragma unroll
    for (int a = 0; a < 2; ++a)
#pragma unroll
        for (int b = 0; b < 2; ++b)
#pragma unroll
            for (int m = 0; m < 4; ++m)
#pragma unroll
                for (int n = 0; n < 2; ++n) acc[a][b][m][n] = AccT{};
    bf16x8 At[4][2], B0[2][2], B1[2][2];
    const char* cA = (const char*)g.A + (size_t)cur.pm * tstep; const char* cB = (const char*)g.Bt + (size_t)cur.pn * tstep;
    S.a_ready(cur);
    if constexpr (SP2) {
        PG8_STAGE(PG8_SB(0, 0), cB, voffB); PG8_STAGE(PG8_SB(0, 1), cB + hstep, voffB); PG8_STAGE(PG8_SA(0, 0), cA, voffA); PG8_STAGE(PG8_SA(0, 1), cA + hstep, voffA);
        if (wr == 1) PG8_BAR;
        PG8_WAIT_V(2); PG8_BAR;
        PG8_STAGE(PG8_SB(1, 0), cB + kstep, voffB); PG8_STAGE(PG8_SA(1, 0), cA + kstep, voffA); PG8_STAGE(PG8_SB(1, 1), cB + hstep + kstep, voffB);
        PG8_WAIT_V(6); PG8_BAR;
    } else {
        PG8_STAGE(PG8_SB(0, 0), cB, voffB); PG8_STAGE(PG8_SA(0, 0), cA, voffA); PG8_STAGE(PG8_SB(0, 1), cB + hstep, voffB); PG8_STAGE(PG8_SA(0, 1), cA + hstep, voffA);
        if (wr == 1) PG8_BAR;
        PG8_WAIT_V(4); PG8_BAR;
        PG8_STAGE(PG8_SB(1, 0), cB + kstep, voffB); PG8_STAGE(PG8_SA(1, 0), cA + kstep, voffA); PG8_STAGE(PG8_SB(1, 1), cB + hstep + kstep, voffB);
        PG8_WAIT_V(6); PG8_BAR;
    }
    for (;;) {
        const bool has_next = S.next(ui + 1, nxt);
        const char* nA = has_next ? (const char*)g.A + (size_t)nxt.pm * tstep : cA; const char* nB = has_next ? (const char*)g.Bt + (size_t)nxt.pn * tstep : cB;
        for (int t = 0; t < nt; t += 2) {
            const bool last = (t == nt - 2);
            const char* a1 = cA + (size_t)(t + 1) * kstep;
            const char* a2 = last ? nA : cA + (size_t)(t + 2) * kstep; const char* b2 = last ? nB : cB + (size_t)(t + 2) * kstep;
            const char* a3 = a2 + kstep; const char* b3 = b2 + kstep;
            if (last && has_next) S.a_ready(nxt);
            if constexpr (SP2) {
            PG8_LDB(B0, 0, 0); PG8_LDB(B1, 0, 1); PG8_SCHED; PG8_LDA(At, 0, 0); PG8_STAGE(PG8_SA(1, 1), a1 + hstep, voffA);
            PG8_WAIT_V(8); PG8_WAIT_L(0); PG8_BAR; PG8_MMA(0, 0, At, B0); PG8_MMA(0, 1, At, B1); PG8_BAR; PG8_SCHED;
            PG8_LDA(At, 0, 1); PG8_STAGE(PG8_SB(0, 0), b2, voffB); PG8_STAGE(PG8_SB(0, 1), b2 + hstep, voffB); PG8_STAGE(PG8_SA(0, 0), a2, voffA);
            PG8_WAIT_V(8); PG8_WAIT_L(0); PG8_BAR; PG8_MMA(1, 0, At, B0); PG8_MMA(1, 1, At, B1); PG8_BAR; PG8_SCHED;
            PG8_LDB(B0, 1, 0); PG8_LDB(B1, 1, 1); PG8_SCHED; PG8_LDA(At, 1, 0); PG8_STAGE(PG8_SA(0, 1), a2 + hstep, voffA);
            PG8_WAIT_V(8); PG8_WAIT_L(0); PG8_BAR; PG8_MMA(0, 0, At, B0); PG8_MMA(0, 1, At, B1); PG8_BAR; PG8_SCHED;
            PG8_LDA(At, 1, 1); PG8_STAGE(PG8_SB(1, 0), b3, voffB); PG8_STAGE(PG8_SB(1, 1), b3 + hstep, voffB); PG8_STAGE(PG8_SA(1, 0), a3, voffA);
            PG8_WAIT_V(8); PG8_WAIT_L(0); PG8_BAR; PG8_MMA(1, 0, At, B0); PG8_MMA(1, 1, At, B1); PG8_BAR; PG8_SCHED;
            } else {
            PG8_LDB(B0, 0, 0); PG8_SCHED; PG8_LDA(At, 0, 0); PG8_STAGE(PG8_SA(1, 1), a1 + hstep, voffA);
            PG8_WAIT_L(8); PG8_BAR; PG8_WAIT_L(0); PG8_MMA(0, 0, At, B0); PG8_BAR; PG8_SCHED;
            PG8_LDB(B1, 0, 1); PG8_STAGE(PG8_SB(0, 0), b2, voffB);
            PG8_BAR; PG8_WAIT_L(0); PG8_MMA(0, 1, At, B1); PG8_BAR;
            PG8_LDA(At, 0, 1); PG8_STAGE(PG8_SA(0, 0), a2, voffA);
            PG8_BAR; PG8_WAIT_L(0); PG8_MMA(1, 0, At, B0); PG8_BAR; PG8_SCHED;
            PG8_STAGE(PG8_SB(0, 1), b2 + hstep, voffB);
            PG8_WAIT_V(6); PG8_BAR; PG8_MMA(1, 1, At, B1); PG8_BAR;
            PG8_LDB(B0, 1, 0); PG8_SCHED; PG8_LDA(At, 1, 0); PG8_STAGE(PG8_SA(0, 1), a2 + hstep, voffA);
            PG8_WAIT_L(8); PG8_BAR; PG8_WAIT_L(0); PG8_MMA(0, 0, At, B0); PG8_BAR; PG8_SCHED;
            PG8_LDB(B1, 1, 1); PG8_STAGE(PG8_SB(1, 0), b3, voffB);
            PG8_BAR; PG8_WAIT_L(0); PG8_MMA(0, 1, At, B1); PG8_BAR;
            PG8_LDA(At, 1, 1); PG8_STAGE(PG8_SA(1, 0), a3, voffA);
            PG8_BAR; PG8_WAIT_L(0); PG8_MMA(1, 0, At, B0); PG8_BAR; PG8_SCHED;
            PG8_STAGE(PG8_SB(1, 1), b3 + hstep, voffB);
            PG8_WAIT_V(6); PG8_BAR; PG8_MMA(1, 1, At, B1); PG8_BAR;
            }
        }
        if constexpr (ALIGN_EPI) { if (wr == 0) PG8_BAR; }
        if constexpr (!Epi::AFTER_DRAIN) { E(acc, cur, wr, wc, fr, fq); S.done(cur); }
        if (!has_next) break;
#pragma unroll
        for (int a = 0; a < 2; ++a)
#pragma unroll
            for (int b = 0; b < 2; ++b)
#pragma unroll
                for (int m = 0; m < 4; ++m)
#pragma unroll
                    for (int n = 0; n < 2; ++n) acc[a][b][m][n] = AccT{};
        cur = nxt; cA = nA; cB = nB; ++ui;
        if constexpr (ALIGN_EPI) { if (wr == 1) PG8_BAR; }
    }
    PG8_WAIT_V(0);
    if constexpr (!ALIGN_EPI) { if (wr == 0) PG8_BAR; }
    PG8_BAR;
    if constexpr (Epi::AFTER_DRAIN) { E.fused(acc, cur, wr, wc, fr, fq, lds, wid, lane); S.done(cur); }
#undef PG8_SA
#undef PG8_SB
#undef PG8_STAGE
#undef PG8_LDA
#undef PG8_LDB
#undef PG8_MMA
#undef PG8_WAIT_V
#undef PG8_WAIT_L
#undef PG8_BAR
#undef PG8_SCHED
}

struct EpiProj {
    typedef f32x4 AccT; static constexpr bool PERM = true, AFTER_DRAIN = false;
    bf16_t* q; bf16_t* k; bf16_t* v; bf16_t* us; bf16_t* vs; const int* pos;
    __device__ __forceinline__ void operator()(const f32x4 (&acc)[2][2][4][2], const Unit& u, int wr, int wc, int fr, int fq) const {
        const int row0 = u.pm * BM + wr * 64 + fr, b = u.pm >> 4;
        if (u.pn < 12) {
            const bool isq = u.pn < 6; bf16_t* base = isq ? q : k;
            const int hh = 2 * (isq ? u.pn : u.pn - 6) + (wc >> 1), e0 = 32 * (wc & 1) + 8 * fq;
            const float qs = isq ? 0.08838834764831845f : 1.0f;
            float ir[8];
#pragma unroll
            for (int j = 0; j < 8; ++j) ir[j] = exp2f(-(float)(e0 + j) * (13.287712379549449f / 64.0f)) * 0.15915494309189535f;
#pragma unroll
            for (int ai = 0; ai < 2; ++ai)
#pragma unroll
                for (int m = 0; m < 4; ++m) {
                    const int t = row0 + ai * HALF + m * 16, s = t & 4095;
                    const float pf = (float)pos[t];
                    float o0[8], o1[8];
#pragma unroll
                    for (int n = 0; n < 2; ++n)
#pragma unroll
                        for (int i = 0; i < 4; ++i) { const int j = 4 * n + i;
                            const float f = __builtin_amdgcn_fractf(pf * ir[j]); const float sn = __builtin_amdgcn_sinf(f), cs = __builtin_amdgcn_cosf(f);
                            const float t1 = acc[ai][0][m][n][i], t2 = acc[ai][1][m][n][i];
                            o0[j] = (t1 * cs - t2 * sn) * qs; o1[j] = (t2 * cs + t1 * sn) * qs; }
                    bf16_t* dst = base + ((size_t)(b * 12 + hh) * 4096 + s) * 128 + e0;
                    u32x4 w0, w1;
                    w0.x = cvt_pk_bf16(o0[0], o0[1]); w0.y = cvt_pk_bf16(o0[2], o0[3]); w0.z = cvt_pk_bf16(o0[4], o0[5]); w0.w = cvt_pk_bf16(o0[6], o0[7]);
                    w1.x = cvt_pk_bf16(o1[0], o1[1]); w1.y = cvt_pk_bf16(o1[2], o1[3]); w1.z = cvt_pk_bf16(o1[4], o1[5]); w1.w = cvt_pk_bf16(o1[6], o1[7]);
                    *(u32x4*)dst = w0; *(u32x4*)(dst + 64) = w1; }
        } else if (u.pn < 18) {
            const int e0 = 32 * wc + 8 * fq;
#pragma unroll
            for (int ai = 0; ai < 2; ++ai)
#pragma unroll
                for (int m = 0; m < 4; ++m) { const int t = row0 + ai * HALF + m * 16, s = t & 4095;
#pragma unroll
                    for (int bj = 0; bj < 2; ++bj) { const int hh = 2 * (u.pn - 12) + bj; const f32x4 v0 = acc[ai][bj][m][0], v1 = acc[ai][bj][m][1];
                        u32x4 w; w.x = cvt_pk_bf16(v0[0], v0[1]); w.y = cvt_pk_bf16(v0[2], v0[3]); w.z = cvt_pk_bf16(v1[0], v1[1]); w.w = cvt_pk_bf16(v1[2], v1[3]);
                        *(u32x4*)(v + ((size_t)(b * 12 + hh) * 4096 + s) * 128 + e0) = w; } }
        } else {
            bf16_t* base = u.pn < 20 ? us : vs; const int c0 = 256 * ((u.pn - 18) & 1) + 32 * wc + 8 * fq;
#pragma unroll
            for (int ai = 0; ai < 2; ++ai)
#pragma unroll
                for (int m = 0; m < 4; ++m) { const int t = row0 + ai * HALF + m * 16;
#pragma unroll
                    for (int bj = 0; bj < 2; ++bj) { const f32x4 v0 = acc[ai][bj][m][0], v1 = acc[ai][bj][m][1];
                        const f32x2 a = gelu_pk((f32x2){v0[0], v0[1]}), bb = gelu_pk((f32x2){v0[2], v0[3]}), c = gelu_pk((f32x2){v1[0], v1[1]}), d = gelu_pk((f32x2){v1[2], v1[3]});
                        u32x4 w; w.x = cvt_pk_bf16(a.x, a.y); w.y = cvt_pk_bf16(bb.x, bb.y); w.z = cvt_pk_bf16(c.x, c.y); w.w = cvt_pk_bf16(d.x, d.y);
                        *(u32x4*)(base + (size_t)t * 512 + c0 + 128 * bj) = w; } }
        }
    }
};
struct EpiRes {
    typedef f32x4 AccT; static constexpr bool PERM = true, AFTER_DRAIN = false;
    const float* x; bf16_t* hb; const long long* modq;
    __device__ __forceinline__ void operator()(const f32x4 (&acc)[2][2][4][2], const Unit& u, int wr, int wc, int fr, int fq) const {
        const int row0 = u.pm * BM + wr * 64 + fr, col0 = u.pn * BM + wc * 32 + 8 * fq, b = u.pm >> 4;
        f32x4 gt[2][2];
#pragma unroll
        for (int bj = 0; bj < 2; ++bj)
#pragma unroll
            for (int n = 0; n < 2; ++n) { const long long* mp = modq + b * 12288 + 2 * 2048 + col0 + bj * HALF + n * 4;
#pragma unroll
                for (int i = 0; i < 4; ++i) gt[bj][n][i] = (float)(int)(mp[i] >> 32) + (float)(unsigned)mp[i] * 2.3283064365386963e-10f; }
#pragma unroll
        for (int ai = 0; ai < 2; ++ai)
#pragma unroll
            for (int m = 0; m < 4; ++m) { const size_t off = (size_t)(row0 + ai * HALF + m * 16) * 2048 + col0;
#pragma unroll
                for (int bj = 0; bj < 2; ++bj) { const f32x4 x0 = *(const f32x4*)(x + off + bj * HALF), x1 = *(const f32x4*)(x + off + bj * HALF + 4);
                    const f32x4 v0 = x0 + gt[bj][0] * acc[ai][bj][m][0], v1 = x1 + gt[bj][1] * acc[ai][bj][m][1];
                    u32x4 w; w.x = cvt_pk_bf16(v0[0], v0[1]); w.y = cvt_pk_bf16(v0[2], v0[3]); w.z = cvt_pk_bf16(v1[0], v1[1]); w.w = cvt_pk_bf16(v1[2], v1[3]);
                    *(u32x4*)(hb + off + bj * HALF) = w; } }
    }
};
struct EpiPq {
    typedef f32x4 AccT; static constexpr bool PERM = true, AFTER_DRAIN = false;
    bf16_t* o;
    __device__ __forceinline__ void operator()(const f32x4 (&acc)[2][2][4][2], const Unit& u, int wr, int wc, int fr, int fq) const {
        const int row0 = u.pm * BM + wr * 64 + fr, col0 = u.pn * BM + wc * 32 + 8 * fq;
#pragma unroll
        for (int ai = 0; ai < 2; ++ai)
#pragma unroll
            for (int m = 0; m < 4; ++m) { bf16_t* rowp = o + (size_t)(row0 + ai * HALF + m * 16) * 2048 + col0;
#pragma unroll
                for (int bj = 0; bj < 2; ++bj) { const f32x4 v0 = acc[ai][bj][m][0], v1 = acc[ai][bj][m][1];
                    u32x4 w; w.x = cvt_pk_bf16(v0[0], v0[1]); w.y = cvt_pk_bf16(v0[2], v0[3]); w.z = cvt_pk_bf16(v1[0], v1[1]); w.w = cvt_pk_bf16(v1[2], v1[3]);
                    *(u32x4*)(rowp + bj * HALF) = w; } }
    }
};

__device__ __forceinline__ void deq8(const i32x4 a0, const i32x4 a1, float sr, const f32x4 s0, const f32x4 s1, float (&o)[8]) {
    o[0] = (float)a0[0] * (sr * s0[0]); o[1] = (float)a0[1] * (sr * s0[1]); o[2] = (float)a0[2] * (sr * s0[2]); o[3] = (float)a0[3] * (sr * s0[3]);
    o[4] = (float)a1[0] * (sr * s1[0]); o[5] = (float)a1[1] * (sr * s1[1]); o[6] = (float)a1[2] * (sr * s1[2]); o[7] = (float)a1[3] * (sr * s1[3]);
}
struct EpiProj8 {
    typedef i32x4 AccT; static constexpr bool PERM = true, AFTER_DRAIN = false;
    bf16_t* q; bf16_t* k; bf16_t* v; bf16_t* us; bf16_t* vs; const int* pos; const float* sa; const float* sb;
    __device__ __forceinline__ void operator()(const i32x4 (&acc)[2][2][4][2], const Unit& u, int wr, int wc, int fr, int fq) const {
        const int row0 = u.pm * BM + wr * 64 + fr, b = u.pm >> 4;
        f32x4 sbv[2][2];
#pragma unroll
        for (int bj = 0; bj < 2; ++bj)
#pragma unroll
            for (int n = 0; n < 2; ++n) sbv[bj][n] = *(const f32x4*)(sb + u.pn * BM + bj * HALF + wc * 32 + 8 * fq + 4 * n);
        if (u.pn < 12) {
            const bool isq = u.pn < 6; bf16_t* base = isq ? q : k;
            const int hh = 2 * (isq ? u.pn : u.pn - 6) + (wc >> 1), e0 = 32 * (wc & 1) + 8 * fq;
            const float qs = isq ? 0.08838834764831845f : 1.0f;
            float ir[8];
#pragma unroll
            for (int j = 0; j < 8; ++j) ir[j] = exp2f(-(float)(e0 + j) * (13.287712379549449f / 64.0f)) * 0.15915494309189535f;
#pragma unroll
            for (int ai = 0; ai < 2; ++ai)
#pragma unroll
                for (int m = 0; m < 4; ++m) {
                    const int t = row0 + ai * HALF + m * 16, s = t & 4095;
                    const float pf = (float)pos[t], sr = sa[t] * qs;
                    float x0[8], x1[8], o0[8], o1[8];
                    deq8(acc[ai][0][m][0], acc[ai][0][m][1], sr, sbv[0][0], sbv[0][1], x0); deq8(acc[ai][1][m][0], acc[ai][1][m][1], sr, sbv[1][0], sbv[1][1], x1);
#pragma unroll
                    for (int j = 0; j < 8; ++j) { const float f = __builtin_amdgcn_fractf(pf * ir[j]); const float sn = __builtin_amdgcn_sinf(f), cs = __builtin_amdgcn_cosf(f);
                        o0[j] = x0[j] * cs - x1[j] * sn; o1[j] = x1[j] * cs + x0[j] * sn; }
                    bf16_t* dst = base + ((size_t)(b * 12 + hh) * 4096 + s) * 128 + e0;
                    u32x4 w0, w1;
                    w0.x = cvt_pk_bf16(o0[0], o0[1]); w0.y = cvt_pk_bf16(o0[2], o0[3]); w0.z = cvt_pk_bf16(o0[4], o0[5]); w0.w = cvt_pk_bf16(o0[6], o0[7]);
                    w1.x = cvt_pk_bf16(o1[0], o1[1]); w1.y = cvt_pk_bf16(o1[2], o1[3]); w1.z = cvt_pk_bf16(o1[4], o1[5]); w1.w = cvt_pk_bf16(o1[6], o1[7]);
                    *(u32x4*)dst = w0; *(u32x4*)(dst + 64) = w1; }
        } else if (u.pn < 18) {
            const int e0 = 32 * wc + 8 * fq;
#pragma unroll
            for (int ai = 0; ai < 2; ++ai)
#pragma unroll
                for (int m = 0; m < 4; ++m) { const int t = row0 + ai * HALF + m * 16, s = t & 4095; const float sr = sa[t];
#pragma unroll
                    for (int bj = 0; bj < 2; ++bj) { const int hh = 2 * (u.pn - 12) + bj; float x[8]; deq8(acc[ai][bj][m][0], acc[ai][bj][m][1], sr, sbv[bj][0], sbv[bj][1], x);
                        u32x4 w; w.x = cvt_pk_bf16(x[0], x[1]); w.y = cvt_pk_bf16(x[2], x[3]); w.z = cvt_pk_bf16(x[4], x[5]); w.w = cvt_pk_bf16(x[6], x[7]);
                        *(u32x4*)(v + ((size_t)(b * 12 + hh) * 4096 + s) * 128 + e0) = w; } }
        } else {
            bf16_t* base = u.pn < 20 ? us : vs; const int c0 = 256 * ((u.pn - 18) & 1) + 32 * wc + 8 * fq;
#pragma unroll
            for (int ai = 0; ai < 2; ++ai)
#pragma unroll
                for (int m = 0; m < 4; ++m) { const int t = row0 + ai * HALF + m * 16; const float sr = sa[t];
#pragma unroll
                    for (int bj = 0; bj < 2; ++bj) { float x[8]; deq8(acc[ai][bj][m][0], acc[ai][bj][m][1], sr, sbv[bj][0], sbv[bj][1], x);
                        const f32x2 a = gelu_pk((f32x2){x[0], x[1]}), bb = gelu_pk((f32x2){x[2], x[3]}), c = gelu_pk((f32x2){x[4], x[5]}), d = gelu_pk((f32x2){x[6], x[7]});
                        u32x4 w; w.x = cvt_pk_bf16(a.x, a.y); w.y = cvt_pk_bf16(bb.x, bb.y); w.z = cvt_pk_bf16(c.x, c.y); w.w = cvt_pk_bf16(d.x, d.y);
                        *(u32x4*)(base + (size_t)t * 512 + c0 + 128 * bj) = w; } }
        }
    }
};
struct EpiRes8 {
    typedef i32x4 AccT; static constexpr bool PERM = true, AFTER_DRAIN = false;
    const float* x; bf16_t* hb; const long long* modq; const float* sa; const float* sb;
    __device__ __forceinline__ void operator()(const i32x4 (&acc)[2][2][4][2], const Unit& u, int wr, int wc, int fr, int fq) const {
        const int row0 = u.pm * BM + wr * 64 + fr, col0 = u.pn * BM + wc * 32 + 8 * fq, b = u.pm >> 4;
        f32x4 gs[2][2];
#pragma unroll
        for (int bj = 0; bj < 2; ++bj)
#pragma unroll
            for (int n = 0; n < 2; ++n) { const long long* mp = modq + b * 12288 + 2 * 2048 + col0 + bj * HALF + n * 4; const f32x4 sv = *(const f32x4*)(sb + col0 + bj * HALF + n * 4);
#pragma unroll
                for (int i = 0; i < 4; ++i) gs[bj][n][i] = ((float)(int)(mp[i] >> 32) + (float)(unsigned)mp[i] * 2.3283064365386963e-10f) * sv[i]; }
#pragma unroll
        for (int ai = 0; ai < 2; ++ai)
#pragma unroll
            for (int m = 0; m < 4; ++m) { const int t = row0 + ai * HALF + m * 16; const size_t off = (size_t)t * 2048 + col0; const float sr = sa[t];
#pragma unroll
                for (int bj = 0; bj < 2; ++bj) { const f32x4 x0 = *(const f32x4*)(x + off + bj * HALF), x1 = *(const f32x4*)(x + off + bj * HALF + 4);
                    float d[8]; deq8(acc[ai][bj][m][0], acc[ai][bj][m][1], sr, gs[bj][0], gs[bj][1], d);
                    u32x4 w; w.x = cvt_pk_bf16(x0[0] + d[0], x0[1] + d[1]); w.y = cvt_pk_bf16(x0[2] + d[2], x0[3] + d[3]); w.z = cvt_pk_bf16(x1[0] + d[4], x1[1] + d[5]); w.w = cvt_pk_bf16(x1[2] + d[6], x1[3] + d[7]);
                    *(u32x4*)(hb + off + bj * HALF) = w; } }
    }
};
struct EpiPq8 {
    typedef i32x4 AccT; static constexpr bool PERM = true, AFTER_DRAIN = false;
    bf16_t* o; const float* sa; const float* sb;
    __device__ __forceinline__ void operator()(const i32x4 (&acc)[2][2][4][2], const Unit& u, int wr, int wc, int fr, int fq) const {
        const int row0 = u.pm * BM + wr * 64 + fr, col0 = u.pn * BM + wc * 32 + 8 * fq;
        f32x4 sbv[2][2];
#pragma unroll
        for (int bj = 0; bj < 2; ++bj)
#pragma unroll
            for (int n = 0; n < 2; ++n) sbv[bj][n] = *(const f32x4*)(sb + col0 + bj * HALF + n * 4);
#pragma unroll
        for (int ai = 0; ai < 2; ++ai)
#pragma unroll
            for (int m = 0; m < 4; ++m) { const int t = row0 + ai * HALF + m * 16; bf16_t* rowp = o + (size_t)t * 2048 + col0; const float sr = sa[t];
#pragma unroll
                for (int bj = 0; bj < 2; ++bj) { float d[8]; deq8(acc[ai][bj][m][0], acc[ai][bj][m][1], sr, sbv[bj][0], sbv[bj][1], d);
                    u32x4 w; w.x = cvt_pk_bf16(d[0], d[1]); w.y = cvt_pk_bf16(d[2], d[3]); w.z = cvt_pk_bf16(d[4], d[5]); w.w = cvt_pk_bf16(d[6], d[7]);
                    *(u32x4*)(rowp + bj * HALF) = w; } }
    }
};
}

__device__ __forceinline__ void phase_gemm1(const Params& p, unsigned char* lds) {
    const float* scl = (const float*)(p.ws + OFF_SCL);
    pg8::Gemm g{(const bf16_t*)(p.ws + OFF_A), (const bf16_t*)(p.ws + OFF_WIN), T, DIN, D / 2};
    pg8::StaticOrder So; So.init(T, DIN, (int)gridDim.x, (int)blockIdx.x);
    pg8::EpiProj8 Ep{(bf16_t*)(p.ws + OFF_QKV), (bf16_t*)(p.ws + OFF_QKV + QKV_ONE), (bf16_t*)(p.ws + OFF_QKV + 2 * QKV_ONE), (bf16_t*)(p.ws + OFF_US), (bf16_t*)(p.ws + OFF_VS), p.pos, scl + SCL_HS, scl + SCL_WS + WS_IN};
    pg8::gemm_phase<pg8::EpiProj8, pg8::StaticOrder, true, true>((PG8_LAS unsigned char*)lds, g, So, Ep);
}
__device__ __forceinline__ void phase_gemm2(const Params& p, unsigned char* lds) {
    const float* scl = (const float*)(p.ws + OFF_SCL);
    pg8::Gemm g{(const bf16_t*)(p.ws + OFF_QKV), (const bf16_t*)(p.ws + OFF_WOUT), T, D, D / 2};
    pg8::StaticOrder So; So.init(T, D, (int)gridDim.x, (int)blockIdx.x);
    pg8::EpiRes8 Ep{p.x, (bf16_t*)(p.ws + OFF_O12), (const long long*)(p.ws + OFF_MOD), scl + SCL_MS, scl + SCL_WS + WS_OUT};
    pg8::gemm_phase<pg8::EpiRes8, pg8::StaticOrder, false, true>((PG8_LAS unsigned char*)lds, g, So, Ep);
}
__device__ __forceinline__ void phase_gemm3(const Params& p, unsigned char* lds) {
    const float* scl = (const float*)(p.ws + OFF_SCL);
    pg8::Gemm g{(const bf16_t*)(p.ws + OFF_US), (const bf16_t*)(p.ws + OFF_WQ), T, D, D / 2};
    pg8::StaticOrder So; So.init(T, D, (int)gridDim.x, (int)blockIdx.x);
    pg8::EpiPq8 Ep{(bf16_t*)(p.ws + OFF_QKV + (size_t)T * D * 2), (const float*)(p.ws + OFF_SGUO), scl + SCL_WS + WS_Q};
    pg8::gemm_phase<pg8::EpiPq8, pg8::StaticOrder, true, true>((PG8_LAS unsigned char*)lds, g, So, Ep);
}

__device__ __forceinline__ void conv_transpose(const float* __restrict__ W, int N, bf16_t* __restrict__ WT, int perm_limit, float* tile, int bid, int nblk, int tid) {
    const int ntiles = 32 * (N / 64);
    for (int tI = bid; tI < ntiles; tI += nblk) {
        const int tk = tI & 31, tn = tI >> 5, k0 = tk * 64, n0 = tn * 64;
        int l0 = n0;
        if (n0 < perm_limit) { const int base = n0 & ~255, pb = (n0 >> 6) & 3, bj = pb >> 1, qhi = pb & 1; l0 = base + 64 * bj + 128 * qhi; }
        __syncthreads();
#pragma unroll
        for (int pass = 0; pass < 2; ++pass) { const int r = pass * 32 + (tid >> 4), c4 = (tid & 15) * 4;
            const float4 v = *(const float4*)(W + (size_t)(k0 + r) * N + l0 + c4);
            tile[r * 65 + c4 + 0] = v.x; tile[r * 65 + c4 + 1] = v.y; tile[r * 65 + c4 + 2] = v.z; tile[r * 65 + c4 + 3] = v.w; }
        __syncthreads();
        const int n = tid >> 3, kq = (tid & 7) * 8;
        u32x4 w;
        w.x = pack2(tile[(kq + 0) * 65 + n], tile[(kq + 1) * 65 + n]); w.y = pack2(tile[(kq + 2) * 65 + n], tile[(kq + 3) * 65 + n]);
        w.z = pack2(tile[(kq + 4) * 65 + n], tile[(kq + 5) * 65 + n]); w.w = pack2(tile[(kq + 6) * 65 + n], tile[(kq + 7) * 65 + n]);
        *(u32x4*)(WT + (size_t)(n0 + n) * D + k0 + kq) = w;
    }
}
__device__ __forceinline__ void conv_flat(const float* __restrict__ src, bf16_t* __restrict__ dst, size_t n8, int bid, int nblk, int tid) {
    for (size_t i = (size_t)bid * NTHR + tid; i < n8; i += (size_t)nblk * NTHR) {
        const float4 a = ((const float4*)src)[2 * i], b = ((const float4*)src)[2 * i + 1];
        u32x4 w; w.x = pack2(a.x, a.y); w.y = pack2(a.z, a.w); w.z = pack2(b.x, b.y); w.w = pack2(b.z, b.w);
        ((u32x4*)dst)[i] = w; }
}
__device__ __forceinline__ unsigned q8pack(float a, float b, float c, float d, int bias) {
    const int qa = (int)rintf(a) + bias, qb = (int)rintf(b) + bias, qc = (int)rintf(c) + bias, qd = (int)rintf(d) + bias;
    return (unsigned)(qa & 255) | ((unsigned)(qb & 255) << 8) | ((unsigned)(qc & 255) << 16) | ((unsigned)(qd & 255) << 24);
}
template <int BIAS> __device__ __forceinline__ void conv_rows_i8(const float* __restrict__ src, unsigned char* __restrict__ dst, float* __restrict__ inv, int bid, int nblk, int tid) {
    const int lane = tid & 63, gw = bid * NWV + (tid >> 6), nw = nblk * NWV;
    for (int r = gw; r < NEXP; r += nw) {
        const float4* row = (const float4*)(src + (size_t)r * D);
        float4 v[8]; float m = 0.f;
#pragma unroll
        for (int i = 0; i < 8; ++i) { v[i] = row[i * 64 + lane]; m = fmaxf(m, fmaxf(fmaxf(fabsf(v[i].x), fabsf(v[i].y)), fmaxf(fabsf(v[i].z), fabsf(v[i].w)))); }
        m = wave_max(m);
        const float sc = m > 0.f ? 127.0f / m : 0.f, isc = m * (1.0f / 127.0f);
        unsigned char* drow = dst + (size_t)(lane >> 5) * SLICE_BYTES + (size_t)r * 128 + (lane & 31) * 4;
#pragma unroll
        for (int i = 0; i < 8; ++i) *(unsigned*)(drow + (size_t)(2 * i) * SLICE_BYTES) = q8pack(v[i].x * sc, v[i].y * sc, v[i].z * sc, v[i].w * sc, BIAS);
        if (lane == 0) inv[r] = isc;
    }
}
__device__ __forceinline__ void conv_colmax(const float* __restrict__ W, int N, float* __restrict__ pm  , float* red, int bid, int nblk, int tid) {
    const int lane = tid & 63, wv = tid >> 6, nitems = (N / 256) * 4;
    for (int it = bid; it < nitems; it += nblk) {
        const int cb = it >> 2, kg = it & 3;
        const float* wp = W + (size_t)(kg * 512 + wv * 64) * N + cb * 256 + lane * 4;
        float4 m = make_float4(0.f, 0.f, 0.f, 0.f);
#pragma unroll 1
        for (int k0 = 0; k0 < 64; k0 += 16) {
            float4 w[16];
#pragma unroll
            for (int kk = 0; kk < 16; ++kk) w[kk] = *(const float4*)(wp + (size_t)(k0 + kk) * N);
#pragma unroll
            for (int kk = 0; kk < 16; ++kk) { m.x = fmaxf(m.x, fabsf(w[kk].x)); m.y = fmaxf(m.y, fabsf(w[kk].y)); m.z = fmaxf(m.z, fabsf(w[kk].z)); m.w = fmaxf(m.w, fabsf(w[kk].w)); }
        }
        __syncthreads();
        *(float4*)(red + wv * 256 + lane * 4) = m;
        __syncthreads();
        if (tid < 256) { float mm = 0.f;
#pragma unroll
            for (int w8 = 0; w8 < 8; ++w8) mm = fmaxf(mm, red[w8 * 256 + tid]);
            pm[kg * NWCOL + cb * 256 + tid] = mm; }
    }
}
__device__ __forceinline__ void conv_transpose_q8(const float* __restrict__ W, int N, unsigned char* __restrict__ WT, const float* __restrict__ pm, float* __restrict__ wscale, int perm_limit, float* tile, int bid, int nblk, int tid) {
    const int ntiles = 32 * (N / 64);
    for (int tI = bid; tI < ntiles; tI += nblk) {
        const int tk = tI & 31, tn = tI >> 5, k0 = tk * 64, n0 = tn * 64;
        int l0 = n0;
        if (n0 < perm_limit) { const int base = n0 & ~255, pb = (n0 >> 6) & 3, bj = pb >> 1, qhi = pb & 1; l0 = base + 64 * bj + 128 * qhi; }
        __syncthreads();
#pragma unroll
        for (int pass = 0; pass < 2; ++pass) { const int r = pass * 32 + (tid >> 4), c4 = (tid & 15) * 4;
            const float4 v = *(const float4*)(W + (size_t)(k0 + r) * N + l0 + c4);
            tile[r * 65 + c4 + 0] = v.x; tile[r * 65 + c4 + 1] = v.y; tile[r * 65 + c4 + 2] = v.z; tile[r * 65 + c4 + 3] = v.w; }
        __syncthreads();
        const int n = tid >> 3, kq = (tid & 7) * 8, lc = l0 + n;
        const float cm = fmaxf(fmaxf(pm[lc], pm[NWCOL + lc]), fmaxf(pm[2 * NWCOL + lc], pm[3 * NWCOL + lc]));
        const float sc = cm > 0.f ? 127.0f / cm : 0.f;
        u32x2 w;
        w.x = q8pack(tile[(kq + 0) * 65 + n] * sc, tile[(kq + 1) * 65 + n] * sc, tile[(kq + 2) * 65 + n] * sc, tile[(kq + 3) * 65 + n] * sc, 0);
        w.y = q8pack(tile[(kq + 4) * 65 + n] * sc, tile[(kq + 5) * 65 + n] * sc, tile[(kq + 6) * 65 + n] * sc, tile[(kq + 7) * 65 + n] * sc, 0);
        *(u32x2*)(WT + (size_t)(n0 + n) * D + k0 + kq) = w;
        if (tk == 0 && kq == 0) wscale[n0 + n] = cm * (1.0f / 127.0f);
    }
}
__device__ __forceinline__ void phase_quant_weights(const Params& p, unsigned char* lds) {
    const int tid = threadIdx.x, bid = blockIdx.x, nblk = gridDim.x;
    const float* scl = (const float*)(p.ws + OFF_SCL); float* ws = (float*)(p.ws + OFF_SCL) + SCL_WS;
    conv_transpose_q8(p.w_in, DIN, p.ws + OFF_WIN, scl + SCL_PM + WS_IN, ws + WS_IN, 3072, (float*)lds, bid, nblk, tid);
    conv_transpose_q8(p.w_out, D, p.ws + OFF_WOUT, scl + SCL_PM + WS_OUT, ws + WS_OUT, 0, (float*)lds, bid, nblk, tid);
    conv_transpose_q8(p.peer_w_q, D, p.ws + OFF_WQ, scl + SCL_PM + WS_Q, ws + WS_Q, 0, (float*)lds, bid, nblk, tid);
}
__device__ __forceinline__ void phase_conv(const Params& p, unsigned char* lds, bool dup = false) {
    const int tid = threadIdx.x, bid = blockIdx.x, nblk = gridDim.x;
    unsigned long long* mod = (unsigned long long*)(p.ws + OFF_MOD);
    unsigned long long cts = 0; CSTAMP(0);
    for (int it = bid; it < (dup ? 0 : 192); it += nblk) {
        const int cb = it % 48, kg = it / 48, lane = tid & 63, wv = tid >> 6;
        float* sc = (float*)lds;
        float* red = (float*)lds + 2048;
        __syncthreads();
        for (int i = tid; i < 2048; i += NTHR) { const int b = i >> 9, kk = i & 511; const float cv = p.c[b * D + kg * 512 + kk]; sc[i] = cv / (1.f + __expf(-cv)); }
        __syncthreads();
        float acc[4][4];
#pragma unroll
        for (int b = 0; b < 4; ++b) { acc[b][0] = 0.f; acc[b][1] = 0.f; acc[b][2] = 0.f; acc[b][3] = 0.f; }
        const float* wp = p.w_ada + (size_t)(kg * 512 + wv * 64) * 12288 + cb * 256 + lane * 4;
#pragma unroll 1
        for (int k0 = 0; k0 < 64; k0 += 16) {
            float4 w[16];
#pragma unroll
            for (int kk = 0; kk < 16; ++kk) w[kk] = *(const float4*)(wp + (size_t)(k0 + kk) * 12288);
#pragma unroll
            for (int kk = 0; kk < 16; ++kk)
#pragma unroll
                for (int b = 0; b < 4; ++b) { const float sv = sc[b * 512 + wv * 64 + k0 + kk];
                    acc[b][0] += sv * w[kk].x; acc[b][1] += sv * w[kk].y; acc[b][2] += sv * w[kk].z; acc[b][3] += sv * w[kk].w; }
        }
#pragma unroll
        for (int b = 0; b < 4; ++b) *(float4*)(red + (wv * 4 + b) * 256 + lane * 4) = make_float4(acc[b][0], acc[b][1], acc[b][2], acc[b][3]);
        __syncthreads();
        if (tid < 256) {
#pragma unroll
            for (int b = 0; b < 4; ++b) { float sum = 0.f;
#pragma unroll
                for (int w8 = 0; w8 < 8; ++w8) sum += red[(w8 * 4 + b) * 256 + tid];
                const int col = cb * 256 + tid;
                if (kg == 0) sum += p.b_ada[col];
                atomicAdd(mod + b * 12288 + col, (unsigned long long)__double2ll_rn((double)sum * 4294967296.0)); }
        }
    }
    CSTAMP(1);
    { float* pm = (float*)(p.ws + OFF_SCL) + SCL_PM;
      conv_colmax(p.w_in, DIN, pm + WS_IN, (float*)lds, bid, nblk, tid); conv_colmax(p.w_out, D, pm + WS_OUT, (float*)lds, bid, nblk, tid); conv_colmax(p.peer_w_q, D, pm + WS_Q, (float*)lds, bid, nblk, tid); }
    CSTAMP(2);
    conv_rows_i8<0>(p.peer_u, p.ws + OFF_UTAB, (float*)(p.ws + OFF_UTAB + TAB8_BYTES), bid, nblk, tid);
    conv_rows_i8<128>(p.peer_v, p.ws + OFF_VTAB, (float*)(p.ws + OFF_VTAB + TAB8_BYTES), bid, nblk, tid);
    conv_flat(p.peer_sub_keys, (bf16_t*)(p.ws + OFF_SUBK), (size_t)8 * 2 * 128 * 128 / 8, bid, nblk, tid);
    CSTAMP(3);
    { bf16_t* sw = (bf16_t*)(p.ws + OFF_SGUW);
      for (int i = bid * NTHR + tid; i < 4 * 128 * 128; i += nblk * NTHR) { const int jj = i & 127, ii = (i >> 7) & 127; sw[i] = f2bf(jj <= ii ? p.sgu_w[i] : 0.f); } }
}

template <bool Q8, bool SRC16, bool W16> __device__ __forceinline__ void phase_norm_mod(const Params& p, const void* __restrict__ src_, const float* __restrict__ g, int sh_i, int sc_i, bf16_t* __restrict__ dst, unsigned char* __restrict__ dst8, float* __restrict__ dscale) {
    const int lane = threadIdx.x & 63, gw = blockIdx.x * NWV + __builtin_amdgcn_readfirstlane(threadIdx.x >> 6), nw = gridDim.x * NWV;
    const int wpb = nw >> 2;
    const int b = gw / wpb, r0 = gw - b * wpb;
    if (b >= NB) return;
    float4 ca[8], cb[8];
#pragma unroll
    for (int i = 0; i < 8; ++i) { const int col = i * 256 + lane * 4; const float4 gg = *(const float4*)(g + col), sc = mod4(p, b, sc_i, col), sh = mod4(p, b, sh_i, col);
        ca[i] = make_float4(gg.x * (1.f + sc.x), gg.y * (1.f + sc.y), gg.z * (1.f + sc.z), gg.w * (1.f + sc.w)); cb[i] = sh; }
    float4 vf[8]; u32x2 vh[8];
#define NM_LOAD(tt) do { _Pragma("unroll") for (int i = 0; i < 8; ++i) { if (SRC16) vh[i] = *(const u32x2*)((const bf16_t*)src_ + (size_t)(tt) * D + i * 256 + lane * 4); else vf[i] = *(const float4*)((const float*)src_ + (size_t)(tt) * D + i * 256 + lane * 4); } } while (0)
    if (r0 < S) NM_LOAD(b * S + r0);
    for (int r = r0; r < S; r += wpb) {
        const int t = b * S + r;
        float4 v[8]; float ss = 0.f;
#pragma unroll
        for (int i = 0; i < 8; ++i) { v[i] = SRC16 ? make_float4(bflo(vh[i].x), bfhi(vh[i].x), bflo(vh[i].y), bfhi(vh[i].y)) : vf[i];
            ss += v[i].x * v[i].x + v[i].y * v[i].y + v[i].z * v[i].z + v[i].w * v[i].w; }
        if (r + wpb < S) NM_LOAD(t + wpb);
        ss = wave_sum(ss); const float rstd = rsqrtf(ss * (1.0f / D) + 1e-6f);
        float m = 0.f;
#pragma unroll
        for (int i = 0; i < 8; ++i) { const int col = i * 256 + lane * 4;
            v[i].x = v[i].x * rstd * ca[i].x + cb[i].x; v[i].y = v[i].y * rstd * ca[i].y + cb[i].y; v[i].z = v[i].z * rstd * ca[i].z + cb[i].z; v[i].w = v[i].w * rstd * ca[i].w + cb[i].w;
            if (W16) { u32x2 w; w.x = pack2(v[i].x, v[i].y); w.y = pack2(v[i].z, v[i].w); *(u32x2*)(dst + (size_t)t * D + col) = w; }
            if (Q8) m = fmaxf(m, fmaxf(fmaxf(fabsf(v[i].x), fabsf(v[i].y)), fmaxf(fabsf(v[i].z), fabsf(v[i].w)))); }
        if (Q8) {
            m = wave_max(m); const float sc8 = m > 0.f ? 127.0f / m : 0.f;
            unsigned* x8 = (unsigned*)(dst8 + (size_t)t * D);
#pragma unroll
            for (int i = 0; i < 8; ++i) x8[i * 64 + lane] = q8pack(v[i].x * sc8, v[i].y * sc8, v[i].z * sc8, v[i].w * sc8, 0);
            if (lane == 0) dscale[t] = m * (1.0f / 127.0f);
        }
    }
#undef NM_LOAD
}

#define LAS __attribute__((address_space(3)))
typedef short bf16x8 __attribute__((ext_vector_type(8)));
typedef short s16x4 __attribute__((ext_vector_type(4)));
constexpr int ATT_VOFF = 65536, ATT_VSTRIDE = 288;
__device__ __forceinline__ unsigned cvt_pk(float lo, float hi) { unsigned r; asm volatile("v_cvt_pk_bf16_f32 %0, %1, %2" : "=v"(r) : "v"(lo), "v"(hi)); return r; }
struct AttnItem { int pat, bh, r, n, dsh; };
__device__ __forceinline__ AttnItem attn_decode(int item) {
    AttnItem a; a.pat = item / 1536; const int rem = item % 1536; a.bh = rem >> 5; const int ci = rem & 31;
    a.dsh = 2 * a.pat; const int nblk = 32 >> a.dsh; a.r = ci / nblk; a.n = ci % nblk; return a;
}
__device__ __forceinline__ void attn_issue(const AttnItem& a, const bf16_t* qb, const bf16_t* kb, const bf16_t* vb, int tid, int w, int l15, int g, u32x4 (&kr)[8], u32x4 (&vr)[8], bf16x8 (&qf)[4]) {
    const size_t hb = (size_t)a.bh * S;
#pragma unroll
    for (int i = 0; i < 8; ++i) { const int ch = i * NTHR + tid, kk = ch >> 4, c = ch & 15;
        if (a.n > 0 || kk >= 128) { const int tp = (((a.n - 1) * 128 + kk) << a.dsh) + a.r;
            kr[i] = *(const u32x4*)(kb + (hb + tp) * E + c * 8); vr[i] = *(const u32x4*)(vb + (hb + tp) * E + c * 8); } }
    const int tq = ((a.n * 128 + 16 * w + l15) << a.dsh) + a.r;
#pragma unroll
    for (int ks = 0; ks < 4; ++ks) qf[ks] = *(const bf16x8*)(qb + (hb + tq) * E + 32 * ks + 8 * g);
}
__device__ __forceinline__ void phase_attn(const Params& p, unsigned char* lds_) {
    LAS unsigned char* lds = (LAS unsigned char*)lds_;
    const int tid = threadIdx.x, lane = tid & 63, w = __builtin_amdgcn_readfirstlane(tid >> 6), l15 = lane & 15, g = lane >> 4;
    const bf16_t* qb = (const bf16_t*)(p.ws + OFF_QKV); const bf16_t* kb = (const bf16_t*)(p.ws + OFF_QKV + QKV_ONE); const bf16_t* vb = (const bf16_t*)(p.ws + OFF_QKV + 2 * QKV_ONE);
    float* lse = (float*)(p.ws + OFF_LSE);
    const int G = gridDim.x, vcu = (G % 8 == 0) ? (int)(blockIdx.x & 7) * (G >> 3) + (int)(blockIdx.x >> 3) : (int)blockIdx.x;
    const float NEG = -__builtin_inff();
    constexpr int NITEMS = 3 * 48 * 32;
    u32x4 kr[8], vr[8]; bf16x8 qn[4];
    if (vcu < NITEMS) attn_issue(attn_decode(vcu), qb, kb, vb, tid, w, l15, g, kr, vr, qn);
    for (int item = vcu; item < NITEMS; item += G) {
        const AttnItem a = attn_decode(item);
        const int pat = a.pat, bh = a.bh, r = a.r, n = a.n, dsh = a.dsh;
        __syncthreads();
#pragma unroll
        for (int i = 0; i < 8; ++i) { const int ch = i * NTHR + tid, kk = ch >> 4, c = ch & 15;
            if (n > 0 || kk >= 128) { *(LAS u32x4*)(lds + kk * 256 + ((c ^ (kk & 15)) << 4)) = kr[i]; *(LAS u32x4*)(lds + ATT_VOFF + kk * ATT_VSTRIDE + c * 16) = vr[i]; } }
        bf16x8 qf[4];
#pragma unroll
        for (int ks = 0; ks < 4; ++ks) { qf[ks] = qn[ks]; asm volatile("" : "+v"(qf[ks])); }
        __syncthreads();
        if (item + G < NITEMS) attn_issue(attn_decode(item + G), qb, kb, vb, tid, w, l15, g, kr, vr, qn);
        const int jj = 16 * w + l15, tq = ((n * 128 + jj) << dsh) + r;
        const int s0 = w >> 1;
        f32x4 sA[5], sB[5];
#define ATT_LDK(dst, step_, kp_) do { const int _kA = 32 * (step_) + l15, _kB = _kA + 16; _Pragma("unroll") for (int q = 0; q < 2; ++q) { const int ks = 2 * (kp_) + q; \
            dst[2 * q] = *(const LAS bf16x8*)(lds + _kA * 256 + (((4 * ks + g) ^ (_kA & 15)) << 4)); dst[2 * q + 1] = *(const LAS bf16x8*)(lds + _kB * 256 + (((4 * ks + g) ^ (_kB & 15)) << 4)); } } while (0)
        bf16x8 kc[4], kn[4];
        ATT_LDK(kc, s0, 0);
#pragma unroll
        for (int gi = 0; gi < 10; ++gi) {
            const int si = gi >> 1, kp = gi & 1, step = s0 + si;
            if (gi < 9) ATT_LDK(kn, s0 + ((gi + 1) >> 1), (gi + 1) & 1);
            __builtin_amdgcn_sched_barrier(0);
            if (kp == 0) { sA[si] = (f32x4){0.f, 0.f, 0.f, 0.f}; sB[si] = (f32x4){0.f, 0.f, 0.f, 0.f}; }
            if (!(n == 0 && step < 4)) {
#pragma unroll
                for (int q = 0; q < 2; ++q) { sA[si] = __builtin_amdgcn_mfma_f32_16x16x32_bf16(kc[2 * q], qf[2 * kp + q], sA[si], 0, 0, 0); sB[si] = __builtin_amdgcn_mfma_f32_16x16x32_bf16(kc[2 * q + 1], qf[2 * kp + q], sB[si], 0, 0, 0); } }
            if (kp == 1 && (n == 0 && step < 4)) { sA[si] = (f32x4){NEG, NEG, NEG, NEG}; sB[si] = (f32x4){NEG, NEG, NEG, NEG}; }
            if (kp == 1 && (si == 0 || si == 4)) {
#pragma unroll
                for (int rg = 0; rg < 4; ++rg) { const int ka = 32 * step + 4 * g + rg, kb2 = ka + 16;
                    const bool oka = (unsigned)(ka - jj) <= 128u, okb = (unsigned)(kb2 - jj) <= 128u;
                    sA[si][rg] = oka ? sA[si][rg] : NEG; sB[si][rg] = okb ? sB[si][rg] : NEG; } }
            if (gi < 9) {
#pragma unroll
                for (int q = 0; q < 4; ++q) kc[q] = kn[q]; }
        }
#undef ATT_LDK
        float m = NEG;
#pragma unroll
        for (int si = 0; si < 5; ++si)
#pragma unroll
            for (int rg = 0; rg < 4; ++rg) m = fmaxf(m, fmaxf(sA[si][rg], sB[si][rg]));
        m = fmaxf(m, __shfl_xor(m, 16)); m = fmaxf(m, __shfl_xor(m, 32));
        float l = 0.f; const float mL = m * 1.4426950408889634f;
#pragma unroll
        for (int si = 0; si < 5; ++si)
#pragma unroll
            for (int rg = 0; rg < 4; ++rg) { sA[si][rg] = __builtin_amdgcn_exp2f(sA[si][rg] * 1.4426950408889634f - mL); sB[si][rg] = __builtin_amdgcn_exp2f(sB[si][rg] * 1.4426950408889634f - mL); l += sA[si][rg] + sB[si][rg]; }
        l += __shfl_xor(l, 16); l += __shfl_xor(l, 32);
        f32x4 o[8];
#pragma unroll
        for (int dt = 0; dt < 8; ++dt) o[dt] = (f32x4){0.f, 0.f, 0.f, 0.f};
#define ATT_LDV(dst, step_, hf_) do { LAS unsigned char* _vr = lds + ATT_VOFF + (32 * (step_) + 4 * g + (l15 >> 2)) * ATT_VSTRIDE + (l15 & 3) * 8 + (hf_) * 128; _Pragma("unroll") for (int q = 0; q < 4; ++q) { \
            dst[2 * q] = __builtin_amdgcn_ds_read_tr16_b64_v4i16((LAS s16x4*)(_vr + q * 32)); dst[2 * q + 1] = __builtin_amdgcn_ds_read_tr16_b64_v4i16((LAS s16x4*)(_vr + q * 32 + 16 * ATT_VSTRIDE)); } } while (0)
        bf16x8 pfa[5];
#pragma unroll
        for (int si = 0; si < 5; ++si) { u32x4 pw; pw.x = cvt_pk(sA[si][0], sA[si][1]); pw.y = cvt_pk(sA[si][2], sA[si][3]); pw.z = cvt_pk(sB[si][0], sB[si][1]); pw.w = cvt_pk(sB[si][2], sB[si][3]); pfa[si] = *reinterpret_cast<const bf16x8*>(&pw); }
        s16x4 vc[8], vn[8];
        ATT_LDV(vc, s0, 0);
#pragma unroll
        for (int gi = 0; gi < 10; ++gi) {
            const int si = gi >> 1, hf = gi & 1, step = s0 + si;
            if (gi < 9) ATT_LDV(vn, s0 + ((gi + 1) >> 1), (gi + 1) & 1);
            __builtin_amdgcn_sched_barrier(0);
            if (!(n == 0 && step < 4)) {
#pragma unroll
                for (int q = 0; q < 4; ++q) { const s16x4 v0 = vc[2 * q], v1 = vc[2 * q + 1];
                    const bf16x8 vf = {v0[0], v0[1], v0[2], v0[3], v1[0], v1[1], v1[2], v1[3]};
                    o[4 * hf + q] = __builtin_amdgcn_mfma_f32_16x16x32_bf16(vf, pfa[si], o[4 * hf + q], 0, 0, 0); } }
            if (gi < 9) {
#pragma unroll
                for (int q = 0; q < 8; ++q) vc[q] = vn[q]; }
        }
#undef ATT_LDV
        const float il = 1.0f / l; const int b_ = bh / HA, h = bh % HA; const size_t tg = (size_t)b_ * S + tq;
        bf16_t* orow = P_opat(p, pat) + tg * DA + h * E + 4 * g;
#pragma unroll
        for (int dt = 0; dt < 8; ++dt) { u32x2 ww; ww.x = cvt_pk(o[dt][0] * il, o[dt][1] * il); ww.y = cvt_pk(o[dt][2] * il, o[dt][3] * il); *(u32x2*)(orow + 16 * dt) = ww; }
        if (g == 0) lse[((size_t)pat * T + tg) * HA + h] = m + __logf(l);
    }
}

__device__ __forceinline__ void phase_sgu(const Params& p, unsigned char* lds_) {
    LAS unsigned char* lds = (LAS unsigned char*)lds_;
    const int tid = threadIdx.x, lane = tid & 63, w = __builtin_amdgcn_readfirstlane(tid >> 6), l15 = lane & 15, g = lane >> 4;
    const bf16_t* vsb = (const bf16_t*)(p.ws + OFF_VS); const bf16_t* usb = (const bf16_t*)(p.ws + OFF_US); bf16_t* ob = (bf16_t*)(p.ws + OFF_SGUO);
    const bf16_t* sw = (const bf16_t*)(p.ws + OFF_SGUW);
    for (int item = blockIdx.x; item < (T / 128) * HS; item += gridDim.x) {
        const int h = item & 3, t0 = (item >> 2) * 128;
        __syncthreads();
        {
            const int j = tid >> 2, part = tid & 3;
            const u32x4* src = (const u32x4*)(vsb + (size_t)(t0 + j) * DS + h * E + part * 32);
            u32x4 x[4]; float sum = 0.f;
#pragma unroll
            for (int i = 0; i < 4; ++i) { x[i] = src[i]; sum += bflo(x[i].x) + bfhi(x[i].x) + bflo(x[i].y) + bfhi(x[i].y) + bflo(x[i].z) + bfhi(x[i].z) + bflo(x[i].w) + bfhi(x[i].w); }
            sum += __shfl_xor(sum, 1); sum += __shfl_xor(sum, 2);
            const float mu = sum * (1.0f / E); float var = 0.f;
#pragma unroll
            for (int i = 0; i < 4; ++i) { float dd;
                dd = bflo(x[i].x) - mu; var += dd * dd; dd = bfhi(x[i].x) - mu; var += dd * dd; dd = bflo(x[i].y) - mu; var += dd * dd; dd = bfhi(x[i].y) - mu; var += dd * dd;
                dd = bflo(x[i].z) - mu; var += dd * dd; dd = bfhi(x[i].z) - mu; var += dd * dd; dd = bflo(x[i].w) - mu; var += dd * dd; dd = bfhi(x[i].w) - mu; var += dd * dd; }
            var += __shfl_xor(var, 1); var += __shfl_xor(var, 2);
            const float rs = rsqrtf(var * (1.0f / E) + 1e-5f);
            const float* lg = p.sgu_ln_g + h * E + part * 32; const float* lb = p.sgu_ln_b + h * E + part * 32;
#pragma unroll
            for (int i = 0; i < 4; ++i) { const float4 g0 = *(const float4*)(lg + i * 8), g1 = *(const float4*)(lg + i * 8 + 4), b0 = *(const float4*)(lb + i * 8), b1 = *(const float4*)(lb + i * 8 + 4);
                u32x4 o; o.x = cvt_pk((bflo(x[i].x) - mu) * rs * g0.x + b0.x, (bfhi(x[i].x) - mu) * rs * g0.y + b0.y); o.y = cvt_pk((bflo(x[i].y) - mu) * rs * g0.z + b0.z, (bfhi(x[i].y) - mu) * rs * g0.w + b0.w);
                o.z = cvt_pk((bflo(x[i].z) - mu) * rs * g1.x + b1.x, (bfhi(x[i].z) - mu) * rs * g1.y + b1.y); o.w = cvt_pk((bflo(x[i].w) - mu) * rs * g1.z + b1.z, (bfhi(x[i].w) - mu) * rs * g1.w + b1.w);
                *(LAS u32x4*)(lds + j * ATT_VSTRIDE + part * 64 + i * 16) = o; }
        }
        __syncthreads();
        f32x4 acc[8];
#pragma unroll
        for (int et = 0; et < 8; ++et) acc[et] = (f32x4){0.f, 0.f, 0.f, 0.f};
        const int irow = 16 * w + l15, nsteps = (16 * w + 15) / 32 + 1;
        const bf16_t* wrow = sw + ((size_t)h * 128 + irow) * 128;
        for (int st = 0; st < nsteps; ++st) {
            const u32x2 wa = *(const u32x2*)(wrow + 32 * st + 4 * g), wb = *(const u32x2*)(wrow + 32 * st + 16 + 4 * g);
            u32x4 wf4; wf4.x = wa.x; wf4.y = wa.y; wf4.z = wb.x; wf4.w = wb.y;
            const bf16x8 wf = *reinterpret_cast<const bf16x8*>(&wf4);
            LAS unsigned char* vrow = lds + (32 * st + 4 * g + (l15 >> 2)) * ATT_VSTRIDE + (l15 & 3) * 8;
#pragma unroll
            for (int et = 0; et < 8; ++et) {
                const s16x4 v0 = __builtin_amdgcn_ds_read_tr16_b64_v4i16((LAS s16x4*)(vrow + et * 32));
                const s16x4 v1 = __builtin_amdgcn_ds_read_tr16_b64_v4i16((LAS s16x4*)(vrow + et * 32 + 16 * ATT_VSTRIDE));
                const bf16x8 vf = {v0[0], v0[1], v0[2], v0[3], v1[0], v1[1], v1[2], v1[3]};
                acc[et] = __builtin_amdgcn_mfma_f32_16x16x32_bf16(vf, wf, acc[et], 0, 0, 0); }
        }
        const float bias = p.sgu_b[h * 128 + irow];
        const size_t base = (size_t)(t0 + irow) * DS + h * E + 4 * g;
#pragma unroll
        for (int et = 0; et < 8; ++et) { const u32x2 uu = *(const u32x2*)(usb + base + 16 * et);
            u32x2 oo; oo.x = cvt_pk(bflo(uu.x) * (acc[et][0] + bias), bfhi(uu.x) * (acc[et][1] + bias)); oo.y = cvt_pk(bflo(uu.y) * (acc[et][2] + bias), bfhi(uu.y) * (acc[et][3] + bias));
            *(u32x2*)(ob + base + 16 * et) = oo; }
    }
}

__device__ __forceinline__ void phase_combine(const Params& p) {
    const int lane = threadIdx.x & 63, gw = blockIdx.x * NWV + __builtin_amdgcn_readfirstlane(threadIdx.x >> 6), nw = gridDim.x * NWV;
    const float* lse = (const float*)(p.ws + OFF_LSE);
    const bf16_t* sg = (const bf16_t*)(p.ws + OFF_SGUO);
    const bf16_t* o0 = P_opat(p, 0); const bf16_t* o1 = P_opat(p, 1); const bf16_t* o2 = P_opat(p, 2);
    float ga[24], gs[8];
#pragma unroll
    for (int i = 0; i < 3; ++i) { const int col0 = (lane + 64 * i) * 8; const float4 g0 = *(const float4*)(p.g_attn_out + col0), g1 = *(const float4*)(p.g_attn_out + col0 + 4);
        ga[i * 8 + 0] = g0.x; ga[i * 8 + 1] = g0.y; ga[i * 8 + 2] = g0.z; ga[i * 8 + 3] = g0.w; ga[i * 8 + 4] = g1.x; ga[i * 8 + 5] = g1.y; ga[i * 8 + 6] = g1.z; ga[i * 8 + 7] = g1.w; }
    { const float4 g0 = *(const float4*)(p.g_sgu_out + lane * 8), g1 = *(const float4*)(p.g_sgu_out + lane * 8 + 4);
      gs[0] = g0.x; gs[1] = g0.y; gs[2] = g0.z; gs[3] = g0.w; gs[4] = g1.x; gs[5] = g1.y; gs[6] = g1.z; gs[7] = g1.w; }
    u32x4 xa[3], xb[3], xc[3], xs; float l0 = 0.f, l1 = 0.f, l2 = 0.f;
#define CB_LOAD(tt) do { _Pragma("unroll") for (int i = 0; i < 3; ++i) { const size_t o = (size_t)(tt) * DA + (lane + 64 * i) * 8; xa[i] = *(const u32x4*)(o0 + o); xb[i] = *(const u32x4*)(o1 + o); xc[i] = *(const u32x4*)(o2 + o); } \
        xs = *(const u32x4*)(sg + (size_t)(tt) * DS + lane * 8); \
        if (lane < HA) { l0 = lse[((size_t)0 * T + (tt)) * HA + lane]; l1 = lse[((size_t)1 * T + (tt)) * HA + lane]; l2 = lse[((size_t)2 * T + (tt)) * HA + lane]; } } while (0)
    if (gw < T) CB_LOAD(gw);
    for (int t = gw; t < T; t += nw) {
        float w0 = 0.f, w1 = 0.f, w2 = 0.f;
        if (lane < HA) { const float m = fmaxf(l0, fmaxf(l1, l2)); const float e0 = __expf(l0 - m), e1 = __expf(l1 - m), e2 = __expf(l2 - m); const float is = 1.0f / (e0 + e1 + e2);
            w0 = e0 * is; w1 = e1 * is; w2 = e2 * is; }
        float av[3][8]; float ss = 0.f;
#pragma unroll
        for (int i = 0; i < 3; ++i) { const int hh = ((lane + 64 * i) * 8) >> 7;
            const float a0 = __shfl(w0, hh), a1 = __shfl(w1, hh), a2 = __shfl(w2, hh);
            const u32x4 x0 = xa[i], x1 = xb[i], x2 = xc[i];
            av[i][0] = a0 * bflo(x0.x) + a1 * bflo(x1.x) + a2 * bflo(x2.x); av[i][1] = a0 * bfhi(x0.x) + a1 * bfhi(x1.x) + a2 * bfhi(x2.x);
            av[i][2] = a0 * bflo(x0.y) + a1 * bflo(x1.y) + a2 * bflo(x2.y); av[i][3] = a0 * bfhi(x0.y) + a1 * bfhi(x1.y) + a2 * bfhi(x2.y);
            av[i][4] = a0 * bflo(x0.z) + a1 * bflo(x1.z) + a2 * bflo(x2.z); av[i][5] = a0 * bfhi(x0.z) + a1 * bfhi(x1.z) + a2 * bfhi(x2.z);
            av[i][6] = a0 * bflo(x0.w) + a1 * bflo(x1.w) + a2 * bflo(x2.w); av[i][7] = a0 * bfhi(x0.w) + a1 * bfhi(x1.w) + a2 * bfhi(x2.w);
#pragma unroll
            for (int j = 0; j < 8; ++j) ss += av[i][j] * av[i][j]; }
        float sv[8] = {bflo(xs.x), bfhi(xs.x), bflo(xs.y), bfhi(xs.y), bflo(xs.z), bfhi(xs.z), bflo(xs.w), bfhi(xs.w)}; float s2 = 0.f;
#pragma unroll
        for (int j = 0; j < 8; ++j) s2 += sv[j] * sv[j];
        if (t + nw < T) CB_LOAD(t + nw);
        ss = wave_sum(ss); const float rs = rsqrtf(ss * (1.0f / DA) + 1e-6f);
        s2 = wave_sum(s2); const float r2 = rsqrtf(s2 * (1.0f / DS) + 1e-6f);
        float m = 0.f;
#pragma unroll
        for (int i = 0; i < 3; ++i)
#pragma unroll
            for (int j = 0; j < 8; ++j) { av[i][j] = av[i][j] * rs * ga[i * 8 + j]; m = fmaxf(m, fabsf(av[i][j])); }
#pragma unroll
        for (int j = 0; j < 8; ++j) { sv[j] = sv[j] * r2 * gs[j]; m = fmaxf(m, fabsf(sv[j])); }
        m = wave_max(m); const float sc8 = m > 0.f ? 127.0f / m : 0.f;
        unsigned char* mrow = p.ws + OFF_QKV + (size_t)t * D;
#pragma unroll
        for (int i = 0; i < 3; ++i) { u32x2 w; w.x = q8pack(av[i][0] * sc8, av[i][1] * sc8, av[i][2] * sc8, av[i][3] * sc8, 0); w.y = q8pack(av[i][4] * sc8, av[i][5] * sc8, av[i][6] * sc8, av[i][7] * sc8, 0);
            *(u32x2*)(mrow + (lane + 64 * i) * 8) = w; }
        { u32x2 w; w.x = q8pack(sv[0] * sc8, sv[1] * sc8, sv[2] * sc8, sv[3] * sc8, 0); w.y = q8pack(sv[4] * sc8, sv[5] * sc8, sv[6] * sc8, sv[7] * sc8, 0);
          *(u32x2*)(mrow + DA + lane * 8) = w; }
        if (lane == 0) ((float*)(p.ws + OFF_SCL))[SCL_MS + t] = m * (1.0f / 127.0f);
    }
#undef CB_LOAD
}

__device__ __forceinline__ int f2key(float f) { const int b = __float_as_int(f); return b ^ ((b >> 31) & 0x7fffffff); }
__device__ __forceinline__ float key2f(int k) { return __int_as_float(k ^ ((k >> 31) & 0x7fffffff)); }
typedef int i32x16 __attribute__((ext_vector_type(16)));
typedef float f32x16v __attribute__((ext_vector_type(16)));
#define TK_CE(v, i, l) do { const int _a = v[i], _b = v[l]; v[i] = max(_a, _b); v[l] = min(_a, _b); } while (0)
__device__ __forceinline__ i32x16 sort16_desc(i32x16 v) {
#pragma unroll
    for (int lk = 1; lk <= 4; ++lk)
#pragma unroll
        for (int lj = 3; lj >= 0; --lj) { if (lj >= lk) continue; const int k = 1 << lk, j = 1 << lj;
#pragma unroll
            for (int i = 0; i < 16; ++i) { const int l = i ^ j; if (l > i) { if ((i & k) == 0) TK_CE(v, i, l); else TK_CE(v, l, i); } } }
    return v;
}
__device__ __forceinline__ i32x16 bitonic_merge16_desc(i32x16 v) {
#pragma unroll
    for (int lj = 3; lj >= 0; --lj) { const int j = 1 << lj;
#pragma unroll
        for (int i = 0; i < 16; ++i) { const int l = i ^ j; if (l > i) TK_CE(v, i, l); } }
    return v;
}
__device__ __forceinline__ i32x16 merge_top16(i32x16 a, i32x16 b) {
#pragma unroll
    for (int i = 0; i < 16; ++i) a[i] = max(a[i], b[15 - i]);
    return bitonic_merge16_desc(a);
}
__device__ __forceinline__ i32x16 xlane_merge_top16(i32x16 a, int xr) {
    i32x16 b;
#pragma unroll
    for (int i = 0; i < 16; ++i) b[i] = __shfl_xor(a[i], xr);
    return merge_top16(a, b);
}
__device__ __forceinline__ int sel2i(bool c, int x, int y) { return c ? y : x; }
__device__ __forceinline__ int sel16(i32x16 v, int i) {
    const bool c0 = (i & 1) != 0, c1 = (i & 2) != 0, c2 = (i & 4) != 0, c3 = (i & 8) != 0;
    const int a0 = sel2i(c0, v[0], v[1]), a1 = sel2i(c0, v[2], v[3]), a2 = sel2i(c0, v[4], v[5]), a3 = sel2i(c0, v[6], v[7]);
    const int a4 = sel2i(c0, v[8], v[9]), a5 = sel2i(c0, v[10], v[11]), a6 = sel2i(c0, v[12], v[13]), a7 = sel2i(c0, v[14], v[15]);
    const int b0 = sel2i(c1, a0, a1), b1 = sel2i(c1, a2, a3), b2 = sel2i(c1, a4, a5), b3 = sel2i(c1, a6, a7);
    const int d0 = sel2i(c2, b0, b1), d1 = sel2i(c2, b2, b3);
    return sel2i(c3, d0, d1);
}
__device__ __forceinline__ int sel4i(int g, int a, int b, int c, int d) { return g == 0 ? a : (g == 1 ? b : (g == 2 ? c : d)); }
__device__ __forceinline__ float sel4f(int g, float a, float b, float c, float d) { return g == 0 ? a : (g == 1 ? b : (g == 2 ? c : d)); }
constexpr int TK_TAB[64] = {
    0x00, 0x01, 0x02, 0x03, 0x04, 0x05, 0x06, 0x07, 0x08, 0x09, 0x0A, 0x0B, 0x0C, 0x0D, 0x0E, 0x0F,
    0x10, 0x11, 0x12, 0x13, 0x14, 0x15, 0x16, 0x17, 0x40, 0x41, 0x42, 0x80, 0x90, 0xFF, 0xFF, 0xFF,
    0x20, 0x21, 0x22, 0x23, 0x24, 0x30, 0x31, 0x32, 0x33, 0x50, 0x51, 0xA0, 0xB0, 0xFF, 0xFF, 0xFF,
    0x60, 0x61, 0x70, 0x71, 0xC0, 0xD0, 0xE0, 0xF0, 0xFF, 0xFF, 0xFF, 0xFF, 0xFF, 0xFF, 0xFF, 0xFF};
template <int C> __device__ __forceinline__ int tk_make_cand(i32x16 sp0, i32x16 sp1, int g) {
    constexpr int NONE = (int)0x80000000;
    constexpr int e0 = TK_TAB[C], e1 = TK_TAB[16 + C], e2 = TK_TAB[32 + C], e3 = TK_TAB[48 + C];
    constexpr int r0 = (e0 >> 4) & 15, r1 = e1 == 0xFF ? 0 : (e1 >> 4) & 15, r2 = e2 == 0xFF ? 0 : (e2 >> 4) & 15, r3 = e3 == 0xFF ? 0 : (e3 >> 4) & 15;
    constexpr int c0 = e0 & 15, c1 = e1 == 0xFF ? 0 : e1 & 15, c2 = e2 == 0xFF ? 0 : e2 & 15, c3 = e3 == 0xFF ? 0 : e3 & 15;
    const int av = sel4i(g, sp0[r0], sp0[r1], sp0[r2], sp0[r3]);
    const int bv = sel4i(g, sp1[c0], sp1[c1], sp1[c2], sp1[c3]);
    const int code = sel4i(g, e0, e1, e2, e3);
    const float sum = key2f(av & ~127) + key2f(bv & ~127);
    return code == 0xFF ? NONE : ((f2key(sum) & ~255) | code);
}
__device__ __forceinline__ void phase_topk(const Params& p, unsigned char* lds_) {
    LAS unsigned char* lds = (LAS unsigned char*)lds_;
    const int tid = threadIdx.x, lane = tid & 63, w = __builtin_amdgcn_readfirstlane(tid >> 6), l15 = lane & 15, g = lane >> 4;
    const bf16_t* pq = (const bf16_t*)(p.ws + OFF_QKV + (size_t)T * D * 2); const bf16_t* skb = (const bf16_t*)(p.ws + OFF_SUBK);
    int* idxo = (int*)(p.ws + OFF_IDX); float* gato = (float*)(p.ws + OFF_GATE);
    int cur_h = -1;
    for (int task = blockIdx.x; task < (T / 128) * PH; task += gridDim.x) {
        const int h = task & 7, tt = task >> 3;
        if (h != cur_h) {
            __syncthreads();
#pragma unroll
            for (int i = 0; i < 8; ++i) { const int ch = i * NTHR + tid, row = ch >> 4, c = ch & 15;
                *(LAS u32x4*)(lds + row * 256 + ((c ^ (row & 15)) << 4)) = *(const u32x4*)(skb + ((size_t)h * 256 + row) * 128 + c * 8); }
            __syncthreads();
            cur_h = h;
        }
        const int t = tt * 128 + 16 * w + l15;
        i32x16 sp0, sp1;
#pragma unroll
        for (int pp = 0; pp < 2; ++pp) {
            bf16x8 bq[4];
#pragma unroll
            for (int ks = 0; ks < 4; ++ks) bq[ks] = *(const bf16x8*)(pq + (size_t)t * D + h * 256 + pp * 128 + 32 * ks + 8 * g);
            i32x16 ka, kb2;
#pragma unroll
            for (int kt = 0; kt < 8; ++kt) {
                f32x4 a = {0.f, 0.f, 0.f, 0.f};
                const int row = pp * 128 + 16 * kt + l15;
#pragma unroll
                for (int ks = 0; ks < 4; ++ks) { const bf16x8 kf = *(const LAS bf16x8*)(lds + row * 256 + (((4 * ks + g) ^ (row & 15)) << 4)); a = __builtin_amdgcn_mfma_f32_16x16x32_bf16(kf, bq[ks], a, 0, 0, 0); }
#pragma unroll
                for (int rg = 0; rg < 4; ++rg) { const int key = (f2key(a[rg]) & ~127) | (16 * kt + rg + 4 * g);
                    if (kt < 4) ka[kt * 4 + rg] = key; else kb2[(kt - 4) * 4 + rg] = key; }
            }
            ka = merge_top16(sort16_desc(ka), sort16_desc(kb2));
            ka = xlane_merge_top16(ka, 16); ka = xlane_merge_top16(ka, 32);
            if (pp == 0) sp0 = ka; else sp1 = ka;
        }
        i32x16 cd;
        cd[0] = tk_make_cand<0>(sp0, sp1, g); cd[1] = tk_make_cand<1>(sp0, sp1, g); cd[2] = tk_make_cand<2>(sp0, sp1, g); cd[3] = tk_make_cand<3>(sp0, sp1, g);
        cd[4] = tk_make_cand<4>(sp0, sp1, g); cd[5] = tk_make_cand<5>(sp0, sp1, g); cd[6] = tk_make_cand<6>(sp0, sp1, g); cd[7] = tk_make_cand<7>(sp0, sp1, g);
        cd[8] = tk_make_cand<8>(sp0, sp1, g); cd[9] = tk_make_cand<9>(sp0, sp1, g); cd[10] = tk_make_cand<10>(sp0, sp1, g); cd[11] = tk_make_cand<11>(sp0, sp1, g);
        cd[12] = tk_make_cand<12>(sp0, sp1, g); cd[13] = tk_make_cand<13>(sp0, sp1, g); cd[14] = tk_make_cand<14>(sp0, sp1, g); cd[15] = tk_make_cand<15>(sp0, sp1, g);
        cd = sort16_desc(cd); cd = xlane_merge_top16(cd, 16); cd = xlane_merge_top16(cd, 32);
        f32x16v ex; float sum = 0.f; const float m0 = key2f(cd[0] & ~255);
#pragma unroll
        for (int i = 0; i < 16; ++i) { ex[i] = __expf(key2f(cd[i] & ~255) - m0); sum += ex[i]; }
        const float is = 1.0f / sum;
        int oi[4]; float og[4];
#pragma unroll
        for (int c = 0; c < 4; ++c) {
            const int key = sel4i(g, cd[c], cd[4 + c], cd[8 + c], cd[12 + c]);
            const float e = sel4f(g, ex[c], ex[4 + c], ex[8 + c], ex[12 + c]);
            const int i1 = sel16(sp0, (key >> 4) & 15) & 127, i2 = sel16(sp1, key & 15) & 127;
            oi[c] = i1 * 128 + i2; og[c] = e * is; }
        *(int4*)(idxo + (size_t)t * 128 + h * PK + 4 * g) = make_int4(oi[0], oi[1], oi[2], oi[3]);
        *(float4*)(gato + (size_t)t * 128 + h * PK + 4 * g) = make_float4(og[0], og[1], og[2], og[3]);
    }
}

typedef float f32x2v __attribute__((ext_vector_type(2)));
typedef float f32x8v __attribute__((ext_vector_type(8)));
__device__ __forceinline__ int dot16_i8(const u32x4 w, const u32x4 x) {
    int s = __builtin_amdgcn_sdot4((int)w.x, (int)x.x, 0, false); s = __builtin_amdgcn_sdot4((int)w.y, (int)x.y, s, false);
    s = __builtin_amdgcn_sdot4((int)w.z, (int)x.z, s, false); return __builtin_amdgcn_sdot4((int)w.w, (int)x.w, s, false);
}
__device__ __forceinline__ void axpy16_u8(const u32x4 w, float cw, float* acc) {
    float f[16];
#pragma unroll
    for (int q = 0; q < 4; ++q) { const unsigned ww = w[q];
        f[4 * q + 0] = __uint_as_float(__builtin_amdgcn_perm(0x47000000u, ww, 0x07060004u)); f[4 * q + 1] = __uint_as_float(__builtin_amdgcn_perm(0x47000000u, ww, 0x07060104u));
        f[4 * q + 2] = __uint_as_float(__builtin_amdgcn_perm(0x47000000u, ww, 0x07060204u)); f[4 * q + 3] = __uint_as_float(__builtin_amdgcn_perm(0x47000000u, ww, 0x07060304u)); }
    __builtin_amdgcn_sched_barrier(0);
#pragma unroll
    for (int j = 0; j < 16; ++j) acc[j] = fmaf(cw, f[j], acc[j]);
    __builtin_amdgcn_sched_barrier(0);
}
typedef _Float16 h2v __attribute__((ext_vector_type(2)));
__device__ __forceinline__ void axpy16x2_u8(const u32x4 wa, const u32x4 wb, h2v cwp, float* acc) {
#pragma unroll
    for (int q = 0; q < 4; ++q) { const unsigned ua = wa[q], ub = wb[q];
        unsigned p0 = __builtin_amdgcn_perm(ub, ua, 0x0C040C00u), p1 = __builtin_amdgcn_perm(ub, ua, 0x0C050C01u), p2 = __builtin_amdgcn_perm(ub, ua, 0x0C060C02u), p3 = __builtin_amdgcn_perm(ub, ua, 0x0C070C03u);
        acc[4 * q + 0] = __builtin_amdgcn_fdot2(*reinterpret_cast<h2v*>(&p0), cwp, acc[4 * q + 0], false); acc[4 * q + 1] = __builtin_amdgcn_fdot2(*reinterpret_cast<h2v*>(&p1), cwp, acc[4 * q + 1], false);
        acc[4 * q + 2] = __builtin_amdgcn_fdot2(*reinterpret_cast<h2v*>(&p2), cwp, acc[4 * q + 2], false); acc[4 * q + 3] = __builtin_amdgcn_fdot2(*reinterpret_cast<h2v*>(&p3), cwp, acc[4 * q + 3], false); }
}
typedef int i32x8v __attribute__((ext_vector_type(8)));
typedef int i32x4v __attribute__((ext_vector_type(4)));
typedef int i32x2v __attribute__((ext_vector_type(2)));
__device__ __forceinline__ int red8_piece(i32x8v r, int lane) {
    const bool b2 = (lane & 4) != 0, b1 = (lane & 2) != 0, b0 = (lane & 1) != 0;
    i32x4v q; i32x2v pp;
#pragma unroll
    for (int k = 0; k < 4; ++k) { const int lo = r[k], hi = r[k + 4]; const int kp = b2 ? hi : lo, sn = b2 ? lo : hi; q[k] = kp + __shfl_xor(sn, 4); }
#pragma unroll
    for (int k = 0; k < 2; ++k) { const int lo = q[k], hi = q[k + 2]; const int kp = b1 ? hi : lo, sn = b1 ? lo : hi; pp[k] = kp + __shfl_xor(sn, 2); }
    const int lo = pp[0], hi = pp[1]; const int kp = b0 ? hi : lo, sn = b0 ? lo : hi;
    return kp + __shfl_xor(sn, 1);
}
constexpr int PEER_CHUNK = 16;
template <int WHICH, int MODE = 0> __device__ __forceinline__ void peer_chunk(const Params& p, int t0, int s, int lane) {
    const int sub = lane >> 3, piece = lane & 7;
    const int* idx = (const int*)(p.ws + OFF_IDX) + sub * 16;
    const unsigned char* tab = p.ws + (WHICH == 0 ? OFF_UTAB : OFF_VTAB) + (size_t)s * SLICE_BYTES;
    const unsigned pof = (unsigned)piece * 16u;
    const unsigned char* xbase = p.ws + OFF_US + s * 128 + piece * 16;
    const unsigned* wbase = (const unsigned*)(p.ws + OFF_GATE) + sub * 8;
    int4 ec[4], en[4];
    u32x4 wA[8], wB[8];
    u32x4 xr; u32x4 cwv[2]; float cws = 0.f;
#define PEER_RD(ev) (*(const u32x4*)(tab + (((unsigned)(ev) << 7) + pof)))
#define PEER_LD8(dst, ev0, ev1) do { if (MODE == 2) { dst[0] = (u32x4){(unsigned)ev0.x, (unsigned)ev0.y, 0x38383838u, 0x30303030u}; dst[1] = dst[0]; dst[2] = dst[0]; dst[3] = dst[0]; dst[4] = (u32x4){(unsigned)ev1.x, (unsigned)ev1.y, 0x38383838u, 0x30303030u}; dst[5] = dst[4]; dst[6] = dst[4]; dst[7] = dst[4]; break; } \
        dst[0] = PEER_RD(ev0.x); dst[1] = PEER_RD(ev0.y); dst[2] = PEER_RD(ev0.z); dst[3] = PEER_RD(ev0.w); dst[4] = PEER_RD(ev1.x); dst[5] = PEER_RD(ev1.y); dst[6] = PEER_RD(ev1.z); dst[7] = PEER_RD(ev1.w); } while (0)
#pragma unroll
    for (int q = 0; q < 4; ++q) ec[q] = *(const int4*)(idx + (size_t)t0 * 128 + 4 * q);
    PEER_LD8(wA, ec[0], ec[1]);
    if (WHICH == 0) { xr = *(const u32x4*)(xbase + (size_t)t0 * D); }
    else {
#pragma unroll
        for (int q = 0; q < 2; ++q) cwv[q] = *(const u32x4*)(wbase + (size_t)t0 * 128 + 4 * q);
        cws = __uint_as_float(wbase[(size_t)t0 * 128 + 64 - sub * 7]); }
#pragma unroll
    for (int q = 0; q < 4; ++q) en[q] = *(const int4*)(idx + (size_t)(t0 + 1) * 128 + 4 * q);
#pragma unroll 1
    for (int k = 0; k < PEER_CHUNK; ++k) {
        const int t = t0 + k;
        PEER_LD8(wB, ec[2], ec[3]);
        if (WHICH == 0) {
            const u32x4 xc = xr;
            i32x8v r0, r1;
#pragma unroll
            for (int i = 0; i < 8; ++i) r0[i] = MODE == 1 ? (int)(wA[i].x ^ wA[i].y ^ wA[i].z ^ wA[i].w ^ xc.x) : dot16_i8(wA[i], xc);
            if (k < PEER_CHUNK - 1) { PEER_LD8(wA, en[0], en[1]); xr = *(const u32x4*)(xbase + (size_t)(t + 1) * D); }
#pragma unroll
            for (int i = 0; i < 8; ++i) r1[i] = MODE == 1 ? (int)(wB[i].x ^ wB[i].y ^ wB[i].z ^ wB[i].w ^ xc.y) : dot16_i8(wB[i], xc);
            const int v0 = red8_piece(r0, lane), v1 = red8_piece(r1, lane);
            int* part = (int*)(p.ws + OFF_QKV) + ((size_t)s * T + t) * 128 + sub * 16 + piece;
            part[0] = v0; part[8] = v1;
        } else {
            float acc[16];
#pragma unroll
            for (int j = 0; j < 16; ++j) acc[j] = 0.f;
            const u32x4 c0 = cwv[0], c1 = cwv[1]; const float cwsum = cws;
            h2v cp[8];
            { unsigned u0 = c0.x, u1 = c0.y, u2 = c0.z, u3 = c0.w, u4 = c1.x, u5 = c1.y, u6 = c1.z, u7 = c1.w;
              cp[0] = *reinterpret_cast<h2v*>(&u0); cp[1] = *reinterpret_cast<h2v*>(&u1); cp[2] = *reinterpret_cast<h2v*>(&u2); cp[3] = *reinterpret_cast<h2v*>(&u3);
              cp[4] = *reinterpret_cast<h2v*>(&u4); cp[5] = *reinterpret_cast<h2v*>(&u5); cp[6] = *reinterpret_cast<h2v*>(&u6); cp[7] = *reinterpret_cast<h2v*>(&u7); }
            axpy16x2_u8(wA[0], wA[1], cp[0], acc); axpy16x2_u8(wA[2], wA[3], cp[1], acc); axpy16x2_u8(wA[4], wA[5], cp[2], acc); axpy16x2_u8(wA[6], wA[7], cp[3], acc);
            if (k < PEER_CHUNK - 1) { PEER_LD8(wA, en[0], en[1]);
#pragma unroll
                for (int q = 0; q < 2; ++q) cwv[q] = *(const u32x4*)(wbase + (size_t)(t + 1) * 128 + 4 * q);
                cws = __uint_as_float(wbase[(size_t)(t + 1) * 128 + 64 - sub * 7]); }
            axpy16x2_u8(wB[0], wB[1], cp[4], acc); axpy16x2_u8(wB[2], wB[3], cp[5], acc); axpy16x2_u8(wB[4], wB[5], cp[6], acc); axpy16x2_u8(wB[6], wB[7], cp[7], acc);
            f32x16v a16;
#pragma unroll
            for (int j = 0; j < 16; ++j) a16[j] = fmaf(acc[j], 65536.0f, -0.5f * cwsum);
            const bool b3 = (lane & 8) != 0;
            f32x8v q8; f32x4 q4; f32x2v q2;
#pragma unroll
            for (int j = 0; j < 8; ++j) { const auto sw = __builtin_amdgcn_permlane32_swap(__float_as_uint(a16[j]), __float_as_uint(a16[j + 8]), false, false); q8[j] = __uint_as_float(sw[0]) + __uint_as_float(sw[1]); }
#pragma unroll
            for (int j = 0; j < 4; ++j) { const auto sw = __builtin_amdgcn_permlane16_swap(__float_as_uint(q8[j]), __float_as_uint(q8[j + 4]), false, false); q4[j] = __uint_as_float(sw[0]) + __uint_as_float(sw[1]); }
#pragma unroll
            for (int j = 0; j < 2; ++j) { const float lo = q4[j], hi = q4[j + 2]; const float kp = b3 ? hi : lo, sn = b3 ? lo : hi; q2[j] = kp + __shfl_xor(sn, 8); }
            bf16_t* po = (bf16_t*)(p.ws + OFF_A) + (size_t)t * D + s * 128 + piece * 16 + 2 * sub;
            *(unsigned*)po = cvt_pk(q2[0], q2[1]);
        }
#pragma unroll
        for (int q = 0; q < 4; ++q) ec[q] = en[q];
        if (k < PEER_CHUNK - 2) {
#pragma unroll
            for (int q = 0; q < 4; ++q) en[q] = *(const int4*)(idx + (size_t)(t + 2) * 128 + 4 * q); }
    }
#undef PEER_LD8
#undef PEER_RD
}
template <int WHICH, int MODE = 0, int QSET = WHICH> __device__ __forceinline__ void phase_peer_sliced(const Params& p, unsigned xcc) {
    unsigned* qh = (unsigned*)(p.ws + OFF_CTL + OFF_QUEUE) + QSET * 16 * 64;
    const int lane = threadIdx.x & 63;
    for (int rnd = 0; rnd < 16; ++rnd) {
        const int s = (int)((xcc + 8u * (unsigned)(rnd & 1) + (unsigned)(rnd >> 1)) & 15u);
        unsigned c = 0; if (lane == 0) c = atomicAdd(qh + s * 64, 1u);
        c = __builtin_amdgcn_readfirstlane(c);
        while (c < (unsigned)(T / PEER_CHUNK)) {
            unsigned cn = 0; if (lane == 0) cn = atomicAdd(qh + s * 64, 1u);
            peer_chunk<WHICH, MODE>(p, (int)c * PEER_CHUNK, s, lane);
            c = __builtin_amdgcn_readfirstlane(cn);
        }
    }
}
__device__ __forceinline__ void phase_peer_w(const Params& p) {
    const int lane = threadIdx.x & 63, gw = blockIdx.x * NWV + __builtin_amdgcn_readfirstlane(threadIdx.x >> 6), nw = gridDim.x * NWV;
    const int* part = (const int*)(p.ws + OFF_QKV); const int* idx = (const int*)(p.ws + OFF_IDX); float* gate = (float*)(p.ws + OFF_GATE);
    const float* uinv = (const float*)(p.ws + OFF_UTAB + TAB8_BYTES); const float* vinv = (const float*)(p.ws + OFF_VTAB + TAB8_BYTES); const float* xs = (const float*)(p.ws + OFF_SGUO);
    int2 pv[16], e = make_int2(0, 0); float2 g = make_float2(0.f, 0.f); float xsc = 0.f, ui0 = 0.f, ui1 = 0.f, vi0 = 0.f, vi1 = 0.f;
#define PW_LOAD(tt) do { _Pragma("unroll") for (int s = 0; s < 16; ++s) pv[s] = *(const int2*)(part + ((size_t)s * T + (tt)) * 128 + 2 * lane); \
        e = *(const int2*)(idx + (size_t)(tt) * 128 + 2 * lane); g = *(const float2*)(gate + (size_t)(tt) * 128 + 2 * lane); xsc = xs[(tt)]; \
        ui0 = uinv[e.x]; ui1 = uinv[e.y]; vi0 = vinv[e.x]; vi1 = vinv[e.y]; } while (0)
    if (gw < T) PW_LOAD(gw);
    for (int t = gw; t < T; t += nw) {
        int a0 = 0, a1 = 0;
#pragma unroll
        for (int s = 0; s < 16; ++s) { a0 += pv[s].x; a1 += pv[s].y; }
        const float w0 = g.x * gelu_erf((float)a0 * (xsc * ui0)) * vi0, w1 = g.y * gelu_erf((float)a1 * (xsc * ui1)) * vi1;
        if (t + nw < T) PW_LOAD(t + nw);
        h2v hp; hp.x = (_Float16)(w0 * 256.f); hp.y = (_Float16)(w1 * 256.f);
        float sm = (float)hp.x + (float)hp.y;
        sm += __shfl_xor(sm, 1); sm += __shfl_xor(sm, 2); sm += __shfl_xor(sm, 4);
        ((unsigned*)gate)[(size_t)t * 128 + lane] = *reinterpret_cast<unsigned*>(&hp);
        if ((lane & 7) == 0) gate[(size_t)t * 128 + 64 + (lane >> 3)] = sm;
    }
#undef PW_LOAD
}
__device__ __forceinline__ void phase_peer_final(const Params& p) {
    const int lane = threadIdx.x & 63, gw = blockIdx.x * NWV + __builtin_amdgcn_readfirstlane(threadIdx.x >> 6), nw = gridDim.x * NWV;
    const bf16_t* peer = (const bf16_t*)(p.ws + OFF_A); const bf16_t* hb = (const bf16_t*)(p.ws + OFF_O12);
    const int wpb = nw >> 2, b = gw / wpb, r0 = gw - b * wpb;
    if (b >= NB) return;
    float gt[32], gf[32];
#pragma unroll
    for (int i = 0; i < 4; ++i) { const int col = i * 512 + lane * 8; const float4 g0 = mod4(p, b, 5, col), g1 = mod4(p, b, 5, col + 4), f0 = *(const float4*)(p.g_final + col), f1 = *(const float4*)(p.g_final + col + 4);
        gt[i * 8 + 0] = g0.x; gt[i * 8 + 1] = g0.y; gt[i * 8 + 2] = g0.z; gt[i * 8 + 3] = g0.w; gt[i * 8 + 4] = g1.x; gt[i * 8 + 5] = g1.y; gt[i * 8 + 6] = g1.z; gt[i * 8 + 7] = g1.w;
        gf[i * 8 + 0] = f0.x; gf[i * 8 + 1] = f0.y; gf[i * 8 + 2] = f0.z; gf[i * 8 + 3] = f0.w; gf[i * 8 + 4] = f1.x; gf[i * 8 + 5] = f1.y; gf[i * 8 + 6] = f1.z; gf[i * 8 + 7] = f1.w; }
    u32x4 pw[4], hw[4];
#define PF_LOAD(tt) do { _Pragma("unroll") for (int i = 0; i < 4; ++i) { pw[i] = *(const u32x4*)(peer + (size_t)(tt) * D + i * 512 + lane * 8); hw[i] = *(const u32x4*)(hb + (size_t)(tt) * D + i * 512 + lane * 8); } } while (0)
    if (r0 < S) PF_LOAD(b * S + r0);
    for (int r = r0; r < S; r += wpb) {
        const int t = b * S + r; float* orow = p.out + (size_t)t * D; float v[32]; float ss = 0.f;
#pragma unroll
        for (int i = 0; i < 4; ++i) {
            v[i * 8 + 0] = bflo(hw[i].x) + gt[i * 8 + 0] * bflo(pw[i].x); v[i * 8 + 1] = bfhi(hw[i].x) + gt[i * 8 + 1] * bfhi(pw[i].x); v[i * 8 + 2] = bflo(hw[i].y) + gt[i * 8 + 2] * bflo(pw[i].y); v[i * 8 + 3] = bfhi(hw[i].y) + gt[i * 8 + 3] * bfhi(pw[i].y);
            v[i * 8 + 4] = bflo(hw[i].z) + gt[i * 8 + 4] * bflo(pw[i].z); v[i * 8 + 5] = bfhi(hw[i].z) + gt[i * 8 + 5] * bfhi(pw[i].z); v[i * 8 + 6] = bflo(hw[i].w) + gt[i * 8 + 6] * bflo(pw[i].w); v[i * 8 + 7] = bfhi(hw[i].w) + gt[i * 8 + 7] * bfhi(pw[i].w);
#pragma unroll
            for (int j = 0; j < 8; ++j) ss += v[i * 8 + j] * v[i * 8 + j]; }
        if (r + wpb < S) PF_LOAD(t + wpb);
        ss = wave_sum(ss); const float rs = rsqrtf(ss * (1.0f / D) + 1e-6f);
#pragma unroll
        for (int i = 0; i < 4; ++i) { const int col = i * 512 + lane * 8;
            *(float4*)(orow + col) = make_float4(v[i * 8 + 0] * rs * gf[i * 8 + 0], v[i * 8 + 1] * rs * gf[i * 8 + 1], v[i * 8 + 2] * rs * gf[i * 8 + 2], v[i * 8 + 3] * rs * gf[i * 8 + 3]);
            *(float4*)(orow + col + 4) = make_float4(v[i * 8 + 4] * rs * gf[i * 8 + 4], v[i * 8 + 5] * rs * gf[i * 8 + 5], v[i * 8 + 6] * rs * gf[i * 8 + 6], v[i * 8 + 7] * rs * gf[i * 8 + 7]); }
    }
#undef PF_LOAD
}

constexpr int LDS_BYTES = 147456;

#define XB_TMO      128
#define XB_XCNT(j)  (256  + 64 * (j))
#define XB_XSUB(j)  (1280 + 64 * (j))
#define XB_XGEN(j)  (2304 + 64 * (j))
#define XB_TOP      3328
#define XB_TOPGEN   3392
#define XCD_BAR_WORDS 3456
#define XB_SPIN_CAP (1u << 18)

__device__ __forceinline__ unsigned xb_ld(unsigned* p)              { return __hip_atomic_load(p, __ATOMIC_RELAXED, __HIP_MEMORY_SCOPE_AGENT); }
__device__ __forceinline__ unsigned xb_add(unsigned* p, unsigned v) { return __hip_atomic_fetch_add(p, v, __ATOMIC_RELAXED, __HIP_MEMORY_SCOPE_AGENT); }
__device__ __forceinline__ unsigned xb_xcc_id() { return (unsigned)__builtin_amdgcn_s_getreg((3 << 11) | 20) & 0xFu; }
#define XB_SPIN(cond, bar) do { unsigned _sp = 0; while (cond) { __builtin_amdgcn_s_sleep(1); \
    if ((++_sp & 255u) == 0u) { if (xb_ld(&(bar)[XB_TMO])) break; if (_sp > XB_SPIN_CAP) { atomicAdd(&(bar)[XB_TMO], 1u); break; } } } } while (0)

struct XcdBarrier {
    unsigned* bar; unsigned x;
    volatile LAS unsigned* st;
};

__device__ __forceinline__ XcdBarrier xcd_barrier_post(unsigned* bar, volatile LAS unsigned* st) {
    XcdBarrier b; b.bar = bar; b.x = xb_xcc_id(); b.st = st;
    if (threadIdx.x == 0) (void)xb_add(&bar[XB_XCNT(b.x)], 1u);
    return b;
}
__device__ __forceinline__ void xcd_barrier_complete(unsigned* bar, unsigned x, unsigned& nloc, unsigned& nx) {
    const unsigned G = gridDim.x * gridDim.y * gridDim.z;
    unsigned sum, cnt, mine, sp = 0u;
    for (;;) {
        sum = 0u; cnt = 0u; mine = 0u;
#pragma unroll
        for (unsigned j = 0; j < 16; ++j) { const unsigned c = xb_ld(&bar[XB_XCNT(j)]); sum += c; cnt += (c > 0u) ? 1u : 0u; mine = (j == x) ? c : mine; }
        if (sum == G) break;
        __builtin_amdgcn_s_sleep(1);
        if ((++sp & 255u) == 0u) { if (xb_ld(&bar[XB_TMO])) break; if (sp > XB_SPIN_CAP) { atomicAdd(&bar[XB_TMO], 1u); break; } }
    }
    nloc = mine > 0u ? mine : 1u; nx = cnt > 0u ? cnt : 1u;
}

__device__ __forceinline__ void xcd_barrier(const XcdBarrier& b) {
    asm volatile("s_waitcnt vmcnt(0)" ::: "memory");
    __syncthreads();
    if (threadIdx.x == 0) {
        unsigned* bar = b.bar;
        __builtin_amdgcn_s_waitcnt(0);
        unsigned nloc = b.st[0], nx = b.st[1];
        if (nloc == 0u) { xcd_barrier_complete(bar, b.x, nloc, nx); b.st[0] = nloc; b.st[1] = nx; }
        const unsigned old = xb_add(&bar[XB_XSUB(b.x)], 1u);
        const unsigned gen = old / nloc;
        if (old + 1u == (gen + 1u) * nloc) {
            __builtin_amdgcn_fence(__ATOMIC_RELEASE, "agent");
            asm volatile("s_waitcnt vmcnt(0)" ::: "memory");
            const unsigned og = xb_add(&bar[XB_TOP], 1u);
            const unsigned tg = og / nx;
            if (og + 1u == (tg + 1u) * nx) xb_add(&bar[XB_TOPGEN], 1u);
            else XB_SPIN(xb_ld(&bar[XB_TOPGEN]) == tg, bar);
            __builtin_amdgcn_fence(__ATOMIC_ACQUIRE, "agent");
            xb_add(&bar[XB_XGEN(b.x)], 1u);
            asm volatile("s_waitcnt vmcnt(0)" ::: "memory");
        } else {
            XB_SPIN(xb_ld(&bar[XB_XGEN(b.x)]) == gen, bar);
            __builtin_amdgcn_fence(__ATOMIC_ACQUIRE, "agent");
            asm volatile("s_waitcnt vmcnt(0)" ::: "memory");
        }
    }
    __syncthreads();
}

#ifndef PHASE_MASK
#define PHASE_MASK 0x3FF
#endif
#ifndef PROBE_DUP
#define PROBE_DUP 0
#endif
#ifndef TS_SEL
#define TS_SEL -1
#endif
#define TSTAMP(k) do { if (TS_SEL >= 0) { const unsigned long long _t = __builtin_amdgcn_s_memrealtime(); if (TS_SEL + 1 == (k)) { const unsigned long long _d = _t - ts_a; while (__builtin_amdgcn_s_memrealtime() - _t < _d) __builtin_amdgcn_s_sleep(8); } ts_a = __builtin_amdgcn_s_memrealtime(); } } while (0)
#define GBAR() xcd_barrier(xbar)
#define RUNPH(bit, call, dupcall) do { if (PHASE_MASK & (bit)) { if (PROBE_DUP & (bit)) { dupcall; GBAR(); } call; GBAR(); } } while (0)
__global__ void __launch_bounds__(NTHR, 2) k_mega(Params p) {
    extern __shared__ __attribute__((aligned(16))) unsigned char lds[];
    cg::grid_group grid = cg::this_grid();
    volatile LAS unsigned* xst = (volatile LAS unsigned*)((LAS unsigned char*)lds + LDS_BYTES);
    if (threadIdx.x < 4) xst[threadIdx.x] = 0u;
    __syncthreads();
    XcdBarrier xbar = xcd_barrier_post((unsigned*)(p.ws + OFF_CTL), xst);
    unsigned long long ts_a = 0; TSTAMP(0);
    if (p.ws == nullptr) grid.sync();
    if (PHASE_MASK & 1) { if (PROBE_DUP & 1) { phase_conv(p, lds, true); GBAR(); } phase_conv(p, lds); GBAR(); }
    TSTAMP(1);
    RUNPH(2, (phase_norm_mod<true, false, false>(p, p.x, p.g_norm1, 0, 1, nullptr, p.ws + OFF_A, (float*)(p.ws + OFF_SCL) + SCL_HS), phase_quant_weights(p, lds)), (phase_norm_mod<true, false, false>(p, p.x, p.g_norm1, 0, 1, nullptr, p.ws + OFF_A, (float*)(p.ws + OFF_SCL) + SCL_HS)));
    TSTAMP(2);
    RUNPH(4, phase_gemm1(p, lds), phase_gemm1(p, lds));
    TSTAMP(3);
    if (PROBE_DUP & 1024) { phase_sgu(p, lds); GBAR(); }
    RUNPH(8, (phase_attn(p, lds), phase_sgu(p, lds)), phase_attn(p, lds));
    TSTAMP(4);
    RUNPH(16, phase_combine(p), phase_combine(p));
    TSTAMP(5);
    RUNPH(32, phase_gemm2(p, lds), phase_gemm2(p, lds));
    TSTAMP(6);
    RUNPH(64, (phase_norm_mod<true, true, false>(p, p.ws + OFF_O12, p.g_norm2, 3, 4, nullptr, p.ws + OFF_US, (float*)(p.ws + OFF_SGUO))), (phase_norm_mod<true, true, false>(p, p.ws + OFF_O12, p.g_norm2, 3, 4, nullptr, p.ws + OFF_US, (float*)(p.ws + OFF_SGUO))));
    TSTAMP(7);
    RUNPH(128, phase_gemm3(p, lds), phase_gemm3(p, lds));
    TSTAMP(8);
    RUNPH(256, phase_topk(p, lds), phase_topk(p, lds));
    TSTAMP(9);
    if (PHASE_MASK & 512) {
        if (PROBE_DUP == 2048) { phase_peer_sliced<0, 0, 2>(p, xbar.x); GBAR(); }
        if (PROBE_DUP == 4096) { phase_peer_sliced<0, 1, 2>(p, xbar.x); GBAR(); }
        if (PROBE_DUP == 8192) { phase_peer_sliced<0, 2, 2>(p, xbar.x); GBAR(); }
        phase_peer_sliced<0>(p, xbar.x); GBAR();
        TSTAMP(10);
        phase_peer_w(p); GBAR();
        TSTAMP(11);
        if (PROBE_DUP == 16384) { phase_peer_sliced<1, 0, 3>(p, xbar.x); GBAR(); }
        phase_peer_sliced<1>(p, xbar.x); GBAR();
        TSTAMP(12);
        phase_peer_final(p);
        TSTAMP(13);
    }
}

#ifndef MEGA
#define MEGA 1
#endif
extern "C" void kernel_launch(void* const* d_in, const int* in_sizes, int n_in, void* d_out, int out_size, void* d_ws, size_t ws_size, hipStream_t stream) {
    if (n_in != 20 || out_size != T * D || ws_size < WS_END) { fprintf(stderr, "kernel_launch: unexpected problem (n_in %d out %d ws %zu, need %zu)\n", n_in, out_size, ws_size, (size_t)WS_END); return; }
    Params p{};
    p.x = (const float*)d_in[0]; p.c = (const float*)d_in[1]; p.pos = (const int*)d_in[2]; p.w_ada = (const float*)d_in[3]; p.b_ada = (const float*)d_in[4];
    p.g_norm1 = (const float*)d_in[5]; p.w_in = (const float*)d_in[6]; p.g_attn_out = (const float*)d_in[7]; p.g_sgu_out = (const float*)d_in[8];
    p.sgu_w = (const float*)d_in[9]; p.sgu_b = (const float*)d_in[10]; p.sgu_ln_g = (const float*)d_in[11]; p.sgu_ln_b = (const float*)d_in[12];
    p.w_out = (const float*)d_in[13]; p.g_norm2 = (const float*)d_in[14]; p.peer_w_q = (const float*)d_in[15]; p.peer_sub_keys = (const float*)d_in[16];
    p.peer_u = (const float*)d_in[17]; p.peer_v = (const float*)d_in[18]; p.g_final = (const float*)d_in[19];
    p.out = (float*)d_out; p.ws = (unsigned char*)d_ws;
    (void)hipMemsetAsync((char*)d_ws + OFF_CTL, 0, OFF_SCL - OFF_CTL, stream);
#if MEGA
    static int grid_blocks = 0;
    if (!grid_blocks) {
        int dev = 0, cus = 0, per_cu = 0;
        (void)hipGetDevice(&dev); (void)hipDeviceGetAttribute(&cus, hipDeviceAttributeMultiprocessorCount, dev);
        (void)hipFuncSetAttribute((const void*)k_mega, hipFuncAttributeMaxDynamicSharedMemorySize, LDS_BYTES + 16);
        (void)hipOccupancyMaxActiveBlocksPerMultiprocessor(&per_cu, (const void*)k_mega, NTHR, LDS_BYTES + 16);
        if (per_cu < 1) { fprintf(stderr, "kernel_launch: occupancy query says %d blocks per CU\n", per_cu); per_cu = 1; }
        if (per_cu > 1) per_cu = 1;
        grid_blocks = cus * per_cu;
    }
    void* args[] = {(void*)&p};
    hipError_t e = hipLaunchCooperativeKernel((const void*)k_mega, dim3(grid_blocks), dim3(NTHR), args, LDS_BYTES + 16, stream);
    if (e != hipSuccess) fprintf(stderr, "cooperative launch failed: %s (grid %d)\n", hipGetErrorString(e), grid_blocks);
#endif
}
```

```cpp
#include <hip/hip_runtime.h>
#include <hip/hip_cooperative_groups.h>
#include <cstdio>
#include <cstdint>
namespace cg = cooperative_groups;
#define LAS_ __attribute__((address_space(3)))
#ifndef CONV_TS
#define CONV_TS -1
#endif
#define CSTAMP(k) do { if (CONV_TS >= 0) { __syncthreads(); const unsigned long long _t = __builtin_amdgcn_s_memrealtime(); if (CONV_TS + 1 == (k)) { const unsigned long long _d = _t - cts; while (__builtin_amdgcn_s_memrealtime() - _t < _d) __builtin_amdgcn_s_sleep(8); } cts = __builtin_amdgcn_s_memrealtime(); } } while (0)

constexpr int D = 2048, NB = 4, S = 4096, T = NB * S;
constexpr int E = 128, HA = 12, HS = 4, DA = 1536, DS = 512, DIN = 5632;
constexpr int PH = 8, PK = 16, NEXP = 16384;
constexpr int NTHR = 512, NWV = 8;

typedef unsigned short bf16_t;
typedef unsigned u32x4 __attribute__((ext_vector_type(4)));
typedef unsigned u32x2 __attribute__((ext_vector_type(2)));
typedef float f32x4 __attribute__((ext_vector_type(4)));

__device__ __forceinline__ bf16_t f2bf(float f) { unsigned u = __float_as_uint(f); u += 0x7FFFu + ((u >> 16) & 1u); return (bf16_t)(u >> 16); }
__device__ __forceinline__ float bf2f(bf16_t b) { return __uint_as_float(((unsigned)b) << 16); }
__device__ __forceinline__ unsigned pack2(float lo, float hi) { return (unsigned)f2bf(lo) | ((unsigned)f2bf(hi) << 16); }
__device__ __forceinline__ float bflo(unsigned w) { return __uint_as_float(w << 16); }
__device__ __forceinline__ float bfhi(unsigned w) { return __uint_as_float(w & 0xffff0000u); }
__device__ __forceinline__ float wave_sum(float v) {
#pragma unroll
    for (int o = 32; o >= 1; o >>= 1) v += __shfl_xor(v, o);
    return v; }
__device__ __forceinline__ float wave_max(float v) {
#pragma unroll
    for (int o = 32; o >= 1; o >>= 1) v = fmaxf(v, __shfl_xor(v, o));
    return v; }
__device__ __forceinline__ int wave_min_i(int v) {
#pragma unroll
    for (int o = 32; o >= 1; o >>= 1) v = min(v, __shfl_xor(v, o));
    return v; }
__device__ __forceinline__ float gelu_erf(float v) { return 0.5f * v * (1.0f + erff(v * 0.70710678118654752f)); }

constexpr size_t OFF_CTL  = 0;
constexpr size_t OFF_MOD  = 65536;
constexpr size_t OFF_SCL  = OFF_MOD + 393216;
constexpr int SCL_HS = 0, SCL_MS = T, SCL_WS = 2 * T, SCL_PM = 2 * T + 9728, WS_IN = 0, WS_OUT = 5632, WS_Q = 7680, NWCOL = 9728;
constexpr size_t OFF_SGUW = OFF_SCL + 1048576;
constexpr size_t OFF_SUBK = OFF_SGUW + 131072;
constexpr size_t OFF_LSE  = OFF_SUBK + 524288;
constexpr size_t OFF_IDX  = OFF_LSE + (size_t)3 * T * 12 * 4;
constexpr size_t OFF_GATE = OFF_IDX + (size_t)T * 128 * 4;
constexpr size_t OFF_WIN  = OFF_GATE + (size_t)T * 128 * 4;
constexpr size_t OFF_WOUT = OFF_WIN + (size_t)DIN * D * 2;
constexpr size_t OFF_WQ   = OFF_WOUT + (size_t)D * D * 2;
constexpr size_t OFF_UTAB = OFF_WQ + (size_t)D * D * 2;
constexpr size_t TAB8_BYTES = (size_t)NEXP * D;
constexpr size_t SLICE_BYTES = (size_t)NEXP * 128;
constexpr size_t OFF_QUEUE = 32768;
constexpr size_t OFF_VTAB = OFF_UTAB + (size_t)NEXP * D * 2;
constexpr size_t OFF_A    = OFF_VTAB + (size_t)NEXP * D * 2;
constexpr size_t OFF_QKV  = OFF_A + (size_t)T * D * 2;
constexpr size_t QKV_ONE  = (size_t)T * DA * 2;
constexpr size_t OFF_US   = OFF_QKV + 3 * QKV_ONE;
constexpr size_t OFF_VS   = OFF_US + (size_t)T * DS * 2;
constexpr size_t OFF_SGUO = OFF_VS + (size_t)T * DS * 2;
constexpr size_t OFF_O12  = OFF_SGUO + (size_t)T * DS * 2;
constexpr size_t WS_END   = OFF_O12 + 2 * QKV_ONE;

struct Params {
    const float* x; const float* c; const int* pos; const float* w_ada; const float* b_ada; const float* g_norm1; const float* w_in;
    const float* g_attn_out; const float* g_sgu_out; const float* sgu_w; const float* sgu_b; const float* sgu_ln_g; const float* sgu_ln_b;
    const float* w_out; const float* g_norm2; const float* peer_w_q; const float* peer_sub_keys; const float* peer_u; const float* peer_v;
    const float* g_final; float* out; unsigned char* ws;
};
__device__ __forceinline__ float fx2f(long long v) { return (float)(int)(v >> 32) + (float)(unsigned)v * 2.3283064365386963e-10f; }
__device__ __forceinline__ float mod1(const Params& p, int b, int i, int col) { return fx2f(((const long long*)(p.ws + OFF_MOD))[b * 12288 + i * D + col]); }
__device__ __forceinline__ float4 mod4q(const long long* mp) { return make_float4(fx2f(mp[0]), fx2f(mp[1]), fx2f(mp[2]), fx2f(mp[3])); }
__device__ __forceinline__ float4 mod4(const Params& p, int b, int i, int col) { return mod4q((const long long*)(p.ws + OFF_MOD) + b * 12288 + i * D + col); }
__device__ __forceinline__ bf16_t* P_opat(const Params& p, int pat) { return (bf16_t*)(pat == 0 ? p.ws + OFF_A : p.ws + OFF_O12 + (size_t)(pat - 1) * QKV_ONE); }

namespace pg8 {
#define PG8_LAS __attribute__((address_space(3)))
typedef unsigned short bf16_t;
typedef short bf16x8 __attribute__((ext_vector_type(8)));
typedef float f32x4 __attribute__((ext_vector_type(4)));
typedef unsigned u32x4 __attribute__((ext_vector_type(4)));
constexpr int BM = 256, BK = 64, HALF = 128, HTB = HALF * BK * 2  , STAGE_BYTES = 8 * HTB, NXCD = 8, WGM = 8;

__host__ __device__ __forceinline__ int lds_byte(int r, int c) { const int st = (r >> 4) * 2 + (c >> 5), rr = r & 15, cc = c & 31, ob = rr * 64 + cc * 2; return st * 1024 + (ob ^ (((ob >> 9) & 1) << 5)); }
__host__ __device__ __forceinline__ void stage_rc(int b, int& R, int& C) { const int st = b / 1024, sb = b % 1024, swz = sb ^ (((sb >> 9) & 1) << 5); R = (st >> 1) * 16 + swz / 64; C = (st & 1) * 32 + (swz % 64) / 2; }
__host__ __device__ __forceinline__ int perm32(int rho) { const int n = rho >> 4, i = rho & 15; return 8 * (i >> 2) + 4 * n + (i & 3); }

struct Unit { int pm, pn; };
struct Gemm { const bf16_t* A; const bf16_t* Bt; int M, N, K; };

struct StaticOrder {
    int nM, nN, nwg, G, c;
    __host__ __device__ void init(int M, int N, int G_, int c_) { nM = M / BM; nN = N / BM; nwg = nM * nN; G = G_; c = c_; }
    __host__ __device__ bool next(int i, Unit& u) const {
        const long L = (long)i * G + c; if (L >= nwg) return false;
        int wgid = (int)L; { const int q = nwg / NXCD, r = nwg % NXCD, xcd = wgid % NXCD, off = wgid / NXCD; wgid = (xcd < r ? xcd * (q + 1) : r * (q + 1) + (xcd - r) * q) + off; }
        const int nig = WGM * nN, gid = wgid / nig, fm = gid * WGM, gsz = (nM - fm) < WGM ? (nM - fm) : WGM;
        u.pm = fm + ((wgid % nig) % gsz); u.pn = (wgid % nig) / gsz; return true;
    }
    __device__ __forceinline__ void a_ready(const Unit&) const {}
    __device__ __forceinline__ void done(const Unit&) const {}
};

__device__ __forceinline__ unsigned cvt_pk_bf16(float lo, float hi) { unsigned r; asm volatile("v_cvt_pk_bf16_f32 %0, %1, %2" : "=v"(r) : "v"(lo), "v"(hi)); return r; }
typedef float f32x2 __attribute__((ext_vector_type(2)));
__device__ __forceinline__ f32x2 gelu_pk(f32x2 v) {
    const f32x2 av = __builtin_elementwise_abs(v), d = av * 0.2316418882f + 1.0f;
    f32x2 t; t.x = __builtin_amdgcn_rcpf(d.x); t.y = __builtin_amdgcn_rcpf(d.y);
    f32x2 q = t * 0.5307027145f + (-0.7265760135f); q = q * t + 0.7107068705f; q = q * t + (-0.142248368f); q = q * t + 0.127414796f; q = q * t;
    const f32x2 s = (v * v) * (-0.72134752044f);
    f32x2 e; e.x = __builtin_amdgcn_exp2f(s.x); e.y = __builtin_amdgcn_exp2f(s.y);
    const f32x2 m = v * (q * e), r = v - m;
    f32x2 o; o.x = v.x < 0.f ? m.x : r.x; o.y = v.y < 0.f ? m.y : r.y; return o;
}

typedef int i32x4 __attribute__((ext_vector_type(4)));
__device__ __forceinline__ f32x4 mma1(bf16x8 b, bf16x8 a, f32x4 c) { return __builtin_amdgcn_mfma_f32_16x16x32_bf16(b, a, c, 0, 0, 0); }
__device__ __forceinline__ i32x4 mma1(bf16x8 b, bf16x8 a, i32x4 c) { return __builtin_amdgcn_mfma_i32_16x16x64_i8(__builtin_bit_cast(i32x4, b), __builtin_bit_cast(i32x4, a), c, 0, 0, 0); }
template <class Epi, class Sched, bool ALIGN_EPI = false, bool SP2 = false>
__device__ __forceinline__ void gemm_phase(PG8_LAS unsigned char* lds, const Gemm g, const Sched& S, const Epi& E) {
    int tid = threadIdx.x; asm volatile("" : "+v"(tid));
    const int wid = __builtin_amdgcn_readfirstlane(tid >> 6), lane = tid & 63, wr = wid >> 2, wc = wid & 3, fr = lane & 15, fq = lane >> 4;
    const int K = g.K, nt = K / BK;
    unsigned voffA[2], voffB[2];
#pragma unroll
    for (int i = 0; i < 2; ++i) { int R, C; stage_rc(tid * 16 + i * 8192, R, C); const int Rb = Epi::PERM ? ((R & ~31) + perm32(R & 31)) : R;
        voffA[i] = (unsigned)(R * K + C) * 2u; voffB[i] = (unsigned)(Rb * K + C) * 2u; }
    const size_t kstep = (size_t)(BK * 2);
    const size_t hstep = (size_t)HALF * K * 2;
    const size_t tstep = 2 * hstep;
    const unsigned ldsw = (unsigned)wid * 1024u;
    const int aoff = lds_byte(wr * 64 + fr, fq * 8), boff = lds_byte(wc * 32 + fr, fq * 8);
#define PG8_SA(b, h) (((b) * 2 + (h)) * HTB)
#define PG8_SB(b, h) ((4 + (b) * 2 + (h)) * HTB)
#define PG8_STAGE(bufoff, gbase, voff) do { _Pragma("unroll") for (int _i = 0; _i < 2; ++_i) \
        __builtin_amdgcn_global_load_lds((const unsigned*)((const char*)(gbase) + (voff)[_i]), (PG8_LAS unsigned*)(lds + (bufoff) + ldsw + _i * 8192), 16, 0, 0); } while (0)
#define PG8_LDA(dst, b, h) do { _Pragma("unroll") for (int m = 0; m < 4; ++m) _Pragma("unroll") for (int k = 0; k < 2; ++k) dst[m][k] = *(const PG8_LAS bf16x8*)(lds + PG8_SA(b, h) + aoff + m * 2048 + k * 1024); } while (0)
#define PG8_LDB(dst, b, h) do { _Pragma("unroll") for (int n = 0; n < 2; ++n) _Pragma("unroll") for (int k = 0; k < 2; ++k) dst[n][k] = *(const PG8_LAS bf16x8*)(lds + PG8_SB(b, h) + boff + n * 2048 + k * 1024); } while (0)
#define PG8_MMA(ai, bj, At, Bt) do { __builtin_amdgcn_s_setprio(1); _Pragma("unroll") for (int m = 0; m < 4; ++m) _Pragma("unroll") for (int n = 0; n < 2; ++n) _Pragma("unroll") for (int k = 0; k < 2; ++k) \
        acc[ai][bj][m][n] = mma1(Bt[n][k], At[m][k], acc[ai][bj][m][n]); __builtin_amdgcn_s_setprio(0); } while (0)
#define PG8_WAIT_V(n) asm volatile("s_waitcnt vmcnt(" #n ")" ::: "memory")
#define PG8_WAIT_L(n) asm volatile("s_waitcnt lgkmcnt(" #n ")" ::: "memory")
#define PG8_BAR __builtin_amdgcn_s_barrier()
#define PG8_SCHED __builtin_amdgcn_sched_barrier(0)
    Unit cur, nxt; int ui = 0;
    if (!S.next(0, cur)) return;
    typedef typename Epi::AccT AccT;
    AccT acc[2][2][4][2];
#pragma unroll
    for (int a = 0; a < 2; ++a)
#pragma unroll
        for (int b = 0; b < 2; ++b)
#pragma unroll
            for (int m = 0; m < 4; ++m)
#pragma unroll
                for (int n = 0; n < 2; ++n) acc[a][b][m][n] = AccT{};
    bf16x8 At[4][2], B0[2][2], B1[2][2];
    const char* cA = (const char*)g.A + (size_t)cur.pm * tstep; const char* cB = (const char*)g.Bt + (size_t)cur.pn * tstep;
    S.a_ready(cur);
    if constexpr (SP2) {
        PG8_STAGE(PG8_SB(0, 0), cB, voffB); PG8_STAGE(PG8_SB(0, 1), cB + hstep, voffB); PG8_STAGE(PG8_SA(0, 0), cA, voffA); PG8_STAGE(PG8_SA(0, 1), cA + hstep, voffA);
        if (wr == 1) PG8_BAR;
        PG8_WAIT_V(2); PG8_BAR;
        PG8_STAGE(PG8_SB(1, 0), cB + kstep, voffB); PG8_STAGE(PG8_SA(1, 0), cA + kstep, voffA); PG8_STAGE(PG8_SB(1, 1), cB + hstep + kstep, voffB);
        PG8_WAIT_V(6); PG8_BAR;
    } else {
        PG8_STAGE(PG8_SB(0, 0), cB, voffB); PG8_STAGE(PG8_SA(0, 0), cA, voffA); PG8_STAGE(PG8_SB(0, 1), cB + hstep, voffB); PG8_STAGE(PG8_SA(0, 1), cA + hstep, voffA);
        if (wr == 1) PG8_BAR;
        PG8_WAIT_V(4); PG8_BAR;
        PG8_STAGE(PG8_SB(1, 0), cB + kstep, voffB); PG8_STAGE(PG8_SA(1, 0), cA + kstep, voffA); PG8_STAGE(PG8_SB(1, 1), cB + hstep + kstep, voffB);
        PG8_WAIT_V(6); PG8_BAR;
    }
    for (;;) {
        const bool has_next = S.next(ui + 1, nxt);
        const char* nA = has_next ? (const char*)g.A + (size_t)nxt.pm * tstep : cA; const char* nB = has_next ? (const char*)g.Bt + (size_t)nxt.pn * tstep : cB;
        for (int t = 0; t < nt; t += 2) {
            const bool last = (t == nt - 2);
            const char* a1 = cA + (size_t)(t + 1) * kstep;
            const char* a2 = last ? nA : cA + (size_t)(t + 2) * kstep; const char* b2 = last ? nB : cB + (size_t)(t + 2) * kstep;
            const char* a3 = a2 + kstep; const char* b3 = b2 + kstep;
            if (last && has_next) S.a_ready(nxt);
            if constexpr (SP2) {
            PG8_LDB(B0, 0, 0); PG8_LDB(B1, 0, 1); PG8_SCHED; PG8_LDA(At, 0, 0); PG8_STAGE(PG8_SA(1, 1), a1 + hstep, voffA);
            PG8_WAIT_V(8); PG8_WAIT_L(0); PG8_BAR; PG8_MMA(0, 0, At, B0); PG8_MMA(0, 1, At, B1); PG8_BAR; PG8_SCHED;
            PG8_LDA(At, 0, 1); PG8_STAGE(PG8_SB(0, 0), b2, voffB); PG8_STAGE(PG8_SB(0, 1), b2 + hstep, voffB); PG8_STAGE(PG8_SA(0, 0), a2, voffA);
            PG8_WAIT_V(8); PG8_WAIT_L(0); PG8_BAR; PG8_MMA(1, 0, At, B0); PG8_MMA(1, 1, At, B1); PG8_BAR; PG8_SCHED;
            PG8_LDB(B0, 1, 0); PG8_LDB(B1, 1, 1); PG8_SCHED; PG8_LDA(At, 1, 0); PG8_STAGE(PG8_SA(0, 1), a2 + hstep, voffA);
            PG8_WAIT_V(8); PG8_WAIT_L(0); PG8_BAR; PG8_MMA(0, 0, At, B0); PG8_MMA(0, 1, At, B1); PG8_BAR; PG8_SCHED;
            PG8_LDA(At, 1, 1); PG8_STAGE(PG8_SB(1, 0), b3, voffB); PG8_STAGE(PG8_SB(1, 1), b3 + hstep, voffB); PG8_STAGE(PG8_SA(1, 0), a3, voffA);
            PG8_WAIT_V(8); PG8_WAIT_L(0); PG8_BAR; PG8_MMA(1, 0, At, B0); PG8_MMA(1, 1, At, B1); PG8_BAR; PG8_SCHED;
            } else {
            PG8_LDB(B0, 0, 0); PG8_SCHED; PG8_LDA(At, 0, 0); PG8_STAGE(PG8_SA(1, 1), a1 + hstep, voffA);
            PG8_WAIT_L(8); PG8_BAR; PG8_WAIT_L(0); PG8_MMA(0, 0, At, B0); PG8_BAR; PG8_SCHED;
            PG8_LDB(B1, 0, 1); PG8_STAGE(PG8_SB(0, 0), b2, voffB);
            PG8_BAR; PG8_WAIT_L(0); PG8_MMA(0, 1, At, B1); PG8_BAR;
            PG8_LDA(At, 0, 1); PG8_STAGE(PG8_SA(0, 0), a2, voffA);
            PG8_BAR; PG8_WAIT_L(0); PG8_MMA(1, 0, At, B0); PG8_BAR; PG8_SCHED;
            PG8_STAGE(PG8_SB(0, 1), b2 + hstep, voffB);
            PG8_WAIT_V(6); PG8_BAR; PG8_MMA(1, 1, At, B1); PG8_BAR;
            PG8_LDB(B0, 1, 0); PG8_SCHED; PG8_LDA(At, 1, 0); PG8_STAGE(PG8_SA(0, 1), a2 + hstep, voffA);
            PG8_WAIT_L(8); PG8_BAR; PG8_WAIT_L(0); PG8_MMA(0, 0, At, B0); PG8_BAR; PG8_SCHED;
            PG8_LDB(B1, 1, 1); PG8_STAGE(PG8_SB(1, 0), b3, voffB);
            PG8_BAR; PG8_WAIT_L(0); PG8_MMA(0, 1, At, B1); PG8_BAR;
            PG8_LDA(At, 1, 1); PG8_STAGE(PG8_SA(1, 0), a3, voffA);
            PG8_BAR; PG8_WAIT_L(0); PG8_MMA(1, 0, At, B0); PG8_BAR; PG8_SCHED;
            PG8_STAGE(PG8_SB(1, 1), b3 + hstep, voffB);
            PG8_WAIT_V(6); PG8_BAR; PG8_MMA(1, 1, At, B1); PG8_BAR;
            }
        }
        if constexpr (ALIGN_EPI) { if (wr == 0) PG8_BAR; }
        if constexpr (!Epi::AFTER_DRAIN) { E(acc, cur, wr, wc, fr, fq); S.done(cur); }
        if (!has_next) break;
#pragma unroll
        for (int a = 0; a < 2; ++a)
#pragma unroll
            for (int b = 0; b < 2; ++b)
#pragma unroll
                for (int m = 0; m < 4; ++m)
#pragma unroll
                    for (int n = 0; n < 2; ++n) acc[a][b][m][n] = AccT{};
        cur = nxt; cA = nA; cB = nB; ++ui;
        if constexpr (ALIGN_EPI) { if (wr == 1) PG8_BAR; }
    }
    PG8_WAIT_V(0);
    if constexpr (!ALIGN_EPI) { if (wr == 0) PG8_BAR; }
    PG8_BAR;
    if constexpr (Epi::AFTER_DRAIN) { E.fused(acc, cur, wr, wc, fr, fq, lds, wid, lane); S.done(cur); }
#undef PG8_SA
#undef PG8_SB
#undef PG8_STAGE
#undef PG8_LDA
#undef PG8_LDB
#undef PG8_MMA
#undef PG8_WAIT_V
#undef PG8_WAIT_L
#undef PG8_BAR
#undef PG8_SCHED
}

struct EpiProj {
    typedef f32x4 AccT; static constexpr bool PERM = true, AFTER_DRAIN = false;
    bf16_t* q; bf16_t* k; bf16_t* v; bf16_t* us; bf16_t* vs; const int* pos;
    __device__ __forceinline__ void operator()(const f32x4 (&acc)[2][2][4][2], const Unit& u, int wr, int wc, int fr, int fq) const {
        const int row0 = u.pm * BM + wr * 64 + fr, b = u.pm >> 4;
        if (u.pn < 12) {
            const bool isq = u.pn < 6; bf16_t* base = isq ? q : k;
            const int hh = 2 * (isq ? u.pn : u.pn - 6) + (wc >> 1), e0 = 32 * (wc & 1) + 8 * fq;
            const float qs = isq ? 0.08838834764831845f : 1.0f;
            float ir[8];
#pragma unroll
            for (int j = 0; j < 8; ++j) ir[j] = exp2f(-(float)(e0 + j) * (13.287712379549449f / 64.0f)) * 0.15915494309189535f;
#pragma unroll
            for (int ai = 0; ai < 2; ++ai)
#pragma unroll
                for (int m = 0; m < 4; ++m) {
                    const int t = row0 + ai * HALF + m * 16, s = t & 4095;
                    const float pf = (float)pos[t];
                    float o0[8], o1[8];
#pragma unroll
                    for (int n = 0; n < 2; ++n)
#pragma unroll
                        for (int i = 0; i < 4; ++i) { const int j = 4 * n + i;
                            const float f = __builtin_amdgcn_fractf(pf * ir[j]); const float sn = __builtin_amdgcn_sinf(f), cs = __builtin_amdgcn_cosf(f);
                            const float t1 = acc[ai][0][m][n][i], t2 = acc[ai][1][m][n][i];
                            o0[j] = (t1 * cs - t2 * sn) * qs; o1[j] = (t2 * cs + t1 * sn) * qs; }
                    bf16_t* dst = base + ((size_t)(b * 12 + hh) * 4096 + s) * 128 + e0;
                    u32x4 w0, w1;
                    w0.x = cvt_pk_bf16(o0[0], o0[1]); w0.y = cvt_pk_bf16(o0[2], o0[3]); w0.z = cvt_pk_bf16(o0[4], o0[5]); w0.w = cvt_pk_bf16(o0[6], o0[7]);
                    w1.x = cvt_pk_bf16(o1[0], o1[1]); w1.y = cvt_pk_bf16(o1[2], o1[3]); w1.z = cvt_pk_bf16(o1[4], o1[5]); w1.w = cvt_pk_bf16(o1[6], o1[7]);
                    *(u32x4*)dst = w0; *(u32x4*)(dst + 64) = w1; }
        } else if (u.pn < 18) {
            const int e0 = 32 * wc + 8 * fq;
#pragma unroll
            for (int ai = 0; ai < 2; ++ai)
#pragma unroll
                for (int m = 0; m < 4; ++m) { const int t = row0 + ai * HALF + m * 16, s = t & 4095;
#pragma unroll
                    for (int bj = 0; bj < 2; ++bj) { const int hh = 2 * (u.pn - 12) + bj; const f32x4 v0 = acc[ai][bj][m][0], v1 = acc[ai][bj][m][1];
                        u32x4 w; w.x = cvt_pk_bf16(v0[0], v0[1]); w.y = cvt_pk_bf16(v0[2], v0[3]); w.z = cvt_pk_bf16(v1[0], v1[1]); w.w = cvt_pk_bf16(v1[2], v1[3]);
                        *(u32x4*)(v + ((size_t)(b * 12 + hh) * 4096 + s) * 128 + e0) = w; } }
        } else {
            bf16_t* base = u.pn < 20 ? us : vs; const int c0 = 256 * ((u.pn - 18) & 1) + 32 * wc + 8 * fq;
#pragma unroll
            for (int ai = 0; ai < 2; ++ai)
#pragma unroll
                for (int m = 0; m < 4; ++m) { const int t = row0 + ai * HALF + m * 16;
#pragma unroll
                    for (int bj = 0; bj < 2; ++bj) { const f32x4 v0 = acc[ai][bj][m][0], v1 = acc[ai][bj][m][1];
                        const f32x2 a = gelu_pk((f32x2){v0[0], v0[1]}), bb = gelu_pk((f32x2){v0[2], v0[3]}), c = gelu_pk((f32x2){v1[0], v1[1]}), d = gelu_pk((f32x2){v1[2], v1[3]});
                        u32x4 w; w.x = cvt_pk_bf16(a.x, a.y); w.y = cvt_pk_bf16(bb.x, bb.y); w.z = cvt_pk_bf16(c.x, c.y); w.w = cvt_pk_bf16(d.x, d.y);
                        *(u32x4*)(base + (size_t)t * 512 + c0 + 128 * bj) = w; } }
        }
    }
};
struct EpiRes {
    typedef f32x4 AccT; static constexpr bool PERM = true, AFTER_DRAIN = false;
    const float* x; bf16_t* hb; const long long* modq;
    __device__ __forceinline__ void operator()(const f32x4 (&acc)[2][2][4][2], const Unit& u, int wr, int wc, int fr, int fq) const {
        const int row0 = u.pm * BM + wr * 64 + fr, col0 = u.pn * BM + wc * 32 + 8 * fq, b = u.pm >> 4;
        f32x4 gt[2][2];
#pragma unroll
        for (int bj = 0; bj < 2; ++bj)
#pragma unroll
            for (int n = 0; n < 2; ++n) { const long long* mp = modq + b * 12288 + 2 * 2048 + col0 + bj * HALF + n * 4;
#pragma unroll
                for (int i = 0; i < 4; ++i) gt[bj][n][i] = (float)(int)(mp[i] >> 32) + (float)(unsigned)mp[i] * 2.3283064365386963e-10f; }
#pragma unroll
        for (int ai = 0; ai < 2; ++ai)
#pragma unroll
            for (int m = 0; m < 4; ++m) { const size_t off = (size_t)(row0 + ai * HALF + m * 16) * 2048 + col0;
#pragma unroll
                for (int bj = 0; bj < 2; ++bj) { const f32x4 x0 = *(const f32x4*)(x + off + bj * HALF), x1 = *(const f32x4*)(x + off + bj * HALF + 4);
                    const f32x4 v0 = x0 + gt[bj][0] * acc[ai][bj][m][0], v1 = x1 + gt[bj][1] * acc[ai][bj][m][1];
                    u32x4 w; w.x = cvt_pk_bf16(v0[0], v0[1]); w.y = cvt_pk_bf16(v0[2], v0[3]); w.z = cvt_pk_bf16(v1[0], v1[1]); w.w = cvt_pk_bf16(v1[2], v1[3]);
                    *(u32x4*)(hb + off + bj * HALF) = w; } }
    }
};
struct EpiPq {
    typedef f32x4 AccT; static constexpr bool PERM = true, AFTER_DRAIN = false;
    bf16_t* o;
    __device__ __forceinline__ void operator()(const f32x4 (&acc)[2][2][4][2], const Unit& u, int wr, int wc, int fr, int fq) const {
        const int row0 = u.pm * BM + wr * 64 + fr, col0 = u.pn * BM + wc * 32 + 8 * fq;
#pragma unroll
        for (int ai = 0; ai < 2; ++ai)
#pragma unroll
            for (int m = 0; m < 4; ++m) { bf16_t* rowp = o + (size_t)(row0 + ai * HALF + m * 16) * 2048 + col0;
#pragma unroll
                for (int bj = 0; bj < 2; ++bj) { const f32x4 v0 = acc[ai][bj][m][0], v1 = acc[ai][bj][m][1];
                    u32x4 w; w.x = cvt_pk_bf16(v0[0], v0[1]); w.y = cvt_pk_bf16(v0[2], v0[3]); w.z = cvt_pk_bf16(v1[0], v1[1]); w.w = cvt_pk_bf16(v1[2], v1[3]);
                    *(u32x4*)(rowp + bj * HALF) = w; } }
    }
};

__device__ __forceinline__ void deq8(const i32x4 a0, const i32x4 a1, float sr, const f32x4 s0, const f32x4 s1, float (&o)[8]) {
    o[0] = (float)a0[0] * (sr * s0[0]); o[1] = (float)a0[1] * (sr * s0[1]); o[2] = (float)a0[2] * (sr * s0[2]); o[3] = (float)a0[3] * (sr * s0[3]);
    o[4] = (float)a1[0] * (sr * s1[0]); o[5] = (float)a1[1] * (sr * s1[1]); o[6] = (float)a1[2] * (sr * s1[2]); o[7] = (float)a1[3] * (sr * s1[3]);
}
struct EpiProj8 {
    typedef i32x4 AccT; static constexpr bool PERM = true, AFTER_DRAIN = false;
    bf16_t* q; bf16_t* k; bf16_t* v; bf16_t* us; bf16_t* vs; const int* pos; const float* sa; const float* sb;
    __device__ __forceinline__ void operator()(const i32x4 (&acc)[2][2][4][2], const Unit& u, int wr, int wc, int fr, int fq) const {
        const int row0 = u.pm * BM + wr * 64 + fr, b = u.pm >> 4;
        f32x4 sbv[2][2];
#pragma unroll
        for (int bj = 0; bj < 2; ++bj)
#pragma unroll
            for (int n = 0; n < 2; ++n) sbv[bj][n] = *(const f32x4*)(sb + u.pn * BM + bj * HALF + wc * 32 + 8 * fq + 4 * n);
        if (u.pn < 12) {
            const bool isq = u.pn < 6; bf16_t* base = isq ? q : k;
            const int hh = 2 * (isq ? u.pn : u.pn - 6) + (wc >> 1), e0 = 32 * (wc & 1) + 8 * fq;
            const float qs = isq ? 0.08838834764831845f : 1.0f;
            float ir[8];
#pragma unroll
            for (int j = 0; j < 8; ++j) ir[j] = exp2f(-(float)(e0 + j) * (13.287712379549449f / 64.0f)) * 0.15915494309189535f;
#pragma unroll
            for (int ai = 0; ai < 2; ++ai)
#pragma unroll
                for (int m = 0; m < 4; ++m) {
                    const int t = row0 + ai * HALF + m * 16, s = t & 4095;
                    const float pf = (float)pos[t], sr = sa[t] * qs;
                    float x0[8], x1[8], o0[8], o1[8];
                    deq8(acc[ai][0][m][0], acc[ai][0][m][1], sr, sbv[0][0], sbv[0][1], x0); deq8(acc[ai][1][m][0], acc[ai][1][m][1], sr, sbv[1][0], sbv[1][1], x1);
#pragma unroll
                    for (int j = 0; j < 8; ++j) { const float f = __builtin_amdgcn_fractf(pf * ir[j]); const float sn = __builtin_amdgcn_sinf(f), cs = __builtin_amdgcn_cosf(f);
                        o0[j] = x0[j] * cs - x1[j] * sn; o1[j] = x1[j] * cs + x0[j] * sn; }
                    bf16_t* dst = base + ((size_t)(b * 12 + hh) * 4096 + s) * 128 + e0;
                    u32x4 w0, w1;
                    w0.x = cvt_pk_bf16(o0[0], o0[1]); w0.y = cvt_pk_bf16(o0[2], o0[3]); w0.z = cvt_pk_bf16(o0[4], o0[5]); w0.w = cvt_pk_bf16(o0[6], o0[7]);
                    w1.x = cvt_pk_bf16(o1[0], o1[1]); w1.y = cvt_pk_bf16(o1[2], o1[3]); w1.z = cvt_pk_bf16(o1[4], o1[5]); w1.w = cvt_pk_bf16(o1[6], o1[7]);
                    *(u32x4*)dst = w0; *(u32x4*)(dst + 64) = w1; }
        } else if (u.pn < 18) {
            const int e0 = 32 * wc + 8 * fq;
#pragma unroll
            for (int ai = 0; ai < 2; ++ai)
#pragma unroll
                for (int m = 0; m < 4; ++m) { const int t = row0 + ai * HALF + m * 16, s = t & 4095; const float sr = sa[t];
#pragma unroll
                    for (int bj = 0; bj < 2; ++bj) { const int hh = 2 * (u.pn - 12) + bj; float x[8]; deq8(acc[ai][bj][m][0], acc[ai][bj][m][1], sr, sbv[bj][0], sbv[bj][1], x);
                        u32x4 w; w.x = cvt_pk_bf16(x[0], x[1]); w.y = cvt_pk_bf16(x[2], x[3]); w.z = cvt_pk_bf16(x[4], x[5]); w.w = cvt_pk_bf16(x[6], x[7]);
                        *(u32x4*)(v + ((size_t)(b * 12 + hh) * 4096 + s) * 128 + e0) = w; } }
        } else {
            bf16_t* base = u.pn < 20 ? us : vs; const int c0 = 256 * ((u.pn - 18) & 1) + 32 * wc + 8 * fq;
#pragma unroll
            for (int ai = 0; ai < 2; ++ai)
#pragma unroll
                for (int m = 0; m < 4; ++m) { const int t = row0 + ai * HALF + m * 16; const float sr = sa[t];
#pragma unroll
                    for (int bj = 0; bj < 2; ++bj) { float x[8]; deq8(acc[ai][bj][m][0], acc[ai][bj][m][1], sr, sbv[bj][0], sbv[bj][1], x);
                        const f32x2 a = gelu_pk((f32x2){x[0], x[1]}), bb = gelu_pk((f32x2){x[2], x[3]}), c = gelu_pk((f32x2){x[4], x[5]}), d = gelu_pk((f32x2){x[6], x[7]});
                        u32x4 w; w.x = cvt_pk_bf16(a.x, a.y); w.y = cvt_pk_bf16(bb.x, bb.y); w.z = cvt_pk_bf16(c.x, c.y); w.w = cvt_pk_bf16(d.x, d.y);
                        *(u32x4*)(base + (size_t)t * 512 + c0 + 128 * bj) = w; } }
        }
    }
};
struct EpiRes8 {
    typedef i32x4 AccT; static constexpr bool PERM = true, AFTER_DRAIN = false;
    bf16_t* db; const long long* modq; const float* sa; const float* sb;
    __device__ __forceinline__ void operator()(const i32x4 (&acc)[2][2][4][2], const Unit& u, int wr, int wc, int fr, int fq) const {
        const int row0 = u.pm * BM + wr * 64 + fr, col0 = u.pn * BM + wc * 32 + 8 * fq, b = u.pm >> 4;
        f32x4 gs[2][2];
#pragma unroll
        for (int bj = 0; bj < 2; ++bj)
#pragma unroll
            for (int n = 0; n < 2; ++n) { const long long* mp = modq + b * 12288 + 2 * 2048 + col0 + bj * HALF + n * 4; const f32x4 sv = *(const f32x4*)(sb + col0 + bj * HALF + n * 4);
#pragma unroll
                for (int i = 0; i < 4; ++i) gs[bj][n][i] = ((float)(int)(mp[i] >> 32) + (float)(unsigned)mp[i] * 2.3283064365386963e-10f) * sv[i]; }
#pragma unroll
        for (int ai = 0; ai < 2; ++ai)
#pragma unroll
            for (int m = 0; m < 4; ++m) { const int t = row0 + ai * HALF + m * 16; const size_t off = (size_t)t * 2048 + col0; const float sr = sa[t];
#pragma unroll
                for (int bj = 0; bj < 2; ++bj) { float d[8]; deq8(acc[ai][bj][m][0], acc[ai][bj][m][1], sr, gs[bj][0], gs[bj][1], d);
                    u32x4 w; w.x = cvt_pk_bf16(d[0], d[1]); w.y = cvt_pk_bf16(d[2], d[3]); w.z = cvt_pk_bf16(d[4], d[5]); w.w = cvt_pk_bf16(d[6], d[7]);
                    *(u32x4*)(db + off + bj * HALF) = w; } }
    }
};
struct EpiPq8 {
    typedef i32x4 AccT; static constexpr bool PERM = true, AFTER_DRAIN = false;
    bf16_t* o; const float* sa; const float* sb;
    __device__ __forceinline__ void operator()(const i32x4 (&acc)[2][2][4][2], const Unit& u, int wr, int wc, int fr, int fq) const {
        const int row0 = u.pm * BM + wr * 64 + fr, col0 = u.pn * BM + wc * 32 + 8 * fq;
        f32x4 sbv[2][2];
#pragma unroll
        for (int bj = 0; bj < 2; ++bj)
#pragma unroll
            for (int n = 0; n < 2; ++n) sbv[bj][n] = *(const f32x4*)(sb + col0 + bj * HALF + n * 4);
#pragma unroll
        for (int ai = 0; ai < 2; ++ai)
#pragma unroll
            for (int m = 0; m < 4; ++m) { const int t = row0 + ai * HALF + m * 16; bf16_t* rowp = o + (size_t)t * 2048 + col0; const float sr = sa[t];
#pragma unroll
                for (int bj = 0; bj < 2; ++bj) { float d[8]; deq8(acc[ai][bj][m][0], acc[ai][bj][m][1], sr, sbv[bj][0], sbv[bj][1], d);
                    u32x4 w; w.x = cvt_pk_bf16(d[0], d[1]); w.y = cvt_pk_bf16(d[2], d[3]); w.z = cvt_pk_bf16(d[4], d[5]); w.w = cvt_pk_bf16(d[6], d[7]);
                    *(u32x4*)(rowp + bj * HALF) = w; } }
    }
};
}

__device__ __forceinline__ void phase_gemm1(const Params& p, unsigned char* lds) {
    const float* scl = (const float*)(p.ws + OFF_SCL);
    pg8::Gemm g{(const bf16_t*)(p.ws + OFF_A), (const bf16_t*)(p.ws + OFF_WIN), T, DIN, D / 2};
    pg8::StaticOrder So; So.init(T, DIN, (int)gridDim.x, (int)blockIdx.x);
    pg8::EpiProj8 Ep{(bf16_t*)(p.ws + OFF_QKV), (bf16_t*)(p.ws + OFF_QKV + QKV_ONE), (bf16_t*)(p.ws + OFF_QKV + 2 * QKV_ONE), (bf16_t*)(p.ws + OFF_US), (bf16_t*)(p.ws + OFF_VS), p.pos, scl + SCL_HS, scl + SCL_WS + WS_IN};
    pg8::gemm_phase<pg8::EpiProj8, pg8::StaticOrder, true, true>((PG8_LAS unsigned char*)lds, g, So, Ep);
}
__device__ __forceinline__ void phase_gemm2(const Params& p, unsigned char* lds) {
    const float* scl = (const float*)(p.ws + OFF_SCL);
    pg8::Gemm g{(const bf16_t*)(p.ws + OFF_QKV), (const bf16_t*)(p.ws + OFF_WOUT), T, D, D / 2};
    pg8::StaticOrder So; So.init(T, D, (int)gridDim.x, (int)blockIdx.x);
    pg8::EpiRes8 Ep{(bf16_t*)(p.ws + OFF_O12), (const long long*)(p.ws + OFF_MOD), scl + SCL_MS, scl + SCL_WS + WS_OUT};
    pg8::gemm_phase<pg8::EpiRes8, pg8::StaticOrder, true, true>((PG8_LAS unsigned char*)lds, g, So, Ep);
}
__device__ __forceinline__ void phase_gemm3(const Params& p, unsigned char* lds) {
    const float* scl = (const float*)(p.ws + OFF_SCL);
    pg8::Gemm g{(const bf16_t*)(p.ws + OFF_US), (const bf16_t*)(p.ws + OFF_WQ), T, D, D / 2};
    pg8::StaticOrder So; So.init(T, D, (int)gridDim.x, (int)blockIdx.x);
    pg8::EpiPq8 Ep{(bf16_t*)(p.ws + OFF_QKV + (size_t)T * D * 2), (const float*)(p.ws + OFF_SGUO), scl + SCL_WS + WS_Q};
    pg8::gemm_phase<pg8::EpiPq8, pg8::StaticOrder, true, true>((PG8_LAS unsigned char*)lds, g, So, Ep);
}

__device__ __forceinline__ void conv_transpose(const float* __restrict__ W, int N, bf16_t* __restrict__ WT, int perm_limit, float* tile, int bid, int nblk, int tid) {
    const int ntiles = 32 * (N / 64);
    for (int tI = bid; tI < ntiles; tI += nblk) {
        const int tk = tI & 31, tn = tI >> 5, k0 = tk * 64, n0 = tn * 64;
        int l0 = n0;
        if (n0 < perm_limit) { const int base = n0 & ~255, pb = (n0 >> 6) & 3, bj = pb >> 1, qhi = pb & 1; l0 = base + 64 * bj + 128 * qhi; }
        __syncthreads();
#pragma unroll
        for (int pass = 0; pass < 2; ++pass) { const int r = pass * 32 + (tid >> 4), c4 = (tid & 15) * 4;
            const float4 v = *(const float4*)(W + (size_t)(k0 + r) * N + l0 + c4);
            tile[r * 65 + c4 + 0] = v.x; tile[r * 65 + c4 + 1] = v.y; tile[r * 65 + c4 + 2] = v.z; tile[r * 65 + c4 + 3] = v.w; }
        __syncthreads();
        const int n = tid >> 3, kq = (tid & 7) * 8;
        u32x4 w;
        w.x = pack2(tile[(kq + 0) * 65 + n], tile[(kq + 1) * 65 + n]); w.y = pack2(tile[(kq + 2) * 65 + n], tile[(kq + 3) * 65 + n]);
        w.z = pack2(tile[(kq + 4) * 65 + n], tile[(kq + 5) * 65 + n]); w.w = pack2(tile[(kq + 6) * 65 + n], tile[(kq + 7) * 65 + n]);
        *(u32x4*)(WT + (size_t)(n0 + n) * D + k0 + kq) = w;
    }
}
__device__ __forceinline__ void conv_flat(const float* __restrict__ src, bf16_t* __restrict__ dst, size_t n8, int bid, int nblk, int tid) {
    for (size_t i = (size_t)bid * NTHR + tid; i < n8; i += (size_t)nblk * NTHR) {
        const float4 a = ((const float4*)src)[2 * i], b = ((const float4*)src)[2 * i + 1];
        u32x4 w; w.x = pack2(a.x, a.y); w.y = pack2(a.z, a.w); w.z = pack2(b.x, b.y); w.w = pack2(b.z, b.w);
        ((u32x4*)dst)[i] = w; }
}
__device__ __forceinline__ unsigned q8pack(float a, float b, float c, float d, int bias) {
    const int qa = (int)rintf(a) + bias, qb = (int)rintf(b) + bias, qc = (int)rintf(c) + bias, qd = (int)rintf(d) + bias;
    return (unsigned)(qa & 255) | ((unsigned)(qb & 255) << 8) | ((unsigned)(qc & 255) << 16) | ((unsigned)(qd & 255) << 24);
}
template <int BIAS> __device__ __forceinline__ void conv_rows_i8(const float* __restrict__ src, unsigned char* __restrict__ dst, float* __restrict__ inv, int bid, int nblk, int tid) {
    const int lane = tid & 63, gw = bid * NWV + (tid >> 6), nw = nblk * NWV;
    for (int r = gw; r < NEXP; r += nw) {
        const float4* row = (const float4*)(src + (size_t)r * D);
        float4 v[8]; float m = 0.f;
#pragma unroll
        for (int i = 0; i < 8; ++i) { v[i] = row[i * 64 + lane]; m = fmaxf(m, fmaxf(fmaxf(fabsf(v[i].x), fabsf(v[i].y)), fmaxf(fabsf(v[i].z), fabsf(v[i].w)))); }
        m = wave_max(m);
        const float sc = m > 0.f ? 127.0f / m : 0.f, isc = m * (1.0f / 127.0f);
        unsigned char* drow = dst + (size_t)(lane >> 5) * SLICE_BYTES + (size_t)r * 128 + (lane & 31) * 4;
#pragma unroll
        for (int i = 0; i < 8; ++i) *(unsigned*)(drow + (size_t)(2 * i) * SLICE_BYTES) = q8pack(v[i].x * sc, v[i].y * sc, v[i].z * sc, v[i].w * sc, BIAS);
        if (lane == 0) inv[r] = isc;
    }
}
constexpr int NPM = 16;
__device__ __forceinline__ void conv_colmax_item(const float* __restrict__ W, int N, float* __restrict__ pm  , float* red, int it, int tid) {
    const int lane = tid & 63, wv = tid >> 6;
    const int cb = it / NPM, kg = it % NPM;
    const float* wp = W + (size_t)(kg * 128 + wv * 16) * N + cb * 256 + lane * 4;
    float4 w[16];
#pragma unroll
    for (int kk = 0; kk < 16; ++kk) w[kk] = *(const float4*)(wp + (size_t)kk * N);
    float4 m = make_float4(0.f, 0.f, 0.f, 0.f);
#pragma unroll
    for (int kk = 0; kk < 16; ++kk) { m.x = fmaxf(m.x, fabsf(w[kk].x)); m.y = fmaxf(m.y, fabsf(w[kk].y)); m.z = fmaxf(m.z, fabsf(w[kk].z)); m.w = fmaxf(m.w, fabsf(w[kk].w)); }
    __syncthreads();
    *(float4*)(red + wv * 256 + lane * 4) = m;
    __syncthreads();
    if (tid < 256) { float mm = 0.f;
#pragma unroll
        for (int w8 = 0; w8 < 8; ++w8) mm = fmaxf(mm, red[w8 * 256 + tid]);
        pm[kg * NWCOL + cb * 256 + tid] = mm; }
}
__device__ __forceinline__ void conv_tables_queue(const Params& p, unsigned* qh, int tid, unsigned char* lds) {
    int lane = tid & 63; asm volatile("" : "+v"(lane));
    const int wv = __builtin_amdgcn_readfirstlane(tid >> 6);
    volatile LAS_ unsigned* sh = (volatile LAS_ unsigned*)((LAS_ unsigned char*)lds);
    float4 v[8];
#define CT_LOAD(src_, rr) do { const float4* _row = (const float4*)((src_) + (size_t)(rr) * D); _Pragma("unroll") for (int i = 0; i < 8; ++i) v[i] = _row[i * 64 + lane]; } while (0)
    __syncthreads();
    if (tid == 0) sh[0] = atomicAdd(qh, 1u);
    __syncthreads();
    unsigned c = sh[0];
    if (c < 512u) CT_LOAD(c < 256u ? p.peer_u : p.peer_v, (c & 255u) * 64u + wv * 8);
    while (c < 512u) {
        __syncthreads();
        unsigned cn = 0; if (tid == 0) cn = atomicAdd(qh, 1u);
        const bool isv = c >= 256u; const float* src = isv ? p.peer_v : p.peer_u; const int bias = isv ? 128 : 0;
        unsigned char* dst = p.ws + (isv ? OFF_VTAB : OFF_UTAB); float* inv = (float*)(dst + TAB8_BYTES);
#pragma unroll 1
        for (int k = 0; k < 8; ++k) {
            const int r = (int)(c & 255u) * 64 + wv * 8 + k;
            float4 w[8]; float m = 0.f;
#pragma unroll
            for (int i = 0; i < 8; ++i) { w[i] = v[i]; m = fmaxf(m, fmaxf(fmaxf(fabsf(w[i].x), fabsf(w[i].y)), fmaxf(fabsf(w[i].z), fabsf(w[i].w)))); }
            if (k < 7) CT_LOAD(src, r + 1);
            else { if (tid == 0) sh[0] = cn; __syncthreads(); cn = sh[0]; if (cn < 512u) CT_LOAD(cn < 256u ? p.peer_u : p.peer_v, (cn & 255u) * 64u + wv * 8); }
            m = wave_max(m);
            const float sc = m > 0.f ? 127.0f / m : 0.f;
            unsigned char* drow = dst + (size_t)(lane >> 5) * SLICE_BYTES + (size_t)r * 128 + (lane & 31) * 4;
#pragma unroll
            for (int i = 0; i < 8; ++i) *(unsigned*)(drow + (size_t)(2 * i) * SLICE_BYTES) = q8pack(w[i].x * sc, w[i].y * sc, w[i].z * sc, w[i].w * sc, bias);
            if (lane == 0) inv[r] = m * (1.0f / 127.0f);
        }
        c = cn;
    }
#undef CT_LOAD
}
__device__ __forceinline__ void conv_transpose_q8(const float* __restrict__ W, int N, unsigned char* __restrict__ WT, const float* __restrict__ pm, float* __restrict__ wscale, int perm_limit, float* tile, int bid, int nblk, int tid) {
    const int ntiles = 32 * (N / 64);
    for (int tI = bid; tI < ntiles; tI += nblk) {
        const int tk = tI & 31, tn = tI >> 5, k0 = tk * 64, n0 = tn * 64;
        int l0 = n0;
        if (n0 < perm_limit) { const int base = n0 & ~255, pb = (n0 >> 6) & 3, bj = pb >> 1, qhi = pb & 1; l0 = base + 64 * bj + 128 * qhi; }
        __syncthreads();
#pragma unroll
        for (int pass = 0; pass < 2; ++pass) { const int r = pass * 32 + (tid >> 4), c4 = (tid & 15) * 4;
            const float4 v = *(const float4*)(W + (size_t)(k0 + r) * N + l0 + c4);
            tile[r * 65 + c4 + 0] = v.x; tile[r * 65 + c4 + 1] = v.y; tile[r * 65 + c4 + 2] = v.z; tile[r * 65 + c4 + 3] = v.w; }
        __syncthreads();
        const int n = tid >> 3, kq = (tid & 7) * 8, lc = l0 + n;
        float cm = 0.f;
#pragma unroll
        for (int q = 0; q < NPM; ++q) cm = fmaxf(cm, pm[q * NWCOL + lc]);
        const float sc = cm > 0.f ? 127.0f / cm : 0.f;
        u32x2 w;
        w.x = q8pack(tile[(kq + 0) * 65 + n] * sc, tile[(kq + 1) * 65 + n] * sc, tile[(kq + 2) * 65 + n] * sc, tile[(kq + 3) * 65 + n] * sc, 0);
        w.y = q8pack(tile[(kq + 4) * 65 + n] * sc, tile[(kq + 5) * 65 + n] * sc, tile[(kq + 6) * 65 + n] * sc, tile[(kq + 7) * 65 + n] * sc, 0);
        *(u32x2*)(WT + (size_t)(n0 + n) * D + k0 + kq) = w;
        if (tk == 0 && kq == 0) wscale[n0 + n] = cm * (1.0f / 127.0f);
    }
}
__device__ __forceinline__ void phase_quant_weights(const Params& p, unsigned char* lds) {
    const int tid = threadIdx.x, bid = blockIdx.x, nblk = gridDim.x;
    const float* scl = (const float*)(p.ws + OFF_SCL); float* ws = (float*)(p.ws + OFF_SCL) + SCL_WS;
    conv_transpose_q8(p.w_in, DIN, p.ws + OFF_WIN, scl + SCL_PM + WS_IN, ws + WS_IN, 3072, (float*)lds, bid, nblk, tid);
    conv_transpose_q8(p.w_out, D, p.ws + OFF_WOUT, scl + SCL_PM + WS_OUT, ws + WS_OUT, 0, (float*)lds, bid, nblk, tid);
    conv_transpose_q8(p.peer_w_q, D, p.ws + OFF_WQ, scl + SCL_PM + WS_Q, ws + WS_Q, 0, (float*)lds, bid, nblk, tid);
}
__device__ __forceinline__ void phase_conv(const Params& p, unsigned char* lds, bool dup = false) {
    const int tid = threadIdx.x, bid = blockIdx.x, nblk = gridDim.x;
    unsigned long long* mod = (unsigned long long*)(p.ws + OFF_MOD);
    unsigned long long cts = 0; CSTAMP(0);
    for (int it = bid; it < (dup ? 0 : 192); it += nblk) {
        const int cb = it % 48, kg = it / 48, lane = tid & 63, wv = tid >> 6;
        float* sc = (float*)lds;
        float* red = (float*)lds + 2048;
        __syncthreads();
        for (int i = tid; i < 2048; i += NTHR) { const int b = i >> 9, kk = i & 511; const float cv = p.c[b * D + kg * 512 + kk]; sc[i] = cv / (1.f + __expf(-cv)); }
        __syncthreads();
        float acc[4][4];
#pragma unroll
        for (int b = 0; b < 4; ++b) { acc[b][0] = 0.f; acc[b][1] = 0.f; acc[b][2] = 0.f; acc[b][3] = 0.f; }
        const float* wp = p.w_ada + (size_t)(kg * 512 + wv * 64) * 12288 + cb * 256 + lane * 4;
#pragma unroll 1
        for (int k0 = 0; k0 < 64; k0 += 16) {
            float4 w[16];
#pragma unroll
            for (int kk = 0; kk < 16; ++kk) w[kk] = *(const float4*)(wp + (size_t)(k0 + kk) * 12288);
#pragma unroll
            for (int kk = 0; kk < 16; ++kk)
#pragma unroll
                for (int b = 0; b < 4; ++b) { const float sv = sc[b * 512 + wv * 64 + k0 + kk];
                    acc[b][0] += sv * w[kk].x; acc[b][1] += sv * w[kk].y; acc[b][2] += sv * w[kk].z; acc[b][3] += sv * w[kk].w; }
        }
#pragma unroll
        for (int b = 0; b < 4; ++b) *(float4*)(red + (wv * 4 + b) * 256 + lane * 4) = make_float4(acc[b][0], acc[b][1], acc[b][2], acc[b][3]);
        __syncthreads();
        if (tid < 256) {
#pragma unroll
            for (int b = 0; b < 4; ++b) { float sum = 0.f;
#pragma unroll
                for (int w8 = 0; w8 < 8; ++w8) sum += red[(w8 * 4 + b) * 256 + tid];
                const int col = cb * 256 + tid;
                if (kg == 0) sum += p.b_ada[col];
                atomicAdd(mod + b * 12288 + col, (unsigned long long)__double2ll_rn((double)sum * 4294967296.0)); }
        }
    }
    CSTAMP(1);
    { float* pm = (float*)(p.ws + OFF_SCL) + SCL_PM;
      const int vb = (bid + nblk - (192 % nblk)) % nblk;
      for (int it = vb; it < (DIN / 256 + 2 * (D / 256)) * NPM; it += nblk) {
          if (it < (DIN / 256) * NPM) conv_colmax_item(p.w_in, DIN, pm + WS_IN, (float*)lds, it, tid);
          else if (it < (DIN / 256 + D / 256) * NPM) conv_colmax_item(p.w_out, D, pm + WS_OUT, (float*)lds, it - (DIN / 256) * NPM, tid);
          else conv_colmax_item(p.peer_w_q, D, pm + WS_Q, (float*)lds, it - (DIN / 256 + D / 256) * NPM, tid); } }
    CSTAMP(2);
    conv_flat(p.peer_sub_keys, (bf16_t*)(p.ws + OFF_SUBK), (size_t)8 * 2 * 128 * 128 / 8, bid, nblk, tid);
    { bf16_t* sw = (bf16_t*)(p.ws + OFF_SGUW);
      for (int i = bid * NTHR + tid; i < 4 * 128 * 128; i += nblk * NTHR) { const int jj = i & 127, ii = (i >> 7) & 127; sw[i] = f2bf(jj <= ii ? p.sgu_w[i] : 0.f); } }
    CSTAMP(3);
    if (!dup) conv_tables_queue(p, (unsigned*)(p.ws + OFF_CTL + OFF_QUEUE) + 64 * 64, tid, lds);
}

template <bool Q8, bool SRC16, bool W16> __device__ __forceinline__ void phase_norm_mod(const Params& p, const void* __restrict__ src_, const float* __restrict__ g, int sh_i, int sc_i, bf16_t* __restrict__ dst, unsigned char* __restrict__ dst8, float* __restrict__ dscale) {
    const int lane = threadIdx.x & 63, gw = blockIdx.x * NWV + __builtin_amdgcn_readfirstlane(threadIdx.x >> 6), nw = gridDim.x * NWV;
    const int wpb = nw >> 2;
    const int b = gw / wpb, r0 = gw - b * wpb;
    if (b >= NB) return;
    float4 ca[8], cb[8];
#pragma unroll
    for (int i = 0; i < 8; ++i) { const int col = i * 256 + lane * 4; const float4 gg = *(const float4*)(g + col), sc = mod4(p, b, sc_i, col), sh = mod4(p, b, sh_i, col);
        ca[i] = make_float4(gg.x * (1.f + sc.x), gg.y * (1.f + sc.y), gg.z * (1.f + sc.z), gg.w * (1.f + sc.w)); cb[i] = sh; }
    float4 vf[8]; u32x2 vh[8];
#define NM_LOAD(tt) do { _Pragma("unroll") for (int i = 0; i < 8; ++i) { if (SRC16) { vh[i] = *(const u32x2*)((const bf16_t*)src_ + (size_t)(tt) * D + i * 256 + lane * 4); vf[i] = *(const float4*)(p.x + (size_t)(tt) * D + i * 256 + lane * 4); } else vf[i] = *(const float4*)((const float*)src_ + (size_t)(tt) * D + i * 256 + lane * 4); } } while (0)
    if (r0 < S) NM_LOAD(b * S + r0);
    for (int r = r0; r < S; r += wpb) {
        const int t = b * S + r;
        float4 v[8]; float ss = 0.f;
#pragma unroll
        for (int i = 0; i < 8; ++i) { v[i] = SRC16 ? make_float4(vf[i].x + bflo(vh[i].x), vf[i].y + bfhi(vh[i].x), vf[i].z + bflo(vh[i].y), vf[i].w + bfhi(vh[i].y)) : vf[i];
            ss += v[i].x * v[i].x + v[i].y * v[i].y + v[i].z * v[i].z + v[i].w * v[i].w; }
        if (r + wpb < S) NM_LOAD(t + wpb);
        ss = wave_sum(ss); const float rstd = rsqrtf(ss * (1.0f / D) + 1e-6f);
        float m = 0.f;
#pragma unroll
        for (int i = 0; i < 8; ++i) { const int col = i * 256 + lane * 4;
            v[i].x = v[i].x * rstd * ca[i].x + cb[i].x; v[i].y = v[i].y * rstd * ca[i].y + cb[i].y; v[i].z = v[i].z * rstd * ca[i].z + cb[i].z; v[i].w = v[i].w * rstd * ca[i].w + cb[i].w;
            if (W16) { u32x2 w; w.x = pack2(v[i].x, v[i].y); w.y = pack2(v[i].z, v[i].w); *(u32x2*)(dst + (size_t)t * D + col) = w; }
            if (Q8) m = fmaxf(m, fmaxf(fmaxf(fabsf(v[i].x), fabsf(v[i].y)), fmaxf(fabsf(v[i].z), fabsf(v[i].w)))); }
        if (Q8) {
            m = wave_max(m); const float sc8 = m > 0.f ? 127.0f / m : 0.f;
            unsigned* x8 = (unsigned*)(dst8 + (size_t)t * D);
#pragma unroll
            for (int i = 0; i < 8; ++i) x8[i * 64 + lane] = q8pack(v[i].x * sc8, v[i].y * sc8, v[i].z * sc8, v[i].w * sc8, 0);
            if (lane == 0) dscale[t] = m * (1.0f / 127.0f);
        }
    }
#undef NM_LOAD
}

constexpr int NM_CHUNK = 16;
template <bool Q8, bool SRC16, bool W16> __device__ __forceinline__ void phase_norm_mod_q(const Params& p, const void* __restrict__ src_, const float* __restrict__ g, int sh_i, int sc_i, bf16_t* __restrict__ dst, unsigned char* __restrict__ dst8, float* __restrict__ dscale, unsigned* qh) {
    int lane = threadIdx.x & 63; asm volatile("" : "+v"(lane));
    const int gw = blockIdx.x * NWV + __builtin_amdgcn_readfirstlane(threadIdx.x >> 6), nw = gridDim.x * NWV;
    const int b0 = (gw * NB) / nw;
    float4 vf[8]; u32x2 vh[8];
#define NM_LOAD(tt) do { _Pragma("unroll") for (int i = 0; i < 8; ++i) { if (SRC16) { vh[i] = *(const u32x2*)((const bf16_t*)src_ + (size_t)(tt) * D + i * 256 + lane * 4); vf[i] = *(const float4*)(p.x + (size_t)(tt) * D + i * 256 + lane * 4); } else vf[i] = *(const float4*)((const float*)src_ + (size_t)(tt) * D + i * 256 + lane * 4); } } while (0)
    for (int bb = 0; bb < NB; ++bb) {
        const int b = (b0 + bb) & (NB - 1);
        unsigned c = 0; if (lane == 0) c = atomicAdd(qh + b * 64, 1u);
        c = __builtin_amdgcn_readfirstlane(c);
        if (c >= (unsigned)(S / NM_CHUNK)) continue;
        float4 ca[8], cb[8];
#pragma unroll
        for (int i = 0; i < 8; ++i) { const int col = i * 256 + lane * 4; const float4 gg = *(const float4*)(g + col), sc = mod4(p, b, sc_i, col), sh = mod4(p, b, sh_i, col);
            ca[i] = make_float4(gg.x * (1.f + sc.x), gg.y * (1.f + sc.y), gg.z * (1.f + sc.z), gg.w * (1.f + sc.w)); cb[i] = sh; }
        NM_LOAD(b * S + (int)c * NM_CHUNK);
        while (c < (unsigned)(S / NM_CHUNK)) {
            unsigned cn = 0; if (lane == 0) cn = atomicAdd(qh + b * 64, 1u);
#pragma unroll 1
            for (int k = 0; k < NM_CHUNK; ++k) {
                const int t = b * S + (int)c * NM_CHUNK + k;
                float4 v[8]; float ss = 0.f;
#pragma unroll
                for (int i = 0; i < 8; ++i) { v[i] = SRC16 ? make_float4(vf[i].x + bflo(vh[i].x), vf[i].y + bfhi(vh[i].x), vf[i].z + bflo(vh[i].y), vf[i].w + bfhi(vh[i].y)) : vf[i];
                    ss += v[i].x * v[i].x + v[i].y * v[i].y + v[i].z * v[i].z + v[i].w * v[i].w; }
                if (k < NM_CHUNK - 1) NM_LOAD(t + 1);
                else { cn = __builtin_amdgcn_readfirstlane(cn); if (cn < (unsigned)(S / NM_CHUNK)) NM_LOAD(b * S + (int)cn * NM_CHUNK); }
                ss = wave_sum(ss); const float rstd = rsqrtf(ss * (1.0f / D) + 1e-6f);
                float m = 0.f;
#pragma unroll
                for (int i = 0; i < 8; ++i) { const int col = i * 256 + lane * 4;
                    v[i].x = v[i].x * rstd * ca[i].x + cb[i].x; v[i].y = v[i].y * rstd * ca[i].y + cb[i].y; v[i].z = v[i].z * rstd * ca[i].z + cb[i].z; v[i].w = v[i].w * rstd * ca[i].w + cb[i].w;
                    if (W16) { u32x2 w; w.x = pack2(v[i].x, v[i].y); w.y = pack2(v[i].z, v[i].w); *(u32x2*)(dst + (size_t)t * D + col) = w; }
                    if (Q8) m = fmaxf(m, fmaxf(fmaxf(fabsf(v[i].x), fabsf(v[i].y)), fmaxf(fabsf(v[i].z), fabsf(v[i].w)))); }
                if (Q8) {
                    m = wave_max(m); const float sc8 = m > 0.f ? 127.0f / m : 0.f;
                    unsigned* x8 = (unsigned*)(dst8 + (size_t)t * D);
#pragma unroll
                    for (int i = 0; i < 8; ++i) x8[i * 64 + lane] = q8pack(v[i].x * sc8, v[i].y * sc8, v[i].z * sc8, v[i].w * sc8, 0);
                    if (lane == 0) dscale[t] = m * (1.0f / 127.0f);
                }
            }
            c = cn;
        }
    }
#undef NM_LOAD
}

#define LAS __attribute__((address_space(3)))
typedef short bf16x8 __attribute__((ext_vector_type(8)));
typedef short s16x4 __attribute__((ext_vector_type(4)));
constexpr int ATT_VOFF = 65536, ATT_VSTRIDE = 288;
__device__ __forceinline__ unsigned cvt_pk(float lo, float hi) { unsigned r; asm volatile("v_cvt_pk_bf16_f32 %0, %1, %2" : "=v"(r) : "v"(lo), "v"(hi)); return r; }
struct AttnItem { int pat, bh, r, n, dsh; };
__device__ __forceinline__ AttnItem attn_decode(int item) {
    AttnItem a; a.pat = item / 1536; const int rem = item % 1536; a.bh = rem >> 5; const int ci = rem & 31;
    a.dsh = 2 * a.pat; const int nblk = 32 >> a.dsh; a.r = ci / nblk; a.n = ci % nblk; return a;
}
__device__ __forceinline__ void attn_issue(const AttnItem& a, const bf16_t* qb, const bf16_t* kb, const bf16_t* vb, int tid, int w, int l15, int g, u32x4 (&kr)[8], u32x4 (&vr)[8], bf16x8 (&qf)[4]) {
    const size_t hb = (size_t)a.bh * S;
#pragma unroll
    for (int i = 0; i < 8; ++i) { const int ch = i * NTHR + tid, kk = ch >> 4, c = ch & 15;
        if (a.n > 0 || kk >= 128) { const int tp = (((a.n - 1) * 128 + kk) << a.dsh) + a.r;
            kr[i] = *(const u32x4*)(kb + (hb + tp) * E + c * 8); vr[i] = *(const u32x4*)(vb + (hb + tp) * E + c * 8); } }
    const int tq = ((a.n * 128 + 16 * w + l15) << a.dsh) + a.r;
#pragma unroll
    for (int ks = 0; ks < 4; ++ks) qf[ks] = *(const bf16x8*)(qb + (hb + tq) * E + 32 * ks + 8 * g);
}
__device__ __forceinline__ void phase_attn(const Params& p, unsigned char* lds_) {
    LAS unsigned char* lds = (LAS unsigned char*)lds_;
    const int tid = threadIdx.x, lane = tid & 63, w = __builtin_amdgcn_readfirstlane(tid >> 6), l15 = lane & 15, g = lane >> 4;
    const bf16_t* qb = (const bf16_t*)(p.ws + OFF_QKV); const bf16_t* kb = (const bf16_t*)(p.ws + OFF_QKV + QKV_ONE); const bf16_t* vb = (const bf16_t*)(p.ws + OFF_QKV + 2 * QKV_ONE);
    float* lse = (float*)(p.ws + OFF_LSE);
    const int G = gridDim.x, vcu = (G % 8 == 0) ? (int)(blockIdx.x & 7) * (G >> 3) + (int)(blockIdx.x >> 3) : (int)blockIdx.x;
    const float NEG = -__builtin_inff();
    constexpr int NITEMS = 3 * 48 * 32;
    u32x4 kr[8], vr[8]; bf16x8 qn[4];
    if (vcu < NITEMS) attn_issue(attn_decode(vcu), qb, kb, vb, tid, w, l15, g, kr, vr, qn);
    for (int item = vcu; item < NITEMS; item += G) {
        const AttnItem a = attn_decode(item);
        const int pat = a.pat, bh = a.bh, r = a.r, n = a.n, dsh = a.dsh;
        __syncthreads();
#pragma unroll
        for (int i = 0; i < 8; ++i) { const int ch = i * NTHR + tid, kk = ch >> 4, c = ch & 15;
            if (n > 0 || kk >= 128) { *(LAS u32x4*)(lds + kk * 256 + ((c ^ (kk & 15)) << 4)) = kr[i]; *(LAS u32x4*)(lds + ATT_VOFF + kk * ATT_VSTRIDE + c * 16) = vr[i]; } }
        bf16x8 qf[4];
#pragma unroll
        for (int ks = 0; ks < 4; ++ks) { qf[ks] = qn[ks]; asm volatile("" : "+v"(qf[ks])); }
        __syncthreads();
        if (item + G < NITEMS) attn_issue(attn_decode(item + G), qb, kb, vb, tid, w, l15, g, kr, vr, qn);
        const int jj = 16 * w + l15, tq = ((n * 128 + jj) << dsh) + r;
        const int s0 = w >> 1;
        f32x4 sA[5], sB[5];
#define ATT_LDK(dst, step_, kp_) do { const int _kA = 32 * (step_) + l15, _kB = _kA + 16; _Pragma("unroll") for (int q = 0; q < 2; ++q) { const int ks = 2 * (kp_) + q; \
            dst[2 * q] = *(const LAS bf16x8*)(lds + _kA * 256 + (((4 * ks + g) ^ (_kA & 15)) << 4)); dst[2 * q + 1] = *(const LAS bf16x8*)(lds + _kB * 256 + (((4 * ks + g) ^ (_kB & 15)) << 4)); } } while (0)
        bf16x8 kc[4], kn[4];
        ATT_LDK(kc, s0, 0);
#pragma unroll
        for (int gi = 0; gi < 10; ++gi) {
            const int si = gi >> 1, kp = gi & 1, step = s0 + si;
            if (gi < 9) ATT_LDK(kn, s0 + ((gi + 1) >> 1), (gi + 1) & 1);
            __builtin_amdgcn_sched_barrier(0);
            if (kp == 0) { sA[si] = (f32x4){0.f, 0.f, 0.f, 0.f}; sB[si] = (f32x4){0.f, 0.f, 0.f, 0.f}; }
            if (!(n == 0 && step < 4)) {
#pragma unroll
                for (int q = 0; q < 2; ++q) { sA[si] = __builtin_amdgcn_mfma_f32_16x16x32_bf16(kc[2 * q], qf[2 * kp + q], sA[si], 0, 0, 0); sB[si] = __builtin_amdgcn_mfma_f32_16x16x32_bf16(kc[2 * q + 1], qf[2 * kp + q], sB[si], 0, 0, 0); } }
            if (kp == 1 && (n == 0 && step < 4)) { sA[si] = (f32x4){NEG, NEG, NEG, NEG}; sB[si] = (f32x4){NEG, NEG, NEG, NEG}; }
            if (kp == 1 && (si == 0 || si == 4)) {
#pragma unroll
                for (int rg = 0; rg < 4; ++rg) { const int ka = 32 * step + 4 * g + rg, kb2 = ka + 16;
                    const bool oka = (unsigned)(ka - jj) <= 128u, okb = (unsigned)(kb2 - jj) <= 128u;
                    sA[si][rg] = oka ? sA[si][rg] : NEG; sB[si][rg] = okb ? sB[si][rg] : NEG; } }
            if (gi < 9) {
#pragma unroll
                for (int q = 0; q < 4; ++q) kc[q] = kn[q]; }
        }
#undef ATT_LDK
        float m = NEG;
#pragma unroll
        for (int si = 0; si < 5; ++si)
#pragma unroll
            for (int rg = 0; rg < 4; ++rg) m = fmaxf(m, fmaxf(sA[si][rg], sB[si][rg]));
        m = fmaxf(m, __shfl_xor(m, 16)); m = fmaxf(m, __shfl_xor(m, 32));
        float l = 0.f; const float mL = m * 1.4426950408889634f;
#pragma unroll
        for (int si = 0; si < 5; ++si)
#pragma unroll
            for (int rg = 0; rg < 4; ++rg) { sA[si][rg] = __builtin_amdgcn_exp2f(sA[si][rg] * 1.4426950408889634f - mL); sB[si][rg] = __builtin_amdgcn_exp2f(sB[si][rg] * 1.4426950408889634f - mL); l += sA[si][rg] + sB[si][rg]; }
        l += __shfl_xor(l, 16); l += __shfl_xor(l, 32);
        f32x4 o[8];
#pragma unroll
        for (int dt = 0; dt < 8; ++dt) o[dt] = (f32x4){0.f, 0.f, 0.f, 0.f};
#define ATT_LDV(dst, step_, hf_) do { LAS unsigned char* _vr = lds + ATT_VOFF + (32 * (step_) + 4 * g + (l15 >> 2)) * ATT_VSTRIDE + (l15 & 3) * 8 + (hf_) * 128; _Pragma("unroll") for (int q = 0; q < 4; ++q) { \
            dst[2 * q] = __builtin_amdgcn_ds_read_tr16_b64_v4i16((LAS s16x4*)(_vr + q * 32)); dst[2 * q + 1] = __builtin_amdgcn_ds_read_tr16_b64_v4i16((LAS s16x4*)(_vr + q * 32 + 16 * ATT_VSTRIDE)); } } while (0)
        bf16x8 pfa[5];
#pragma unroll
        for (int si = 0; si < 5; ++si) { u32x4 pw; pw.x = cvt_pk(sA[si][0], sA[si][1]); pw.y = cvt_pk(sA[si][2], sA[si][3]); pw.z = cvt_pk(sB[si][0], sB[si][1]); pw.w = cvt_pk(sB[si][2], sB[si][3]); pfa[si] = *reinterpret_cast<const bf16x8*>(&pw); }
        s16x4 vc[8], vn[8];
        ATT_LDV(vc, s0, 0);
#pragma unroll
        for (int gi = 0; gi < 10; ++gi) {
            const int si = gi >> 1, hf = gi & 1, step = s0 + si;
            if (gi < 9) ATT_LDV(vn, s0 + ((gi + 1) >> 1), (gi + 1) & 1);
            __builtin_amdgcn_sched_barrier(0);
            if (!(n == 0 && step < 4)) {
#pragma unroll
                for (int q = 0; q < 4; ++q) { const s16x4 v0 = vc[2 * q], v1 = vc[2 * q + 1];
                    const bf16x8 vf = {v0[0], v0[1], v0[2], v0[3], v1[0], v1[1], v1[2], v1[3]};
                    o[4 * hf + q] = __builtin_amdgcn_mfma_f32_16x16x32_bf16(vf, pfa[si], o[4 * hf + q], 0, 0, 0); } }
            if (gi < 9) {
#pragma unroll
                for (int q = 0; q < 8; ++q) vc[q] = vn[q]; }
        }
#undef ATT_LDV
        const float il = 1.0f / l; const int b_ = bh / HA, h = bh % HA; const size_t tg = (size_t)b_ * S + tq;
        bf16_t* orow = P_opat(p, pat) + tg * DA + h * E + 4 * g;
#pragma unroll
        for (int dt = 0; dt < 8; ++dt) { u32x2 ww; ww.x = cvt_pk(o[dt][0] * il, o[dt][1] * il); ww.y = cvt_pk(o[dt][2] * il, o[dt][3] * il); *(u32x2*)(orow + 16 * dt) = ww; }
        if (g == 0) lse[((size_t)pat * T + tg) * HA + h] = m + __logf(l);
    }
}

__device__ __forceinline__ void phase_sgu(const Params& p, unsigned char* lds_) {
    LAS unsigned char* lds = (LAS unsigned char*)lds_;
    const int tid = threadIdx.x, lane = tid & 63, w = __builtin_amdgcn_readfirstlane(tid >> 6), l15 = lane & 15, g = lane >> 4;
    const bf16_t* vsb = (const bf16_t*)(p.ws + OFF_VS); const bf16_t* usb = (const bf16_t*)(p.ws + OFF_US); bf16_t* ob = (bf16_t*)(p.ws + OFF_SGUO);
    const bf16_t* sw = (const bf16_t*)(p.ws + OFF_SGUW);
    for (int item = blockIdx.x; item < (T / 128) * HS; item += gridDim.x) {
        const int h = item & 3, t0 = (item >> 2) * 128;
        __syncthreads();
        {
            const int j = tid >> 2, part = tid & 3;
            const u32x4* src = (const u32x4*)(vsb + (size_t)(t0 + j) * DS + h * E + part * 32);
            u32x4 x[4]; float sum = 0.f;
#pragma unroll
            for (int i = 0; i < 4; ++i) { x[i] = src[i]; sum += bflo(x[i].x) + bfhi(x[i].x) + bflo(x[i].y) + bfhi(x[i].y) + bflo(x[i].z) + bfhi(x[i].z) + bflo(x[i].w) + bfhi(x[i].w); }
            sum += __shfl_xor(sum, 1); sum += __shfl_xor(sum, 2);
            const float mu = sum * (1.0f / E); float var = 0.f;
#pragma unroll
            for (int i = 0; i < 4; ++i) { float dd;
                dd = bflo(x[i].x) - mu; var += dd * dd; dd = bfhi(x[i].x) - mu; var += dd * dd; dd = bflo(x[i].y) - mu; var += dd * dd; dd = bfhi(x[i].y) - mu; var += dd * dd;
                dd = bflo(x[i].z) - mu; var += dd * dd; dd = bfhi(x[i].z) - mu; var += dd * dd; dd = bflo(x[i].w) - mu; var += dd * dd; dd = bfhi(x[i].w) - mu; var += dd * dd; }
            var += __shfl_xor(var, 1); var += __shfl_xor(var, 2);
            const float rs = rsqrtf(var * (1.0f / E) + 1e-5f);
            const float* lg = p.sgu_ln_g + h * E + part * 32; const float* lb = p.sgu_ln_b + h * E + part * 32;
#pragma unroll
            for (int i = 0; i < 4; ++i) { const float4 g0 = *(const float4*)(lg + i * 8), g1 = *(const float4*)(lg + i * 8 + 4), b0 = *(const float4*)(lb + i * 8), b1 = *(const float4*)(lb + i * 8 + 4);
                u32x4 o; o.x = cvt_pk((bflo(x[i].x) - mu) * rs * g0.x + b0.x, (bfhi(x[i].x) - mu) * rs * g0.y + b0.y); o.y = cvt_pk((bflo(x[i].y) - mu) * rs * g0.z + b0.z, (bfhi(x[i].y) - mu) * rs * g0.w + b0.w);
                o.z = cvt_pk((bflo(x[i].z) - mu) * rs * g1.x + b1.x, (bfhi(x[i].z) - mu) * rs * g1.y + b1.y); o.w = cvt_pk((bflo(x[i].w) - mu) * rs * g1.z + b1.z, (bfhi(x[i].w) - mu) * rs * g1.w + b1.w);
                *(LAS u32x4*)(lds + j * ATT_VSTRIDE + part * 64 + i * 16) = o; }
        }
        __syncthreads();
        f32x4 acc[8];
#pragma unroll
        for (int et = 0; et < 8; ++et) acc[et] = (f32x4){0.f, 0.f, 0.f, 0.f};
        const int irow = 16 * w + l15, nsteps = (16 * w + 15) / 32 + 1;
        const bf16_t* wrow = sw + ((size_t)h * 128 + irow) * 128;
        for (int st = 0; st < nsteps; ++st) {
            const u32x2 wa = *(const u32x2*)(wrow + 32 * st + 4 * g), wb = *(const u32x2*)(wrow + 32 * st + 16 + 4 * g);
            u32x4 wf4; wf4.x = wa.x; wf4.y = wa.y; wf4.z = wb.x; wf4.w = wb.y;
            const bf16x8 wf = *reinterpret_cast<const bf16x8*>(&wf4);
            LAS unsigned char* vrow = lds + (32 * st + 4 * g + (l15 >> 2)) * ATT_VSTRIDE + (l15 & 3) * 8;
#pragma unroll
            for (int et = 0; et < 8; ++et) {
                const s16x4 v0 = __builtin_amdgcn_ds_read_tr16_b64_v4i16((LAS s16x4*)(vrow + et * 32));
                const s16x4 v1 = __builtin_amdgcn_ds_read_tr16_b64_v4i16((LAS s16x4*)(vrow + et * 32 + 16 * ATT_VSTRIDE));
                const bf16x8 vf = {v0[0], v0[1], v0[2], v0[3], v1[0], v1[1], v1[2], v1[3]};
                acc[et] = __builtin_amdgcn_mfma_f32_16x16x32_bf16(vf, wf, acc[et], 0, 0, 0); }
        }
        const float bias = p.sgu_b[h * 128 + irow];
        const size_t base = (size_t)(t0 + irow) * DS + h * E + 4 * g;
#pragma unroll
        for (int et = 0; et < 8; ++et) { const u32x2 uu = *(const u32x2*)(usb + base + 16 * et);
            u32x2 oo; oo.x = cvt_pk(bflo(uu.x) * (acc[et][0] + bias), bfhi(uu.x) * (acc[et][1] + bias)); oo.y = cvt_pk(bflo(uu.y) * (acc[et][2] + bias), bfhi(uu.y) * (acc[et][3] + bias));
            *(u32x2*)(ob + base + 16 * et) = oo; }
    }
}

__device__ __forceinline__ void phase_combine(const Params& p) {
    const int lane = threadIdx.x & 63, gw = blockIdx.x * NWV + __builtin_amdgcn_readfirstlane(threadIdx.x >> 6), nw = gridDim.x * NWV;
    const float* lse = (const float*)(p.ws + OFF_LSE);
    const bf16_t* sg = (const bf16_t*)(p.ws + OFF_SGUO);
    const bf16_t* o0 = P_opat(p, 0); const bf16_t* o1 = P_opat(p, 1); const bf16_t* o2 = P_opat(p, 2);
    float ga[24], gs[8];
#pragma unroll
    for (int i = 0; i < 3; ++i) { const int col0 = (lane + 64 * i) * 8; const float4 g0 = *(const float4*)(p.g_attn_out + col0), g1 = *(const float4*)(p.g_attn_out + col0 + 4);
        ga[i * 8 + 0] = g0.x; ga[i * 8 + 1] = g0.y; ga[i * 8 + 2] = g0.z; ga[i * 8 + 3] = g0.w; ga[i * 8 + 4] = g1.x; ga[i * 8 + 5] = g1.y; ga[i * 8 + 6] = g1.z; ga[i * 8 + 7] = g1.w; }
    { const float4 g0 = *(const float4*)(p.g_sgu_out + lane * 8), g1 = *(const float4*)(p.g_sgu_out + lane * 8 + 4);
      gs[0] = g0.x; gs[1] = g0.y; gs[2] = g0.z; gs[3] = g0.w; gs[4] = g1.x; gs[5] = g1.y; gs[6] = g1.z; gs[7] = g1.w; }
    u32x4 xa[3], xb[3], xc[3], xs; float l0 = 0.f, l1 = 0.f, l2 = 0.f;
#define CB_LOAD(tt) do { _Pragma("unroll") for (int i = 0; i < 3; ++i) { const size_t o = (size_t)(tt) * DA + (lane + 64 * i) * 8; xa[i] = *(const u32x4*)(o0 + o); xb[i] = *(const u32x4*)(o1 + o); xc[i] = *(const u32x4*)(o2 + o); } \
        xs = *(const u32x4*)(sg + (size_t)(tt) * DS + lane * 8); \
        if (lane < HA) { l0 = lse[((size_t)0 * T + (tt)) * HA + lane]; l1 = lse[((size_t)1 * T + (tt)) * HA + lane]; l2 = lse[((size_t)2 * T + (tt)) * HA + lane]; } } while (0)
    if (gw < T) CB_LOAD(gw);
    for (int t = gw; t < T; t += nw) {
        float w0 = 0.f, w1 = 0.f, w2 = 0.f;
        if (lane < HA) { const float m = fmaxf(l0, fmaxf(l1, l2)); const float e0 = __expf(l0 - m), e1 = __expf(l1 - m), e2 = __expf(l2 - m); const float is = 1.0f / (e0 + e1 + e2);
            w0 = e0 * is; w1 = e1 * is; w2 = e2 * is; }
        float av[3][8]; float ss = 0.f;
#pragma unroll
        for (int i = 0; i < 3; ++i) { const int hh = ((lane + 64 * i) * 8) >> 7;
            const float a0 = __shfl(w0, hh), a1 = __shfl(w1, hh), a2 = __shfl(w2, hh);
            const u32x4 x0 = xa[i], x1 = xb[i], x2 = xc[i];
            av[i][0] = a0 * bflo(x0.x) + a1 * bflo(x1.x) + a2 * bflo(x2.x); av[i][1] = a0 * bfhi(x0.x) + a1 * bfhi(x1.x) + a2 * bfhi(x2.x);
            av[i][2] = a0 * bflo(x0.y) + a1 * bflo(x1.y) + a2 * bflo(x2.y); av[i][3] = a0 * bfhi(x0.y) + a1 * bfhi(x1.y) + a2 * bfhi(x2.y);
            av[i][4] = a0 * bflo(x0.z) + a1 * bflo(x1.z) + a2 * bflo(x2.z); av[i][5] = a0 * bfhi(x0.z) + a1 * bfhi(x1.z) + a2 * bfhi(x2.z);
            av[i][6] = a0 * bflo(x0.w) + a1 * bflo(x1.w) + a2 * bflo(x2.w); av[i][7] = a0 * bfhi(x0.w) + a1 * bfhi(x1.w) + a2 * bfhi(x2.w);
#pragma unroll
            for (int j = 0; j < 8; ++j) ss += av[i][j] * av[i][j]; }
        float sv[8] = {bflo(xs.x), bfhi(xs.x), bflo(xs.y), bfhi(xs.y), bflo(xs.z), bfhi(xs.z), bflo(xs.w), bfhi(xs.w)}; float s2 = 0.f;
#pragma unroll
        for (int j = 0; j < 8; ++j) s2 += sv[j] * sv[j];
        if (t + nw < T) CB_LOAD(t + nw);
        ss = wave_sum(ss); const float rs = rsqrtf(ss * (1.0f / DA) + 1e-6f);
        s2 = wave_sum(s2); const float r2 = rsqrtf(s2 * (1.0f / DS) + 1e-6f);
        float m = 0.f;
#pragma unroll
        for (int i = 0; i < 3; ++i)
#pragma unroll
            for (int j = 0; j < 8; ++j) { av[i][j] = av[i][j] * rs * ga[i * 8 + j]; m = fmaxf(m, fabsf(av[i][j])); }
#pragma unroll
        for (int j = 0; j < 8; ++j) { sv[j] = sv[j] * r2 * gs[j]; m = fmaxf(m, fabsf(sv[j])); }
        m = wave_max(m); const float sc8 = m > 0.f ? 127.0f / m : 0.f;
        unsigned char* mrow = p.ws + OFF_QKV + (size_t)t * D;
#pragma unroll
        for (int i = 0; i < 3; ++i) { u32x2 w; w.x = q8pack(av[i][0] * sc8, av[i][1] * sc8, av[i][2] * sc8, av[i][3] * sc8, 0); w.y = q8pack(av[i][4] * sc8, av[i][5] * sc8, av[i][6] * sc8, av[i][7] * sc8, 0);
            *(u32x2*)(mrow + (lane + 64 * i) * 8) = w; }
        { u32x2 w; w.x = q8pack(sv[0] * sc8, sv[1] * sc8, sv[2] * sc8, sv[3] * sc8, 0); w.y = q8pack(sv[4] * sc8, sv[5] * sc8, sv[6] * sc8, sv[7] * sc8, 0);
          *(u32x2*)(mrow + DA + lane * 8) = w; }
        if (lane == 0) ((float*)(p.ws + OFF_SCL))[SCL_MS + t] = m * (1.0f / 127.0f);
    }
#undef CB_LOAD
}

__device__ __forceinline__ int f2key(float f) { const int b = __float_as_int(f); return b ^ ((b >> 31) & 0x7fffffff); }
__device__ __forceinline__ float key2f(int k) { return __int_as_float(k ^ ((k >> 31) & 0x7fffffff)); }
typedef int i32x16 __attribute__((ext_vector_type(16)));
typedef float f32x16v __attribute__((ext_vector_type(16)));
#define TK_CE(v, i, l) do { const int _a = v[i], _b = v[l]; v[i] = max(_a, _b); v[l] = min(_a, _b); } while (0)
__device__ __forceinline__ i32x16 sort16_desc(i32x16 v) {
#pragma unroll
    for (int lk = 1; lk <= 4; ++lk)
#pragma unroll
        for (int lj = 3; lj >= 0; --lj) { if (lj >= lk) continue; const int k = 1 << lk, j = 1 << lj;
#pragma unroll
            for (int i = 0; i < 16; ++i) { const int l = i ^ j; if (l > i) { if ((i & k) == 0) TK_CE(v, i, l); else TK_CE(v, l, i); } } }
    return v;
}
__device__ __forceinline__ i32x16 bitonic_merge16_desc(i32x16 v) {
#pragma unroll
    for (int lj = 3; lj >= 0; --lj) { const int j = 1 << lj;
#pragma unroll
        for (int i = 0; i < 16; ++i) { const int l = i ^ j; if (l > i) TK_CE(v, i, l); } }
    return v;
}
__device__ __forceinline__ i32x16 merge_top16(i32x16 a, i32x16 b) {
#pragma unroll
    for (int i = 0; i < 16; ++i) a[i] = max(a[i], b[15 - i]);
    return bitonic_merge16_desc(a);
}
__device__ __forceinline__ i32x16 xlane_merge_top16(i32x16 a, int xr) {
    i32x16 b;
#pragma unroll
    for (int i = 0; i < 16; ++i) b[i] = __shfl_xor(a[i], xr);
    return merge_top16(a, b);
}
__device__ __forceinline__ int sel2i(bool c, int x, int y) { return c ? y : x; }
__device__ __forceinline__ int sel16(i32x16 v, int i) {
    const bool c0 = (i & 1) != 0, c1 = (i & 2) != 0, c2 = (i & 4) != 0, c3 = (i & 8) != 0;
    const int a0 = sel2i(c0, v[0], v[1]), a1 = sel2i(c0, v[2], v[3]), a2 = sel2i(c0, v[4], v[5]), a3 = sel2i(c0, v[6], v[7]);
    const int a4 = sel2i(c0, v[8], v[9]), a5 = sel2i(c0, v[10], v[11]), a6 = sel2i(c0, v[12], v[13]), a7 = sel2i(c0, v[14], v[15]);
    const int b0 = sel2i(c1, a0, a1), b1 = sel2i(c1, a2, a3), b2 = sel2i(c1, a4, a5), b3 = sel2i(c1, a6, a7);
    const int d0 = sel2i(c2, b0, b1), d1 = sel2i(c2, b2, b3);
    return sel2i(c3, d0, d1);
}
__device__ __forceinline__ int sel4i(int g, int a, int b, int c, int d) { return g == 0 ? a : (g == 1 ? b : (g == 2 ? c : d)); }
__device__ __forceinline__ float sel4f(int g, float a, float b, float c, float d) { return g == 0 ? a : (g == 1 ? b : (g == 2 ? c : d)); }
constexpr int TK_TAB[64] = {
    0x00, 0x01, 0x02, 0x03, 0x04, 0x05, 0x06, 0x07, 0x08, 0x09, 0x0A, 0x0B, 0x0C, 0x0D, 0x0E, 0x0F,
    0x10, 0x11, 0x12, 0x13, 0x14, 0x15, 0x16, 0x17, 0x40, 0x41, 0x42, 0x80, 0x90, 0xFF, 0xFF, 0xFF,
    0x20, 0x21, 0x22, 0x23, 0x24, 0x30, 0x31, 0x32, 0x33, 0x50, 0x51, 0xA0, 0xB0, 0xFF, 0xFF, 0xFF,
    0x60, 0x61, 0x70, 0x71, 0xC0, 0xD0, 0xE0, 0xF0, 0xFF, 0xFF, 0xFF, 0xFF, 0xFF, 0xFF, 0xFF, 0xFF};
template <int C> __device__ __forceinline__ int tk_make_cand(i32x16 sp0, i32x16 sp1, int g) {
    constexpr int NONE = (int)0x80000000;
    constexpr int e0 = TK_TAB[C], e1 = TK_TAB[16 + C], e2 = TK_TAB[32 + C], e3 = TK_TAB[48 + C];
    constexpr int r0 = (e0 >> 4) & 15, r1 = e1 == 0xFF ? 0 : (e1 >> 4) & 15, r2 = e2 == 0xFF ? 0 : (e2 >> 4) & 15, r3 = e3 == 0xFF ? 0 : (e3 >> 4) & 15;
    constexpr int c0 = e0 & 15, c1 = e1 == 0xFF ? 0 : e1 & 15, c2 = e2 == 0xFF ? 0 : e2 & 15, c3 = e3 == 0xFF ? 0 : e3 & 15;
    const int av = sel4i(g, sp0[r0], sp0[r1], sp0[r2], sp0[r3]);
    const int bv = sel4i(g, sp1[c0], sp1[c1], sp1[c2], sp1[c3]);
    const int code = sel4i(g, e0, e1, e2, e3);
    const float sum = key2f(av & ~127) + key2f(bv & ~127);
    return code == 0xFF ? NONE : ((f2key(sum) & ~255) | code);
}
__device__ __forceinline__ void phase_topk(const Params& p, unsigned char* lds_) {
    LAS unsigned char* lds = (LAS unsigned char*)lds_;
    const int tid = threadIdx.x, lane = tid & 63, w = __builtin_amdgcn_readfirstlane(tid >> 6), l15 = lane & 15, g = lane >> 4;
    const bf16_t* pq = (const bf16_t*)(p.ws + OFF_QKV + (size_t)T * D * 2); const bf16_t* skb = (const bf16_t*)(p.ws + OFF_SUBK);
    int* idxo = (int*)(p.ws + OFF_IDX); float* gato = (float*)(p.ws + OFF_GATE);
    int cur_h = -1;
    for (int task = blockIdx.x; task < (T / 128) * PH; task += gridDim.x) {
        const int h = task & 7, tt = task >> 3;
        if (h != cur_h) {
            __syncthreads();
#pragma unroll
            for (int i = 0; i < 8; ++i) { const int ch = i * NTHR + tid, row = ch >> 4, c = ch & 15;
                *(LAS u32x4*)(lds + row * 256 + ((c ^ (row & 15)) << 4)) = *(const u32x4*)(skb + ((size_t)h * 256 + row) * 128 + c * 8); }
            __syncthreads();
            cur_h = h;
        }
        const int t = tt * 128 + 16 * w + l15;
        i32x16 sp0, sp1;
#pragma unroll
        for (int pp = 0; pp < 2; ++pp) {
            bf16x8 bq[4];
#pragma unroll
            for (int ks = 0; ks < 4; ++ks) bq[ks] = *(const bf16x8*)(pq + (size_t)t * D + h * 256 + pp * 128 + 32 * ks + 8 * g);
            i32x16 ka, kb2;
#pragma unroll
            for (int kt = 0; kt < 8; ++kt) {
                f32x4 a = {0.f, 0.f, 0.f, 0.f};
                const int row = pp * 128 + 16 * kt + l15;
#pragma unroll
                for (int ks = 0; ks < 4; ++ks) { const bf16x8 kf = *(const LAS bf16x8*)(lds + row * 256 + (((4 * ks + g) ^ (row & 15)) << 4)); a = __builtin_amdgcn_mfma_f32_16x16x32_bf16(kf, bq[ks], a, 0, 0, 0); }
#pragma unroll
                for (int rg = 0; rg < 4; ++rg) { const int key = (f2key(a[rg]) & ~127) | (16 * kt + rg + 4 * g);
                    if (kt < 4) ka[kt * 4 + rg] = key; else kb2[(kt - 4) * 4 + rg] = key; }
            }
            ka = merge_top16(sort16_desc(ka), sort16_desc(kb2));
            ka = xlane_merge_top16(ka, 16); ka = xlane_merge_top16(ka, 32);
            if (pp == 0) sp0 = ka; else sp1 = ka;
        }
        i32x16 cd;
        cd[0] = tk_make_cand<0>(sp0, sp1, g); cd[1] = tk_make_cand<1>(sp0, sp1, g); cd[2] = tk_make_cand<2>(sp0, sp1, g); cd[3] = tk_make_cand<3>(sp0, sp1, g);
        cd[4] = tk_make_cand<4>(sp0, sp1, g); cd[5] = tk_make_cand<5>(sp0, sp1, g); cd[6] = tk_make_cand<6>(sp0, sp1, g); cd[7] = tk_make_cand<7>(sp0, sp1, g);
        cd[8] = tk_make_cand<8>(sp0, sp1, g); cd[9] = tk_make_cand<9>(sp0, sp1, g); cd[10] = tk_make_cand<10>(sp0, sp1, g); cd[11] = tk_make_cand<11>(sp0, sp1, g);
        cd[12] = tk_make_cand<12>(sp0, sp1, g); cd[13] = tk_make_cand<13>(sp0, sp1, g); cd[14] = tk_make_cand<14>(sp0, sp1, g); cd[15] = tk_make_cand<15>(sp0, sp1, g);
        cd = sort16_desc(cd); cd = xlane_merge_top16(cd, 16); cd = xlane_merge_top16(cd, 32);
        f32x16v ex; float sum = 0.f; const float m0 = key2f(cd[0] & ~255);
#pragma unroll
        for (int i = 0; i < 16; ++i) { ex[i] = __expf(key2f(cd[i] & ~255) - m0); sum += ex[i]; }
        const float is = 1.0f / sum;
        int oi[4]; float og[4];
#pragma unroll
        for (int c = 0; c < 4; ++c) {
            const int key = sel4i(g, cd[c], cd[4 + c], cd[8 + c], cd[12 + c]);
            const float e = sel4f(g, ex[c], ex[4 + c], ex[8 + c], ex[12 + c]);
            const int i1 = sel16(sp0, (key >> 4) & 15) & 127, i2 = sel16(sp1, key & 15) & 127;
            oi[c] = i1 * 128 + i2; og[c] = e * is; }
        *(int4*)(idxo + (size_t)t * 128 + h * PK + 4 * g) = make_int4(oi[0], oi[1], oi[2], oi[3]);
        *(float4*)(gato + (size_t)t * 128 + h * PK + 4 * g) = make_float4(og[0], og[1], og[2], og[3]);
    }
}

typedef float f32x2v __attribute__((ext_vector_type(2)));
typedef float f32x8v __attribute__((ext_vector_type(8)));
__device__ __forceinline__ int dot16_i8(const u32x4 w, const u32x4 x) {
    int s = __builtin_amdgcn_sdot4((int)w.x, (int)x.x, 0, false); s = __builtin_amdgcn_sdot4((int)w.y, (int)x.y, s, false);
    s = __builtin_amdgcn_sdot4((int)w.z, (int)x.z, s, false); return __builtin_amdgcn_sdot4((int)w.w, (int)x.w, s, false);
}
__device__ __forceinline__ void axpy16_u8(const u32x4 w, float cw, float* acc) {
    float f[16];
#pragma unroll
    for (int q = 0; q < 4; ++q) { const unsigned ww = w[q];
        f[4 * q + 0] = __uint_as_float(__builtin_amdgcn_perm(0x47000000u, ww, 0x07060004u)); f[4 * q + 1] = __uint_as_float(__builtin_amdgcn_perm(0x47000000u, ww, 0x07060104u));
        f[4 * q + 2] = __uint_as_float(__builtin_amdgcn_perm(0x47000000u, ww, 0x07060204u)); f[4 * q + 3] = __uint_as_float(__builtin_amdgcn_perm(0x47000000u, ww, 0x07060304u)); }
    __builtin_amdgcn_sched_barrier(0);
#pragma unroll
    for (int j = 0; j < 16; ++j) acc[j] = fmaf(cw, f[j], acc[j]);
    __builtin_amdgcn_sched_barrier(0);
}
typedef _Float16 h2v __attribute__((ext_vector_type(2)));
__device__ __forceinline__ void axpy16x2_u8(const u32x4 wa, const u32x4 wb, h2v cwp, float* acc) {
#pragma unroll
    for (int q = 0; q < 4; ++q) { const unsigned ua = wa[q], ub = wb[q];
        unsigned p0 = __builtin_amdgcn_perm(ub, ua, 0x0C040C00u), p1 = __builtin_amdgcn_perm(ub, ua, 0x0C050C01u), p2 = __builtin_amdgcn_perm(ub, ua, 0x0C060C02u), p3 = __builtin_amdgcn_perm(ub, ua, 0x0C070C03u);
        acc[4 * q + 0] = __builtin_amdgcn_fdot2(*reinterpret_cast<h2v*>(&p0), cwp, acc[4 * q + 0], false); acc[4 * q + 1] = __builtin_amdgcn_fdot2(*reinterpret_cast<h2v*>(&p1), cwp, acc[4 * q + 1], false);
        acc[4 * q + 2] = __builtin_amdgcn_fdot2(*reinterpret_cast<h2v*>(&p2), cwp, acc[4 * q + 2], false); acc[4 * q + 3] = __builtin_amdgcn_fdot2(*reinterpret_cast<h2v*>(&p3), cwp, acc[4 * q + 3], false); }
}
typedef int i32x8v __attribute__((ext_vector_type(8)));
typedef int i32x4v __attribute__((ext_vector_type(4)));
typedef int i32x2v __attribute__((ext_vector_type(2)));
__device__ __forceinline__ int red8_piece(i32x8v r, int lane) {
    const bool b2 = (lane & 4) != 0, b1 = (lane & 2) != 0, b0 = (lane & 1) != 0;
    i32x4v q; i32x2v pp;
#pragma unroll
    for (int k = 0; k < 4; ++k) { const int lo = r[k], hi = r[k + 4]; const int kp = b2 ? hi : lo, sn = b2 ? lo : hi; q[k] = kp + __shfl_xor(sn, 4); }
#pragma unroll
    for (int k = 0; k < 2; ++k) { const int lo = q[k], hi = q[k + 2]; const int kp = b1 ? hi : lo, sn = b1 ? lo : hi; pp[k] = kp + __shfl_xor(sn, 2); }
    const int lo = pp[0], hi = pp[1]; const int kp = b0 ? hi : lo, sn = b0 ? lo : hi;
    return kp + __shfl_xor(sn, 1);
}
constexpr int PEER_CHUNK = 16;
template <int WHICH, int MODE = 0> __device__ __forceinline__ void peer_chunk(const Params& p, int t0, int s, int lane) {
    const int sub = lane >> 3, piece = lane & 7;
    const int* idx = (const int*)(p.ws + OFF_IDX) + sub * 16;
    const unsigned char* tab = p.ws + (WHICH == 0 ? OFF_UTAB : OFF_VTAB) + (size_t)s * SLICE_BYTES;
    const unsigned pof = (unsigned)piece * 16u;
    const unsigned char* xbase = p.ws + OFF_US + s * 128 + piece * 16;
    const unsigned* wbase = (const unsigned*)(p.ws + OFF_GATE) + sub * 8;
    int4 ec[4], en[4];
    u32x4 wA[8], wB[8];
    u32x4 xr; u32x4 cwv[2]; float cws = 0.f;
#define PEER_RD(ev) (*(const u32x4*)(tab + (((unsigned)(ev) << 7) + pof)))
#define PEER_LD8(dst, ev0, ev1) do { if (MODE == 2) { dst[0] = (u32x4){(unsigned)ev0.x, (unsigned)ev0.y, 0x38383838u, 0x30303030u}; dst[1] = dst[0]; dst[2] = dst[0]; dst[3] = dst[0]; dst[4] = (u32x4){(unsigned)ev1.x, (unsigned)ev1.y, 0x38383838u, 0x30303030u}; dst[5] = dst[4]; dst[6] = dst[4]; dst[7] = dst[4]; break; } \
        dst[0] = PEER_RD(ev0.x); dst[1] = PEER_RD(ev0.y); dst[2] = PEER_RD(ev0.z); dst[3] = PEER_RD(ev0.w); dst[4] = PEER_RD(ev1.x); dst[5] = PEER_RD(ev1.y); dst[6] = PEER_RD(ev1.z); dst[7] = PEER_RD(ev1.w); } while (0)
#pragma unroll
    for (int q = 0; q < 4; ++q) ec[q] = *(const int4*)(idx + (size_t)t0 * 128 + 4 * q);
    PEER_LD8(wA, ec[0], ec[1]);
    if (WHICH == 0) { xr = *(const u32x4*)(xbase + (size_t)t0 * D); }
    else {
#pragma unroll
        for (int q = 0; q < 2; ++q) cwv[q] = *(const u32x4*)(wbase + (size_t)t0 * 128 + 4 * q);
        cws = __uint_as_float(wbase[(size_t)t0 * 128 + 64 - sub * 7]); }
#pragma unroll
    for (int q = 0; q < 4; ++q) en[q] = *(const int4*)(idx + (size_t)(t0 + 1) * 128 + 4 * q);
#pragma unroll 1
    for (int k = 0; k < PEER_CHUNK; ++k) {
        const int t = t0 + k;
        PEER_LD8(wB, ec[2], ec[3]);
        if (WHICH == 0) {
            const u32x4 xc = xr;
            i32x8v r0, r1;
#pragma unroll
            for (int i = 0; i < 8; ++i) r0[i] = MODE == 1 ? (int)(wA[i].x ^ wA[i].y ^ wA[i].z ^ wA[i].w ^ xc.x) : dot16_i8(wA[i], xc);
            if (k < PEER_CHUNK - 1) { PEER_LD8(wA, en[0], en[1]); xr = *(const u32x4*)(xbase + (size_t)(t + 1) * D); }
#pragma unroll
            for (int i = 0; i < 8; ++i) r1[i] = MODE == 1 ? (int)(wB[i].x ^ wB[i].y ^ wB[i].z ^ wB[i].w ^ xc.y) : dot16_i8(wB[i], xc);
            const int v0 = red8_piece(r0, lane), v1 = red8_piece(r1, lane);
            int* part = (int*)(p.ws + OFF_QKV) + ((size_t)s * T + t) * 128 + sub * 16 + piece;
            part[0] = v0; part[8] = v1;
        } else {
            float acc[16];
#pragma unroll
            for (int j = 0; j < 16; ++j) acc[j] = 0.f;
            const u32x4 c0 = cwv[0], c1 = cwv[1]; const float cwsum = cws;
            h2v cp[8];
            { unsigned u0 = c0.x, u1 = c0.y, u2 = c0.z, u3 = c0.w, u4 = c1.x, u5 = c1.y, u6 = c1.z, u7 = c1.w;
              cp[0] = *reinterpret_cast<h2v*>(&u0); cp[1] = *reinterpret_cast<h2v*>(&u1); cp[2] = *reinterpret_cast<h2v*>(&u2); cp[3] = *reinterpret_cast<h2v*>(&u3);
              cp[4] = *reinterpret_cast<h2v*>(&u4); cp[5] = *reinterpret_cast<h2v*>(&u5); cp[6] = *reinterpret_cast<h2v*>(&u6); cp[7] = *reinterpret_cast<h2v*>(&u7); }
            axpy16x2_u8(wA[0], wA[1], cp[0], acc); axpy16x2_u8(wA[2], wA[3], cp[1], acc); axpy16x2_u8(wA[4], wA[5], cp[2], acc); axpy16x2_u8(wA[6], wA[7], cp[3], acc);
            if (k < PEER_CHUNK - 1) { PEER_LD8(wA, en[0], en[1]);
#pragma unroll
                for (int q = 0; q < 2; ++q) cwv[q] = *(const u32x4*)(wbase + (size_t)(t + 1) * 128 + 4 * q);
                cws = __uint_as_float(wbase[(size_t)(t + 1) * 128 + 64 - sub * 7]); }
            axpy16x2_u8(wB[0], wB[1], cp[4], acc); axpy16x2_u8(wB[2], wB[3], cp[5], acc); axpy16x2_u8(wB[4], wB[5], cp[6], acc); axpy16x2_u8(wB[6], wB[7], cp[7], acc);
            f32x16v a16;
#pragma unroll
            for (int j = 0; j < 16; ++j) a16[j] = fmaf(acc[j], 65536.0f, -0.5f * cwsum);
            const bool b3 = (lane & 8) != 0;
            f32x8v q8; f32x4 q4; f32x2v q2;
#pragma unroll
            for (int j = 0; j < 8; ++j) { const auto sw = __builtin_amdgcn_permlane32_swap(__float_as_uint(a16[j]), __float_as_uint(a16[j + 8]), false, false); q8[j] = __uint_as_float(sw[0]) + __uint_as_float(sw[1]); }
#pragma unroll
            for (int j = 0; j < 4; ++j) { const auto sw = __builtin_amdgcn_permlane16_swap(__float_as_uint(q8[j]), __float_as_uint(q8[j + 4]), false, false); q4[j] = __uint_as_float(sw[0]) + __uint_as_float(sw[1]); }
#pragma unroll
            for (int j = 0; j < 2; ++j) { const float lo = q4[j], hi = q4[j + 2]; const float kp = b3 ? hi : lo, sn = b3 ? lo : hi; q2[j] = kp + __shfl_xor(sn, 8); }
            bf16_t* po = (bf16_t*)(p.ws + OFF_A) + (size_t)t * D + s * 128 + piece * 16 + 2 * sub;
            *(unsigned*)po = cvt_pk(q2[0], q2[1]);
        }
#pragma unroll
        for (int q = 0; q < 4; ++q) ec[q] = en[q];
        if (k < PEER_CHUNK - 2) {
#pragma unroll
            for (int q = 0; q < 4; ++q) en[q] = *(const int4*)(idx + (size_t)(t + 2) * 128 + 4 * q); }
    }
#undef PEER_LD8
#undef PEER_RD
}
template <int WHICH, int MODE = 0, int QSET = WHICH> __device__ __forceinline__ void phase_peer_sliced(const Params& p, unsigned xcc) {
    unsigned* qh = (unsigned*)(p.ws + OFF_CTL + OFF_QUEUE) + QSET * 16 * 64;
    const int lane = threadIdx.x & 63;
    for (int rnd = 0; rnd < 16; ++rnd) {
        const int s = (int)((xcc + 8u * (unsigned)(rnd & 1) + (unsigned)(rnd >> 1)) & 15u);
        unsigned c = 0; if (lane == 0) c = atomicAdd(qh + s * 64, 1u);
        c = __builtin_amdgcn_readfirstlane(c);
        while (c < (unsigned)(T / PEER_CHUNK)) {
            unsigned cn = 0; if (lane == 0) cn = atomicAdd(qh + s * 64, 1u);
            peer_chunk<WHICH, MODE>(p, (int)c * PEER_CHUNK, s, lane);
            c = __builtin_amdgcn_readfirstlane(cn);
        }
    }
}
__device__ __forceinline__ void phase_peer_w(const Params& p) {
    const int lane = threadIdx.x & 63, gw = blockIdx.x * NWV + __builtin_amdgcn_readfirstlane(threadIdx.x >> 6), nw = gridDim.x * NWV;
    const int* part = (const int*)(p.ws + OFF_QKV); const int* idx = (const int*)(p.ws + OFF_IDX); float* gate = (float*)(p.ws + OFF_GATE);
    const float* uinv = (const float*)(p.ws + OFF_UTAB + TAB8_BYTES); const float* vinv = (const float*)(p.ws + OFF_VTAB + TAB8_BYTES); const float* xs = (const float*)(p.ws + OFF_SGUO);
    int2 pv[16], e = make_int2(0, 0); float2 g = make_float2(0.f, 0.f); float xsc = 0.f, ui0 = 0.f, ui1 = 0.f, vi0 = 0.f, vi1 = 0.f;
#define PW_LOAD(tt) do { _Pragma("unroll") for (int s = 0; s < 16; ++s) pv[s] = *(const int2*)(part + ((size_t)s * T + (tt)) * 128 + 2 * lane); \
        e = *(const int2*)(idx + (size_t)(tt) * 128 + 2 * lane); g = *(const float2*)(gate + (size_t)(tt) * 128 + 2 * lane); xsc = xs[(tt)]; \
        ui0 = uinv[e.x]; ui1 = uinv[e.y]; vi0 = vinv[e.x]; vi1 = vinv[e.y]; } while (0)
    if (gw < T) PW_LOAD(gw);
    for (int t = gw; t < T; t += nw) {
        int a0 = 0, a1 = 0;
#pragma unroll
        for (int s = 0; s < 16; ++s) { a0 += pv[s].x; a1 += pv[s].y; }
        const float w0 = g.x * gelu_erf((float)a0 * (xsc * ui0)) * vi0, w1 = g.y * gelu_erf((float)a1 * (xsc * ui1)) * vi1;
        if (t + nw < T) PW_LOAD(t + nw);
        h2v hp; hp.x = (_Float16)(w0 * 256.f); hp.y = (_Float16)(w1 * 256.f);
        float sm = (float)hp.x + (float)hp.y;
        sm += __shfl_xor(sm, 1); sm += __shfl_xor(sm, 2); sm += __shfl_xor(sm, 4);
        ((unsigned*)gate)[(size_t)t * 128 + lane] = *reinterpret_cast<unsigned*>(&hp);
        if ((lane & 7) == 0) gate[(size_t)t * 128 + 64 + (lane >> 3)] = sm;
    }
#undef PW_LOAD
}
__device__ __forceinline__ void phase_peer_final(const Params& p) {
    const int lane = threadIdx.x & 63, gw = blockIdx.x * NWV + __builtin_amdgcn_readfirstlane(threadIdx.x >> 6), nw = gridDim.x * NWV;
    const bf16_t* peer = (const bf16_t*)(p.ws + OFF_A); const bf16_t* hb = (const bf16_t*)(p.ws + OFF_O12);
    const int wpb = nw >> 2, b = gw / wpb, r0 = gw - b * wpb;
    if (b >= NB) return;
    float gt[32], gf[32];
#pragma unroll
    for (int i = 0; i < 4; ++i) { const int col = i * 512 + lane * 8; const float4 g0 = mod4(p, b, 5, col), g1 = mod4(p, b, 5, col + 4), f0 = *(const float4*)(p.g_final + col), f1 = *(const float4*)(p.g_final + col + 4);
        gt[i * 8 + 0] = g0.x; gt[i * 8 + 1] = g0.y; gt[i * 8 + 2] = g0.z; gt[i * 8 + 3] = g0.w; gt[i * 8 + 4] = g1.x; gt[i * 8 + 5] = g1.y; gt[i * 8 + 6] = g1.z; gt[i * 8 + 7] = g1.w;
        gf[i * 8 + 0] = f0.x; gf[i * 8 + 1] = f0.y; gf[i * 8 + 2] = f0.z; gf[i * 8 + 3] = f0.w; gf[i * 8 + 4] = f1.x; gf[i * 8 + 5] = f1.y; gf[i * 8 + 6] = f1.z; gf[i * 8 + 7] = f1.w; }
    u32x4 pw[4], hw[4]; float4 xa[4], xb[4];
#define PF_LOAD(tt) do { _Pragma("unroll") for (int i = 0; i < 4; ++i) { pw[i] = *(const u32x4*)(peer + (size_t)(tt) * D + i * 512 + lane * 8); hw[i] = *(const u32x4*)(hb + (size_t)(tt) * D + i * 512 + lane * 8); \
        xa[i] = *(const float4*)(p.x + (size_t)(tt) * D + i * 512 + lane * 8); xb[i] = *(const float4*)(p.x + (size_t)(tt) * D + i * 512 + lane * 8 + 4); } } while (0)
    if (r0 < S) PF_LOAD(b * S + r0);
    for (int r = r0; r < S; r += wpb) {
        const int t = b * S + r; float* orow = p.out + (size_t)t * D; float v[32]; float ss = 0.f;
#pragma unroll
        for (int i = 0; i < 4; ++i) {
            v[i * 8 + 0] = xa[i].x + bflo(hw[i].x) + gt[i * 8 + 0] * bflo(pw[i].x); v[i * 8 + 1] = xa[i].y + bfhi(hw[i].x) + gt[i * 8 + 1] * bfhi(pw[i].x); v[i * 8 + 2] = xa[i].z + bflo(hw[i].y) + gt[i * 8 + 2] * bflo(pw[i].y); v[i * 8 + 3] = xa[i].w + bfhi(hw[i].y) + gt[i * 8 + 3] * bfhi(pw[i].y);
            v[i * 8 + 4] = xb[i].x + bflo(hw[i].z) + gt[i * 8 + 4] * bflo(pw[i].z); v[i * 8 + 5] = xb[i].y + bfhi(hw[i].z) + gt[i * 8 + 5] * bfhi(pw[i].z); v[i * 8 + 6] = xb[i].z + bflo(hw[i].w) + gt[i * 8 + 6] * bflo(pw[i].w); v[i * 8 + 7] = xb[i].w + bfhi(hw[i].w) + gt[i * 8 + 7] * bfhi(pw[i].w);
#pragma unroll
            for (int j = 0; j < 8; ++j) ss += v[i * 8 + j] * v[i * 8 + j]; }
        if (r + wpb < S) PF_LOAD(t + wpb);
        ss = wave_sum(ss); const float rs = rsqrtf(ss * (1.0f / D) + 1e-6f);
#pragma unroll
        for (int i = 0; i < 4; ++i) { const int col = i * 512 + lane * 8;
            *(float4*)(orow + col) = make_float4(v[i * 8 + 0] * rs * gf[i * 8 + 0], v[i * 8 + 1] * rs * gf[i * 8 + 1], v[i * 8 + 2] * rs * gf[i * 8 + 2], v[i * 8 + 3] * rs * gf[i * 8 + 3]);
            *(float4*)(orow + col + 4) = make_float4(v[i * 8 + 4] * rs * gf[i * 8 + 4], v[i * 8 + 5] * rs * gf[i * 8 + 5], v[i * 8 + 6] * rs * gf[i * 8 + 6], v[i * 8 + 7] * rs * gf[i * 8 + 7]); }
    }
#undef PF_LOAD
}

constexpr int LDS_BYTES = 147456;

#define XB_TMO      128
#define XB_XCNT(j)  (256  + 64 * (j))
#define XB_XSUB(j)  (1280 + 64 * (j))
#define XB_XGEN(j)  (2304 + 64 * (j))
#define XB_TOP      3328
#define XB_TOPGEN   3392
#define XCD_BAR_WORDS 3456
#define XB_SPIN_CAP (1u << 18)

__device__ __forceinline__ unsigned xb_ld(unsigned* p)              { return __hip_atomic_load(p, __ATOMIC_RELAXED, __HIP_MEMORY_SCOPE_AGENT); }
__device__ __forceinline__ unsigned xb_add(unsigned* p, unsigned v) { return __hip_atomic_fetch_add(p, v, __ATOMIC_RELAXED, __HIP_MEMORY_SCOPE_AGENT); }
__device__ __forceinline__ unsigned xb_xcc_id() { return (unsigned)__builtin_amdgcn_s_getreg((3 << 11) | 20) & 0xFu; }
#define XB_SPIN(cond, bar) do { unsigned _sp = 0; while (cond) { __builtin_amdgcn_s_sleep(1); \
    if ((++_sp & 255u) == 0u) { if (xb_ld(&(bar)[XB_TMO])) break; if (_sp > XB_SPIN_CAP) { atomicAdd(&(bar)[XB_TMO], 1u); break; } } } } while (0)

struct XcdBarrier {
    unsigned* bar; unsigned x;
    volatile LAS unsigned* st;
};

__device__ __forceinline__ XcdBarrier xcd_barrier_post(unsigned* bar, volatile LAS unsigned* st) {
    XcdBarrier b; b.bar = bar; b.x = xb_xcc_id(); b.st = st;
    if (threadIdx.x == 0) (void)xb_add(&bar[XB_XCNT(b.x)], 1u);
    return b;
}
__device__ __forceinline__ void xcd_barrier_complete(unsigned* bar, unsigned x, unsigned& nloc, unsigned& nx) {
    const unsigned G = gridDim.x * gridDim.y * gridDim.z;
    unsigned sum, cnt, mine, sp = 0u;
    for (;;) {
        sum = 0u; cnt = 0u; mine = 0u;
#pragma unroll
        for (unsigned j = 0; j < 16; ++j) { const unsigned c = xb_ld(&bar[XB_XCNT(j)]); sum += c; cnt += (c > 0u) ? 1u : 0u; mine = (j == x) ? c : mine; }
        if (sum == G) break;
        __builtin_amdgcn_s_sleep(1);
        if ((++sp & 255u) == 0u) { if (xb_ld(&bar[XB_TMO])) break; if (sp > XB_SPIN_CAP) { atomicAdd(&bar[XB_TMO], 1u); break; } }
    }
    nloc = mine > 0u ? mine : 1u; nx = cnt > 0u ? cnt : 1u;
}

__device__ __forceinline__ void xcd_barrier(const XcdBarrier& b) {
    asm volatile("s_waitcnt vmcnt(0)" ::: "memory");
    __syncthreads();
    if (threadIdx.x == 0) {
        unsigned* bar = b.bar;
        __builtin_amdgcn_s_waitcnt(0);
        unsigned nloc = b.st[0], nx = b.st[1];
        if (nloc == 0u) { xcd_barrier_complete(bar, b.x, nloc, nx); b.st[0] = nloc; b.st[1] = nx; }
        const unsigned old = xb_add(&bar[XB_XSUB(b.x)], 1u);
        const unsigned gen = old / nloc;
        if (old + 1u == (gen + 1u) * nloc) {
            __builtin_amdgcn_fence(__ATOMIC_RELEASE, "agent");
            asm volatile("s_waitcnt vmcnt(0)" ::: "memory");
            const unsigned og = xb_add(&bar[XB_TOP], 1u);
            const unsigned tg = og / nx;
            if (og + 1u == (tg + 1u) * nx) xb_add(&bar[XB_TOPGEN], 1u);
            else XB_SPIN(xb_ld(&bar[XB_TOPGEN]) == tg, bar);
            __builtin_amdgcn_fence(__ATOMIC_ACQUIRE, "agent");
            xb_add(&bar[XB_XGEN(b.x)], 1u);
            asm volatile("s_waitcnt vmcnt(0)" ::: "memory");
        } else {
            XB_SPIN(xb_ld(&bar[XB_XGEN(b.x)]) == gen, bar);
            __builtin_amdgcn_fence(__ATOMIC_ACQUIRE, "agent");
            asm volatile("s_waitcnt vmcnt(0)" ::: "memory");
        }
    }
    __syncthreads();
}

#ifndef PHASE_MASK
#define PHASE_MASK 0x3FF
#endif
#ifndef PROBE_DUP
#define PROBE_DUP 0
#endif
#ifndef TS_SEL
#define TS_SEL -1
#endif
#define TSTAMP(k) do { if (TS_SEL >= 0) { const unsigned long long _t = __builtin_amdgcn_s_memrealtime(); if (TS_SEL + 1 == (k)) { const unsigned long long _d = _t - ts_a; while (__builtin_amdgcn_s_memrealtime() - _t < _d) __builtin_amdgcn_s_sleep(8); } ts_a = __builtin_amdgcn_s_memrealtime(); } } while (0)
#define GBAR() xcd_barrier(xbar)
#define RUNPH(bit, call, dupcall) do { if (PHASE_MASK & (bit)) { if (PROBE_DUP & (bit)) { dupcall; GBAR(); } call; GBAR(); } } while (0)
__global__ void __launch_bounds__(NTHR, 2) k_mega(Params p) {
    extern __shared__ __attribute__((aligned(16))) unsigned char lds[];
    cg::grid_group grid = cg::this_grid();
    volatile LAS unsigned* xst = (volatile LAS unsigned*)((LAS unsigned char*)lds + LDS_BYTES);
    if (threadIdx.x < 4) xst[threadIdx.x] = 0u;
    __syncthreads();
    XcdBarrier xbar = xcd_barrier_post((unsigned*)(p.ws + OFF_CTL), xst);
    unsigned long long ts_a = 0; TSTAMP(0);
    if (p.ws == nullptr) grid.sync();
    if (PHASE_MASK & 1) { if (PROBE_DUP & 1) { phase_conv(p, lds, true); GBAR(); } phase_conv(p, lds); GBAR(); }
    TSTAMP(1);
    RUNPH(2, (phase_norm_mod<true, false, false>(p, p.x, p.g_norm1, 0, 1, nullptr, p.ws + OFF_A, (float*)(p.ws + OFF_SCL) + SCL_HS), phase_quant_weights(p, lds)), (phase_norm_mod<true, false, false>(p, p.x, p.g_norm1, 0, 1, nullptr, p.ws + OFF_A, (float*)(p.ws + OFF_SCL) + SCL_HS)));
    TSTAMP(2);
    RUNPH(4, phase_gemm1(p, lds), phase_gemm1(p, lds));
    TSTAMP(3);
    if (PROBE_DUP & 1024) { phase_sgu(p, lds); GBAR(); }
    RUNPH(8, (phase_attn(p, lds), phase_sgu(p, lds)), phase_attn(p, lds));
    TSTAMP(4);
    RUNPH(16, phase_combine(p), phase_combine(p));
    TSTAMP(5);
    RUNPH(32, phase_gemm2(p, lds), phase_gemm2(p, lds));
    TSTAMP(6);
    RUNPH(64, (phase_norm_mod<true, true, false>(p, p.ws + OFF_O12, p.g_norm2, 3, 4, nullptr, p.ws + OFF_US, (float*)(p.ws + OFF_SGUO))), (phase_norm_mod<true, true, false>(p, p.ws + OFF_O12, p.g_norm2, 3, 4, nullptr, p.ws + OFF_US, (float*)(p.ws + OFF_SGUO))));
    TSTAMP(7);
    RUNPH(128, phase_gemm3(p, lds), phase_gemm3(p, lds));
    TSTAMP(8);
    RUNPH(256, phase_topk(p, lds), phase_topk(p, lds));
    TSTAMP(9);
    if (PHASE_MASK & 512) {
        if (PROBE_DUP == 2048) { phase_peer_sliced<0, 0, 2>(p, xbar.x); GBAR(); }
        if (PROBE_DUP == 4096) { phase_peer_sliced<0, 1, 2>(p, xbar.x); GBAR(); }
        if (PROBE_DUP == 8192) { phase_peer_sliced<0, 2, 2>(p, xbar.x); GBAR(); }
        phase_peer_sliced<0>(p, xbar.x); GBAR();
        TSTAMP(10);
        phase_peer_w(p); GBAR();
        TSTAMP(11);
        if (PROBE_DUP == 16384) { phase_peer_sliced<1, 0, 3>(p, xbar.x); GBAR(); }
        phase_peer_sliced<1>(p, xbar.x); GBAR();
        TSTAMP(12);
        phase_peer_final(p);
        TSTAMP(13);
    }
}

#ifndef MEGA
#define MEGA 1
#endif
extern "C" void kernel_launch(void* const* d_in, const int* in_sizes, int n_in, void* d_out, int out_size, void* d_ws, size_t ws_size, hipStream_t stream) {
    if (n_in != 20 || out_size != T * D || ws_size < WS_END) { fprintf(stderr, "kernel_launch: unexpected problem (n_in %d out %d ws %zu, need %zu)\n", n_in, out_size, ws_size, (size_t)WS_END); return; }
    Params p{};
    p.x = (const float*)d_in[0]; p.c = (const float*)d_in[1]; p.pos = (const int*)d_in[2]; p.w_ada = (const float*)d_in[3]; p.b_ada = (const float*)d_in[4];
    p.g_norm1 = (const float*)d_in[5]; p.w_in = (const float*)d_in[6]; p.g_attn_out = (const float*)d_in[7]; p.g_sgu_out = (const float*)d_in[8];
    p.sgu_w = (const float*)d_in[9]; p.sgu_b = (const float*)d_in[10]; p.sgu_ln_g = (const float*)d_in[11]; p.sgu_ln_b = (const float*)d_in[12];
    p.w_out = (const float*)d_in[13]; p.g_norm2 = (const float*)d_in[14]; p.peer_w_q = (const float*)d_in[15]; p.peer_sub_keys = (const float*)d_in[16];
    p.peer_u = (const float*)d_in[17]; p.peer_v = (const float*)d_in[18]; p.g_final = (const float*)d_in[19];
    p.out = (float*)d_out; p.ws = (unsigned char*)d_ws;
    (void)hipMemsetAsync((char*)d_ws + OFF_CTL, 0, OFF_SCL - OFF_CTL, stream);
#if MEGA
    static int grid_blocks = 0;
    if (!grid_blocks) {
        int dev = 0, cus = 0, per_cu = 0;
        (void)hipGetDevice(&dev); (void)hipDeviceGetAttribute(&cus, hipDeviceAttributeMultiprocessorCount, dev);
        (void)hipFuncSetAttribute((const void*)k_mega, hipFuncAttributeMaxDynamicSharedMemorySize, LDS_BYTES + 16);
        (void)hipOccupancyMaxActiveBlocksPerMultiprocessor(&per_cu, (const void*)k_mega, NTHR, LDS_BYTES + 16);
        if (per_cu < 1) { fprintf(stderr, "kernel_launch: occupancy query says %d blocks per CU\n", per_cu); per_cu = 1; }
        if (per_cu > 1) per_cu = 1;
        grid_blocks = cus * per_cu;
    }
    void* args[] = {(void*)&p};
    hipError_t e = hipLaunchCooperativeKernel((const void*)k_mega, dim3(grid_blocks), dim3(NTHR), args, LDS_BYTES + 16, stream);
    if (e != hipSuccess) fprintf(stderr, "cooperative launch failed: %s (grid %d)\n", hipGetErrorString(e), grid_blocks);
#endif
}
```

```cpp
#include <hip/hip_runtime.h>
#include <hip/hip_cooperative_groups.h>
#include <cstdio>
#include <cstdint>
namespace cg = cooperative_groups;
#define LAS_ __attribute__((address_space(3)))
#ifndef CONV_TS
#define CONV_TS -1
#endif
#define CSTAMP(k) do { if (CONV_TS >= 0) { __syncthreads(); const unsigned long long _t = __builtin_amdgcn_s_memrealtime(); if (CONV_TS + 1 == (k)) { const unsigned long long _d = _t - cts; while (__builtin_amdgcn_s_memrealtime() - _t < _d) __builtin_amdgcn_s_sleep(8); } cts = __builtin_amdgcn_s_memrealtime(); } } while (0)

constexpr int D = 2048, NB = 4, S = 4096, T = NB * S;
constexpr int E = 128, HA = 12, HS = 4, DA = 1536, DS = 512, DIN = 5632;
constexpr int PH = 8, PK = 16, NEXP = 16384;
constexpr int NTHR = 512, NWV = 8;

typedef unsigned short bf16_t;
typedef unsigned u32x4 __attribute__((ext_vector_type(4)));
typedef unsigned u32x2 __attribute__((ext_vector_type(2)));
typedef float f32x4 __attribute__((ext_vector_type(4)));

__device__ __forceinline__ bf16_t f2bf(float f) { unsigned u = __float_as_uint(f); u += 0x7FFFu + ((u >> 16) & 1u); return (bf16_t)(u >> 16); }
__device__ __forceinline__ float bf2f(bf16_t b) { return __uint_as_float(((unsigned)b) << 16); }
__device__ __forceinline__ unsigned pack2(float lo, float hi) { return (unsigned)f2bf(lo) | ((unsigned)f2bf(hi) << 16); }
__device__ __forceinline__ float bflo(unsigned w) { return __uint_as_float(w << 16); }
__device__ __forceinline__ float bfhi(unsigned w) { return __uint_as_float(w & 0xffff0000u); }
__device__ __forceinline__ float wave_sum(float v) {
#pragma unroll
    for (int o = 32; o >= 1; o >>= 1) v += __shfl_xor(v, o);
    return v; }
__device__ __forceinline__ float wave_max(float v) {
#pragma unroll
    for (int o = 32; o >= 1; o >>= 1) v = fmaxf(v, __shfl_xor(v, o));
    return v; }
__device__ __forceinline__ int wave_min_i(int v) {
#pragma unroll
    for (int o = 32; o >= 1; o >>= 1) v = min(v, __shfl_xor(v, o));
    return v; }
__device__ __forceinline__ float gelu_erf(float v) { return 0.5f * v * (1.0f + erff(v * 0.70710678118654752f)); }

constexpr size_t OFF_CTL  = 0;
constexpr size_t OFF_MOD  = 65536;
constexpr size_t OFF_SCL  = OFF_MOD + 393216;
constexpr int SCL_HS = 0, SCL_MS = T, SCL_WS = 2 * T, SCL_PM = 2 * T + 9728, WS_IN = 0, WS_OUT = 5632, WS_Q = 7680, NWCOL = 9728;
constexpr size_t OFF_SGUW = OFF_SCL + 1048576;
constexpr size_t OFF_SUBK = OFF_SGUW + 131072;
constexpr size_t OFF_LSE  = OFF_SUBK + 524288;
constexpr size_t OFF_IDX  = OFF_LSE + (size_t)3 * T * 12 * 4;
constexpr size_t OFF_GATE = OFF_IDX + (size_t)T * 128 * 4;
constexpr size_t OFF_WIN  = OFF_GATE + (size_t)T * 128 * 4;
constexpr size_t OFF_WOUT = OFF_WIN + (size_t)DIN * D * 2;
constexpr size_t OFF_WQ   = OFF_WOUT + (size_t)D * D * 2;
constexpr size_t OFF_UTAB = OFF_WQ + (size_t)D * D * 2;
constexpr size_t TAB8_BYTES = (size_t)NEXP * D;
constexpr size_t SLICE_BYTES = (size_t)NEXP * 128;
constexpr size_t OFF_QUEUE = 32768;
constexpr size_t OFF_VTAB = OFF_UTAB + (size_t)NEXP * D + 65536;
constexpr size_t OFF_A    = OFF_VTAB + (size_t)NEXP * D + 65536;
constexpr size_t OFF_QKV  = OFF_A + (size_t)T * D * 2;
constexpr size_t QKV_ONE  = (size_t)T * DA * 2;
constexpr size_t OFF_US   = OFF_QKV + 3 * QKV_ONE;
constexpr size_t OFF_VS   = OFF_US + (size_t)T * DS * 2;
constexpr size_t OFF_SGUO = OFF_VS + (size_t)T * DS * 2;
constexpr size_t OFF_O12  = OFF_SGUO + (size_t)T * DS * 2;
constexpr size_t OFF_XB   = OFF_O12 + 2 * QKV_ONE;
constexpr size_t WS_END   = OFF_XB + (size_t)T * D * 2;

struct Params {
    const float* x; const float* c; const int* pos; const float* w_ada; const float* b_ada; const float* g_norm1; const float* w_in;
    const float* g_attn_out; const float* g_sgu_out; const float* sgu_w; const float* sgu_b; const float* sgu_ln_g; const float* sgu_ln_b;
    const float* w_out; const float* g_norm2; const float* peer_w_q; const float* peer_sub_keys; const float* peer_u; const float* peer_v;
    const float* g_final; float* out; unsigned char* ws;
};
__device__ __forceinline__ float fx2f(long long v) { return (float)(int)(v >> 32) + (float)(unsigned)v * 2.3283064365386963e-10f; }
__device__ __forceinline__ float mod1(const Params& p, int b, int i, int col) { return fx2f(((const long long*)(p.ws + OFF_MOD))[b * 12288 + i * D + col]); }
__device__ __forceinline__ float4 mod4q(const long long* mp) { return make_float4(fx2f(mp[0]), fx2f(mp[1]), fx2f(mp[2]), fx2f(mp[3])); }
__device__ __forceinline__ float4 mod4(const Params& p, int b, int i, int col) { return mod4q((const long long*)(p.ws + OFF_MOD) + b * 12288 + i * D + col); }
__device__ __forceinline__ bf16_t* P_opat(const Params& p, int pat) { return (bf16_t*)(pat == 0 ? p.ws + OFF_A : p.ws + OFF_O12 + (size_t)(pat - 1) * QKV_ONE); }

namespace pg8 {
#define PG8_LAS __attribute__((address_space(3)))
typedef unsigned short bf16_t;
typedef short bf16x8 __attribute__((ext_vector_type(8)));
typedef float f32x4 __attribute__((ext_vector_type(4)));
typedef unsigned u32x4 __attribute__((ext_vector_type(4)));
constexpr int BM = 256, BK = 64, HALF = 128, HTB = HALF * BK * 2  , STAGE_BYTES = 8 * HTB, NXCD = 8, WGM = 8;

__host__ __device__ __forceinline__ int lds_byte(int r, int c) { const int st = (r >> 4) * 2 + (c >> 5), rr = r & 15, cc = c & 31, ob = rr * 64 + cc * 2; return st * 1024 + (ob ^ (((ob >> 9) & 1) << 5)); }
__host__ __device__ __forceinline__ void stage_rc(int b, int& R, int& C) { const int st = b / 1024, sb = b % 1024, swz = sb ^ (((sb >> 9) & 1) << 5); R = (st >> 1) * 16 + swz / 64; C = (st & 1) * 32 + (swz % 64) / 2; }
__host__ __device__ __forceinline__ int perm32(int rho) { const int n = rho >> 4, i = rho & 15; return 8 * (i >> 2) + 4 * n + (i & 3); }

struct Unit { int pm, pn; };
struct Gemm { const bf16_t* A; const bf16_t* Bt; int M, N, K; };

struct StaticOrder {
    int nM, nN, nwg, G, c;
    __host__ __device__ void init(int M, int N, int G_, int c_) { nM = M / BM; nN = N / BM; nwg = nM * nN; G = G_; c = c_; }
    __host__ __device__ bool next(int i, Unit& u) const {
        const long L = (long)i * G + c; if (L >= nwg) return false;
        int wgid = (int)L; { const int q = nwg / NXCD, r = nwg % NXCD, xcd = wgid % NXCD, off = wgid / NXCD; wgid = (xcd < r ? xcd * (q + 1) : r * (q + 1) + (xcd - r) * q) + off; }
        const int nig = WGM * nN, gid = wgid / nig, fm = gid * WGM, gsz = (nM - fm) < WGM ? (nM - fm) : WGM;
        u.pm = fm + ((wgid % nig) % gsz); u.pn = (wgid % nig) / gsz; return true;
    }
    __device__ __forceinline__ void a_ready(const Unit&) const {}
    __device__ __forceinline__ void done(const Unit&) const {}
};

__device__ __forceinline__ unsigned cvt_pk_bf16(float lo, float hi) { unsigned r; asm volatile("v_cvt_pk_bf16_f32 %0, %1, %2" : "=v"(r) : "v"(lo), "v"(hi)); return r; }
typedef float f32x2 __attribute__((ext_vector_type(2)));
__device__ __forceinline__ f32x2 gelu_pk(f32x2 v) {
    const f32x2 av = __builtin_elementwise_abs(v), d = av * 0.2316418882f + 1.0f;
    f32x2 t; t.x = __builtin_amdgcn_rcpf(d.x); t.y = __builtin_amdgcn_rcpf(d.y);
    f32x2 q = t * 0.5307027145f + (-0.7265760135f); q = q * t + 0.7107068705f; q = q * t + (-0.142248368f); q = q * t + 0.127414796f; q = q * t;
    const f32x2 s = (v * v) * (-0.72134752044f);
    f32x2 e; e.x = __builtin_amdgcn_exp2f(s.x); e.y = __builtin_amdgcn_exp2f(s.y);
    const f32x2 m = v * (q * e), r = v - m;
    f32x2 o; o.x = v.x < 0.f ? m.x : r.x; o.y = v.y < 0.f ? m.y : r.y; return o;
}

typedef int i32x4 __attribute__((ext_vector_type(4)));
__device__ __forceinline__ f32x4 mma1(bf16x8 b, bf16x8 a, f32x4 c) { return __builtin_amdgcn_mfma_f32_16x16x32_bf16(b, a, c, 0, 0, 0); }
__device__ __forceinline__ i32x4 mma1(bf16x8 b, bf16x8 a, i32x4 c) { return __builtin_amdgcn_mfma_i32_16x16x64_i8(__builtin_bit_cast(i32x4, b), __builtin_bit_cast(i32x4, a), c, 0, 0, 0); }
template <class Epi, class Sched, bool ALIGN_EPI = false, bool SP2 = false>
__device__ __forceinline__ void gemm_phase(PG8_LAS unsigned char* lds, const Gemm g, const Sched& S, const Epi& E) {
    int tid = threadIdx.x; asm volatile("" : "+v"(tid));
    const int wid = __builtin_amdgcn_readfirstlane(tid >> 6), lane = tid & 63, wr = wid >> 2, wc = wid & 3, fr = lane & 15, fq = lane >> 4;
    const int K = g.K, nt = K / BK;
    unsigned voffA[2], voffB[2];
#pragma unroll
    for (int i = 0; i < 2; ++i) { int R, C; stage_rc(tid * 16 + i * 8192, R, C); const int Rb = Epi::PERM ? ((R & ~31) + perm32(R & 31)) : R;
        voffA[i] = (unsigned)(R * K + C) * 2u; voffB[i] = (unsigned)(Rb * K + C) * 2u; }
    const size_t kstep = (size_t)(BK * 2);
    const size_t hstep = (size_t)HALF * K * 2;
    const size_t tstep = 2 * hstep;
    const unsigned ldsw = (unsigned)wid * 1024u;
    const int aoff = lds_byte(wr * 64 + fr, fq * 8), boff = lds_byte(wc * 32 + fr, fq * 8);
#define PG8_SA(b, h) (((b) * 2 + (h)) * HTB)
#define PG8_SB(b, h) ((4 + (b) * 2 + (h)) * HTB)
#define PG8_STAGE(bufoff, gbase, voff) do { _Pragma("unroll") for (int _i = 0; _i < 2; ++_i) \
        __builtin_amdgcn_global_load_lds((const unsigned*)((const char*)(gbase) + (voff)[_i]), (PG8_LAS unsigned*)(lds + (bufoff) + ldsw + _i * 8192), 16, 0, 0); } while (0)
#define PG8_LDA(dst, b, h) do { _Pragma("unroll") for (int m = 0; m < 4; ++m) _Pragma("unroll") for (int k = 0; k < 2; ++k) dst[m][k] = *(const PG8_LAS bf16x8*)(lds + PG8_SA(b, h) + aoff + m * 2048 + k * 1024); } while (0)
#define PG8_LDB(dst, b, h) do { _Pragma("unroll") for (int n = 0; n < 2; ++n) _Pragma("unroll") for (int k = 0; k < 2; ++k) dst[n][k] = *(const PG8_LAS bf16x8*)(lds + PG8_SB(b, h) + boff + n * 2048 + k * 1024); } while (0)
#define PG8_MMA(ai, bj, At, Bt) do { __builtin_amdgcn_s_setprio(1); _Pragma("unroll") for (int m = 0; m < 4; ++m) _Pragma("unroll") for (int n = 0; n < 2; ++n) _Pragma("unroll") for (int k = 0; k < 2; ++k) \
        acc[ai][bj][m][n] = mma1(Bt[n][k], At[m][k], acc[ai][bj][m][n]); __builtin_amdgcn_s_setprio(0); } while (0)
#define PG8_WAIT_V(n) asm volatile("s_waitcnt vmcnt(" #n ")" ::: "memory")
#define PG8_WAIT_L(n) asm volatile("s_waitcnt lgkmcnt(" #n ")" ::: "memory")
#define PG8_BAR __builtin_amdgcn_s_barrier()
#define PG8_SCHED __builtin_amdgcn_sched_barrier(0)
    Unit cur, nxt; int ui = 0;
    if (!S.next(0, cur)) return;
    typedef typename Epi::AccT AccT;
    AccT acc[2][2][4][2];
#pragma unroll
    for (int a = 0; a < 2; ++a)
#pragma unroll
        for (int b = 0; b < 2; ++b)
#pragma unroll
            for (int m = 0; m < 4; ++m)
#pragma unroll
                for (int n = 0; n < 2; ++n) acc[a][b][m][n] = AccT{};
    bf16x8 At[4][2], B0[2][2], B1[2][2];
    const char* cA = (const char*)g.A + (size_t)cur.pm * tstep; const char* cB = (const char*)g.Bt + (size_t)cur.pn * tstep;
    S.a_ready(cur);
    if constexpr (SP2) {
        PG8_STAGE(PG8_SB(0, 0), cB, voffB); PG8_STAGE(PG8_SB(0, 1), cB + hstep, voffB); PG8_STAGE(PG8_SA(0, 0), cA, voffA); PG8_STAGE(PG8_SA(0, 1), cA + hstep, voffA);
        if (wr == 1) PG8_BAR;
        PG8_WAIT_V(2); PG8_BAR;
        PG8_STAGE(PG8_SB(1, 0), cB + kstep, voffB); PG8_STAGE(PG8_SA(1, 0), cA + kstep, voffA); PG8_STAGE(PG8_SB(1, 1), cB + hstep + kstep, voffB);
        PG8_WAIT_V(6); PG8_BAR;
    } else {
        PG8_STAGE(PG8_SB(0, 0), cB, voffB); PG8_STAGE(PG8_SA(0, 0), cA, voffA); PG8_STAGE(PG8_SB(0, 1), cB + hstep, voffB); PG8_STAGE(PG8_SA(0, 1), cA + hstep, voffA);
        if (wr == 1) PG8_BAR;
        PG8_WAIT_V(4); PG8_BAR;
        PG8_STAGE(PG8_SB(1, 0), cB + kstep, voffB); PG8_STAGE(PG8_SA(1, 0), cA + kstep, voffA); PG8_STAGE(PG8_SB(1, 1), cB + hstep + kstep, voffB);
        PG8_WAIT_V(6); PG8_BAR;
    }
    for (;;) {
        const bool has_next = S.next(ui + 1, nxt);
        const char* nA = has_next ? (const char*)g.A + (size_t)nxt.pm * tstep : cA; const char* nB = has_next ? (const char*)g.Bt + (size_t)nxt.pn * tstep : cB;
        for (int t = 0; t < nt; t += 2) {
            const bool last = (t == nt - 2);
            const char* a1 = cA + (size_t)(t + 1) * kstep;
            const char* a2 = last ? nA : cA + (size_t)(t + 2) * kstep; const char* b2 = last ? nB : cB + (size_t)(t + 2) * kstep;
            const char* a3 = a2 + kstep; const char* b3 = b2 + kstep;
            if (last && has_next) S.a_ready(nxt);
            if constexpr (SP2) {
            PG8_LDB(B0, 0, 0); PG8_LDB(B1, 0, 1); PG8_SCHED; PG8_LDA(At, 0, 0); PG8_STAGE(PG8_SA(1, 1), a1 + hstep, voffA);
            PG8_WAIT_V(8); PG8_WAIT_L(0); PG8_BAR; PG8_MMA(0, 0, At, B0); PG8_MMA(0, 1, At, B1); PG8_BAR; PG8_SCHED;
            PG8_LDA(At, 0, 1); PG8_STAGE(PG8_SB(0, 0), b2, voffB); PG8_STAGE(PG8_SB(0, 1), b2 + hstep, voffB); PG8_STAGE(PG8_SA(0, 0), a2, voffA);
            PG8_WAIT_V(8); PG8_WAIT_L(0); PG8_BAR; PG8_MMA(1, 0, At, B0); PG8_MMA(1, 1, At, B1); PG8_BAR; PG8_SCHED;
            PG8_LDB(B0, 1, 0); PG8_LDB(B1, 1, 1); PG8_SCHED; PG8_LDA(At, 1, 0); PG8_STAGE(PG8_SA(0, 1), a2 + hstep, voffA);
            PG8_WAIT_V(8); PG8_WAIT_L(0); PG8_BAR; PG8_MMA(0, 0, At, B0); PG8_MMA(0, 1, At, B1); PG8_BAR; PG8_SCHED;
            PG8_LDA(At, 1, 1); PG8_STAGE(PG8_SB(1, 0), b3, voffB); PG8_STAGE(PG8_SB(1, 1), b3 + hstep, voffB); PG8_STAGE(PG8_SA(1, 0), a3, voffA);
            PG8_WAIT_V(8); PG8_WAIT_L(0); PG8_BAR; PG8_MMA(1, 0, At, B0); PG8_MMA(1, 1, At, B1); PG8_BAR; PG8_SCHED;
            } else {
            PG8_LDB(B0, 0, 0); PG8_SCHED; PG8_LDA(At, 0, 0); PG8_STAGE(PG8_SA(1, 1), a1 + hstep, voffA);
            PG8_WAIT_L(8); PG8_BAR; PG8_WAIT_L(0); PG8_MMA(0, 0, At, B0); PG8_BAR; PG8_SCHED;
            PG8_LDB(B1, 0, 1); PG8_STAGE(PG8_SB(0, 0), b2, voffB);
            PG8_BAR; PG8_WAIT_L(0); PG8_MMA(0, 1, At, B1); PG8_BAR;
            PG8_LDA(At, 0, 1); PG8_STAGE(PG8_SA(0, 0), a2, voffA);
            PG8_BAR; PG8_WAIT_L(0); PG8_MMA(1, 0, At, B0); PG8_BAR; PG8_SCHED;
            PG8_STAGE(PG8_SB(0, 1), b2 + hstep, voffB);
            PG8_WAIT_V(6); PG8_BAR; PG8_MMA(1, 1, At, B1); PG8_BAR;
            PG8_LDB(B0, 1, 0); PG8_SCHED; PG8_LDA(At, 1, 0); PG8_STAGE(PG8_SA(0, 1), a2 + hstep, voffA);
            PG8_WAIT_L(8); PG8_BAR; PG8_WAIT_L(0); PG8_MMA(0, 0, At, B0); PG8_BAR; PG8_SCHED;
            PG8_LDB(B1, 1, 1); PG8_STAGE(PG8_SB(1, 0), b3, voffB);
            PG8_BAR; PG8_WAIT_L(0); PG8_MMA(0, 1, At, B1); PG8_BAR;
            PG8_LDA(At, 1, 1); PG8_STAGE(PG8_SA(1, 0), a3, voffA);
            PG8_BAR; PG8_WAIT_L(0); PG8_MMA(1, 0, At, B0); PG8_BAR; PG8_SCHED;
            PG8_STAGE(PG8_SB(1, 1), b3 + hstep, voffB);
            PG8_WAIT_V(6); PG8_BAR; PG8_MMA(1, 1, At, B1); PG8_BAR;
            }
        }
        if constexpr (ALIGN_EPI) { if (wr == 0) PG8_BAR; }
        if constexpr (!Epi::AFTER_DRAIN) { E(acc, cur, wr, wc, fr, fq); S.done(cur); }
        if (!has_next) break;
#pragma unroll
        for (int a = 0; a < 2; ++a)
#pragma unroll
            for (int b = 0; b < 2; ++b)
#pragma unroll
                for (int m = 0; m < 4; ++m)
#pragma unroll
                    for (int n = 0; n < 2; ++n) acc[a][b][m][n] = AccT{};
        cur = nxt; cA = nA; cB = nB; ++ui;
        if constexpr (ALIGN_EPI) { if (wr == 1) PG8_BAR; }
    }
    PG8_WAIT_V(0);
    if constexpr (!ALIGN_EPI) { if (wr == 0) PG8_BAR; }
    PG8_BAR;
    if constexpr (Epi::AFTER_DRAIN) { E.fused(acc, cur, wr, wc, fr, fq, lds, wid, lane); S.done(cur); }
#undef PG8_SA
#undef PG8_SB
#undef PG8_STAGE
#undef PG8_LDA
#undef PG8_LDB
#undef PG8_MMA
#undef PG8_WAIT_V
#undef PG8_WAIT_L
#undef PG8_BAR
#undef PG8_SCHED
}

struct EpiProj {
    typedef f32x4 AccT; static constexpr bool PERM = true, AFTER_DRAIN = false;
    bf16_t* q; bf16_t* k; bf16_t* v; bf16_t* us; bf16_t* vs; const int* pos;
    __device__ __forceinline__ void operator()(const f32x4 (&acc)[2][2][4][2], const Unit& u, int wr, int wc, int fr, int fq) const {
        const int row0 = u.pm * BM + wr * 64 + fr, b = u.pm >> 4;
        if (u.pn < 12) {
            const bool isq = u.pn < 6; bf16_t* base = isq ? q : k;
            const int hh = 2 * (isq ? u.pn : u.pn - 6) + (wc >> 1), e0 = 32 * (wc & 1) + 8 * fq;
            const float qs = isq ? 0.08838834764831845f : 1.0f;
            float ir[8];
#pragma unroll
            for (int j = 0; j < 8; ++j) ir[j] = exp2f(-(float)(e0 + j) * (13.287712379549449f / 64.0f)) * 0.15915494309189535f;
#pragma unroll
            for (int ai = 0; ai < 2; ++ai)
#pragma unroll
                for (int m = 0; m < 4; ++m) {
                    const int t = row0 + ai * HALF + m * 16, s = t & 4095;
                    const float pf = (float)pos[t];
                    float o0[8], o1[8];
#pragma unroll
                    for (int n = 0; n < 2; ++n)
#pragma unroll
                        for (int i = 0; i < 4; ++i) { const int j = 4 * n + i;
                            const float f = __builtin_amdgcn_fractf(pf * ir[j]); const float sn = __builtin_amdgcn_sinf(f), cs = __builtin_amdgcn_cosf(f);
                            const float t1 = acc[ai][0][m][n][i], t2 = acc[ai][1][m][n][i];
                            o0[j] = (t1 * cs - t2 * sn) * qs; o1[j] = (t2 * cs + t1 * sn) * qs; }
                    bf16_t* dst = base + ((size_t)(b * 12 + hh) * 4096 + s) * 128 + e0;
                    u32x4 w0, w1;
                    w0.x = cvt_pk_bf16(o0[0], o0[1]); w0.y = cvt_pk_bf16(o0[2], o0[3]); w0.z = cvt_pk_bf16(o0[4], o0[5]); w0.w = cvt_pk_bf16(o0[6], o0[7]);
                    w1.x = cvt_pk_bf16(o1[0], o1[1]); w1.y = cvt_pk_bf16(o1[2], o1[3]); w1.z = cvt_pk_bf16(o1[4], o1[5]); w1.w = cvt_pk_bf16(o1[6], o1[7]);
                    *(u32x4*)dst = w0; *(u32x4*)(dst + 64) = w1; }
        } else if (u.pn < 18) {
            const int e0 = 32 * wc + 8 * fq;
#pragma unroll
            for (int ai = 0; ai < 2; ++ai)
#pragma unroll
                for (int m = 0; m < 4; ++m) { const int t = row0 + ai * HALF + m * 16, s = t & 4095;
#pragma unroll
                    for (int bj = 0; bj < 2; ++bj) { const int hh = 2 * (u.pn - 12) + bj; const f32x4 v0 = acc[ai][bj][m][0], v1 = acc[ai][bj][m][1];
                        u32x4 w; w.x = cvt_pk_bf16(v0[0], v0[1]); w.y = cvt_pk_bf16(v0[2], v0[3]); w.z = cvt_pk_bf16(v1[0], v1[1]); w.w = cvt_pk_bf16(v1[2], v1[3]);
                        *(u32x4*)(v + ((size_t)(b * 12 + hh) * 4096 + s) * 128 + e0) = w; } }
        } else {
            bf16_t* base = u.pn < 20 ? us : vs; const int c0 = 256 * ((u.pn - 18) & 1) + 32 * wc + 8 * fq;
#pragma unroll
            for (int ai = 0; ai < 2; ++ai)
#pragma unroll
                for (int m = 0; m < 4; ++m) { const int t = row0 + ai * HALF + m * 16;
#pragma unroll
                    for (int bj = 0; bj < 2; ++bj) { const f32x4 v0 = acc[ai][bj][m][0], v1 = acc[ai][bj][m][1];
                        const f32x2 a = gelu_pk((f32x2){v0[0], v0[1]}), bb = gelu_pk((f32x2){v0[2], v0[3]}), c = gelu_pk((f32x2){v1[0], v1[1]}), d = gelu_pk((f32x2){v1[2], v1[3]});
                        u32x4 w; w.x = cvt_pk_bf16(a.x, a.y); w.y = cvt_pk_bf16(bb.x, bb.y); w.z = cvt_pk_bf16(c.x, c.y); w.w = cvt_pk_bf16(d.x, d.y);
                        *(u32x4*)(base + (size_t)t * 512 + c0 + 128 * bj) = w; } }
        }
    }
};
struct EpiRes {
    typedef f32x4 AccT; static constexpr bool PERM = true, AFTER_DRAIN = false;
    const float* x; bf16_t* hb; const long long* modq;
    __device__ __forceinline__ void operator()(const f32x4 (&acc)[2][2][4][2], const Unit& u, int wr, int wc, int fr, int fq) const {
        const int row0 = u.pm * BM + wr * 64 + fr, col0 = u.pn * BM + wc * 32 + 8 * fq, b = u.pm >> 4;
        f32x4 gt[2][2];
#pragma unroll
        for (int bj = 0; bj < 2; ++bj)
#pragma unroll
            for (int n = 0; n < 2; ++n) { const long long* mp = modq + b * 12288 + 2 * 2048 + col0 + bj * HALF + n * 4;
#pragma unroll
                for (int i = 0; i < 4; ++i) gt[bj][n][i] = (float)(int)(mp[i] >> 32) + (float)(unsigned)mp[i] * 2.3283064365386963e-10f; }
#pragma unroll
        for (int ai = 0; ai < 2; ++ai)
#pragma unroll
            for (int m = 0; m < 4; ++m) { const size_t off = (size_t)(row0 + ai * HALF + m * 16) * 2048 + col0;
#pragma unroll
                for (int bj = 0; bj < 2; ++bj) { const f32x4 x0 = *(const f32x4*)(x + off + bj * HALF), x1 = *(const f32x4*)(x + off + bj * HALF + 4);
                    const f32x4 v0 = x0 + gt[bj][0] * acc[ai][bj][m][0], v1 = x1 + gt[bj][1] * acc[ai][bj][m][1];
                    u32x4 w; w.x = cvt_pk_bf16(v0[0], v0[1]); w.y = cvt_pk_bf16(v0[2], v0[3]); w.z = cvt_pk_bf16(v1[0], v1[1]); w.w = cvt_pk_bf16(v1[2], v1[3]);
                    *(u32x4*)(hb + off + bj * HALF) = w; } }
    }
};
struct EpiPq {
    typedef f32x4 AccT; static constexpr bool PERM = true, AFTER_DRAIN = false;
    bf16_t* o;
    __device__ __forceinline__ void operator()(const f32x4 (&acc)[2][2][4][2], const Unit& u, int wr, int wc, int fr, int fq) const {
        const int row0 = u.pm * BM + wr * 64 + fr, col0 = u.pn * BM + wc * 32 + 8 * fq;
#pragma unroll
        for (int ai = 0; ai < 2; ++ai)
#pragma unroll
            for (int m = 0; m < 4; ++m) { bf16_t* rowp = o + (size_t)(row0 + ai * HALF + m * 16) * 2048 + col0;
#pragma unroll
                for (int bj = 0; bj < 2; ++bj) { const f32x4 v0 = acc[ai][bj][m][0], v1 = acc[ai][bj][m][1];
                    u32x4 w; w.x = cvt_pk_bf16(v0[0], v0[1]); w.y = cvt_pk_bf16(v0[2], v0[3]); w.z = cvt_pk_bf16(v1[0], v1[1]); w.w = cvt_pk_bf16(v1[2], v1[3]);
                    *(u32x4*)(rowp + bj * HALF) = w; } }
    }
};

__device__ __forceinline__ void deq8(const i32x4 a0, const i32x4 a1, float sr, const f32x4 s0, const f32x4 s1, float (&o)[8]) {
    o[0] = (float)a0[0] * (sr * s0[0]); o[1] = (float)a0[1] * (sr * s0[1]); o[2] = (float)a0[2] * (sr * s0[2]); o[3] = (float)a0[3] * (sr * s0[3]);
    o[4] = (float)a1[0] * (sr * s1[0]); o[5] = (float)a1[1] * (sr * s1[1]); o[6] = (float)a1[2] * (sr * s1[2]); o[7] = (float)a1[3] * (sr * s1[3]);
}
struct EpiProj8 {
    typedef i32x4 AccT; static constexpr bool PERM = true, AFTER_DRAIN = false;
    bf16_t* q; bf16_t* k; bf16_t* v; bf16_t* us; bf16_t* vs; const int* pos; const float* sa; const float* sb;
    __device__ __forceinline__ void operator()(const i32x4 (&acc)[2][2][4][2], const Unit& u, int wr, int wc, int fr, int fq) const {
        const int row0 = u.pm * BM + wr * 64 + fr, b = u.pm >> 4;
        f32x4 sbv[2][2];
#pragma unroll
        for (int bj = 0; bj < 2; ++bj)
#pragma unroll
            for (int n = 0; n < 2; ++n) sbv[bj][n] = *(const f32x4*)(sb + u.pn * BM + bj * HALF + wc * 32 + 8 * fq + 4 * n);
        if (u.pn < 12) {
            const bool isq = u.pn < 6; bf16_t* base = isq ? q : k;
            const int hh = 2 * (isq ? u.pn : u.pn - 6) + (wc >> 1), e0 = 32 * (wc & 1) + 8 * fq;
            const float qs = isq ? 0.08838834764831845f : 1.0f;
            float ir[8];
#pragma unroll
            for (int j = 0; j < 8; ++j) ir[j] = exp2f(-(float)(e0 + j) * (13.287712379549449f / 64.0f)) * 0.15915494309189535f;
#pragma unroll
            for (int ai = 0; ai < 2; ++ai)
#pragma unroll
                for (int m = 0; m < 4; ++m) {
                    const int t = row0 + ai * HALF + m * 16, s = t & 4095;
                    const float pf = (float)pos[t], sr = sa[t] * qs;
                    float x0[8], x1[8], o0[8], o1[8];
                    deq8(acc[ai][0][m][0], acc[ai][0][m][1], sr, sbv[0][0], sbv[0][1], x0); deq8(acc[ai][1][m][0], acc[ai][1][m][1], sr, sbv[1][0], sbv[1][1], x1);
#pragma unroll
                    for (int j = 0; j < 8; ++j) { const float f = __builtin_amdgcn_fractf(pf * ir[j]); const float sn = __builtin_amdgcn_sinf(f), cs = __builtin_amdgcn_cosf(f);
                        o0[j] = x0[j] * cs - x1[j] * sn; o1[j] = x1[j] * cs + x0[j] * sn; }
                    bf16_t* dst = base + ((size_t)(b * 12 + hh) * 4096 + s) * 128 + e0;
                    u32x4 w0, w1;
                    w0.x = cvt_pk_bf16(o0[0], o0[1]); w0.y = cvt_pk_bf16(o0[2], o0[3]); w0.z = cvt_pk_bf16(o0[4], o0[5]); w0.w = cvt_pk_bf16(o0[6], o0[7]);
                    w1.x = cvt_pk_bf16(o1[0], o1[1]); w1.y = cvt_pk_bf16(o1[2], o1[3]); w1.z = cvt_pk_bf16(o1[4], o1[5]); w1.w = cvt_pk_bf16(o1[6], o1[7]);
                    *(u32x4*)dst = w0; *(u32x4*)(dst + 64) = w1; }
        } else if (u.pn < 18) {
            const int e0 = 32 * wc + 8 * fq;
#pragma unroll
            for (int ai = 0; ai < 2; ++ai)
#pragma unroll
                for (int m = 0; m < 4; ++m) { const int t = row0 + ai * HALF + m * 16, s = t & 4095; const float sr = sa[t];
#pragma unroll
                    for (int bj = 0; bj < 2; ++bj) { const int hh = 2 * (u.pn - 12) + bj; float x[8]; deq8(acc[ai][bj][m][0], acc[ai][bj][m][1], sr, sbv[bj][0], sbv[bj][1], x);
                        u32x4 w; w.x = cvt_pk_bf16(x[0], x[1]); w.y = cvt_pk_bf16(x[2], x[3]); w.z = cvt_pk_bf16(x[4], x[5]); w.w = cvt_pk_bf16(x[6], x[7]);
                        *(u32x4*)(v + ((size_t)(b * 12 + hh) * 4096 + s) * 128 + e0) = w; } }
        } else {
            bf16_t* base = u.pn < 20 ? us : vs; const int c0 = 256 * ((u.pn - 18) & 1) + 32 * wc + 8 * fq;
#pragma unroll
            for (int ai = 0; ai < 2; ++ai)
#pragma unroll
                for (int m = 0; m < 4; ++m) { const int t = row0 + ai * HALF + m * 16; const float sr = sa[t];
#pragma unroll
                    for (int bj = 0; bj < 2; ++bj) { float x[8]; deq8(acc[ai][bj][m][0], acc[ai][bj][m][1], sr, sbv[bj][0], sbv[bj][1], x);
                        const f32x2 a = gelu_pk((f32x2){x[0], x[1]}), bb = gelu_pk((f32x2){x[2], x[3]}), c = gelu_pk((f32x2){x[4], x[5]}), d = gelu_pk((f32x2){x[6], x[7]});
                        u32x4 w; w.x = cvt_pk_bf16(a.x, a.y); w.y = cvt_pk_bf16(bb.x, bb.y); w.z = cvt_pk_bf16(c.x, c.y); w.w = cvt_pk_bf16(d.x, d.y);
                        *(u32x4*)(base + (size_t)t * 512 + c0 + 128 * bj) = w; } }
        }
    }
};
struct EpiRes8 {
    typedef i32x4 AccT; static constexpr bool PERM = true, AFTER_DRAIN = false;
    bf16_t* db; const long long* modq; const float* sa; const float* sb;
    __device__ __forceinline__ void operator()(const i32x4 (&acc)[2][2][4][2], const Unit& u, int wr, int wc, int fr, int fq) const {
        const int row0 = u.pm * BM + wr * 64 + fr, col0 = u.pn * BM + wc * 32 + 8 * fq, b = u.pm >> 4;
        f32x4 gs[2][2];
#pragma unroll
        for (int bj = 0; bj < 2; ++bj)
#pragma unroll
            for (int n = 0; n < 2; ++n) { const long long* mp = modq + b * 12288 + 2 * 2048 + col0 + bj * HALF + n * 4; const f32x4 sv = *(const f32x4*)(sb + col0 + bj * HALF + n * 4);
#pragma unroll
                for (int i = 0; i < 4; ++i) gs[bj][n][i] = ((float)(int)(mp[i] >> 32) + (float)(unsigned)mp[i] * 2.3283064365386963e-10f) * sv[i]; }
#pragma unroll
        for (int ai = 0; ai < 2; ++ai)
#pragma unroll
            for (int m = 0; m < 4; ++m) { const int t = row0 + ai * HALF + m * 16; const size_t off = (size_t)t * 2048 + col0; const float sr = sa[t];
#pragma unroll
                for (int bj = 0; bj < 2; ++bj) { float d[8]; deq8(acc[ai][bj][m][0], acc[ai][bj][m][1], sr, gs[bj][0], gs[bj][1], d);
                    u32x4 w; w.x = cvt_pk_bf16(d[0], d[1]); w.y = cvt_pk_bf16(d[2], d[3]); w.z = cvt_pk_bf16(d[4], d[5]); w.w = cvt_pk_bf16(d[6], d[7]);
                    *(u32x4*)(db + off + bj * HALF) = w; } }
    }
};
struct EpiPq8 {
    typedef i32x4 AccT; static constexpr bool PERM = true, AFTER_DRAIN = false;
    bf16_t* o; const float* sa; const float* sb;
    __device__ __forceinline__ void operator()(const i32x4 (&acc)[2][2][4][2], const Unit& u, int wr, int wc, int fr, int fq) const {
        const int row0 = u.pm * BM + wr * 64 + fr, col0 = u.pn * BM + wc * 32 + 8 * fq;
        f32x4 sbv[2][2];
#pragma unroll
        for (int bj = 0; bj < 2; ++bj)
#pragma unroll
            for (int n = 0; n < 2; ++n) sbv[bj][n] = *(const f32x4*)(sb + col0 + bj * HALF + n * 4);
#pragma unroll
        for (int ai = 0; ai < 2; ++ai)
#pragma unroll
            for (int m = 0; m < 4; ++m) { const int t = row0 + ai * HALF + m * 16; bf16_t* rowp = o + (size_t)t * 2048 + col0; const float sr = sa[t];
#pragma unroll
                for (int bj = 0; bj < 2; ++bj) { float d[8]; deq8(acc[ai][bj][m][0], acc[ai][bj][m][1], sr, sbv[bj][0], sbv[bj][1], d);
                    u32x4 w; w.x = cvt_pk_bf16(d[0], d[1]); w.y = cvt_pk_bf16(d[2], d[3]); w.z = cvt_pk_bf16(d[4], d[5]); w.w = cvt_pk_bf16(d[6], d[7]);
                    *(u32x4*)(rowp + bj * HALF) = w; } }
    }
};
}

__device__ __forceinline__ void phase_gemm1(const Params& p, unsigned char* lds) {
    const float* scl = (const float*)(p.ws + OFF_SCL);
    pg8::Gemm g{(const bf16_t*)(p.ws + OFF_A), (const bf16_t*)(p.ws + OFF_WIN), T, DIN, D / 2};
    pg8::StaticOrder So; So.init(T, DIN, (int)gridDim.x, (int)blockIdx.x);
    pg8::EpiProj8 Ep{(bf16_t*)(p.ws + OFF_QKV), (bf16_t*)(p.ws + OFF_QKV + QKV_ONE), (bf16_t*)(p.ws + OFF_QKV + 2 * QKV_ONE), (bf16_t*)(p.ws + OFF_US), (bf16_t*)(p.ws + OFF_VS), p.pos, scl + SCL_HS, scl + SCL_WS + WS_IN};
    pg8::gemm_phase<pg8::EpiProj8, pg8::StaticOrder, true, true>((PG8_LAS unsigned char*)lds, g, So, Ep);
}
__device__ __forceinline__ void phase_gemm2(const Params& p, unsigned char* lds) {
    const float* scl = (const float*)(p.ws + OFF_SCL);
    pg8::Gemm g{(const bf16_t*)(p.ws + OFF_QKV), (const bf16_t*)(p.ws + OFF_WOUT), T, D, D / 2};
    pg8::StaticOrder So; So.init(T, D, (int)gridDim.x, (int)blockIdx.x);
    pg8::EpiRes8 Ep{(bf16_t*)(p.ws + OFF_O12), (const long long*)(p.ws + OFF_MOD), scl + SCL_MS, scl + SCL_WS + WS_OUT};
    pg8::gemm_phase<pg8::EpiRes8, pg8::StaticOrder, true, true>((PG8_LAS unsigned char*)lds, g, So, Ep);
}
__device__ __forceinline__ void phase_gemm3(const Params& p, unsigned char* lds) {
    const float* scl = (const float*)(p.ws + OFF_SCL);
    pg8::Gemm g{(const bf16_t*)(p.ws + OFF_US), (const bf16_t*)(p.ws + OFF_WQ), T, D, D / 2};
    pg8::StaticOrder So; So.init(T, D, (int)gridDim.x, (int)blockIdx.x);
    pg8::EpiPq8 Ep{(bf16_t*)(p.ws + OFF_QKV + (size_t)T * D * 2), (const float*)(p.ws + OFF_SGUO), scl + SCL_WS + WS_Q};
    pg8::gemm_phase<pg8::EpiPq8, pg8::StaticOrder, true, true>((PG8_LAS unsigned char*)lds, g, So, Ep);
}

__device__ __forceinline__ void conv_transpose(const float* __restrict__ W, int N, bf16_t* __restrict__ WT, int perm_limit, float* tile, int bid, int nblk, int tid) {
    const int ntiles = 32 * (N / 64);
    for (int tI = bid; tI < ntiles; tI += nblk) {
        const int tk = tI & 31, tn = tI >> 5, k0 = tk * 64, n0 = tn * 64;
        int l0 = n0;
        if (n0 < perm_limit) { const int base = n0 & ~255, pb = (n0 >> 6) & 3, bj = pb >> 1, qhi = pb & 1; l0 = base + 64 * bj + 128 * qhi; }
        __syncthreads();
#pragma unroll
        for (int pass = 0; pass < 2; ++pass) { const int r = pass * 32 + (tid >> 4), c4 = (tid & 15) * 4;
            const float4 v = *(const float4*)(W + (size_t)(k0 + r) * N + l0 + c4);
            tile[r * 65 + c4 + 0] = v.x; tile[r * 65 + c4 + 1] = v.y; tile[r * 65 + c4 + 2] = v.z; tile[r * 65 + c4 + 3] = v.w; }
        __syncthreads();
        const int n = tid >> 3, kq = (tid & 7) * 8;
        u32x4 w;
        w.x = pack2(tile[(kq + 0) * 65 + n], tile[(kq + 1) * 65 + n]); w.y = pack2(tile[(kq + 2) * 65 + n], tile[(kq + 3) * 65 + n]);
        w.z = pack2(tile[(kq + 4) * 65 + n], tile[(kq + 5) * 65 + n]); w.w = pack2(tile[(kq + 6) * 65 + n], tile[(kq + 7) * 65 + n]);
        *(u32x4*)(WT + (size_t)(n0 + n) * D + k0 + kq) = w;
    }
}
__device__ __forceinline__ void conv_flat(const float* __restrict__ src, bf16_t* __restrict__ dst, size_t n8, int bid, int nblk, int tid) {
    for (size_t i = (size_t)bid * NTHR + tid; i < n8; i += (size_t)nblk * NTHR) {
        const float4 a = ((const float4*)src)[2 * i], b = ((const float4*)src)[2 * i + 1];
        u32x4 w; w.x = pack2(a.x, a.y); w.y = pack2(a.z, a.w); w.z = pack2(b.x, b.y); w.w = pack2(b.z, b.w);
        ((u32x4*)dst)[i] = w; }
}
__device__ __forceinline__ unsigned q8pack(float a, float b, float c, float d, int bias) {
    const int qa = (int)rintf(a) + bias, qb = (int)rintf(b) + bias, qc = (int)rintf(c) + bias, qd = (int)rintf(d) + bias;
    return (unsigned)(qa & 255) | ((unsigned)(qb & 255) << 8) | ((unsigned)(qc & 255) << 16) | ((unsigned)(qd & 255) << 24);
}
template <int BIAS> __device__ __forceinline__ void conv_rows_i8(const float* __restrict__ src, unsigned char* __restrict__ dst, float* __restrict__ inv, int bid, int nblk, int tid) {
    const int lane = tid & 63, gw = bid * NWV + (tid >> 6), nw = nblk * NWV;
    for (int r = gw; r < NEXP; r += nw) {
        const float4* row = (const float4*)(src + (size_t)r * D);
        float4 v[8]; float m = 0.f;
#pragma unroll
        for (int i = 0; i < 8; ++i) { v[i] = row[i * 64 + lane]; m = fmaxf(m, fmaxf(fmaxf(fabsf(v[i].x), fabsf(v[i].y)), fmaxf(fabsf(v[i].z), fabsf(v[i].w)))); }
        m = wave_max(m);
        const float sc = m > 0.f ? 127.0f / m : 0.f, isc = m * (1.0f / 127.0f);
        unsigned char* drow = dst + (size_t)(lane >> 5) * SLICE_BYTES + (size_t)r * 128 + (lane & 31) * 4;
#pragma unroll
        for (int i = 0; i < 8; ++i) *(unsigned*)(drow + (size_t)(2 * i) * SLICE_BYTES) = q8pack(v[i].x * sc, v[i].y * sc, v[i].z * sc, v[i].w * sc, BIAS);
        if (lane == 0) inv[r] = isc;
    }
}
constexpr int NPM = 16;
__device__ __forceinline__ void conv_colmax_item(const float* __restrict__ W, int N, float* __restrict__ pm  , float* red, int it, int tid) {
    const int lane = tid & 63, wv = tid >> 6;
    const int cb = it / NPM, kg = it % NPM;
    const float* wp = W + (size_t)(kg * 128 + wv * 16) * N + cb * 256 + lane * 4;
    float4 w[16];
#pragma unroll
    for (int kk = 0; kk < 16; ++kk) w[kk] = *(const float4*)(wp + (size_t)kk * N);
    float4 m = make_float4(0.f, 0.f, 0.f, 0.f);
#pragma unroll
    for (int kk = 0; kk < 16; ++kk) { m.x = fmaxf(m.x, fabsf(w[kk].x)); m.y = fmaxf(m.y, fabsf(w[kk].y)); m.z = fmaxf(m.z, fabsf(w[kk].z)); m.w = fmaxf(m.w, fabsf(w[kk].w)); }
    __syncthreads();
    *(float4*)(red + wv * 256 + lane * 4) = m;
    __syncthreads();
    if (tid < 256) { float mm = 0.f;
#pragma unroll
        for (int w8 = 0; w8 < 8; ++w8) mm = fmaxf(mm, red[w8 * 256 + tid]);
        pm[kg * NWCOL + cb * 256 + tid] = mm; }
}
__device__ __forceinline__ void conv_tables_queue(const Params& p, unsigned* qh, int tid, unsigned char* lds) {
    int lane = tid & 63; asm volatile("" : "+v"(lane));
    const int wv = __builtin_amdgcn_readfirstlane(tid >> 6);
    volatile LAS_ unsigned* sh = (volatile LAS_ unsigned*)((LAS_ unsigned char*)lds);
    float4 v[8];
#define CT_LOAD(src_, rr) do { const float4* _row = (const float4*)((src_) + (size_t)(rr) * D); _Pragma("unroll") for (int i = 0; i < 8; ++i) v[i] = _row[i * 64 + lane]; } while (0)
    __syncthreads();
    if (tid == 0) sh[0] = atomicAdd(qh, 1u);
    __syncthreads();
    unsigned c = sh[0];
    if (c < 512u) CT_LOAD(c < 256u ? p.peer_u : p.peer_v, (c & 255u) * 64u + wv * 8);
    while (c < 512u) {
        __syncthreads();
        unsigned cn = 0; if (tid == 0) cn = atomicAdd(qh, 1u);
        const bool isv = c >= 256u; const float* src = isv ? p.peer_v : p.peer_u; const int bias = isv ? 128 : 0;
        unsigned char* dst = p.ws + (isv ? OFF_VTAB : OFF_UTAB); float* inv = (float*)(dst + TAB8_BYTES);
#pragma unroll 1
        for (int k = 0; k < 8; ++k) {
            const int r = (int)(c & 255u) * 64 + wv * 8 + k;
            float4 w[8]; float m = 0.f;
#pragma unroll
            for (int i = 0; i < 8; ++i) { w[i] = v[i]; m = fmaxf(m, fmaxf(fmaxf(fabsf(w[i].x), fabsf(w[i].y)), fmaxf(fabsf(w[i].z), fabsf(w[i].w)))); }
            if (k < 7) CT_LOAD(src, r + 1);
            else { if (tid == 0) sh[0] = cn; __syncthreads(); cn = sh[0]; if (cn < 512u) CT_LOAD(cn < 256u ? p.peer_u : p.peer_v, (cn & 255u) * 64u + wv * 8); }
            m = wave_max(m);
            const float sc = m > 0.f ? 127.0f / m : 0.f;
            unsigned char* drow = dst + (size_t)(lane >> 5) * SLICE_BYTES + (size_t)r * 128 + (lane & 31) * 4;
#pragma unroll
            for (int i = 0; i < 8; ++i) *(unsigned*)(drow + (size_t)(2 * i) * SLICE_BYTES) = q8pack(w[i].x * sc, w[i].y * sc, w[i].z * sc, w[i].w * sc, bias);
            if (lane == 0) inv[r] = m * (1.0f / 127.0f);
        }
        c = cn;
    }
#undef CT_LOAD
}
__device__ __forceinline__ void conv_transpose_q8(const float* __restrict__ W, int N, unsigned char* __restrict__ WT, const float* __restrict__ pm, float* __restrict__ wscale, int perm_limit, float* tile, int bid, int nblk, int tid) {
    const int ntiles = 32 * (N / 64);
    for (int tI = bid; tI < ntiles; tI += nblk) {
        const int tk = tI & 31, tn = tI >> 5, k0 = tk * 64, n0 = tn * 64;
        int l0 = n0;
        if (n0 < perm_limit) { const int base = n0 & ~255, pb = (n0 >> 6) & 3, bj = pb >> 1, qhi = pb & 1; l0 = base + 64 * bj + 128 * qhi; }
        __syncthreads();
#pragma unroll
        for (int pass = 0; pass < 2; ++pass) { const int r = pass * 32 + (tid >> 4), c4 = (tid & 15) * 4;
            const float4 v = *(const float4*)(W + (size_t)(k0 + r) * N + l0 + c4);
            tile[r * 65 + c4 + 0] = v.x; tile[r * 65 + c4 + 1] = v.y; tile[r * 65 + c4 + 2] = v.z; tile[r * 65 + c4 + 3] = v.w; }
        __syncthreads();
        const int n = tid >> 3, kq = (tid & 7) * 8, lc = l0 + n;
        float cm = 0.f;
#pragma unroll
        for (int q = 0; q < NPM; ++q) cm = fmaxf(cm, pm[q * NWCOL + lc]);
        const float sc = cm > 0.f ? 127.0f / cm : 0.f;
        u32x2 w;
        w.x = q8pack(tile[(kq + 0) * 65 + n] * sc, tile[(kq + 1) * 65 + n] * sc, tile[(kq + 2) * 65 + n] * sc, tile[(kq + 3) * 65 + n] * sc, 0);
        w.y = q8pack(tile[(kq + 4) * 65 + n] * sc, tile[(kq + 5) * 65 + n] * sc, tile[(kq + 6) * 65 + n] * sc, tile[(kq + 7) * 65 + n] * sc, 0);
        *(u32x2*)(WT + (size_t)(n0 + n) * D + k0 + kq) = w;
        if (tk == 0 && kq == 0) wscale[n0 + n] = cm * (1.0f / 127.0f);
    }
}
__device__ __forceinline__ void phase_quant_weights(const Params& p, unsigned char* lds) {
    const int tid = threadIdx.x, bid = blockIdx.x, nblk = gridDim.x;
    const float* scl = (const float*)(p.ws + OFF_SCL); float* ws = (float*)(p.ws + OFF_SCL) + SCL_WS;
    conv_transpose_q8(p.w_in, DIN, p.ws + OFF_WIN, scl + SCL_PM + WS_IN, ws + WS_IN, 3072, (float*)lds, bid, nblk, tid);
    conv_transpose_q8(p.w_out, D, p.ws + OFF_WOUT, scl + SCL_PM + WS_OUT, ws + WS_OUT, 0, (float*)lds, bid, nblk, tid);
    conv_transpose_q8(p.peer_w_q, D, p.ws + OFF_WQ, scl + SCL_PM + WS_Q, ws + WS_Q, 0, (float*)lds, bid, nblk, tid);
}
__device__ __forceinline__ void phase_conv(const Params& p, unsigned char* lds, bool dup = false) {
    const int tid = threadIdx.x, bid = blockIdx.x, nblk = gridDim.x;
    unsigned long long* mod = (unsigned long long*)(p.ws + OFF_MOD);
    unsigned long long cts = 0; CSTAMP(0);
    for (int it = bid; it < (dup ? 0 : 192); it += nblk) {
        const int cb = it % 48, kg = it / 48, lane = tid & 63, wv = tid >> 6;
        float* sc = (float*)lds;
        float* red = (float*)lds + 2048;
        __syncthreads();
        for (int i = tid; i < 2048; i += NTHR) { const int b = i >> 9, kk = i & 511; const float cv = p.c[b * D + kg * 512 + kk]; sc[i] = cv / (1.f + __expf(-cv)); }
        __syncthreads();
        float acc[4][4];
#pragma unroll
        for (int b = 0; b < 4; ++b) { acc[b][0] = 0.f; acc[b][1] = 0.f; acc[b][2] = 0.f; acc[b][3] = 0.f; }
        const float* wp = p.w_ada + (size_t)(kg * 512 + wv * 64) * 12288 + cb * 256 + lane * 4;
#pragma unroll 1
        for (int k0 = 0; k0 < 64; k0 += 16) {
            float4 w[16];
#pragma unroll
            for (int kk = 0; kk < 16; ++kk) w[kk] = *(const float4*)(wp + (size_t)(k0 + kk) * 12288);
#pragma unroll
            for (int kk = 0; kk < 16; ++kk)
#pragma unroll
                for (int b = 0; b < 4; ++b) { const float sv = sc[b * 512 + wv * 64 + k0 + kk];
                    acc[b][0] += sv * w[kk].x; acc[b][1] += sv * w[kk].y; acc[b][2] += sv * w[kk].z; acc[b][3] += sv * w[kk].w; }
        }
#pragma unroll
        for (int b = 0; b < 4; ++b) *(float4*)(red + (wv * 4 + b) * 256 + lane * 4) = make_float4(acc[b][0], acc[b][1], acc[b][2], acc[b][3]);
        __syncthreads();
        if (tid < 256) {
#pragma unroll
            for (int b = 0; b < 4; ++b) { float sum = 0.f;
#pragma unroll
                for (int w8 = 0; w8 < 8; ++w8) sum += red[(w8 * 4 + b) * 256 + tid];
                const int col = cb * 256 + tid;
                if (kg == 0) sum += p.b_ada[col];
                atomicAdd(mod + b * 12288 + col, (unsigned long long)__double2ll_rn((double)sum * 4294967296.0)); }
        }
    }
    CSTAMP(1);
    { float* pm = (float*)(p.ws + OFF_SCL) + SCL_PM;
      const int vb = (bid + nblk - (192 % nblk)) % nblk;
      for (int it = vb; it < (DIN / 256 + 2 * (D / 256)) * NPM; it += nblk) {
          if (it < (DIN / 256) * NPM) conv_colmax_item(p.w_in, DIN, pm + WS_IN, (float*)lds, it, tid);
          else if (it < (DIN / 256 + D / 256) * NPM) conv_colmax_item(p.w_out, D, pm + WS_OUT, (float*)lds, it - (DIN / 256) * NPM, tid);
          else conv_colmax_item(p.peer_w_q, D, pm + WS_Q, (float*)lds, it - (DIN / 256 + D / 256) * NPM, tid); } }
    CSTAMP(2);
    conv_flat(p.peer_sub_keys, (bf16_t*)(p.ws + OFF_SUBK), (size_t)8 * 2 * 128 * 128 / 8, bid, nblk, tid);
    { bf16_t* sw = (bf16_t*)(p.ws + OFF_SGUW);
      for (int i = bid * NTHR + tid; i < 4 * 128 * 128; i += nblk * NTHR) { const int jj = i & 127, ii = (i >> 7) & 127; sw[i] = f2bf(jj <= ii ? p.sgu_w[i] : 0.f); } }
    CSTAMP(3);
    if (!dup) conv_tables_queue(p, (unsigned*)(p.ws + OFF_CTL + OFF_QUEUE) + 64 * 64, tid, lds);
}

template <bool Q8, bool SRC16, bool W16, int XB = 0> __device__ __forceinline__ void phase_norm_mod(const Params& p, const void* __restrict__ src_, const float* __restrict__ g, int sh_i, int sc_i, bf16_t* __restrict__ dst, unsigned char* __restrict__ dst8, float* __restrict__ dscale) {
    const int lane = threadIdx.x & 63, gw = blockIdx.x * NWV + __builtin_amdgcn_readfirstlane(threadIdx.x >> 6), nw = gridDim.x * NWV;
    const int wpb = nw >> 2;
    const int b = gw / wpb, r0 = gw - b * wpb;
    if (b >= NB) return;
    float4 ca[8], cb[8];
#pragma unroll
    for (int i = 0; i < 8; ++i) { const int col = i * 256 + lane * 4; const float4 gg = *(const float4*)(g + col), sc = mod4(p, b, sc_i, col), sh = mod4(p, b, sh_i, col);
        ca[i] = make_float4(gg.x * (1.f + sc.x), gg.y * (1.f + sc.y), gg.z * (1.f + sc.z), gg.w * (1.f + sc.w)); cb[i] = sh; }
    float4 vf[8]; u32x2 vh[8];
#define NM_LOAD(tt) do { _Pragma("unroll") for (int i = 0; i < 8; ++i) { if (SRC16) { vh[i] = *(const u32x2*)((const bf16_t*)src_ + (size_t)(tt) * D + i * 256 + lane * 4); \
            if (XB == 2) { const u32x2 _x = *(const u32x2*)((const bf16_t*)(p.ws + OFF_XB) + (size_t)(tt) * D + i * 256 + lane * 4); vf[i] = make_float4(bflo(_x.x), bfhi(_x.x), bflo(_x.y), bfhi(_x.y)); } else vf[i] = *(const float4*)(p.x + (size_t)(tt) * D + i * 256 + lane * 4); } \
        else vf[i] = *(const float4*)((const float*)src_ + (size_t)(tt) * D + i * 256 + lane * 4); } } while (0)
    if (r0 < S) NM_LOAD(b * S + r0);
    for (int r = r0; r < S; r += wpb) {
        const int t = b * S + r;
        float4 v[8]; float ss = 0.f;
#pragma unroll
        for (int i = 0; i < 8; ++i) { v[i] = SRC16 ? make_float4(vf[i].x + bflo(vh[i].x), vf[i].y + bfhi(vh[i].x), vf[i].z + bflo(vh[i].y), vf[i].w + bfhi(vh[i].y)) : vf[i];
            if (XB == 1) { u32x2 w; w.x = pack2(v[i].x, v[i].y); w.y = pack2(v[i].z, v[i].w); *(u32x2*)((bf16_t*)(p.ws + OFF_XB) + (size_t)t * D + i * 256 + lane * 4) = w; }
            ss += v[i].x * v[i].x + v[i].y * v[i].y + v[i].z * v[i].z + v[i].w * v[i].w; }
        if (r + wpb < S) NM_LOAD(t + wpb);
        ss = wave_sum(ss); const float rstd = rsqrtf(ss * (1.0f / D) + 1e-6f);
        float m = 0.f;
#pragma unroll
        for (int i = 0; i < 8; ++i) { const int col = i * 256 + lane * 4;
            v[i].x = v[i].x * rstd * ca[i].x + cb[i].x; v[i].y = v[i].y * rstd * ca[i].y + cb[i].y; v[i].z = v[i].z * rstd * ca[i].z + cb[i].z; v[i].w = v[i].w * rstd * ca[i].w + cb[i].w;
            if (W16) { u32x2 w; w.x = pack2(v[i].x, v[i].y); w.y = pack2(v[i].z, v[i].w); *(u32x2*)(dst + (size_t)t * D + col) = w; }
            if (Q8) m = fmaxf(m, fmaxf(fmaxf(fabsf(v[i].x), fabsf(v[i].y)), fmaxf(fabsf(v[i].z), fabsf(v[i].w)))); }
        if (Q8) {
            m = wave_max(m); const float sc8 = m > 0.f ? 127.0f / m : 0.f;
            unsigned* x8 = (unsigned*)(dst8 + (size_t)t * D);
#pragma unroll
            for (int i = 0; i < 8; ++i) x8[i * 64 + lane] = q8pack(v[i].x * sc8, v[i].y * sc8, v[i].z * sc8, v[i].w * sc8, 0);
            if (lane == 0) dscale[t] = m * (1.0f / 127.0f);
        }
    }
#undef NM_LOAD
}

constexpr int NM_CHUNK = 16;
template <bool Q8, bool SRC16, bool W16> __device__ __forceinline__ void phase_norm_mod_q(const Params& p, const void* __restrict__ src_, const float* __restrict__ g, int sh_i, int sc_i, bf16_t* __restrict__ dst, unsigned char* __restrict__ dst8, float* __restrict__ dscale, unsigned* qh) {
    int lane = threadIdx.x & 63; asm volatile("" : "+v"(lane));
    const int gw = blockIdx.x * NWV + __builtin_amdgcn_readfirstlane(threadIdx.x >> 6), nw = gridDim.x * NWV;
    const int b0 = (gw * NB) / nw;
    float4 vf[8]; u32x2 vh[8];
#define NM_LOAD(tt) do { _Pragma("unroll") for (int i = 0; i < 8; ++i) { if (SRC16) { vh[i] = *(const u32x2*)((const bf16_t*)src_ + (size_t)(tt) * D + i * 256 + lane * 4); vf[i] = *(const float4*)(p.x + (size_t)(tt) * D + i * 256 + lane * 4); } else vf[i] = *(const float4*)((const float*)src_ + (size_t)(tt) * D + i * 256 + lane * 4); } } while (0)
    for (int bb = 0; bb < NB; ++bb) {
        const int b = (b0 + bb) & (NB - 1);
        unsigned c = 0; if (lane == 0) c = atomicAdd(qh + b * 64, 1u);
        c = __builtin_amdgcn_readfirstlane(c);
        if (c >= (unsigned)(S / NM_CHUNK)) continue;
        float4 ca[8], cb[8];
#pragma unroll
        for (int i = 0; i < 8; ++i) { const int col = i * 256 + lane * 4; const float4 gg = *(const float4*)(g + col), sc = mod4(p, b, sc_i, col), sh = mod4(p, b, sh_i, col);
            ca[i] = make_float4(gg.x * (1.f + sc.x), gg.y * (1.f + sc.y), gg.z * (1.f + sc.z), gg.w * (1.f + sc.w)); cb[i] = sh; }
        NM_LOAD(b * S + (int)c * NM_CHUNK);
        while (c < (unsigned)(S / NM_CHUNK)) {
            unsigned cn = 0; if (lane == 0) cn = atomicAdd(qh + b * 64, 1u);
#pragma unroll 1
            for (int k = 0; k < NM_CHUNK; ++k) {
                const int t = b * S + (int)c * NM_CHUNK + k;
                float4 v[8]; float ss = 0.f;
#pragma unroll
                for (int i = 0; i < 8; ++i) { v[i] = SRC16 ? make_float4(vf[i].x + bflo(vh[i].x), vf[i].y + bfhi(vh[i].x), vf[i].z + bflo(vh[i].y), vf[i].w + bfhi(vh[i].y)) : vf[i];
                    ss += v[i].x * v[i].x + v[i].y * v[i].y + v[i].z * v[i].z + v[i].w * v[i].w; }
                if (k < NM_CHUNK - 1) NM_LOAD(t + 1);
                else { cn = __builtin_amdgcn_readfirstlane(cn); if (cn < (unsigned)(S / NM_CHUNK)) NM_LOAD(b * S + (int)cn * NM_CHUNK); }
                ss = wave_sum(ss); const float rstd = rsqrtf(ss * (1.0f / D) + 1e-6f);
                float m = 0.f;
#pragma unroll
                for (int i = 0; i < 8; ++i) { const int col = i * 256 + lane * 4;
                    v[i].x = v[i].x * rstd * ca[i].x + cb[i].x; v[i].y = v[i].y * rstd * ca[i].y + cb[i].y; v[i].z = v[i].z * rstd * ca[i].z + cb[i].z; v[i].w = v[i].w * rstd * ca[i].w + cb[i].w;
                    if (W16) { u32x2 w; w.x = pack2(v[i].x, v[i].y); w.y = pack2(v[i].z, v[i].w); *(u32x2*)(dst + (size_t)t * D + col) = w; }
                    if (Q8) m = fmaxf(m, fmaxf(fmaxf(fabsf(v[i].x), fabsf(v[i].y)), fmaxf(fabsf(v[i].z), fabsf(v[i].w)))); }
                if (Q8) {
                    m = wave_max(m); const float sc8 = m > 0.f ? 127.0f / m : 0.f;
                    unsigned* x8 = (unsigned*)(dst8 + (size_t)t * D);
#pragma unroll
                    for (int i = 0; i < 8; ++i) x8[i * 64 + lane] = q8pack(v[i].x * sc8, v[i].y * sc8, v[i].z * sc8, v[i].w * sc8, 0);
                    if (lane == 0) dscale[t] = m * (1.0f / 127.0f);
                }
            }
            c = cn;
        }
    }
#undef NM_LOAD
}

#define LAS __attribute__((address_space(3)))
typedef short bf16x8 __attribute__((ext_vector_type(8)));
typedef short s16x4 __attribute__((ext_vector_type(4)));
constexpr int ATT_VOFF = 65536, ATT_VSTRIDE = 288;
__device__ __forceinline__ unsigned cvt_pk(float lo, float hi) { unsigned r; asm volatile("v_cvt_pk_bf16_f32 %0, %1, %2" : "=v"(r) : "v"(lo), "v"(hi)); return r; }
struct AttnItem { int pat, bh, r, n, dsh; };
__device__ __forceinline__ AttnItem attn_decode(int item) {
    AttnItem a; a.pat = item / 1536; const int rem = item % 1536; a.bh = rem >> 5; const int ci = rem & 31;
    a.dsh = 2 * a.pat; const int nblk = 32 >> a.dsh; a.r = ci / nblk; a.n = ci % nblk; return a;
}
__device__ __forceinline__ void attn_issue(const AttnItem& a, const bf16_t* qb, const bf16_t* kb, const bf16_t* vb, int tid, int w, int l15, int g, u32x4 (&kr)[8], u32x4 (&vr)[8], bf16x8 (&qf)[4]) {
    const size_t hb = (size_t)a.bh * S;
#pragma unroll
    for (int i = 0; i < 8; ++i) { const int ch = i * NTHR + tid, kk = ch >> 4, c = ch & 15;
        if (a.n > 0 || kk >= 128) { const int tp = (((a.n - 1) * 128 + kk) << a.dsh) + a.r;
            kr[i] = *(const u32x4*)(kb + (hb + tp) * E + c * 8); vr[i] = *(const u32x4*)(vb + (hb + tp) * E + c * 8); } }
    const int tq = ((a.n * 128 + 16 * w + l15) << a.dsh) + a.r;
#pragma unroll
    for (int ks = 0; ks < 4; ++ks) qf[ks] = *(const bf16x8*)(qb + (hb + tq) * E + 32 * ks + 8 * g);
}
__device__ __forceinline__ void phase_attn(const Params& p, unsigned char* lds_) {
    LAS unsigned char* lds = (LAS unsigned char*)lds_;
    const int tid = threadIdx.x, lane = tid & 63, w = __builtin_amdgcn_readfirstlane(tid >> 6), l15 = lane & 15, g = lane >> 4;
    const bf16_t* qb = (const bf16_t*)(p.ws + OFF_QKV); const bf16_t* kb = (const bf16_t*)(p.ws + OFF_QKV + QKV_ONE); const bf16_t* vb = (const bf16_t*)(p.ws + OFF_QKV + 2 * QKV_ONE);
    float* lse = (float*)(p.ws + OFF_LSE);
    const int G = gridDim.x, vcu = (G % 8 == 0) ? (int)(blockIdx.x & 7) * (G >> 3) + (int)(blockIdx.x >> 3) : (int)blockIdx.x;
    const float NEG = -__builtin_inff();
    constexpr int NITEMS = 3 * 48 * 32;
    u32x4 kr[8], vr[8]; bf16x8 qn[4];
    if (vcu < NITEMS) attn_issue(attn_decode(vcu), qb, kb, vb, tid, w, l15, g, kr, vr, qn);
    for (int item = vcu; item < NITEMS; item += G) {
        const AttnItem a = attn_decode(item);
        const int pat = a.pat, bh = a.bh, r = a.r, n = a.n, dsh = a.dsh;
        __syncthreads();
#pragma unroll
        for (int i = 0; i < 8; ++i) { const int ch = i * NTHR + tid, kk = ch >> 4, c = ch & 15;
            if (n > 0 || kk >= 128) { *(LAS u32x4*)(lds + kk * 256 + ((c ^ (kk & 15)) << 4)) = kr[i]; *(LAS u32x4*)(lds + ATT_VOFF + kk * ATT_VSTRIDE + c * 16) = vr[i]; } }
        bf16x8 qf[4];
#pragma unroll
        for (int ks = 0; ks < 4; ++ks) { qf[ks] = qn[ks]; asm volatile("" : "+v"(qf[ks])); }
        __syncthreads();
        if (item + G < NITEMS) attn_issue(attn_decode(item + G), qb, kb, vb, tid, w, l15, g, kr, vr, qn);
        const int jj = 16 * w + l15, tq = ((n * 128 + jj) << dsh) + r;
        const int s0 = w >> 1;
        f32x4 sA[5], sB[5];
#define ATT_LDK(dst, step_, kp_) do { const int _kA = 32 * (step_) + l15, _kB = _kA + 16; _Pragma("unroll") for (int q = 0; q < 2; ++q) { const int ks = 2 * (kp_) + q; \
            dst[2 * q] = *(const LAS bf16x8*)(lds + _kA * 256 + (((4 * ks + g) ^ (_kA & 15)) << 4)); dst[2 * q + 1] = *(const LAS bf16x8*)(lds + _kB * 256 + (((4 * ks + g) ^ (_kB & 15)) << 4)); } } while (0)
        bf16x8 kc[4], kn[4];
        ATT_LDK(kc, s0, 0);
#pragma unroll
        for (int gi = 0; gi < 10; ++gi) {
            const int si = gi >> 1, kp = gi & 1, step = s0 + si;
            if (gi < 9) ATT_LDK(kn, s0 + ((gi + 1) >> 1), (gi + 1) & 1);
            __builtin_amdgcn_sched_barrier(0);
            if (kp == 0) { sA[si] = (f32x4){0.f, 0.f, 0.f, 0.f}; sB[si] = (f32x4){0.f, 0.f, 0.f, 0.f}; }
            if (!(n == 0 && step < 4)) {
#pragma unroll
                for (int q = 0; q < 2; ++q) { sA[si] = __builtin_amdgcn_mfma_f32_16x16x32_bf16(kc[2 * q], qf[2 * kp + q], sA[si], 0, 0, 0); sB[si] = __builtin_amdgcn_mfma_f32_16x16x32_bf16(kc[2 * q + 1], qf[2 * kp + q], sB[si], 0, 0, 0); } }
            if (kp == 1 && (n == 0 && step < 4)) { sA[si] = (f32x4){NEG, NEG, NEG, NEG}; sB[si] = (f32x4){NEG, NEG, NEG, NEG}; }
            if (kp == 1 && (si == 0 || si == 4)) {
#pragma unroll
                for (int rg = 0; rg < 4; ++rg) { const int ka = 32 * step + 4 * g + rg, kb2 = ka + 16;
                    const bool oka = (unsigned)(ka - jj) <= 128u, okb = (unsigned)(kb2 - jj) <= 128u;
                    sA[si][rg] = oka ? sA[si][rg] : NEG; sB[si][rg] = okb ? sB[si][rg] : NEG; } }
            if (gi < 9) {
#pragma unroll
                for (int q = 0; q < 4; ++q) kc[q] = kn[q]; }
        }
#undef ATT_LDK
        float m = NEG;
#pragma unroll
        for (int si = 0; si < 5; ++si)
#pragma unroll
            for (int rg = 0; rg < 4; ++rg) m = fmaxf(m, fmaxf(sA[si][rg], sB[si][rg]));
        m = fmaxf(m, __shfl_xor(m, 16)); m = fmaxf(m, __shfl_xor(m, 32));
        float l = 0.f; const float mL = m * 1.4426950408889634f;
#pragma unroll
        for (int si = 0; si < 5; ++si)
#pragma unroll
            for (int rg = 0; rg < 4; ++rg) { sA[si][rg] = __builtin_amdgcn_exp2f(sA[si][rg] * 1.4426950408889634f - mL); sB[si][rg] = __builtin_amdgcn_exp2f(sB[si][rg] * 1.4426950408889634f - mL); l += sA[si][rg] + sB[si][rg]; }
        l += __shfl_xor(l, 16); l += __shfl_xor(l, 32);
        f32x4 o[8];
#pragma unroll
        for (int dt = 0; dt < 8; ++dt) o[dt] = (f32x4){0.f, 0.f, 0.f, 0.f};
#define ATT_LDV(dst, step_, hf_) do { LAS unsigned char* _vr = lds + ATT_VOFF + (32 * (step_) + 4 * g + (l15 >> 2)) * ATT_VSTRIDE + (l15 & 3) * 8 + (hf_) * 128; _Pragma("unroll") for (int q = 0; q < 4; ++q) { \
            dst[2 * q] = __builtin_amdgcn_ds_read_tr16_b64_v4i16((LAS s16x4*)(_vr + q * 32)); dst[2 * q + 1] = __builtin_amdgcn_ds_read_tr16_b64_v4i16((LAS s16x4*)(_vr + q * 32 + 16 * ATT_VSTRIDE)); } } while (0)
        bf16x8 pfa[5];
#pragma unroll
        for (int si = 0; si < 5; ++si) { u32x4 pw; pw.x = cvt_pk(sA[si][0], sA[si][1]); pw.y = cvt_pk(sA[si][2], sA[si][3]); pw.z = cvt_pk(sB[si][0], sB[si][1]); pw.w = cvt_pk(sB[si][2], sB[si][3]); pfa[si] = *reinterpret_cast<const bf16x8*>(&pw); }
        s16x4 vc[8], vn[8];
        ATT_LDV(vc, s0, 0);
#pragma unroll
        for (int gi = 0; gi < 10; ++gi) {
            const int si = gi >> 1, hf = gi & 1, step = s0 + si;
            if (gi < 9) ATT_LDV(vn, s0 + ((gi + 1) >> 1), (gi + 1) & 1);
            __builtin_amdgcn_sched_barrier(0);
            if (!(n == 0 && step < 4)) {
#pragma unroll
                for (int q = 0; q < 4; ++q) { const s16x4 v0 = vc[2 * q], v1 = vc[2 * q + 1];
                    const bf16x8 vf = {v0[0], v0[1], v0[2], v0[3], v1[0], v1[1], v1[2], v1[3]};
                    o[4 * hf + q] = __builtin_amdgcn_mfma_f32_16x16x32_bf16(vf, pfa[si], o[4 * hf + q], 0, 0, 0); } }
            if (gi < 9) {
#pragma unroll
                for (int q = 0; q < 8; ++q) vc[q] = vn[q]; }
        }
#undef ATT_LDV
        const float il = 1.0f / l; const int b_ = bh / HA, h = bh % HA; const size_t tg = (size_t)b_ * S + tq;
        bf16_t* orow = P_opat(p, pat) + tg * DA + h * E + 4 * g;
#pragma unroll
        for (int dt = 0; dt < 8; ++dt) { u32x2 ww; ww.x = cvt_pk(o[dt][0] * il, o[dt][1] * il); ww.y = cvt_pk(o[dt][2] * il, o[dt][3] * il); *(u32x2*)(orow + 16 * dt) = ww; }
        if (g == 0) lse[((size_t)pat * T + tg) * HA + h] = m + __logf(l);
    }
}

__device__ __forceinline__ void phase_sgu(const Params& p, unsigned char* lds_) {
    LAS unsigned char* lds = (LAS unsigned char*)lds_;
    const int tid = threadIdx.x, lane = tid & 63, w = __builtin_amdgcn_readfirstlane(tid >> 6), l15 = lane & 15, g = lane >> 4;
    const bf16_t* vsb = (const bf16_t*)(p.ws + OFF_VS); const bf16_t* usb = (const bf16_t*)(p.ws + OFF_US); bf16_t* ob = (bf16_t*)(p.ws + OFF_SGUO);
    const bf16_t* sw = (const bf16_t*)(p.ws + OFF_SGUW);
    for (int item = blockIdx.x; item < (T / 128) * HS; item += gridDim.x) {
        const int h = item & 3, t0 = (item >> 2) * 128;
        __syncthreads();
        {
            const int j = tid >> 2, part = tid & 3;
            const u32x4* src = (const u32x4*)(vsb + (size_t)(t0 + j) * DS + h * E + part * 32);
            u32x4 x[4]; float sum = 0.f;
#pragma unroll
            for (int i = 0; i < 4; ++i) { x[i] = src[i]; sum += bflo(x[i].x) + bfhi(x[i].x) + bflo(x[i].y) + bfhi(x[i].y) + bflo(x[i].z) + bfhi(x[i].z) + bflo(x[i].w) + bfhi(x[i].w); }
            sum += __shfl_xor(sum, 1); sum += __shfl_xor(sum, 2);
            const float mu = sum * (1.0f / E); float var = 0.f;
#pragma unroll
            for (int i = 0; i < 4; ++i) { float dd;
                dd = bflo(x[i].x) - mu; var += dd * dd; dd = bfhi(x[i].x) - mu; var += dd * dd; dd = bflo(x[i].y) - mu; var += dd * dd; dd = bfhi(x[i].y) - mu; var += dd * dd;
                dd = bflo(x[i].z) - mu; var += dd * dd; dd = bfhi(x[i].z) - mu; var += dd * dd; dd = bflo(x[i].w) - mu; var += dd * dd; dd = bfhi(x[i].w) - mu; var += dd * dd; }
            var += __shfl_xor(var, 1); var += __shfl_xor(var, 2);
            const float rs = rsqrtf(var * (1.0f / E) + 1e-5f);
            const float* lg = p.sgu_ln_g + h * E + part * 32; const float* lb = p.sgu_ln_b + h * E + part * 32;
#pragma unroll
            for (int i = 0; i < 4; ++i) { const float4 g0 = *(const float4*)(lg + i * 8), g1 = *(const float4*)(lg + i * 8 + 4), b0 = *(const float4*)(lb + i * 8), b1 = *(const float4*)(lb + i * 8 + 4);
                u32x4 o; o.x = cvt_pk((bflo(x[i].x) - mu) * rs * g0.x + b0.x, (bfhi(x[i].x) - mu) * rs * g0.y + b0.y); o.y = cvt_pk((bflo(x[i].y) - mu) * rs * g0.z + b0.z, (bfhi(x[i].y) - mu) * rs * g0.w + b0.w);
                o.z = cvt_pk((bflo(x[i].z) - mu) * rs * g1.x + b1.x, (bfhi(x[i].z) - mu) * rs * g1.y + b1.y); o.w = cvt_pk((bflo(x[i].w) - mu) * rs * g1.z + b1.z, (bfhi(x[i].w) - mu) * rs * g1.w + b1.w);
                *(LAS u32x4*)(lds + j * ATT_VSTRIDE + part * 64 + i * 16) = o; }
        }
        __syncthreads();
        f32x4 acc[8];
#pragma unroll
        for (int et = 0; et < 8; ++et) acc[et] = (f32x4){0.f, 0.f, 0.f, 0.f};
        const int irow = 16 * w + l15, nsteps = (16 * w + 15) / 32 + 1;
        const bf16_t* wrow = sw + ((size_t)h * 128 + irow) * 128;
        for (int st = 0; st < nsteps; ++st) {
            const u32x2 wa = *(const u32x2*)(wrow + 32 * st + 4 * g), wb = *(const u32x2*)(wrow + 32 * st + 16 + 4 * g);
            u32x4 wf4; wf4.x = wa.x; wf4.y = wa.y; wf4.z = wb.x; wf4.w = wb.y;
            const bf16x8 wf = *reinterpret_cast<const bf16x8*>(&wf4);
            LAS unsigned char* vrow = lds + (32 * st + 4 * g + (l15 >> 2)) * ATT_VSTRIDE + (l15 & 3) * 8;
#pragma unroll
            for (int et = 0; et < 8; ++et) {
                const s16x4 v0 = __builtin_amdgcn_ds_read_tr16_b64_v4i16((LAS s16x4*)(vrow + et * 32));
                const s16x4 v1 = __builtin_amdgcn_ds_read_tr16_b64_v4i16((LAS s16x4*)(vrow + et * 32 + 16 * ATT_VSTRIDE));
                const bf16x8 vf = {v0[0], v0[1], v0[2], v0[3], v1[0], v1[1], v1[2], v1[3]};
                acc[et] = __builtin_amdgcn_mfma_f32_16x16x32_bf16(vf, wf, acc[et], 0, 0, 0); }
        }
        const float bias = p.sgu_b[h * 128 + irow];
        const size_t base = (size_t)(t0 + irow) * DS + h * E + 4 * g;
#pragma unroll
        for (int et = 0; et < 8; ++et) { const u32x2 uu = *(const u32x2*)(usb + base + 16 * et);
            u32x2 oo; oo.x = cvt_pk(bflo(uu.x) * (acc[et][0] + bias), bfhi(uu.x) * (acc[et][1] + bias)); oo.y = cvt_pk(bflo(uu.y) * (acc[et][2] + bias), bfhi(uu.y) * (acc[et][3] + bias));
            *(u32x2*)(ob + base + 16 * et) = oo; }
    }
}

__device__ __forceinline__ void phase_combine(const Params& p) {
    const int lane = threadIdx.x & 63, gw = blockIdx.x * NWV + __builtin_amdgcn_readfirstlane(threadIdx.x >> 6), nw = gridDim.x * NWV;
    const float* lse = (const float*)(p.ws + OFF_LSE);
    const bf16_t* sg = (const bf16_t*)(p.ws + OFF_SGUO);
    const bf16_t* o0 = P_opat(p, 0); const bf16_t* o1 = P_opat(p, 1); const bf16_t* o2 = P_opat(p, 2);
    float ga[24], gs[8];
#pragma unroll
    for (int i = 0; i < 3; ++i) { const int col0 = (lane + 64 * i) * 8; const float4 g0 = *(const float4*)(p.g_attn_out + col0), g1 = *(const float4*)(p.g_attn_out + col0 + 4);
        ga[i * 8 + 0] = g0.x; ga[i * 8 + 1] = g0.y; ga[i * 8 + 2] = g0.z; ga[i * 8 + 3] = g0.w; ga[i * 8 + 4] = g1.x; ga[i * 8 + 5] = g1.y; ga[i * 8 + 6] = g1.z; ga[i * 8 + 7] = g1.w; }
    { const float4 g0 = *(const float4*)(p.g_sgu_out + lane * 8), g1 = *(const float4*)(p.g_sgu_out + lane * 8 + 4);
      gs[0] = g0.x; gs[1] = g0.y; gs[2] = g0.z; gs[3] = g0.w; gs[4] = g1.x; gs[5] = g1.y; gs[6] = g1.z; gs[7] = g1.w; }
    u32x4 xa[3], xb[3], xc[3], xs; float l0 = 0.f, l1 = 0.f, l2 = 0.f;
#define CB_LOAD(tt) do { _Pragma("unroll") for (int i = 0; i < 3; ++i) { const size_t o = (size_t)(tt) * DA + (lane + 64 * i) * 8; xa[i] = *(const u32x4*)(o0 + o); xb[i] = *(const u32x4*)(o1 + o); xc[i] = *(const u32x4*)(o2 + o); } \
        xs = *(const u32x4*)(sg + (size_t)(tt) * DS + lane * 8); \
        if (lane < HA) { l0 = lse[((size_t)0 * T + (tt)) * HA + lane]; l1 = lse[((size_t)1 * T + (tt)) * HA + lane]; l2 = lse[((size_t)2 * T + (tt)) * HA + lane]; } } while (0)
    if (gw < T) CB_LOAD(gw);
    for (int t = gw; t < T; t += nw) {
        float w0 = 0.f, w1 = 0.f, w2 = 0.f;
        if (lane < HA) { const float m = fmaxf(l0, fmaxf(l1, l2)); const float e0 = __expf(l0 - m), e1 = __expf(l1 - m), e2 = __expf(l2 - m); const float is = 1.0f / (e0 + e1 + e2);
            w0 = e0 * is; w1 = e1 * is; w2 = e2 * is; }
        float av[3][8]; float ss = 0.f;
#pragma unroll
        for (int i = 0; i < 3; ++i) { const int hh = ((lane + 64 * i) * 8) >> 7;
            const float a0 = __shfl(w0, hh), a1 = __shfl(w1, hh), a2 = __shfl(w2, hh);
            const u32x4 x0 = xa[i], x1 = xb[i], x2 = xc[i];
            av[i][0] = a0 * bflo(x0.x) + a1 * bflo(x1.x) + a2 * bflo(x2.x); av[i][1] = a0 * bfhi(x0.x) + a1 * bfhi(x1.x) + a2 * bfhi(x2.x);
            av[i][2] = a0 * bflo(x0.y) + a1 * bflo(x1.y) + a2 * bflo(x2.y); av[i][3] = a0 * bfhi(x0.y) + a1 * bfhi(x1.y) + a2 * bfhi(x2.y);
            av[i][4] = a0 * bflo(x0.z) + a1 * bflo(x1.z) + a2 * bflo(x2.z); av[i][5] = a0 * bfhi(x0.z) + a1 * bfhi(x1.z) + a2 * bfhi(x2.z);
            av[i][6] = a0 * bflo(x0.w) + a1 * bflo(x1.w) + a2 * bflo(x2.w); av[i][7] = a0 * bfhi(x0.w) + a1 * bfhi(x1.w) + a2 * bfhi(x2.w);
#pragma unroll
            for (int j = 0; j < 8; ++j) ss += av[i][j] * av[i][j]; }
        float sv[8] = {bflo(xs.x), bfhi(xs.x), bflo(xs.y), bfhi(xs.y), bflo(xs.z), bfhi(xs.z), bflo(xs.w), bfhi(xs.w)}; float s2 = 0.f;
#pragma unroll
        for (int j = 0; j < 8; ++j) s2 += sv[j] * sv[j];
        if (t + nw < T) CB_LOAD(t + nw);
        ss = wave_sum(ss); const float rs = rsqrtf(ss * (1.0f / DA) + 1e-6f);
        s2 = wave_sum(s2); const float r2 = rsqrtf(s2 * (1.0f / DS) + 1e-6f);
        float m = 0.f;
#pragma unroll
        for (int i = 0; i < 3; ++i)
#pragma unroll
            for (int j = 0; j < 8; ++j) { av[i][j] = av[i][j] * rs * ga[i * 8 + j]; m = fmaxf(m, fabsf(av[i][j])); }
#pragma unroll
        for (int j = 0; j < 8; ++j) { sv[j] = sv[j] * r2 * gs[j]; m = fmaxf(m, fabsf(sv[j])); }
        m = wave_max(m); const float sc8 = m > 0.f ? 127.0f / m : 0.f;
        unsigned char* mrow = p.ws + OFF_QKV + (size_t)t * D;
#pragma unroll
        for (int i = 0; i < 3; ++i) { u32x2 w; w.x = q8pack(av[i][0] * sc8, av[i][1] * sc8, av[i][2] * sc8, av[i][3] * sc8, 0); w.y = q8pack(av[i][4] * sc8, av[i][5] * sc8, av[i][6] * sc8, av[i][7] * sc8, 0);
            *(u32x2*)(mrow + (lane + 64 * i) * 8) = w; }
        { u32x2 w; w.x = q8pack(sv[0] * sc8, sv[1] * sc8, sv[2] * sc8, sv[3] * sc8, 0); w.y = q8pack(sv[4] * sc8, sv[5] * sc8, sv[6] * sc8, sv[7] * sc8, 0);
          *(u32x2*)(mrow + DA + lane * 8) = w; }
        if (lane == 0) ((float*)(p.ws + OFF_SCL))[SCL_MS + t] = m * (1.0f / 127.0f);
    }
#undef CB_LOAD
}

__device__ __forceinline__ int f2key(float f) { const int b = __float_as_int(f); return b ^ ((b >> 31) & 0x7fffffff); }
__device__ __forceinline__ float key2f(int k) { return __int_as_float(k ^ ((k >> 31) & 0x7fffffff)); }
typedef int i32x16 __attribute__((ext_vector_type(16)));
typedef float f32x16v __attribute__((ext_vector_type(16)));
#define TK_CE(v, i, l) do { const int _a = v[i], _b = v[l]; v[i] = max(_a, _b); v[l] = min(_a, _b); } while (0)
__device__ __forceinline__ i32x16 sort16_desc(i32x16 v) {
#pragma unroll
    for (int lk = 1; lk <= 4; ++lk)
#pragma unroll
        for (int lj = 3; lj >= 0; --lj) { if (lj >= lk) continue; const int k = 1 << lk, j = 1 << lj;
#pragma unroll
            for (int i = 0; i < 16; ++i) { const int l = i ^ j; if (l > i) { if ((i & k) == 0) TK_CE(v, i, l); else TK_CE(v, l, i); } } }
    return v;
}
__device__ __forceinline__ i32x16 bitonic_merge16_desc(i32x16 v) {
#pragma unroll
    for (int lj = 3; lj >= 0; --lj) { const int j = 1 << lj;
#pragma unroll
        for (int i = 0; i < 16; ++i) { const int l = i ^ j; if (l > i) TK_CE(v, i, l); } }
    return v;
}
__device__ __forceinline__ i32x16 merge_top16(i32x16 a, i32x16 b) {
#pragma unroll
    for (int i = 0; i < 16; ++i) a[i] = max(a[i], b[15 - i]);
    return bitonic_merge16_desc(a);
}
__device__ __forceinline__ i32x16 xlane_merge_top16(i32x16 a, int xr) {
    i32x16 b;
#pragma unroll
    for (int i = 0; i < 16; ++i) b[i] = __shfl_xor(a[i], xr);
    return merge_top16(a, b);
}
__device__ __forceinline__ int sel2i(bool c, int x, int y) { return c ? y : x; }
__device__ __forceinline__ int sel16(i32x16 v, int i) {
    const bool c0 = (i & 1) != 0, c1 = (i & 2) != 0, c2 = (i & 4) != 0, c3 = (i & 8) != 0;
    const int a0 = sel2i(c0, v[0], v[1]), a1 = sel2i(c0, v[2], v[3]), a2 = sel2i(c0, v[4], v[5]), a3 = sel2i(c0, v[6], v[7]);
    const int a4 = sel2i(c0, v[8], v[9]), a5 = sel2i(c0, v[10], v[11]), a6 = sel2i(c0, v[12], v[13]), a7 = sel2i(c0, v[14], v[15]);
    const int b0 = sel2i(c1, a0, a1), b1 = sel2i(c1, a2, a3), b2 = sel2i(c1, a4, a5), b3 = sel2i(c1, a6, a7);
    const int d0 = sel2i(c2, b0, b1), d1 = sel2i(c2, b2, b3);
    return sel2i(c3, d0, d1);
}
__device__ __forceinline__ int sel4i(int g, int a, int b, int c, int d) { return g == 0 ? a : (g == 1 ? b : (g == 2 ? c : d)); }
__device__ __forceinline__ float sel4f(int g, float a, float b, float c, float d) { return g == 0 ? a : (g == 1 ? b : (g == 2 ? c : d)); }
constexpr int TK_TAB[64] = {
    0x00, 0x01, 0x02, 0x03, 0x04, 0x05, 0x06, 0x07, 0x08, 0x09, 0x0A, 0x0B, 0x0C, 0x0D, 0x0E, 0x0F,
    0x10, 0x11, 0x12, 0x13, 0x14, 0x15, 0x16, 0x17, 0x40, 0x41, 0x42, 0x80, 0x90, 0xFF, 0xFF, 0xFF,
    0x20, 0x21, 0x22, 0x23, 0x24, 0x30, 0x31, 0x32, 0x33, 0x50, 0x51, 0xA0, 0xB0, 0xFF, 0xFF, 0xFF,
    0x60, 0x61, 0x70, 0x71, 0xC0, 0xD0, 0xE0, 0xF0, 0xFF, 0xFF, 0xFF, 0xFF, 0xFF, 0xFF, 0xFF, 0xFF};
template <int C> __device__ __forceinline__ int tk_make_cand(i32x16 sp0, i32x16 sp1, int g) {
    constexpr int NONE = (int)0x80000000;
    constexpr int e0 = TK_TAB[C], e1 = TK_TAB[16 + C], e2 = TK_TAB[32 + C], e3 = TK_TAB[48 + C];
    constexpr int r0 = (e0 >> 4) & 15, r1 = e1 == 0xFF ? 0 : (e1 >> 4) & 15, r2 = e2 == 0xFF ? 0 : (e2 >> 4) & 15, r3 = e3 == 0xFF ? 0 : (e3 >> 4) & 15;
    constexpr int c0 = e0 & 15, c1 = e1 == 0xFF ? 0 : e1 & 15, c2 = e2 == 0xFF ? 0 : e2 & 15, c3 = e3 == 0xFF ? 0 : e3 & 15;
    const int av = sel4i(g, sp0[r0], sp0[r1], sp0[r2], sp0[r3]);
    const int bv = sel4i(g, sp1[c0], sp1[c1], sp1[c2], sp1[c3]);
    const int code = sel4i(g, e0, e1, e2, e3);
    const float sum = key2f(av & ~127) + key2f(bv & ~127);
    return code == 0xFF ? NONE : ((f2key(sum) & ~255) | code);
}
__device__ __forceinline__ void phase_topk(const Params& p, unsigned char* lds_) {
    LAS unsigned char* lds = (LAS unsigned char*)lds_;
    const int tid = threadIdx.x, lane = tid & 63, w = __builtin_amdgcn_readfirstlane(tid >> 6), l15 = lane & 15, g = lane >> 4;
    const bf16_t* pq = (const bf16_t*)(p.ws + OFF_QKV + (size_t)T * D * 2); const bf16_t* skb = (const bf16_t*)(p.ws + OFF_SUBK);
    int* idxo = (int*)(p.ws + OFF_IDX); float* gato = (float*)(p.ws + OFF_GATE);
    int cur_h = -1;
    for (int task = blockIdx.x; task < (T / 128) * PH; task += gridDim.x) {
        const int h = task & 7, tt = task >> 3;
        if (h != cur_h) {
            __syncthreads();
#pragma unroll
            for (int i = 0; i < 8; ++i) { const int ch = i * NTHR + tid, row = ch >> 4, c = ch & 15;
                *(LAS u32x4*)(lds + row * 256 + ((c ^ (row & 15)) << 4)) = *(const u32x4*)(skb + ((size_t)h * 256 + row) * 128 + c * 8); }
            __syncthreads();
            cur_h = h;
        }
        const int t = tt * 128 + 16 * w + l15;
        i32x16 sp0, sp1;
#pragma unroll
        for (int pp = 0; pp < 2; ++pp) {
            bf16x8 bq[4];
#pragma unroll
            for (int ks = 0; ks < 4; ++ks) bq[ks] = *(const bf16x8*)(pq + (size_t)t * D + h * 256 + pp * 128 + 32 * ks + 8 * g);
            i32x16 ka, kb2;
#pragma unroll
            for (int kt = 0; kt < 8; ++kt) {
                f32x4 a = {0.f, 0.f, 0.f, 0.f};
                const int row = pp * 128 + 16 * kt + l15;
#pragma unroll
                for (int ks = 0; ks < 4; ++ks) { const bf16x8 kf = *(const LAS bf16x8*)(lds + row * 256 + (((4 * ks + g) ^ (row & 15)) << 4)); a = __builtin_amdgcn_mfma_f32_16x16x32_bf16(kf, bq[ks], a, 0, 0, 0); }
#pragma unroll
                for (int rg = 0; rg < 4; ++rg) { const int key = (f2key(a[rg]) & ~127) | (16 * kt + rg + 4 * g);
                    if (kt < 4) ka[kt * 4 + rg] = key; else kb2[(kt - 4) * 4 + rg] = key; }
            }
            ka = merge_top16(sort16_desc(ka), sort16_desc(kb2));
            ka = xlane_merge_top16(ka, 16); ka = xlane_merge_top16(ka, 32);
            if (pp == 0) sp0 = ka; else sp1 = ka;
        }
        i32x16 cd;
        cd[0] = tk_make_cand<0>(sp0, sp1, g); cd[1] = tk_make_cand<1>(sp0, sp1, g); cd[2] = tk_make_cand<2>(sp0, sp1, g); cd[3] = tk_make_cand<3>(sp0, sp1, g);
        cd[4] = tk_make_cand<4>(sp0, sp1, g); cd[5] = tk_make_cand<5>(sp0, sp1, g); cd[6] = tk_make_cand<6>(sp0, sp1, g); cd[7] = tk_make_cand<7>(sp0, sp1, g);
        cd[8] = tk_make_cand<8>(sp0, sp1, g); cd[9] = tk_make_cand<9>(sp0, sp1, g); cd[10] = tk_make_cand<10>(sp0, sp1, g); cd[11] = tk_make_cand<11>(sp0, sp1, g);
        cd[12] = tk_make_cand<12>(sp0, sp1, g); cd[13] = tk_make_cand<13>(sp0, sp1, g); cd[14] = tk_make_cand<14>(sp0, sp1, g); cd[15] = tk_make_cand<15>(sp0, sp1, g);
        cd = sort16_desc(cd); cd = xlane_merge_top16(cd, 16); cd = xlane_merge_top16(cd, 32);
        f32x16v ex; float sum = 0.f; const float m0 = key2f(cd[0] & ~255);
#pragma unroll
        for (int i = 0; i < 16; ++i) { ex[i] = __expf(key2f(cd[i] & ~255) - m0); sum += ex[i]; }
        const float is = 1.0f / sum;
        int oi[4]; float og[4];
#pragma unroll
        for (int c = 0; c < 4; ++c) {
            const int key = sel4i(g, cd[c], cd[4 + c], cd[8 + c], cd[12 + c]);
            const float e = sel4f(g, ex[c], ex[4 + c], ex[8 + c], ex[12 + c]);
            const int i1 = sel16(sp0, (key >> 4) & 15) & 127, i2 = sel16(sp1, key & 15) & 127;
            oi[c] = i1 * 128 + i2; og[c] = e * is; }
        *(int4*)(idxo + (size_t)t * 128 + h * PK + 4 * g) = make_int4(oi[0], oi[1], oi[2], oi[3]);
        *(float4*)(gato + (size_t)t * 128 + h * PK + 4 * g) = make_float4(og[0], og[1], og[2], og[3]);
    }
}

typedef float f32x2v __attribute__((ext_vector_type(2)));
typedef float f32x8v __attribute__((ext_vector_type(8)));
__device__ __forceinline__ int dot16_i8(const u32x4 w, const u32x4 x) {
    int s = __builtin_amdgcn_sdot4((int)w.x, (int)x.x, 0, false); s = __builtin_amdgcn_sdot4((int)w.y, (int)x.y, s, false);
    s = __builtin_amdgcn_sdot4((int)w.z, (int)x.z, s, false); return __builtin_amdgcn_sdot4((int)w.w, (int)x.w, s, false);
}
__device__ __forceinline__ void axpy16_u8(const u32x4 w, float cw, float* acc) {
    float f[16];
#pragma unroll
    for (int q = 0; q < 4; ++q) { const unsigned ww = w[q];
        f[4 * q + 0] = __uint_as_float(__builtin_amdgcn_perm(0x47000000u, ww, 0x07060004u)); f[4 * q + 1] = __uint_as_float(__builtin_amdgcn_perm(0x47000000u, ww, 0x07060104u));
        f[4 * q + 2] = __uint_as_float(__builtin_amdgcn_perm(0x47000000u, ww, 0x07060204u)); f[4 * q + 3] = __uint_as_float(__builtin_amdgcn_perm(0x47000000u, ww, 0x07060304u)); }
    __builtin_amdgcn_sched_barrier(0);
#pragma unroll
    for (int j = 0; j < 16; ++j) acc[j] = fmaf(cw, f[j], acc[j]);
    __builtin_amdgcn_sched_barrier(0);
}
typedef _Float16 h2v __attribute__((ext_vector_type(2)));
__device__ __forceinline__ void axpy16x2_u8(const u32x4 wa, const u32x4 wb, h2v cwp, float* acc) {
#pragma unroll
    for (int q = 0; q < 4; ++q) { const unsigned ua = wa[q], ub = wb[q];
        unsigned p0 = __builtin_amdgcn_perm(ub, ua, 0x0C040C00u), p1 = __builtin_amdgcn_perm(ub, ua, 0x0C050C01u), p2 = __builtin_amdgcn_perm(ub, ua, 0x0C060C02u), p3 = __builtin_amdgcn_perm(ub, ua, 0x0C070C03u);
        acc[4 * q + 0] = __builtin_amdgcn_fdot2(*reinterpret_cast<h2v*>(&p0), cwp, acc[4 * q + 0], false); acc[4 * q + 1] = __builtin_amdgcn_fdot2(*reinterpret_cast<h2v*>(&p1), cwp, acc[4 * q + 1], false);
        acc[4 * q + 2] = __builtin_amdgcn_fdot2(*reinterpret_cast<h2v*>(&p2), cwp, acc[4 * q + 2], false); acc[4 * q + 3] = __builtin_amdgcn_fdot2(*reinterpret_cast<h2v*>(&p3), cwp, acc[4 * q + 3], false); }
}
typedef int i32x8v __attribute__((ext_vector_type(8)));
typedef int i32x4v __attribute__((ext_vector_type(4)));
typedef int i32x2v __attribute__((ext_vector_type(2)));
__device__ __forceinline__ int red8_piece(i32x8v r, int lane) {
    const bool b2 = (lane & 4) != 0, b1 = (lane & 2) != 0, b0 = (lane & 1) != 0;
    i32x4v q; i32x2v pp;
#pragma unroll
    for (int k = 0; k < 4; ++k) { const int lo = r[k], hi = r[k + 4]; const int kp = b2 ? hi : lo, sn = b2 ? lo : hi; q[k] = kp + __shfl_xor(sn, 4); }
#pragma unroll
    for (int k = 0; k < 2; ++k) { const int lo = q[k], hi = q[k + 2]; const int kp = b1 ? hi : lo, sn = b1 ? lo : hi; pp[k] = kp + __shfl_xor(sn, 2); }
    const int lo = pp[0], hi = pp[1]; const int kp = b0 ? hi : lo, sn = b0 ? lo : hi;
    return kp + __shfl_xor(sn, 1);
}
constexpr int PEER_CHUNK = 16;
template <int WHICH, int MODE = 0> __device__ __forceinline__ void peer_chunk(const Params& p, int t0, int s, int lane) {
    const int sub = lane >> 3, piece = lane & 7;
    const int* idx = (const int*)(p.ws + OFF_IDX) + sub * 16;
    const unsigned char* tab = p.ws + (WHICH == 0 ? OFF_UTAB : OFF_VTAB) + (size_t)s * SLICE_BYTES;
    const unsigned pof = (unsigned)piece * 16u;
    const unsigned char* xbase = p.ws + OFF_US + s * 128 + piece * 16;
    const unsigned* wbase = (const unsigned*)(p.ws + OFF_GATE) + sub * 8;
    int4 ec[4], en[4];
    u32x4 wA[8], wB[8];
    u32x4 xr; u32x4 cwv[2]; float cws = 0.f;
#define PEER_RD(ev) (*(const u32x4*)(tab + (((unsigned)(ev) << 7) + pof)))
#define PEER_LD8(dst, ev0, ev1) do { if (MODE == 2) { dst[0] = (u32x4){(unsigned)ev0.x, (unsigned)ev0.y, 0x38383838u, 0x30303030u}; dst[1] = dst[0]; dst[2] = dst[0]; dst[3] = dst[0]; dst[4] = (u32x4){(unsigned)ev1.x, (unsigned)ev1.y, 0x38383838u, 0x30303030u}; dst[5] = dst[4]; dst[6] = dst[4]; dst[7] = dst[4]; break; } \
        dst[0] = PEER_RD(ev0.x); dst[1] = PEER_RD(ev0.y); dst[2] = PEER_RD(ev0.z); dst[3] = PEER_RD(ev0.w); dst[4] = PEER_RD(ev1.x); dst[5] = PEER_RD(ev1.y); dst[6] = PEER_RD(ev1.z); dst[7] = PEER_RD(ev1.w); } while (0)
#pragma unroll
    for (int q = 0; q < 4; ++q) ec[q] = *(const int4*)(idx + (size_t)t0 * 128 + 4 * q);
    PEER_LD8(wA, ec[0], ec[1]);
    if (WHICH == 0) { xr = *(const u32x4*)(xbase + (size_t)t0 * D); }
    else {
#pragma unroll
        for (int q = 0; q < 2; ++q) cwv[q] = *(const u32x4*)(wbase + (size_t)t0 * 128 + 4 * q);
        cws = __uint_as_float(wbase[(size_t)t0 * 128 + 64 - sub * 7]); }
#pragma unroll
    for (int q = 0; q < 4; ++q) en[q] = *(const int4*)(idx + (size_t)(t0 + 1) * 128 + 4 * q);
#pragma unroll 1
    for (int k = 0; k < PEER_CHUNK; ++k) {
        const int t = t0 + k;
        PEER_LD8(wB, ec[2], ec[3]);
        if (WHICH == 0) {
            const u32x4 xc = xr;
            i32x8v r0, r1;
#pragma unroll
            for (int i = 0; i < 8; ++i) r0[i] = MODE == 1 ? (int)(wA[i].x ^ wA[i].y ^ wA[i].z ^ wA[i].w ^ xc.x) : dot16_i8(wA[i], xc);
            if (k < PEER_CHUNK - 1) { PEER_LD8(wA, en[0], en[1]); xr = *(const u32x4*)(xbase + (size_t)(t + 1) * D); }
#pragma unroll
            for (int i = 0; i < 8; ++i) r1[i] = MODE == 1 ? (int)(wB[i].x ^ wB[i].y ^ wB[i].z ^ wB[i].w ^ xc.y) : dot16_i8(wB[i], xc);
            const int v0 = red8_piece(r0, lane), v1 = red8_piece(r1, lane);
            bf16_t* part = (bf16_t*)(p.ws + OFF_QKV) + ((size_t)s * T + t) * 128 + sub * 16 + piece;
            part[0] = f2bf((float)v0); part[8] = f2bf((float)v1);
        } else {
            float acc[16];
#pragma unroll
            for (int j = 0; j < 16; ++j) acc[j] = 0.f;
            const u32x4 c0 = cwv[0], c1 = cwv[1]; const float cwsum = cws;
            h2v cp[8];
            { unsigned u0 = c0.x, u1 = c0.y, u2 = c0.z, u3 = c0.w, u4 = c1.x, u5 = c1.y, u6 = c1.z, u7 = c1.w;
              cp[0] = *reinterpret_cast<h2v*>(&u0); cp[1] = *reinterpret_cast<h2v*>(&u1); cp[2] = *reinterpret_cast<h2v*>(&u2); cp[3] = *reinterpret_cast<h2v*>(&u3);
              cp[4] = *reinterpret_cast<h2v*>(&u4); cp[5] = *reinterpret_cast<h2v*>(&u5); cp[6] = *reinterpret_cast<h2v*>(&u6); cp[7] = *reinterpret_cast<h2v*>(&u7); }
            axpy16x2_u8(wA[0], wA[1], cp[0], acc); axpy16x2_u8(wA[2], wA[3], cp[1], acc); axpy16x2_u8(wA[4], wA[5], cp[2], acc); axpy16x2_u8(wA[6], wA[7], cp[3], acc);
            if (k < PEER_CHUNK - 1) { PEER_LD8(wA, en[0], en[1]);
#pragma unroll
                for (int q = 0; q < 2; ++q) cwv[q] = *(const u32x4*)(wbase + (size_t)(t + 1) * 128 + 4 * q);
                cws = __uint_as_float(wbase[(size_t)(t + 1) * 128 + 64 - sub * 7]); }
            axpy16x2_u8(wB[0], wB[1], cp[4], acc); axpy16x2_u8(wB[2], wB[3], cp[5], acc); axpy16x2_u8(wB[4], wB[5], cp[6], acc); axpy16x2_u8(wB[6], wB[7], cp[7], acc);
            f32x16v a16;
#pragma unroll
            for (int j = 0; j < 16; ++j) a16[j] = fmaf(acc[j], 65536.0f, -0.5f * cwsum);
            const bool b3 = (lane & 8) != 0;
            f32x8v q8; f32x4 q4; f32x2v q2;
#pragma unroll
            for (int j = 0; j < 8; ++j) { const auto sw = __builtin_amdgcn_permlane32_swap(__float_as_uint(a16[j]), __float_as_uint(a16[j + 8]), false, false); q8[j] = __uint_as_float(sw[0]) + __uint_as_float(sw[1]); }
#pragma unroll
            for (int j = 0; j < 4; ++j) { const auto sw = __builtin_amdgcn_permlane16_swap(__float_as_uint(q8[j]), __float_as_uint(q8[j + 4]), false, false); q4[j] = __uint_as_float(sw[0]) + __uint_as_float(sw[1]); }
#pragma unroll
            for (int j = 0; j < 2; ++j) { const float lo = q4[j], hi = q4[j + 2]; const float kp = b3 ? hi : lo, sn = b3 ? lo : hi; q2[j] = kp + __shfl_xor(sn, 8); }
            bf16_t* po = (bf16_t*)(p.ws + OFF_A) + (size_t)t * D + s * 128 + piece * 16 + 2 * sub;
            *(unsigned*)po = cvt_pk(q2[0], q2[1]);
        }
#pragma unroll
        for (int q = 0; q < 4; ++q) ec[q] = en[q];
        if (k < PEER_CHUNK - 2) {
#pragma unroll
            for (int q = 0; q < 4; ++q) en[q] = *(const int4*)(idx + (size_t)(t + 2) * 128 + 4 * q); }
    }
#undef PEER_LD8
#undef PEER_RD
}
template <int WHICH, int MODE = 0, int QSET = WHICH> __device__ __forceinline__ void phase_peer_sliced(const Params& p, unsigned xcc) {
    unsigned* qh = (unsigned*)(p.ws + OFF_CTL + OFF_QUEUE) + QSET * 16 * 64;
    const int lane = threadIdx.x & 63;
    for (int rnd = 0; rnd < 16; ++rnd) {
        const int s = (int)((xcc + 8u * (unsigned)(rnd & 1) + (unsigned)(rnd >> 1)) & 15u);
        unsigned c = 0; if (lane == 0) c = atomicAdd(qh + s * 64, 1u);
        c = __builtin_amdgcn_readfirstlane(c);
        while (c < (unsigned)(T / PEER_CHUNK)) {
            unsigned cn = 0; if (lane == 0) cn = atomicAdd(qh + s * 64, 1u);
            peer_chunk<WHICH, MODE>(p, (int)c * PEER_CHUNK, s, lane);
            c = __builtin_amdgcn_readfirstlane(cn);
        }
    }
}
__device__ __forceinline__ void phase_peer_w(const Params& p) {
    const int lane = threadIdx.x & 63, gw = blockIdx.x * NWV + __builtin_amdgcn_readfirstlane(threadIdx.x >> 6), nw = gridDim.x * NWV;
    const bf16_t* part = (const bf16_t*)(p.ws + OFF_QKV); const int* idx = (const int*)(p.ws + OFF_IDX); float* gate = (float*)(p.ws + OFF_GATE);
    const float* uinv = (const float*)(p.ws + OFF_UTAB + TAB8_BYTES); const float* vinv = (const float*)(p.ws + OFF_VTAB + TAB8_BYTES); const float* xs = (const float*)(p.ws + OFF_SGUO);
    unsigned pv[16]; int2 e = make_int2(0, 0); float2 g = make_float2(0.f, 0.f); float xsc = 0.f, ui0 = 0.f, ui1 = 0.f, vi0 = 0.f, vi1 = 0.f;
#define PW_LOAD(tt) do { _Pragma("unroll") for (int s = 0; s < 16; ++s) pv[s] = *(const unsigned*)(part + ((size_t)s * T + (tt)) * 128 + 2 * lane); \
        e = *(const int2*)(idx + (size_t)(tt) * 128 + 2 * lane); g = *(const float2*)(gate + (size_t)(tt) * 128 + 2 * lane); xsc = xs[(tt)]; \
        ui0 = uinv[e.x]; ui1 = uinv[e.y]; vi0 = vinv[e.x]; vi1 = vinv[e.y]; } while (0)
    if (gw < T) PW_LOAD(gw);
    for (int t = gw; t < T; t += nw) {
        float a0 = 0.f, a1 = 0.f;
#pragma unroll
        for (int s = 0; s < 16; ++s) { a0 += bflo(pv[s]); a1 += bfhi(pv[s]); }
        const float w0 = g.x * gelu_erf(a0 * (xsc * ui0)) * vi0, w1 = g.y * gelu_erf(a1 * (xsc * ui1)) * vi1;
        if (t + nw < T) PW_LOAD(t + nw);
        h2v hp; hp.x = (_Float16)(w0 * 256.f); hp.y = (_Float16)(w1 * 256.f);
        float sm = (float)hp.x + (float)hp.y;
        sm += __shfl_xor(sm, 1); sm += __shfl_xor(sm, 2); sm += __shfl_xor(sm, 4);
        ((unsigned*)gate)[(size_t)t * 128 + lane] = *reinterpret_cast<unsigned*>(&hp);
        if ((lane & 7) == 0) gate[(size_t)t * 128 + 64 + (lane >> 3)] = sm;
    }
#undef PW_LOAD
}
__device__ __forceinline__ void phase_peer_final(const Params& p) {
    const int lane = threadIdx.x & 63, gw = blockIdx.x * NWV + __builtin_amdgcn_readfirstlane(threadIdx.x >> 6), nw = gridDim.x * NWV;
    const bf16_t* peer = (const bf16_t*)(p.ws + OFF_A); const bf16_t* hb = (const bf16_t*)(p.ws + OFF_O12);
    const int wpb = nw >> 2, b = gw / wpb, r0 = gw - b * wpb;
    if (b >= NB) return;
    float gt[32], gf[32];
#pragma unroll
    for (int i = 0; i < 4; ++i) { const int col = i * 512 + lane * 8; const float4 g0 = mod4(p, b, 5, col), g1 = mod4(p, b, 5, col + 4), f0 = *(const float4*)(p.g_final + col), f1 = *(const float4*)(p.g_final + col + 4);
        gt[i * 8 + 0] = g0.x; gt[i * 8 + 1] = g0.y; gt[i * 8 + 2] = g0.z; gt[i * 8 + 3] = g0.w; gt[i * 8 + 4] = g1.x; gt[i * 8 + 5] = g1.y; gt[i * 8 + 6] = g1.z; gt[i * 8 + 7] = g1.w;
        gf[i * 8 + 0] = f0.x; gf[i * 8 + 1] = f0.y; gf[i * 8 + 2] = f0.z; gf[i * 8 + 3] = f0.w; gf[i * 8 + 4] = f1.x; gf[i * 8 + 5] = f1.y; gf[i * 8 + 6] = f1.z; gf[i * 8 + 7] = f1.w; }
    u32x4 pw[4], hw[4]; float4 xa[4], xb[4];
#define PF_LOAD(tt) do { _Pragma("unroll") for (int i = 0; i < 4; ++i) { pw[i] = *(const u32x4*)(peer + (size_t)(tt) * D + i * 512 + lane * 8); hw[i] = *(const u32x4*)(hb + (size_t)(tt) * D + i * 512 + lane * 8); \
        { const u32x4 _x = *(const u32x4*)((const bf16_t*)(p.ws + OFF_XB) + (size_t)(tt) * D + i * 512 + lane * 8); xa[i] = make_float4(bflo(_x.x), bfhi(_x.x), bflo(_x.y), bfhi(_x.y)); xb[i] = make_float4(bflo(_x.z), bfhi(_x.z), bflo(_x.w), bfhi(_x.w)); } } } while (0)
    if (r0 < S) PF_LOAD(b * S + r0);
    for (int r = r0; r < S; r += wpb) {
        const int t = b * S + r; float* orow = p.out + (size_t)t * D; float v[32]; float ss = 0.f;
#pragma unroll
        for (int i = 0; i < 4; ++i) {
            v[i * 8 + 0] = xa[i].x + bflo(hw[i].x) + gt[i * 8 + 0] * bflo(pw[i].x); v[i * 8 + 1] = xa[i].y + bfhi(hw[i].x) + gt[i * 8 + 1] * bfhi(pw[i].x); v[i * 8 + 2] = xa[i].z + bflo(hw[i].y) + gt[i * 8 + 2] * bflo(pw[i].y); v[i * 8 + 3] = xa[i].w + bfhi(hw[i].y) + gt[i * 8 + 3] * bfhi(pw[i].y);
            v[i * 8 + 4] = xb[i].x + bflo(hw[i].z) + gt[i * 8 + 4] * bflo(pw[i].z); v[i * 8 + 5] = xb[i].y + bfhi(hw[i].z) + gt[i * 8 + 5] * bfhi(pw[i].z); v[i * 8 + 6] = xb[i].z + bflo(hw[i].w) + gt[i * 8 + 6] * bflo(pw[i].w); v[i * 8 + 7] = xb[i].w + bfhi(hw[i].w) + gt[i * 8 + 7] * bfhi(pw[i].w);
#pragma unroll
            for (int j = 0; j < 8; ++j) ss += v[i * 8 + j] * v[i * 8 + j]; }
        if (r + wpb < S) PF_LOAD(t + wpb);
        ss = wave_sum(ss); const float rs = rsqrtf(ss * (1.0f / D) + 1e-6f);
#pragma unroll
        for (int i = 0; i < 4; ++i) { const int col = i * 512 + lane * 8;
            *(float4*)(orow + col) = make_float4(v[i * 8 + 0] * rs * gf[i * 8 + 0], v[i * 8 + 1] * rs * gf[i * 8 + 1], v[i * 8 + 2] * rs * gf[i * 8 + 2], v[i * 8 + 3] * rs * gf[i * 8 + 3]);
            *(float4*)(orow + col + 4) = make_float4(v[i * 8 + 4] * rs * gf[i * 8 + 4], v[i * 8 + 5] * rs * gf[i * 8 + 5], v[i * 8 + 6] * rs * gf[i * 8 + 6], v[i * 8 + 7] * rs * gf[i * 8 + 7]); }
    }
#undef PF_LOAD
}

constexpr int LDS_BYTES = 147456;

#define XB_TMO      128
#define XB_XCNT(j)  (256  + 64 * (j))
#define XB_XSUB(j)  (1280 + 64 * (j))
#define XB_XGEN(j)  (2304 + 64 * (j))
#define XB_TOP      3328
#define XB_TOPGEN   3392
#define XCD_BAR_WORDS 3456
#define XB_SPIN_CAP (1u << 18)

__device__ __forceinline__ unsigned xb_ld(unsigned* p)              { return __hip_atomic_load(p, __ATOMIC_RELAXED, __HIP_MEMORY_SCOPE_AGENT); }
__device__ __forceinline__ unsigned xb_add(unsigned* p, unsigned v) { return __hip_atomic_fetch_add(p, v, __ATOMIC_RELAXED, __HIP_MEMORY_SCOPE_AGENT); }
__device__ __forceinline__ unsigned xb_xcc_id() { return (unsigned)__builtin_amdgcn_s_getreg((3 << 11) | 20) & 0xFu; }
#define XB_SPIN(cond, bar) do { unsigned _sp = 0; while (cond) { __builtin_amdgcn_s_sleep(1); \
    if ((++_sp & 255u) == 0u) { if (xb_ld(&(bar)[XB_TMO])) break; if (_sp > XB_SPIN_CAP) { atomicAdd(&(bar)[XB_TMO], 1u); break; } } } } while (0)

struct XcdBarrier {
    unsigned* bar; unsigned x;
    volatile LAS unsigned* st;
};

__device__ __forceinline__ XcdBarrier xcd_barrier_post(unsigned* bar, volatile LAS unsigned* st) {
    XcdBarrier b; b.bar = bar; b.x = xb_xcc_id(); b.st = st;
    if (threadIdx.x == 0) (void)xb_add(&bar[XB_XCNT(b.x)], 1u);
    return b;
}
__device__ __forceinline__ void xcd_barrier_complete(unsigned* bar, unsigned x, unsigned& nloc, unsigned& nx) {
    const unsigned G = gridDim.x * gridDim.y * gridDim.z;
    unsigned sum, cnt, mine, sp = 0u;
    for (;;) {
        sum = 0u; cnt = 0u; mine = 0u;
#pragma unroll
        for (unsigned j = 0; j < 16; ++j) { const unsigned c = xb_ld(&bar[XB_XCNT(j)]); sum += c; cnt += (c > 0u) ? 1u : 0u; mine = (j == x) ? c : mine; }
        if (sum == G) break;
        __builtin_amdgcn_s_sleep(1);
        if ((++sp & 255u) == 0u) { if (xb_ld(&bar[XB_TMO])) break; if (sp > XB_SPIN_CAP) { atomicAdd(&bar[XB_TMO], 1u); break; } }
    }
    nloc = mine > 0u ? mine : 1u; nx = cnt > 0u ? cnt : 1u;
}

__device__ __forceinline__ void xcd_barrier(const XcdBarrier& b) {
    asm volatile("s_waitcnt vmcnt(0)" ::: "memory");
    __syncthreads();
    if (threadIdx.x == 0) {
        unsigned* bar = b.bar;
        __builtin_amdgcn_s_waitcnt(0);
        unsigned nloc = b.st[0], nx = b.st[1];
        if (nloc == 0u) { xcd_barrier_complete(bar, b.x, nloc, nx); b.st[0] = nloc; b.st[1] = nx; }
        const unsigned old = xb_add(&bar[XB_XSUB(b.x)], 1u);
        const unsigned gen = old / nloc;
        if (old + 1u == (gen + 1u) * nloc) {
            __builtin_amdgcn_fence(__ATOMIC_RELEASE, "agent");
            asm volatile("s_waitcnt vmcnt(0)" ::: "memory");
            const unsigned og = xb_add(&bar[XB_TOP], 1u);
            const unsigned tg = og / nx;
            if (og + 1u == (tg + 1u) * nx) xb_add(&bar[XB_TOPGEN], 1u);
            else XB_SPIN(xb_ld(&bar[XB_TOPGEN]) == tg, bar);
            __builtin_amdgcn_fence(__ATOMIC_ACQUIRE, "agent");
            xb_add(&bar[XB_XGEN(b.x)], 1u);
            asm volatile("s_waitcnt vmcnt(0)" ::: "memory");
        } else {
            XB_SPIN(xb_ld(&bar[XB_XGEN(b.x)]) == gen, bar);
            __builtin_amdgcn_fence(__ATOMIC_ACQUIRE, "agent");
            asm volatile("s_waitcnt vmcnt(0)" ::: "memory");
        }
    }
    __syncthreads();
}

#ifndef PHASE_MASK
#define PHASE_MASK 0x3FF
#endif
#ifndef PROBE_DUP
#define PROBE_DUP 0
#endif
#ifndef TS_SEL
#define TS_SEL -1
#endif
#define TSTAMP(k) do { if (TS_SEL >= 0) { const unsigned long long _t = __builtin_amdgcn_s_memrealtime(); if (TS_SEL + 1 == (k)) { const unsigned long long _d = _t - ts_a; while (__builtin_amdgcn_s_memrealtime() - _t < _d) __builtin_amdgcn_s_sleep(8); } ts_a = __builtin_amdgcn_s_memrealtime(); } } while (0)
#define GBAR() xcd_barrier(xbar)
#define RUNPH(bit, call, dupcall) do { if (PHASE_MASK & (bit)) { if (PROBE_DUP & (bit)) { dupcall; GBAR(); } call; GBAR(); } } while (0)
__global__ void __launch_bounds__(NTHR, 2) k_mega(Params p) {
    extern __shared__ __attribute__((aligned(16))) unsigned char lds[];
    cg::grid_group grid = cg::this_grid();
    volatile LAS unsigned* xst = (volatile LAS unsigned*)((LAS unsigned char*)lds + LDS_BYTES);
    if (threadIdx.x < 4) xst[threadIdx.x] = 0u;
    __syncthreads();
    XcdBarrier xbar = xcd_barrier_post((unsigned*)(p.ws + OFF_CTL), xst);
    unsigned long long ts_a = 0; TSTAMP(0);
    if (p.ws == nullptr) grid.sync();
    if (PHASE_MASK & 1) { if (PROBE_DUP & 1) { phase_conv(p, lds, true); GBAR(); } phase_conv(p, lds); GBAR(); }
    TSTAMP(1);
    RUNPH(2, (phase_norm_mod<true, false, false, 1>(p, p.x, p.g_norm1, 0, 1, nullptr, p.ws + OFF_A, (float*)(p.ws + OFF_SCL) + SCL_HS), phase_quant_weights(p, lds)), (phase_norm_mod<true, false, false>(p, p.x, p.g_norm1, 0, 1, nullptr, p.ws + OFF_A, (float*)(p.ws + OFF_SCL) + SCL_HS)));
    TSTAMP(2);
    RUNPH(4, phase_gemm1(p, lds), phase_gemm1(p, lds));
    TSTAMP(3);
    if (PROBE_DUP & 1024) { phase_sgu(p, lds); GBAR(); }
    RUNPH(8, (phase_attn(p, lds), phase_sgu(p, lds)), phase_attn(p, lds));
    TSTAMP(4);
    RUNPH(16, phase_combine(p), phase_combine(p));
    TSTAMP(5);
    RUNPH(32, phase_gemm2(p, lds), phase_gemm2(p, lds));
    TSTAMP(6);
    RUNPH(64, (phase_norm_mod<true, true, false, 2>(p, p.ws + OFF_O12, p.g_norm2, 3, 4, nullptr, p.ws + OFF_US, (float*)(p.ws + OFF_SGUO))), (phase_norm_mod<true, true, false>(p, p.ws + OFF_O12, p.g_norm2, 3, 4, nullptr, p.ws + OFF_US, (float*)(p.ws + OFF_SGUO))));
    TSTAMP(7);
    RUNPH(128, phase_gemm3(p, lds), phase_gemm3(p, lds));
    TSTAMP(8);
    RUNPH(256, phase_topk(p, lds), phase_topk(p, lds));
    TSTAMP(9);
    if (PHASE_MASK & 512) {
        if (PROBE_DUP == 2048) { phase_peer_sliced<0, 0, 2>(p, xbar.x); GBAR(); }
        if (PROBE_DUP == 4096) { phase_peer_sliced<0, 1, 2>(p, xbar.x); GBAR(); }
        if (PROBE_DUP == 8192) { phase_peer_sliced<0, 2, 2>(p, xbar.x); GBAR(); }
        phase_peer_sliced<0>(p, xbar.x); GBAR();
        TSTAMP(10);
        phase_peer_w(p); GBAR();
        TSTAMP(11);
        if (PROBE_DUP == 16384) { phase_peer_sliced<1, 0, 3>(p, xbar.x); GBAR(); }
        phase_peer_sliced<1>(p, xbar.x); GBAR();
        TSTAMP(12);
        phase_peer_final(p);
        TSTAMP(13);
    }
}

#ifndef MEGA
#define MEGA 1
#endif
extern "C" void kernel_launch(void* const* d_in, const int* in_sizes, int n_in, void* d_out, int out_size, void* d_ws, size_t ws_size, hipStream_t stream) {
    if (n_in != 20 || out_size != T * D || ws_size < WS_END) { fprintf(stderr, "kernel_launch: unexpected problem (n_in %d out %d ws %zu, need %zu)\n", n_in, out_size, ws_size, (size_t)WS_END); return; }
    Params p{};
    p.x = (const float*)d_in[0]; p.c = (const float*)d_in[1]; p.pos = (const int*)d_in[2]; p.w_ada = (const float*)d_in[3]; p.b_ada = (const float*)d_in[4];
    p.g_norm1 = (const float*)d_in[5]; p.w_in = (const float*)d_in[6]; p.g_attn_out = (const float*)d_in[7]; p.g_sgu_out = (const float*)d_in[8];
    p.sgu_w = (const float*)d_in[9]; p.sgu_b = (const float*)d_in[10]; p.sgu_ln_g = (const float*)d_in[11]; p.sgu_ln_b = (const float*)d_in[12];
    p.w_out = (const float*)d_in[13]; p.g_norm2 = (const float*)d_in[14]; p.peer_w_q = (const float*)d_in[15]; p.peer_sub_keys = (const float*)d_in[16];
    p.peer_u = (const float*)d_in[17]; p.peer_v = (const float*)d_in[18]; p.g_final = (const float*)d_in[19];
    p.out = (float*)d_out; p.ws = (unsigned char*)d_ws;
    (void)hipMemsetAsync((char*)d_ws + OFF_CTL, 0, OFF_SCL - OFF_CTL, stream);
#if MEGA
    static int grid_blocks = 0;
    if (!grid_blocks) {
        int dev = 0, cus = 0, per_cu = 0;
        (void)hipGetDevice(&dev); (void)hipDeviceGetAttribute(&cus, hipDeviceAttributeMultiprocessorCount, dev);
        (void)hipFuncSetAttribute((const void*)k_mega, hipFuncAttributeMaxDynamicSharedMemorySize, LDS_BYTES + 16);
        (void)hipOccupancyMaxActiveBlocksPerMultiprocessor(&per_cu, (const void*)k_mega, NTHR, LDS_BYTES + 16);
        if (per_cu < 1) { fprintf(stderr, "kernel_launch: occupancy query says %d blocks per CU\n", per_cu); per_cu = 1; }
        if (per_cu > 1) per_cu = 1;
        grid_blocks = cus * per_cu;
    }
    void* args[] = {(void*)&p};
    hipError_t e = hipLaunchCooperativeKernel((const void*)k_mega, dim3(grid_blocks), dim3(NTHR), args, LDS_BYTES + 16, stream);
    if (e != hipSuccess) fprintf(stderr, "cooperative launch failed: %s (grid %d)\n", hipGetErrorString(e), grid_blocks);
#endif
}
```
